# Optimizing an MI355X kernel written in HIP

```python
import math
import jax, jax.numpy as jnp
from jax import lax
import numpy as np

D_MODEL = 1024
BATCH = 8
SEQ = 2048
DEPTH = 2

CHUNK = 64
Q_BLOCK = 128
EPS = 1e-6

ML_HEADS = 4
ML_QK_DIM = 64
ML_V_DIM = 128
ML_CONV = 4
DSA_HEADS = 4
DSA_HEAD_DIM = 128
DSA_LATENT = 128
IDX_HEADS = 4
IDX_DIM = 64
DSA_TOPK = 256
FOX_HEADS = 4
FOX_HEAD_DIM = 128
N_BRANCH = 3
BRANCH_WIDTH = 512
N_EXPERTS = 32
TOP_K = 4
D_EXPERT = D_MODEL
SWIGLU_LIMIT = 7.0
SWIGLU_ALPHA = 1.702
MOE_BLOCK = 128

SPLITS = (
    ML_HEADS * ML_QK_DIM,
    ML_HEADS * ML_QK_DIM,
    ML_HEADS * ML_V_DIM,
    ML_HEADS * ML_V_DIM,
    ML_HEADS,
    ML_HEADS,
    DSA_HEADS * DSA_HEAD_DIM,
    DSA_LATENT,
    IDX_HEADS * IDX_DIM,
    IDX_DIM,
    IDX_HEADS,
    3 * FOX_HEADS * FOX_HEAD_DIM,
    FOX_HEADS,
    N_BRANCH * D_MODEL,
)
D_IN = sum(SPLITS)

kernel_name = 'streaming_hybrid_mlstm_dsa_fox_moe'


def rms(x):
    x32 = x.astype(jnp.float32)
    return (x32 * lax.rsqrt(jnp.mean(x32 * x32, axis=-1, keepdims=True) + EPS)).astype(x.dtype)


def causal_dwconv(x, w, b):
    k = w.shape[0]
    y = lax.conv_general_dilated(x, w[:, None, :], window_strides=(1,), padding=[(k - 1, 0)],
                                 dimension_numbers=('NWC', 'WIO', 'NWC'),
                                 feature_group_count=x.shape[-1])
    return y + b


def mlstm_chunkwise(q, k, v, i_pre, f_pre):
    B, S, H, dk = q.shape
    dv = v.shape[-1]
    L = CHUNK
    NC = S // L

    def chunks(a):
        a = a.astype(jnp.float32).reshape((B, NC, L, H) + a.shape[3:])
        return jnp.moveaxis(a, 3, 1)

    qc = chunks(q) * dk ** -0.5
    kc = chunks(k)
    vc = chunks(v)
    ig = chunks(i_pre)
    b = jnp.cumsum(jax.nn.log_sigmoid(chunks(f_pre)), axis=-1)
    b_last = b[..., -1]
    causal = jnp.tril(jnp.ones((L, L), dtype=bool))
    d_log = jnp.where(causal, b[..., :, None] - b[..., None, :] + ig[..., None, :], -jnp.inf)
    w_state = b_last[..., None] - b + ig
    m_loc = jnp.max(w_state, axis=-1)
    e_state = jnp.exp(w_state - m_loc[..., None])
    c_loc = jnp.einsum('bhcl,bhclv,bhclk->bhcvk', e_state, vc, kc)
    n_loc = jnp.einsum('bhcl,bhclk->bhck', e_state, kc)

    def step(carry, inp):
        c_st, n_st, m_st = carry
        cl, nl, ml, bl = inp
        m_new = jnp.maximum(bl + m_st, ml)
        decay = jnp.exp(bl + m_st - m_new)
        scale = jnp.exp(ml - m_new)
        c_new = decay[..., None, None] * c_st + scale[..., None, None] * cl
        n_new = decay[..., None] * n_st + scale[..., None] * nl
        return (c_new, n_new, m_new), (c_st, n_st, m_st)

    init = (jnp.zeros((B, H, dv, dk), jnp.float32),
            jnp.zeros((B, H, dk), jnp.float32),
            jnp.full((B, H), -jnp.inf, jnp.float32))
    xs = (jnp.moveaxis(c_loc, 2, 0), jnp.moveaxis(n_loc, 2, 0),
          jnp.moveaxis(m_loc, 2, 0), jnp.moveaxis(b_last, 2, 0))
    _, (c_prev, n_prev, m_prev) = lax.scan(step, init, xs)
    c_prev = jnp.moveaxis(c_prev, 0, 2)
    n_prev = jnp.moveaxis(n_prev, 0, 2)
    m_prev = jnp.moveaxis(m_prev, 0, 2)

    inter_log = b + m_prev[..., None]
    m_out = jnp.maximum(inter_log, jnp.max(d_log, axis=-1))
    qk = jnp.einsum('bhctk,bhcsk->bhcts', qc, kc) * jnp.exp(d_log - m_out[..., None])
    a_inter = jnp.exp(inter_log - m_out)
    num = (jnp.einsum('bhcts,bhcsv->bhctv', qk, vc)
           + a_inter[..., None] * jnp.einsum('bhcvk,bhctk->bhctv', c_prev, qc))
    den = jnp.sum(qk, axis=-1) + a_inter * jnp.einsum('bhck,bhctk->bhct', n_prev, qc)
    hid = num / jnp.maximum(jnp.abs(den), jnp.exp(-m_out))[..., None]
    return jnp.moveaxis(hid, 1, 3).reshape(B, S, H, dv).astype(v.dtype)


def blockify(a, nqb):
    return jnp.moveaxis(a.reshape((a.shape[0], nqb, Q_BLOCK) + a.shape[2:]), 1, 0)


def dsa_attention(q, ckv, q_idx, k_idx, w_idx, kv_norm_g, w_uk, w_uv):
    B, S, H, dh = q.shape
    n_sel = min(DSA_TOPK, S // 4)
    nqb = S // Q_BLOCK
    ckv = rms(ckv) * kv_norm_g
    q_abs = jnp.einsum('bshd,hcd->bshc', q, w_uk) * dh ** -0.5
    key_chunk = jnp.arange(S) // CHUNK

    def one_block(args):
        qb, qib, wib, qpos = args
        q_chunk = qpos // CHUNK
        idx_logit = jnp.einsum('bthd,bsd->bths', qib, k_idx) * IDX_DIM ** -0.5
        score = jnp.einsum('bth,bths->bts', wib, jax.nn.relu(idx_logit)).astype(jnp.float32)
        score = jnp.where(key_chunk[None, None, :] <= q_chunk[None, :, None], score, -jnp.inf)
        _, sel = lax.top_k(score, n_sel)
        valid = (sel // CHUNK) <= q_chunk[None, :, None]
        kv_sel = jax.vmap(lambda cb, ib: cb[ib])(ckv, sel)
        logits = jnp.einsum('bthc,btkc->bthk', qb, kv_sel).astype(jnp.float32)
        logits = jnp.where(valid[:, :, None, :], logits, -jnp.inf)
        p = jax.nn.softmax(logits, axis=-1).astype(kv_sel.dtype)
        lat = jnp.einsum('bthk,btkc->bthc', p, kv_sel)
        return jnp.einsum('bthc,hcd->bthd', lat, w_uv)

    out = lax.map(one_block, (blockify(q_abs, nqb), blockify(q_idx, nqb), blockify(w_idx, nqb),
                              jnp.arange(S).reshape(nqb, Q_BLOCK)))
    return jnp.moveaxis(out, 0, 1).reshape(B, S, H * dh)


def forgetting_attention(q, k, v, f_pre):
    B, S, H, d = q.shape
    nqb = S // Q_BLOCK
    cum_f = jnp.cumsum(jax.nn.log_sigmoid(f_pre.astype(jnp.float32)), axis=1)
    cum_f_keys = jnp.transpose(cum_f, (0, 2, 1))
    pos = jnp.arange(S)

    def one_block(args):
        qb, fq, qpos = args
        logits = jnp.einsum('bthd,bshd->bhts', qb, k).astype(jnp.float32) * d ** -0.5
        logits = logits + jnp.transpose(fq, (0, 2, 1))[..., :, None] - cum_f_keys[..., None, :]
        logits = jnp.where(pos[None, :] <= qpos[:, None], logits, -jnp.inf)
        p = jax.nn.softmax(logits, axis=-1).astype(v.dtype)
        return jnp.einsum('bhts,bshd->bthd', p, v)

    out = lax.map(one_block, (blockify(q, nqb), blockify(cum_f, nqb), pos.reshape(nqb, Q_BLOCK)))
    return jnp.moveaxis(out, 0, 1).reshape(B, S, H * d)


def hybrid_mixer(h, w_in, b_in, conv_w, conv_b, ml_norm_g, kv_norm_g, w_uk, w_uv,
                 w_br_ml, w_br_dsa, w_br_fox, w_out):
    B, S, _ = h.shape
    proj = h @ w_in + b_in
    (ml_q, ml_k, ml_v, ml_o, ml_i, ml_f, d_q, d_ckv, d_iq, d_ik, d_iw,
     fx_qkv, fx_f, gates) = jnp.split(proj, np.cumsum(SPLITS)[:-1].tolist(), axis=-1)

    qk_conv = jax.nn.silu(causal_dwconv(jnp.concatenate([ml_q, ml_k], axis=-1), conv_w, conv_b))
    mq, mk = jnp.split(qk_conv, 2, axis=-1)
    hid = mlstm_chunkwise(mq.reshape(B, S, ML_HEADS, ML_QK_DIM), mk.reshape(B, S, ML_HEADS, ML_QK_DIM),
                          ml_v.reshape(B, S, ML_HEADS, ML_V_DIM), ml_i, ml_f)
    y_ml = (rms(hid) * ml_norm_g.reshape(ML_HEADS, ML_V_DIM)).reshape(B, S, -1) * jax.nn.sigmoid(ml_o)

    y_dsa = dsa_attention(d_q.reshape(B, S, DSA_HEADS, DSA_HEAD_DIM), d_ckv,
                          d_iq.reshape(B, S, IDX_HEADS, IDX_DIM), d_ik, d_iw * IDX_HEADS ** -0.5,
                          kv_norm_g, w_uk, w_uv)

    fq, fk, fv = jnp.split(fx_qkv.reshape(B, S, 3, FOX_HEADS, FOX_HEAD_DIM), 3, axis=2)
    y_fox = forgetting_attention(fq[:, :, 0], fk[:, :, 0], fv[:, :, 0], fx_f)

    g = jax.nn.sigmoid(gates).reshape(B, S, N_BRANCH, D_MODEL)
    merged = (g[:, :, 0] * (y_ml @ w_br_ml) + g[:, :, 1] * (y_dsa @ w_br_dsa)
              + g[:, :, 2] * (y_fox @ w_br_fox))
    return merged @ w_out


def moe_ffn(x, w_router, b_router, w1, b1, w2, b2):
    B, S, D = x.shape
    N = B * S
    NK = N * TOP_K
    xt = x.reshape(N, D)
    logits = (xt @ w_router + b_router).astype(jnp.float32)
    top_val, top_idx = lax.top_k(logits, TOP_K)
    gate = jax.nn.softmax(top_val, axis=-1).astype(x.dtype)

    e_flat = top_idx.reshape(-1)
    tok_flat = jnp.arange(NK, dtype=jnp.int32) // TOP_K
    order = jnp.argsort(e_flat)
    e_sorted = e_flat[order]
    counts = jnp.zeros((N_EXPERTS,), jnp.int32).at[e_flat].add(1)
    starts = jnp.cumsum(counts) - counts
    padded = (counts + MOE_BLOCK - 1) // MOE_BLOCK * MOE_BLOCK
    pad_ends = jnp.cumsum(padded)
    pad_starts = pad_ends - padded
    dest = pad_starts[e_sorted] + (jnp.arange(NK, dtype=jnp.int32) - starts[e_sorted])
    n_blocks = -(-NK // MOE_BLOCK) + N_EXPERTS
    n_rows = n_blocks * MOE_BLOCK
    row_tok = jnp.full((n_rows,), N, jnp.int32).at[dest].set(tok_flat[order])
    row_gate = jnp.zeros((n_rows,), x.dtype).at[dest].set(gate.reshape(-1)[order])
    blk_expert = jnp.minimum(jnp.searchsorted(pad_ends, jnp.arange(n_blocks) * MOE_BLOCK, side='right'),
                             N_EXPERTS - 1)
    x_pad = jnp.concatenate([xt, jnp.zeros((1, D), xt.dtype)], axis=0)
    xb = x_pad[row_tok].reshape(n_blocks, MOE_BLOCK, D)

    def expert_block(args):
        xe, e = args
        hdn = xe @ w1[e] + b1[e]
        glu = jnp.minimum(hdn[:, :D_EXPERT], SWIGLU_LIMIT)
        lin = jnp.clip(hdn[:, D_EXPERT:], -SWIGLU_LIMIT, SWIGLU_LIMIT)
        act = glu * jax.nn.sigmoid(SWIGLU_ALPHA * glu) * (lin + 1)
        return act @ w2[e] + b2[e]

    yb = lax.map(expert_block, (xb, blk_expert)).reshape(n_rows, D)
    y = jnp.zeros((N + 1, D), x.dtype).at[row_tok].add(yb * row_gate[:, None])
    return y[:N].reshape(B, S, D)


def setup_inputs(seed: int = 0) -> dict:
    key = jax.random.key(seed)
    ks = jax.random.split(key, 24)

    def nrm(k, shape, scale):
        return jax.random.normal(k, shape, jnp.float32) * scale

    offs = np.cumsum((0,) + SPLITS)
    ml_f_off = int(offs[5])
    fx_f_off = int(offs[12])
    b_in = nrm(ks[5], (DEPTH, D_IN), 0.01)
    b_in = b_in.at[:, ml_f_off:ml_f_off + ML_HEADS].add(jnp.linspace(3.0, 6.0, ML_HEADS))
    b_in = b_in.at[:, fx_f_off:fx_f_off + FOX_HEADS].add(jnp.linspace(1.0, 5.0, FOX_HEADS))
    return {
        'x': nrm(ks[0], (BATCH, SEQ, D_MODEL), 1.0),
        'c': nrm(ks[1], (BATCH, D_MODEL), 1.0),
        'w_ada': nrm(ks[2], (DEPTH, D_MODEL, 6 * D_MODEL), 0.5 * D_MODEL ** -0.5),
        'b_ada': nrm(ks[3], (DEPTH, 6 * D_MODEL), 0.01),
        'w_in': nrm(ks[4], (DEPTH, D_MODEL, D_IN), D_MODEL ** -0.5),
        'b_in': b_in,
        'conv_w': nrm(ks[6], (DEPTH, ML_CONV, 2 * ML_HEADS * ML_QK_DIM), ML_CONV ** -0.5),
        'conv_b': nrm(ks[7], (DEPTH, 2 * ML_HEADS * ML_QK_DIM), 0.01),
        'ml_norm_g': 1.0 + nrm(ks[8], (DEPTH, ML_HEADS * ML_V_DIM), 0.02),
        'kv_norm_g': 1.0 + nrm(ks[9], (DEPTH, DSA_LATENT), 0.02),
        'w_uk': nrm(ks[10], (DEPTH, DSA_HEADS, DSA_LATENT, DSA_HEAD_DIM), DSA_HEAD_DIM ** -0.5),
        'w_uv': nrm(ks[11], (DEPTH, DSA_HEADS, DSA_LATENT, DSA_HEAD_DIM), DSA_LATENT ** -0.5),
        'w_br_ml': nrm(ks[12], (DEPTH, ML_HEADS * ML_V_DIM, D_MODEL), BRANCH_WIDTH ** -0.5),
        'w_br_dsa': nrm(ks[13], (DEPTH, DSA_HEADS * DSA_HEAD_DIM, D_MODEL), BRANCH_WIDTH ** -0.5),
        'w_br_fox': nrm(ks[14], (DEPTH, FOX_HEADS * FOX_HEAD_DIM, D_MODEL), BRANCH_WIDTH ** -0.5),
        'w_out': nrm(ks[15], (DEPTH, D_MODEL, D_MODEL), D_MODEL ** -0.5),
        'w_router': nrm(ks[16], (DEPTH, D_MODEL, N_EXPERTS), D_MODEL ** -0.5),
        'b_router': nrm(ks[17], (DEPTH, N_EXPERTS), 0.01),
        'w1': nrm(ks[18], (DEPTH, N_EXPERTS, D_MODEL, 2 * D_EXPERT), D_MODEL ** -0.5),
        'b1': nrm(ks[19], (DEPTH, N_EXPERTS, 2 * D_EXPERT), 0.01),
        'w2': nrm(ks[20], (DEPTH, N_EXPERTS, D_EXPERT, D_MODEL), D_EXPERT ** -0.5),
        'b2': nrm(ks[21], (DEPTH, N_EXPERTS, D_MODEL), 0.01),
        'final_g': 1.0 + nrm(ks[22], (D_MODEL,), 0.02),
    }


def reference(x, c, w_ada, b_ada, w_in, b_in, conv_w, conv_b, ml_norm_g, kv_norm_g, w_uk, w_uv,
              w_br_ml, w_br_dsa, w_br_fox, w_out, w_router, b_router, w1, b1, w2, b2, final_g):
    cond = jax.nn.silu(c)
    for l in range(DEPTH):
        mod = cond @ w_ada[l] + b_ada[l]
        sh1, sc1, g1, sh2, sc2, g2 = jnp.split(mod[:, None, :], 6, axis=-1)
        h = rms(x) * (1 + sc1) + sh1
        x = x + g1 * hybrid_mixer(h, w_in[l], b_in[l], conv_w[l], conv_b[l], ml_norm_g[l], kv_norm_g[l],
                                  w_uk[l], w_uv[l], w_br_ml[l], w_br_dsa[l], w_br_fox[l], w_out[l])
        h = rms(x) * (1 + sc2) + sh2
        x = x + g2 * moe_ffn(h, w_router[l], b_router[l], w1[l], b1[l], w2[l], b2[l])
    return rms(x) * final_g
```

```cpp
#include <hip/hip_runtime.h>
#include <hip/hip_cooperative_groups.h>
#include <cstdio>
#include <cstdint>
namespace cg = cooperative_groups;
#define DUP_MASK 0
__device__ __forceinline__ int hw_lane() { int x; asm volatile("v_mbcnt_lo_u32_b32 %0, -1, 0\n\tv_mbcnt_hi_u32_b32 %0, -1, %0" : "=v"(x)); return x; }
typedef float ozf4_t __attribute__((ext_vector_type(4)));
typedef float ozf16_t __attribute__((ext_vector_type(16)));
__device__ __forceinline__ float ozero() { float z; asm volatile("v_mov_b32 %0, 0" : "=v"(z)); return z; }
__device__ __forceinline__ ozf4_t ozero4() { const float z = ozero(); return (ozf4_t){z, z, z, z}; }
__device__ __forceinline__ ozf16_t ozero16() { const float z = ozero(); return (ozf16_t){z, z, z, z, z, z, z, z, z, z, z, z, z, z, z, z}; }
__device__ __forceinline__ float lshfl(float x, int srclane) { return __builtin_bit_cast(float, __builtin_amdgcn_ds_bpermute(srclane << 2, __builtin_bit_cast(int, x))); }
__device__ __forceinline__ float qxor1(float x) { return __builtin_bit_cast(float, __builtin_amdgcn_mov_dpp(__builtin_bit_cast(int, x), 0xB1, 0xf, 0xf, true)); }
__device__ __forceinline__ float qxor2(float x) { return __builtin_bit_cast(float, __builtin_amdgcn_mov_dpp(__builtin_bit_cast(int, x), 0x4E, 0xf, 0xf, true)); }
__device__ __forceinline__ float hmirror(float x) { return __builtin_bit_cast(float, __builtin_amdgcn_mov_dpp(__builtin_bit_cast(int, x), 0x141, 0xf, 0xf, true)); }
namespace pg8 {
#define PG8_LAS __attribute__((address_space(3)))
typedef unsigned short bf16_t;
typedef short bf16x8 __attribute__((ext_vector_type(8)));
typedef float f32x4 __attribute__((ext_vector_type(4)));
typedef unsigned u32x4 __attribute__((ext_vector_type(4)));
constexpr int BM = 256, BK = 64, HALF = 128, HTB = HALF * BK * 2  , STAGE_BYTES = 8 * HTB, NXCD = 8, WGM = 8;

__host__ __device__ __forceinline__ int lds_byte(int r, int c) { const int st = (r >> 4) * 2 + (c >> 5), rr = r & 15, cc = c & 31, ob = rr * 64 + cc * 2; return st * 1024 + (ob ^ (((ob >> 9) & 1) << 5)); }
__host__ __device__ __forceinline__ void stage_rc(int b, int& R, int& C) { const int st = b / 1024, sb = b % 1024, swz = sb ^ (((sb >> 9) & 1) << 5); R = (st >> 1) * 16 + swz / 64; C = (st & 1) * 32 + (swz % 64) / 2; }
__host__ __device__ __forceinline__ int perm32(int rho) { const int n = rho >> 4, i = rho & 15; return 8 * (i >> 2) + 4 * n + (i & 3); }

struct Unit { int pm, pn; };
struct Gemm { const bf16_t* A; const bf16_t* Bt; int M, N, K; int nt_probe = 0; };

struct StaticOrder {
    int nM, nN, nwg, G, c;
    __host__ __device__ void init(int M, int N, int G_, int c_) { nM = M / BM; nN = N / BM; nwg = nM * nN; G = G_; c = c_; }
    __host__ __device__ bool next(int i, Unit& u) const {
        const long L = (long)i * G + c; if (L >= nwg) return false;
        int wgid = (int)L; { const int q = nwg / NXCD, r = nwg % NXCD, xcd = wgid % NXCD, off = wgid / NXCD; wgid = (xcd < r ? xcd * (q + 1) : r * (q + 1) + (xcd - r) * q) + off; }
        const int nig = WGM * nN, gid = wgid / nig, fm = gid * WGM, gsz = (nM - fm) < WGM ? (nM - fm) : WGM;
        u.pm = fm + ((wgid % nig) % gsz); u.pn = (wgid % nig) / gsz; return true;
    }
    __device__ __forceinline__ void a_ready(const Unit&) const {}
    __device__ __forceinline__ void done(const Unit&) const {}
};

__device__ __forceinline__ unsigned cvt_pk_bf16(float lo, float hi) { unsigned r; asm volatile("v_cvt_pk_bf16_f32 %0, %1, %2" : "=v"(r) : "v"(lo), "v"(hi)); return r; }
__device__ __forceinline__ void glds16s(const void* sbase, unsigned voff, unsigned lds_dst) { unsigned keep;
    asm volatile("s_mov_b32 %0, m0\n\ts_mov_b32 m0, %3\n\ts_nop 0\n\tglobal_load_lds_dwordx4 %1, %2\n\ts_mov_b32 m0, %0" : "=&s"(keep) : "v"(voff), "s"(sbase), "s"(lds_dst) : "memory"); }
typedef int v8i_t __attribute__((ext_vector_type(8)));
typedef int v4i_t __attribute__((ext_vector_type(4)));
template <class T, class = void> struct epi_bias_init { static constexpr bool value = false; };
template <class T> struct epi_bias_init<T, decltype((void)T::BIAS_INIT)> { static constexpr bool value = T::BIAS_INIT; };
template <class T, class = void> struct epi_nstore { static constexpr int value = 0; };
template <class T> struct epi_nstore<T, decltype((void)T::NSTORE)> { static constexpr int value = T::NSTORE; };
template <class Epi, class Sched, bool ALIGN_EPI = false, bool SP2 = false, bool FP8 = false>
__device__ __forceinline__ void gemm_phase(PG8_LAS unsigned char* lds, const Gemm g, const Sched& S, const Epi& E, const int tid) {
    const int wid = __builtin_amdgcn_readfirstlane(tid >> 6), lane = tid & 63, wr = wid >> 2, wc = wid & 3, fr = lane & 15, fq = lane >> 4;
    const int K = g.K, nt = (DUP_MASK != 0 && g.nt_probe) ? g.nt_probe : K / BK;
    unsigned voffA[2], voffB[2];
#pragma unroll
    for (int i = 0; i < 2; ++i) { int R, C; stage_rc(tid * 16 + i * 8192, R, C); const int Rb = Epi::PERM ? ((R & ~31) + perm32(R & 31)) : R;
        voffA[i] = (unsigned)(R * K + C) * 2u; voffB[i] = (unsigned)(Rb * K + C) * 2u; }
    const size_t kstep = (size_t)(BK * 2);
    const size_t hstep = (size_t)HALF * K * 2;
    const size_t tstep = 2 * hstep;
    const unsigned ldsw = (unsigned)wid * 1024u, ldsbase = (unsigned)(uintptr_t)lds;
    const int aoff0 = lds_byte(wr * 64 + fr, fq * 8), aoff1 = aoff0 + 1024;
    const int boff0 = lds_byte(wc * 32 + fr, fq * 8), boff1 = boff0 + 1024;
#define PG8_SA(b, h) (((b) * 2 + (h)) * HTB)
#define PG8_SB(b, h) ((4 + (b) * 2 + (h)) * HTB)
#define PG8_STAGE(bufoff, gbase, voff) do { _Pragma("unroll") for (int _i = 0; _i < 2; ++_i) \
        glds16s((const void*)(gbase), (voff)[_i], (unsigned)__builtin_amdgcn_readfirstlane((int)(ldsbase + (bufoff) + ldsw + _i * 8192))); } while (0)
#define PG8_LDA(dst, b, h) do { _Pragma("unroll") for (int m = 0; m < 4; ++m) { if constexpr (FP8) { \
        const v4i_t lo_ = *(const PG8_LAS v4i_t*)(lds + PG8_SA(b, h) + aoff0 + m * 2048), hi_ = *(const PG8_LAS v4i_t*)(lds + PG8_SA(b, h) + aoff1 + m * 2048); dst##8[m] = __builtin_shufflevector(lo_, hi_, 0, 1, 2, 3, 4, 5, 6, 7); } \
        else { dst[m][0] = *(const PG8_LAS bf16x8*)(lds + PG8_SA(b, h) + aoff0 + m * 2048); dst[m][1] = *(const PG8_LAS bf16x8*)(lds + PG8_SA(b, h) + aoff1 + m * 2048); } } } while (0)
#define PG8_LDB(dst, b, h) do { _Pragma("unroll") for (int n = 0; n < 2; ++n) { if constexpr (FP8) { \
        const v4i_t lo_ = *(const PG8_LAS v4i_t*)(lds + PG8_SB(b, h) + boff0 + n * 2048), hi_ = *(const PG8_LAS v4i_t*)(lds + PG8_SB(b, h) + boff1 + n * 2048); dst##8[n] = __builtin_shufflevector(lo_, hi_, 0, 1, 2, 3, 4, 5, 6, 7); } \
        else { dst[n][0] = *(const PG8_LAS bf16x8*)(lds + PG8_SB(b, h) + boff0 + n * 2048); dst[n][1] = *(const PG8_LAS bf16x8*)(lds + PG8_SB(b, h) + boff1 + n * 2048); } } } while (0)
#define PG8_MMA(ai, bj, At, Bt) do { __builtin_amdgcn_s_setprio(1); _Pragma("unroll") for (int m = 0; m < 4; ++m) _Pragma("unroll") for (int n = 0; n < 2; ++n) { \
        if constexpr (FP8) { asm volatile("v_mfma_scale_f32_16x16x128_f8f6f4 %0, %1, %2, %0, %3, %4 op_sel_hi:[0,0,0]" : "+v"(acc[ai][bj][m][n]) : "v"(Bt##8[n]), "v"(At##8[m]), "v"(sclW), "v"(sclX)); } \
        else { _Pragma("unroll") for (int k = 0; k < 2; ++k) acc[ai][bj][m][n] = __builtin_amdgcn_mfma_f32_16x16x32_bf16(Bt[n][k], At[m][k], acc[ai][bj][m][n], 0, 0, 0); } } __builtin_amdgcn_s_setprio(0); } while (0)
#define PG8_WAIT_V(n) asm volatile("s_waitcnt vmcnt(" #n ")" ::: "memory")
#define PG8_WAIT_VN(n) asm volatile("s_waitcnt vmcnt(%0)" :: "n"(n) : "memory")
#define PG8_WAIT_L(n) asm volatile("s_waitcnt lgkmcnt(" #n ")" ::: "memory")
#define PG8_BAR __builtin_amdgcn_s_barrier()
#define PG8_SCHED __builtin_amdgcn_sched_barrier(0)
    Unit cur, nxt; int ui = 0;
    if (!S.next(0, cur)) return;
    const int sclW = 0x7a7a7a7a, sclX = 0x7f7f7f7f;
    cur.pm = __builtin_amdgcn_readfirstlane(cur.pm); cur.pn = __builtin_amdgcn_readfirstlane(cur.pn);
    f32x4 acc[2][2][4][2];
    constexpr int NST = epi_nstore<Epi>::value;
    f32x4 nb[4];
    if constexpr (epi_bias_init<Epi>::value) {
#pragma unroll
        for (int p = 0; p < 2; ++p) { Unit bu; const int bi = p * 8 + wid;
            if (S.next(bi, bu)) *(PG8_LAS f32x4*)(lds + STAGE_BYTES + bi * 1024 + lane * 16) = *(const f32x4*)E.bias_src(bu, lane); }
        __syncthreads();
        E.load_bias(nb, (const PG8_LAS float*)(lds + STAGE_BYTES), wc, fq); E.set_bias(acc, nb); }
    else {
#pragma unroll
    for (int a = 0; a < 2; ++a)
#pragma unroll
        for (int b = 0; b < 2; ++b)
#pragma unroll
            for (int m = 0; m < 4; ++m)
#pragma unroll
                for (int n = 0; n < 2; ++n) acc[a][b][m][n] = ozero4();
    }
    bf16x8 At[4][2], B0[2][2], B1[2][2]; v8i_t At8[4], B08[2], B18[2];
    const char* cA = (const char*)g.A + (size_t)cur.pm * tstep; const char* cB = (const char*)g.Bt + (size_t)cur.pn * tstep;
    S.a_ready(cur);
    if constexpr (SP2) {
        PG8_STAGE(PG8_SB(0, 0), cB, voffB); PG8_STAGE(PG8_SB(0, 1), cB + hstep, voffB); PG8_STAGE(PG8_SA(0, 0), cA, voffA); PG8_STAGE(PG8_SA(0, 1), cA + hstep, voffA);
        if (wr == 1) PG8_BAR;
        PG8_WAIT_V(2); PG8_BAR;
        PG8_STAGE(PG8_SB(1, 0), cB + kstep, voffB); PG8_STAGE(PG8_SA(1, 0), cA + kstep, voffA); PG8_STAGE(PG8_SB(1, 1), cB + hstep + kstep, voffB);
        PG8_WAIT_V(6); PG8_BAR;
    } else {
        PG8_STAGE(PG8_SB(0, 0), cB, voffB); PG8_STAGE(PG8_SA(0, 0), cA, voffA); PG8_STAGE(PG8_SB(0, 1), cB + hstep, voffB); PG8_STAGE(PG8_SA(0, 1), cA + hstep, voffA);
        if (wr == 1) PG8_BAR;
        PG8_WAIT_V(4); PG8_BAR;
        PG8_STAGE(PG8_SB(1, 0), cB + kstep, voffB); PG8_STAGE(PG8_SA(1, 0), cA + kstep, voffA); PG8_STAGE(PG8_SB(1, 1), cB + hstep + kstep, voffB);
        PG8_WAIT_V(6); PG8_BAR;
    }
    for (;;) {
        const bool has_next = S.next(ui + 1, nxt);
        nxt.pm = __builtin_amdgcn_readfirstlane(nxt.pm); nxt.pn = __builtin_amdgcn_readfirstlane(nxt.pn);
        const char* nA = has_next ? (const char*)g.A + (size_t)nxt.pm * tstep : cA; const char* nB = has_next ? (const char*)g.Bt + (size_t)nxt.pn * tstep : cB;
        for (int t = 0; t < nt; t += 2) {
            const bool last = (t == nt - 2);
            const bool rl = NST > 0 && t == 0 && ui > 0;
            const char* a1 = cA + (size_t)(t + 1) * kstep;
            const char* a2 = last ? nA : cA + (size_t)(t + 2) * kstep; const char* b2 = last ? nB : cB + (size_t)(t + 2) * kstep;
            const char* a3 = a2 + kstep; const char* b3 = b2 + kstep;
            if (last && has_next) S.a_ready(nxt);
            if constexpr (SP2) {
            PG8_LDB(B0, 0, 0); PG8_LDB(B1, 0, 1); PG8_SCHED; PG8_LDA(At, 0, 0); PG8_STAGE(PG8_SA(1, 1), a1 + hstep, voffA);
            if (rl) PG8_WAIT_VN(NST + 2); else PG8_WAIT_V(8);
            PG8_WAIT_L(0); PG8_BAR; PG8_MMA(0, 0, At, B0); PG8_MMA(0, 1, At, B1); PG8_BAR; PG8_SCHED;
            PG8_LDA(At, 0, 1); PG8_STAGE(PG8_SB(0, 0), b2, voffB); PG8_STAGE(PG8_SB(0, 1), b2 + hstep, voffB); PG8_STAGE(PG8_SA(0, 0), a2, voffA);
            if (rl) PG8_WAIT_VN(NST + 8); else PG8_WAIT_V(8);
            PG8_WAIT_L(0); PG8_BAR; PG8_MMA(1, 0, At, B0); PG8_MMA(1, 1, At, B1); PG8_BAR; PG8_SCHED;
            PG8_LDB(B0, 1, 0); PG8_LDB(B1, 1, 1); PG8_SCHED; PG8_LDA(At, 1, 0); PG8_STAGE(PG8_SA(0, 1), a2 + hstep, voffA);
            if (rl) PG8_WAIT_VN(NST + 10); else PG8_WAIT_V(8);
            PG8_WAIT_L(0); PG8_BAR; PG8_MMA(0, 0, At, B0); PG8_MMA(0, 1, At, B1); PG8_BAR; PG8_SCHED;
            PG8_LDA(At, 1, 1); PG8_STAGE(PG8_SB(1, 0), b3, voffB); PG8_STAGE(PG8_SB(1, 1), b3 + hstep, voffB); PG8_STAGE(PG8_SA(1, 0), a3, voffA);
            PG8_WAIT_V(8); PG8_WAIT_L(0); PG8_BAR; PG8_MMA(1, 0, At, B0); PG8_MMA(1, 1, At, B1); PG8_BAR; PG8_SCHED;
            } else {
            PG8_LDB(B0, 0, 0); PG8_SCHED; PG8_LDA(At, 0, 0); PG8_STAGE(PG8_SA(1, 1), a1 + hstep, voffA);
            PG8_WAIT_L(8); PG8_BAR; PG8_WAIT_L(0); PG8_MMA(0, 0, At, B0); PG8_BAR; PG8_SCHED;
            PG8_LDB(B1, 0, 1); PG8_STAGE(PG8_SB(0, 0), b2, voffB);
            PG8_BAR; PG8_WAIT_L(0); PG8_MMA(0, 1, At, B1); PG8_BAR;
            PG8_LDA(At, 0, 1); PG8_STAGE(PG8_SA(0, 0), a2, voffA);
            PG8_BAR; PG8_WAIT_L(0); PG8_MMA(1, 0, At, B0); PG8_BAR; PG8_SCHED;
            PG8_STAGE(PG8_SB(0, 1), b2 + hstep, voffB);
            PG8_WAIT_V(6); PG8_BAR; PG8_MMA(1, 1, At, B1); PG8_BAR;
            PG8_LDB(B0, 1, 0); PG8_SCHED; PG8_LDA(At, 1, 0); PG8_STAGE(PG8_SA(0, 1), a2 + hstep, voffA);
            PG8_WAIT_L(8); PG8_BAR; PG8_WAIT_L(0); PG8_MMA(0, 0, At, B0); PG8_BAR; PG8_SCHED;
            PG8_LDB(B1, 1, 1); PG8_STAGE(PG8_SB(1, 0), b3, voffB);
            PG8_BAR; PG8_WAIT_L(0); PG8_MMA(0, 1, At, B1); PG8_BAR;
            PG8_LDA(At, 1, 1); PG8_STAGE(PG8_SA(1, 0), a3, voffA);
            PG8_BAR; PG8_WAIT_L(0); PG8_MMA(1, 0, At, B0); PG8_BAR; PG8_SCHED;
            PG8_STAGE(PG8_SB(1, 1), b3 + hstep, voffB);
            PG8_WAIT_V(6); PG8_BAR; PG8_MMA(1, 1, At, B1); PG8_BAR;
            }
        }
        if constexpr (FP8) asm volatile("s_nop 15\n\ts_nop 15" ::: "memory");
        if constexpr (ALIGN_EPI) { if (wr == 0) PG8_BAR; }
        if constexpr (epi_bias_init<Epi>::value) { if (has_next) E.load_bias(nb, (const PG8_LAS float*)(lds + STAGE_BYTES + (ui + 1) * 1024), wc, hw_lane() >> 4); }
        if constexpr (!Epi::AFTER_DRAIN) { const int el = hw_lane(); E(acc, cur, wr, wc, el & 15, el >> 4); S.done(cur); }
        if (!has_next) break;
        if constexpr (epi_bias_init<Epi>::value) E.set_bias(acc, nb);
        else {
#pragma unroll
        for (int a = 0; a < 2; ++a)
#pragma unroll
            for (int b = 0; b < 2; ++b)
#pragma unroll
                for (int m = 0; m < 4; ++m)
#pragma unroll
                    for (int n = 0; n < 2; ++n) acc[a][b][m][n] = ozero4();
        }
        cur = nxt; cA = nA; cB = nB; ++ui;
        if constexpr (ALIGN_EPI) { if (wr == 1) PG8_BAR; }
    }
    PG8_WAIT_V(0);
    if constexpr (!ALIGN_EPI) { if (wr == 0) PG8_BAR; }
    PG8_BAR;
    if constexpr (Epi::AFTER_DRAIN) { E.fused(acc, cur, wr, wc, fr, fq, lds, wid, lane); S.done(cur); }
#undef PG8_SA
#undef PG8_SB
#undef PG8_STAGE
#undef PG8_LDA
#undef PG8_LDB
#undef PG8_MMA
#undef PG8_WAIT_V
#undef PG8_WAIT_L
#undef PG8_BAR
#undef PG8_SCHED
}
}
typedef float f32x4 __attribute__((ext_vector_type(4)));
#define LAS __attribute__((address_space(3)))

namespace f8 {
typedef int v8i_t __attribute__((ext_vector_type(8)));
typedef int v4i_t __attribute__((ext_vector_type(4)));
constexpr int STG = 49152;
struct Gemm { const unsigned char* A; const unsigned char* Bt; int K; };
template <class Epi, class Sched>
__device__ __forceinline__ void gemm_phase(LAS unsigned char* lds, const Gemm g, const Sched& S, const Epi& E, const int tid) {
    const int wid = __builtin_amdgcn_readfirstlane(tid >> 6), lane = tid & 63, wr = wid >> 1, wc = wid & 1, fr = lane & 15, fq = lane >> 4;
    const int K = g.K, nt = K >> 7;
    unsigned voff[2];
#pragma unroll
    for (int i = 0; i < 2; ++i) { int R, C; pg8::stage_rc(tid * 16 + i * 8192, R, C); voff[i] = (unsigned)(R * K + C * 2); }
    const unsigned ldsbase = (unsigned)(uintptr_t)lds, ldsw = (unsigned)wid * 1024u;
    const int aoff0 = (wr >> 1) * 16384 + pg8::lds_byte((wr & 1) * 64 + fr, fq * 16), aoff1 = (wr >> 1) * 16384 + pg8::lds_byte((wr & 1) * 64 + fr, fq * 16 + 8);
    const int boff0 = 32768 + pg8::lds_byte(wc * 64 + fr, fq * 16), boff1 = 32768 + pg8::lds_byte(wc * 64 + fr, fq * 16 + 8);
#define F8_STAGE(s, pa, pb, kt) do { const size_t ko_ = (size_t)(kt) * 128; _Pragma("unroll") for (int _i = 0; _i < 2; ++_i) { \
        pg8::glds16s((const void*)((pa) + ko_), voff[_i], (unsigned)__builtin_amdgcn_readfirstlane((int)(ldsbase + (s) * STG + ldsw + _i * 8192))); \
        pg8::glds16s((const void*)((pa) + (size_t)128 * K + ko_), voff[_i], (unsigned)__builtin_amdgcn_readfirstlane((int)(ldsbase + (s) * STG + 16384 + ldsw + _i * 8192))); \
        pg8::glds16s((const void*)((pb) + ko_), voff[_i], (unsigned)__builtin_amdgcn_readfirstlane((int)(ldsbase + (s) * STG + 32768 + ldsw + _i * 8192))); } } while (0)
    pg8::Unit cur, nxt; int ui = 0;
    if (!S.next(0, cur)) return;
    cur.pm = __builtin_amdgcn_readfirstlane(cur.pm); cur.pn = __builtin_amdgcn_readfirstlane(cur.pn);
    const unsigned char* cA = g.A + (size_t)cur.pm * 256 * K; const unsigned char* cB = g.Bt + (size_t)cur.pn * 128 * K;
    bool has_next = S.next(1, nxt);
    nxt.pm = __builtin_amdgcn_readfirstlane(nxt.pm); nxt.pn = __builtin_amdgcn_readfirstlane(nxt.pn);
    const unsigned char* nA = has_next ? g.A + (size_t)nxt.pm * 256 * K : cA; const unsigned char* nB = has_next ? g.Bt + (size_t)nxt.pn * 128 * K : cB;
    F8_STAGE(0, cA, cB, 0);
    if (nt > 1) F8_STAGE(1, cA, cB, 1); else F8_STAGE(1, nA, nB, 0);
    asm volatile("s_waitcnt vmcnt(6)" ::: "memory"); __builtin_amdgcn_s_barrier(); asm volatile("" ::: "memory");
    int st = 0;
    for (;;) {
        f32x4 acc[4][4];
#pragma unroll
        for (int m = 0; m < 4; ++m)
#pragma unroll
            for (int n = 0; n < 4; ++n) acc[m][n] = ozero4();
        for (int t = 0; t < nt; ++t) {
            const int s2 = st >= 1 ? st - 1 : 2;
            if (t + 2 < nt) F8_STAGE(s2, cA, cB, t + 2); else F8_STAGE(s2, nA, nB, t + 2 - nt);
            v8i_t af[4], bfr[4];
            const LAS unsigned char* sb = lds + st * STG;
#pragma unroll
            for (int m = 0; m < 4; ++m) { const v4i_t lo_ = *(const LAS v4i_t*)(sb + aoff0 + m * 2048), hi_ = *(const LAS v4i_t*)(sb + aoff1 + m * 2048); af[m] = __builtin_shufflevector(lo_, hi_, 0, 1, 2, 3, 4, 5, 6, 7); }
#pragma unroll
            for (int n = 0; n < 4; ++n) { const v4i_t lo_ = *(const LAS v4i_t*)(sb + boff0 + n * 2048), hi_ = *(const LAS v4i_t*)(sb + boff1 + n * 2048); bfr[n] = __builtin_shufflevector(lo_, hi_, 0, 1, 2, 3, 4, 5, 6, 7); }
            asm volatile("s_waitcnt lgkmcnt(0)" ::: "memory"); __builtin_amdgcn_sched_barrier(0);
            __builtin_amdgcn_s_setprio(1);
#pragma unroll
            for (int m = 0; m < 4; ++m)
#pragma unroll
                for (int n = 0; n < 4; ++n) acc[m][n] = __builtin_amdgcn_mfma_scale_f32_16x16x128_f8f6f4(bfr[n], af[m], acc[m][n], 0, 0, 0, 0x7a7a7a7a, 0, 0x7f7f7f7f);
            __builtin_amdgcn_s_setprio(0);
            __builtin_amdgcn_sched_barrier(0);
            asm volatile("s_waitcnt vmcnt(6)" ::: "memory"); __builtin_amdgcn_s_barrier(); asm volatile("" ::: "memory");
            st = st == 2 ? 0 : st + 1;
        }
        E(acc, cur, wr, wc, fr, fq);
        if (!has_next) break;
        cur = nxt; cA = nA; cB = nB; ++ui;
        has_next = S.next(ui + 1, nxt);
        nxt.pm = __builtin_amdgcn_readfirstlane(nxt.pm); nxt.pn = __builtin_amdgcn_readfirstlane(nxt.pn);
        nA = has_next ? g.A + (size_t)nxt.pm * 256 * K : cA; nB = has_next ? g.Bt + (size_t)nxt.pn * 128 * K : cB;
    }
    asm volatile("s_waitcnt vmcnt(0)" ::: "memory"); __builtin_amdgcn_s_barrier(); asm volatile("" ::: "memory");
#undef F8_STAGE
}
constexpr int STGW = 65536;
template <class Epi, class Sched>
__device__ __forceinline__ void gemm_phase_w(LAS unsigned char* lds, const Gemm g, const Sched& S, const Epi& E, const int tid) {
    const int wid = __builtin_amdgcn_readfirstlane(tid >> 6), lane = tid & 63, wr = wid >> 1, wc = wid & 1, fr = lane & 15, fq = lane >> 4;
    const int K = g.K, nt = K >> 7;
    unsigned voff[2];
#pragma unroll
    for (int i = 0; i < 2; ++i) { int R, C; pg8::stage_rc(tid * 16 + i * 8192, R, C); voff[i] = (unsigned)(R * K + C * 2); }
    const unsigned ldsbase = (unsigned)(uintptr_t)lds, ldsw = (unsigned)wid * 1024u;
    const int aoff0 = (wr >> 1) * 16384 + pg8::lds_byte((wr & 1) * 64 + fr, fq * 16), aoff1 = (wr >> 1) * 16384 + pg8::lds_byte((wr & 1) * 64 + fr, fq * 16 + 8);
    const int boff0 = 32768 + wc * 16384 + pg8::lds_byte(fr, fq * 16), boff1 = 32768 + wc * 16384 + pg8::lds_byte(fr, fq * 16 + 8);
#define F8W_STAGE(s, pa, pb, kt) do { const size_t ko_ = (size_t)(kt) * 128; _Pragma("unroll") for (int _i = 0; _i < 2; ++_i) { \
        pg8::glds16s((const void*)((pa) + ko_), voff[_i], (unsigned)__builtin_amdgcn_readfirstlane((int)(ldsbase + (s) * STGW + ldsw + _i * 8192))); \
        pg8::glds16s((const void*)((pa) + (size_t)128 * K + ko_), voff[_i], (unsigned)__builtin_amdgcn_readfirstlane((int)(ldsbase + (s) * STGW + 16384 + ldsw + _i * 8192))); \
        pg8::glds16s((const void*)((pb) + ko_), voff[_i], (unsigned)__builtin_amdgcn_readfirstlane((int)(ldsbase + (s) * STGW + 32768 + ldsw + _i * 8192))); \
        pg8::glds16s((const void*)((pb) + (size_t)128 * K + ko_), voff[_i], (unsigned)__builtin_amdgcn_readfirstlane((int)(ldsbase + (s) * STGW + 49152 + ldsw + _i * 8192))); } } while (0)
    pg8::Unit cur, nxt; int ui = 0;
    if (!S.next(0, cur)) return;
    cur.pm = __builtin_amdgcn_readfirstlane(cur.pm); cur.pn = __builtin_amdgcn_readfirstlane(cur.pn);
    const unsigned char* cA = g.A + (size_t)cur.pm * 256 * K; const unsigned char* cB = g.Bt + (size_t)cur.pn * 256 * K;
    bool has_next = S.next(1, nxt);
    nxt.pm = __builtin_amdgcn_readfirstlane(nxt.pm); nxt.pn = __builtin_amdgcn_readfirstlane(nxt.pn);
    const unsigned char* nA = has_next ? g.A + (size_t)nxt.pm * 256 * K : cA; const unsigned char* nB = has_next ? g.Bt + (size_t)nxt.pn * 256 * K : cB;
    F8W_STAGE(0, cA, cB, 0);
    asm volatile("s_waitcnt vmcnt(0)" ::: "memory"); __builtin_amdgcn_s_barrier(); asm volatile("" ::: "memory");
    int st = 0;
    for (;;) {
        f32x4 acc[4][8];
#pragma unroll
        for (int m = 0; m < 4; ++m)
#pragma unroll
            for (int n = 0; n < 8; ++n) acc[m][n] = ozero4();
        for (int t = 0; t < nt; ++t) {
            if (t + 1 < nt) F8W_STAGE(st ^ 1, cA, cB, t + 1); else F8W_STAGE(st ^ 1, nA, nB, 0);
            v8i_t af[4];
            const LAS unsigned char* sb = lds + st * STGW;
#pragma unroll
            for (int m = 0; m < 4; ++m) { const v4i_t lo_ = *(const LAS v4i_t*)(sb + aoff0 + m * 2048), hi_ = *(const LAS v4i_t*)(sb + aoff1 + m * 2048); af[m] = __builtin_shufflevector(lo_, hi_, 0, 1, 2, 3, 4, 5, 6, 7); }
#pragma unroll
            for (int h2 = 0; h2 < 4; ++h2) {
                v8i_t bfr[2];
#pragma unroll
                for (int n = 0; n < 2; ++n) { const v4i_t lo_ = *(const LAS v4i_t*)(sb + boff0 + (2 * h2 + n) * 2048), hi_ = *(const LAS v4i_t*)(sb + boff1 + (2 * h2 + n) * 2048); bfr[n] = __builtin_shufflevector(lo_, hi_, 0, 1, 2, 3, 4, 5, 6, 7); }
                asm volatile("s_waitcnt lgkmcnt(0)" ::: "memory"); __builtin_amdgcn_sched_barrier(0);
                __builtin_amdgcn_s_setprio(1);
#pragma unroll
                for (int m = 0; m < 4; ++m)
#pragma unroll
                    for (int n = 0; n < 2; ++n) acc[m][2 * h2 + n] = __builtin_amdgcn_mfma_scale_f32_16x16x128_f8f6f4(bfr[n], af[m], acc[m][2 * h2 + n], 0, 0, 0, 0x7a7a7a7a, 0, 0x7f7f7f7f);
                __builtin_amdgcn_s_setprio(0);
                __builtin_amdgcn_sched_barrier(0);
            }
            asm volatile("s_waitcnt vmcnt(0)" ::: "memory"); __builtin_amdgcn_s_barrier(); asm volatile("" ::: "memory");
            st ^= 1;
        }
        E(acc, cur, wr, wc, fr, fq);
        if (!has_next) break;
        cur = nxt; cA = nA; cB = nB; ++ui;
        has_next = S.next(ui + 1, nxt);
        nxt.pm = __builtin_amdgcn_readfirstlane(nxt.pm); nxt.pn = __builtin_amdgcn_readfirstlane(nxt.pn);
        nA = has_next ? g.A + (size_t)nxt.pm * 256 * K : cA; nB = has_next ? g.Bt + (size_t)nxt.pn * 256 * K : cB;
    }
    asm volatile("s_waitcnt vmcnt(0)" ::: "memory"); __builtin_amdgcn_s_barrier(); asm volatile("" ::: "memory");
#undef F8W_STAGE
}
}

#define GAS __attribute__((address_space(1)))
#define LAS __attribute__((address_space(3)))
typedef unsigned short bf16;
typedef float f32x4 __attribute__((ext_vector_type(4)));
typedef float f32x2 __attribute__((ext_vector_type(2)));
typedef unsigned u32x4 __attribute__((ext_vector_type(4)));
typedef unsigned u32x2 __attribute__((ext_vector_type(2)));
typedef short bf16x8 __attribute__((ext_vector_type(8)));
typedef GAS unsigned gu32;

constexpr int NTHREADS = 512, NWAVES = 8;
constexpr int D = 1024, NB = 8, S = 2048, M = NB * S, DEPTH = 2;
constexpr int D_IN = 7120, NV = 7168;
constexpr int NE = 32, TOPK = 4, NPAIR = M * TOPK, MP = NPAIR + NE * 256;
constexpr float EPS = 1e-6f;
enum { I_X = 0, I_C, I_WADA, I_BADA, I_WIN, I_BIN, I_CONVW, I_CONVB, I_MLG, I_KVG, I_WUK, I_WUV, I_WBRML, I_WBRDSA, I_WBRFOX, I_WOUT, I_WR, I_BR, I_W1, I_B1, I_W2, I_B2, I_FG };

constexpr size_t MiB = 1u << 20;
constexpr size_t WS_CTL = 0, CTL_ZERO_BYTES = 1 * MiB;
constexpr size_t WS_MOD = 1 * MiB;
constexpr size_t WS_BINP = 2 * MiB;
constexpr size_t WS_WRT = 3 * MiB;
constexpr size_t WS_EIDX = 4 * MiB, WS_GATE = WS_EIDX + 256 * 1024, WS_LRANK = WS_GATE + 256 * 1024, WS_PPOS = WS_LRANK + 256 * 1024, WS_BASE = WS_PPOS + 256 * 1024;
constexpr size_t WS_ROWGATE = 6 * MiB;
constexpr size_t WS_WOUT_T = 8 * MiB;
constexpr size_t WS_WBR_T = 12 * MiB;
constexpr size_t WS_WIN_T = 18 * MiB;
constexpr size_t WS_W1T = 48 * MiB;
constexpr size_t WS_W2T = 304 * MiB;
constexpr size_t WS_X = 432 * MiB;
constexpr size_t WS_XN = 496 * MiB;
constexpr size_t WS_XNL = 528 * MiB;
constexpr size_t WS_ASORT = 560 * MiB;
constexpr size_t WS_ACT = 704 * MiB;
constexpr size_t WS_END = 848 * MiB;
constexpr size_t WS_XN1_8_ = 1352 * MiB, WS_WIN8_ = 1368 * MiB, WS_WOUT8_ = 1400 * MiB;
constexpr size_t WS_XN8 = 1336 * MiB;
constexpr size_t WS_AS8 = WS_ACT, WS_ACT8 = WS_ACT + 72 * MiB;
constexpr size_t WS_DRY = 1208 * MiB;
constexpr int CW_GCNT = 64;
constexpr int CW_BAR = 4096;

constexpr int RING_BYTES = 147456;
constexpr int LDSCTL_OFF = RING_BYTES, MISC_OFF = LDSCTL_OFF + 320;
constexpr int LDS_BYTES = 163840;

__device__ __forceinline__ unsigned f2bf(float f) { unsigned u = __builtin_bit_cast(unsigned, f); return (u + 0x7fffu + ((u >> 16) & 1u)) >> 16; }
__device__ __forceinline__ float bf2f(unsigned b) { return __builtin_bit_cast(float, b << 16); }
__device__ __forceinline__ unsigned pk2(float lo, float hi) { return f2bf(lo) | (f2bf(hi) << 16); }
__device__ __forceinline__ unsigned pk4_fp8(float a, float b, float c, float d) { int w = 0; w = __builtin_amdgcn_cvt_pk_fp8_f32(a, b, w, false); w = __builtin_amdgcn_cvt_pk_fp8_f32(c, d, w, true); return (unsigned)w; }
#define LDS_WAIT() asm volatile("s_waitcnt lgkmcnt(0)" ::: "memory")
#define VM_WAIT() asm volatile("s_waitcnt vmcnt(0)" ::: "memory")

#define XB_TMO      128
#define XB_XCNT(j)  (256  + 64 * (j))
#define XB_XSUB(j)  (1280 + 64 * (j))
#define XB_XGEN(j)  (2304 + 64 * (j))
#define XB_TOP      3328
#define XB_TOPGEN   3392
#define XCD_BAR_WORDS 3456
#define XB_SPIN_CAP (1u << 22)
__device__ __forceinline__ unsigned xb_ld(unsigned* p)              { return __hip_atomic_load(p, __ATOMIC_RELAXED, __HIP_MEMORY_SCOPE_AGENT); }
__device__ __forceinline__ unsigned xb_add(unsigned* p, unsigned v) { return __hip_atomic_fetch_add(p, v, __ATOMIC_RELAXED, __HIP_MEMORY_SCOPE_AGENT); }
__device__ __forceinline__ unsigned xb_xcc_id() { return (unsigned)__builtin_amdgcn_s_getreg((3 << 11) | 20) & 0xFu; }
#define XB_SPIN(cond, bar) do { unsigned _sp = 0; while (cond) { __builtin_amdgcn_s_sleep(1); \
    if ((++_sp & 255u) == 0u) { if (xb_ld(&(bar)[XB_TMO])) break; if (_sp > XB_SPIN_CAP) { atomicAdd(&(bar)[XB_TMO], 1u); break; } } } } while (0)
struct XcdBarrier { unsigned* bar; unsigned x; volatile LAS unsigned* st; bool t0; };
__device__ __forceinline__ XcdBarrier xcd_barrier_post(unsigned* bar, volatile LAS unsigned* st, bool t0) {
    XcdBarrier b; b.bar = bar; b.x = xb_xcc_id(); b.st = st; b.t0 = t0;
    if (t0) (void)xb_add(&bar[XB_XCNT(b.x)], 1u);
    return b;
}
__device__ __forceinline__ void xcd_barrier_complete(unsigned* bar, unsigned x, unsigned& nloc, unsigned& nx) {
    const unsigned G = gridDim.x * gridDim.y * gridDim.z;
    unsigned sum, cnt, mine, sp = 0u;
    for (;;) {
        sum = 0u; cnt = 0u; mine = 0u;
#pragma unroll
        for (unsigned j = 0; j < 16; ++j) { const unsigned c = xb_ld(&bar[XB_XCNT(j)]); sum += c; cnt += (c > 0u) ? 1u : 0u; mine = (j == x) ? c : mine; }
        if (sum == G) break;
        __builtin_amdgcn_s_sleep(1);
        if ((++sp & 255u) == 0u) { if (xb_ld(&bar[XB_TMO])) break; if (sp > XB_SPIN_CAP) { atomicAdd(&bar[XB_TMO], 1u); break; } }
    }
    nloc = mine > 0u ? mine : 1u; nx = cnt > 0u ? cnt : 1u;
}
__device__ __forceinline__ void xcd_barrier(const XcdBarrier& b) {
    asm volatile("s_waitcnt vmcnt(0)" ::: "memory");
    __syncthreads();
    if (b.t0) {
        unsigned* bar = b.bar;
        __builtin_amdgcn_s_waitcnt(0);
        unsigned nloc = b.st[0], nx = b.st[1];
        if (nloc == 0u) { xcd_barrier_complete(bar, b.x, nloc, nx); b.st[0] = nloc; b.st[1] = nx; }
        const unsigned old = xb_add(&bar[XB_XSUB(b.x)], 1u);
        const unsigned gen = old / nloc;
        if (old + 1u == (gen + 1u) * nloc) {
            __builtin_amdgcn_fence(__ATOMIC_RELEASE, "agent");
            asm volatile("s_waitcnt vmcnt(0)" ::: "memory");
            const unsigned og = xb_add(&bar[XB_TOP], 1u);
            const unsigned tg = og / nx;
            if (og + 1u == (tg + 1u) * nx) xb_add(&bar[XB_TOPGEN], 1u);
            else XB_SPIN(xb_ld(&bar[XB_TOPGEN]) == tg, bar);
            __builtin_amdgcn_fence(__ATOMIC_ACQUIRE, "agent");
            xb_add(&bar[XB_XGEN(b.x)], 1u);
            asm volatile("s_waitcnt vmcnt(0)" ::: "memory");
        } else {
            XB_SPIN(xb_ld(&bar[XB_XGEN(b.x)]) == gen, bar);
            __builtin_amdgcn_fence(__ATOMIC_ACQUIRE, "agent");
            asm volatile("s_waitcnt vmcnt(0)" ::: "memory");
        }
    }
    __syncthreads();
}

__device__ __forceinline__ float wave_sum(float v) {
    v += __builtin_bit_cast(float, __builtin_amdgcn_update_dpp(0, __builtin_bit_cast(int, v), 0x128, 0xf, 0xf, false));
    v += __builtin_bit_cast(float, __builtin_amdgcn_update_dpp(0, __builtin_bit_cast(int, v), 0x124, 0xf, 0xf, false));
    v += __builtin_bit_cast(float, __builtin_amdgcn_update_dpp(0, __builtin_bit_cast(int, v), 0x122, 0xf, 0xf, false));
    v += __builtin_bit_cast(float, __builtin_amdgcn_update_dpp(0, __builtin_bit_cast(int, v), 0x121, 0xf, 0xf, false));
    const int b = __builtin_bit_cast(int, v);
    return (__builtin_bit_cast(float, __builtin_amdgcn_readlane(b, 0)) + __builtin_bit_cast(float, __builtin_amdgcn_readlane(b, 16))) + (__builtin_bit_cast(float, __builtin_amdgcn_readlane(b, 32)) + __builtin_bit_cast(float, __builtin_amdgcn_readlane(b, 48)));
}

struct Args { const float* in[23]; float* out; unsigned char* ws; };
struct Frame { LAS unsigned char* lds; int tid, wave; };
#define KARGS ((const __attribute__((address_space(4))) Args*)__builtin_amdgcn_kernarg_segment_ptr())
#define KWS ((GAS unsigned char*)KARGS->ws)
#define KOUT ((GAS float*)KARGS->out)
#define KCTL ((GAS unsigned*)(KWS + WS_CTL))
#define GRIDN ((int)gridDim.x)
__device__ __forceinline__ int vcu_id() { const int G = gridDim.x, bx = blockIdx.x; return (G % 8 == 0) ? (bx % 8) * (G / 8) + bx / 8 : bx; }
#define WSP(T, off) ((T*)(KWS + (off)))
#define KIN(i) ((const float*)(((const __attribute__((address_space(4))) Args*)__builtin_amdgcn_kernarg_segment_ptr())->in[i]))
#define PHASE_BEGIN() do { asm volatile("" : "+s"(F.wave)); F.tid = F.wave * 64 + hw_lane(); } while (0)

__device__ __forceinline__ int vcol_real(int v) {
    if (v < 1536) return v;
    if (v < 2048) return -1;
    if (v < 2176) return 2056 + (v - 2048);
    if (v < 2240) return 2440 + (v - 2176);
    if (v < 2244) return 1536 + (v - 2240);
    if (v < 2248) return 1540 + (v - 2244);
    if (v < 2252) return 2504 + (v - 2248);
    if (v < 2256) return 4044 + (v - 2252);
    if (v < 2304) return -1;
    if (v < 2560) return 2184 + (v - 2304);
    if (v < 4096) return 2508 + (v - 2560);
    return 4048 + (v - 4096);
}
struct P0Item { const float* W; bf16* WT; int ldw, K, destrow0, k0, srccol4; bool valid, fp8; };
__device__ __forceinline__ void p0_load(const P0Item& d, f32x4 (&v)[8], int lane) {
    const int kr = lane >> 3;
#pragma unroll
    for (int i = 0; i < 8; ++i) v[i] = (d.valid && d.srccol4 >= 0) ? *(const f32x4*)(d.W + (size_t)(d.k0 + 8 * i + kr) * d.ldw + d.srccol4) : (f32x4){0.f, 0.f, 0.f, 0.f};
}
__device__ __forceinline__ void p0_finish(const P0Item& d, const f32x4 (&v)[8], LAS float* scr, int lane) {
    if (!d.valid) return;
    const int kr = lane >> 3, n4 = 4 * (lane & 7);
#pragma unroll
    for (int i = 0; i < 8; ++i) *(LAS f32x4*)(scr + (8 * i + kr) * 36 + n4) = v[i];
    LDS_WAIT(); asm volatile("" ::: "memory");
    const int c = lane & 7;
#pragma unroll
    for (int j = 0; j < 4; ++j) { const int n = (lane >> 3) + 8 * j; const LAS float* s = scr + (8 * c) * 36 + n;
        if (d.fp8) { u32x2 o; o.x = pk4_fp8(32.f * s[0 * 36], 32.f * s[1 * 36], 32.f * s[2 * 36], 32.f * s[3 * 36]); o.y = pk4_fp8(32.f * s[4 * 36], 32.f * s[5 * 36], 32.f * s[6 * 36], 32.f * s[7 * 36]);
            *(u32x2*)((unsigned char*)d.WT + (size_t)(d.destrow0 + n) * d.K + d.k0 + 8 * c) = o; }
        else { u32x4 o; o.x = pk2(s[0 * 36], s[1 * 36]); o.y = pk2(s[2 * 36], s[3 * 36]); o.z = pk2(s[4 * 36], s[5 * 36]); o.w = pk2(s[6 * 36], s[7 * 36]);
            *(u32x4*)(d.WT + (size_t)(d.destrow0 + n) * d.K + d.k0 + 8 * c) = o; } }
    LDS_WAIT(); asm volatile("" ::: "memory");
}
__device__ __forceinline__ void p0_moe_weights(Frame& F) {
    PHASE_BEGIN();
    const int tid = F.tid, lane = tid & 63, w = F.wave;
    constexpr int NI1 = 64 * 8 * 8, NI2 = 64 * 8 * 4;
    __syncthreads();
    int buf = 0;
#define P0M_DECODE(it_, is1_, le_, kt_, nb_, Wp_) const bool is1_ = (it_) < NI1; const int r_##it_ = is1_ ? (it_) : (it_) - NI1; \
        const int le_ = is1_ ? r_##it_ >> 6 : r_##it_ >> 5, kt_ = is1_ ? (r_##it_ >> 3) & 7 : (r_##it_ >> 2) & 7, nb_ = is1_ ? r_##it_ & 7 : r_##it_ & 3, ldw_##it_ = is1_ ? 2048 : 1024; \
        const float* Wp_ = (is1_ ? KIN(I_W1) + (size_t)le_ * 1024 * 2048 : KIN(I_W2) + (size_t)le_ * 1024 * 1024) + (size_t)(kt_ * 128 + 16 * w) * ldw_##it_ + nb_ * 256 + 4 * lane;
    f32x4 v[16], vn[16];
    { const int it0 = blockIdx.x; if (it0 < NI1 + NI2) { P0M_DECODE(it0, a_, b_, c_, d_, Wq)
#pragma unroll
        for (int i = 0; i < 16; ++i) v[i] = __builtin_nontemporal_load((const f32x4*)(Wq + (size_t)i * ldw_it0)); } }
    for (int it = blockIdx.x; it < NI1 + NI2; it += GRIDN) {
        P0M_DECODE(it, is1, le, kt, nb, W)
        (void)W;
        { const int itn = it + GRIDN; if (itn < NI1 + NI2) { P0M_DECODE(itn, a_, b_, c_, d_, Wq)
#pragma unroll
            for (int i = 0; i < 16; ++i) vn[i] = __builtin_nontemporal_load((const f32x4*)(Wq + (size_t)i * ldw_itn)); } }
        LAS unsigned* T = (LAS unsigned*)(F.lds + buf * 32768);
#pragma unroll
        for (int g = 0; g < 4; ++g) {
            unsigned d[4];
#pragma unroll
            for (int q = 0; q < 4; ++q) d[q] = pk4_fp8(32.f * v[4 * g + q].x, 32.f * v[4 * g + q].y, 32.f * v[4 * g + q].z, 32.f * v[4 * g + q].w);
            const unsigned x0 = __builtin_amdgcn_perm(d[1], d[0], 0x05010400u), x1 = __builtin_amdgcn_perm(d[1], d[0], 0x07030602u), y0 = __builtin_amdgcn_perm(d[3], d[2], 0x05010400u), y1 = __builtin_amdgcn_perm(d[3], d[2], 0x07030602u);
            const unsigned t[4] = {__builtin_amdgcn_perm(y0, x0, 0x05040100u), __builtin_amdgcn_perm(y0, x0, 0x07060302u), __builtin_amdgcn_perm(y1, x1, 0x05040100u), __builtin_amdgcn_perm(y1, x1, 0x07060302u)};
#pragma unroll
            for (int c = 0; c < 4; ++c) T[(4 * lane + c) * 32 + ((4 * w + g) ^ (lane & 31))] = t[c];
        }
        __syncthreads();
        unsigned char* WT = is1 ? WSP(unsigned char, WS_W1T) + (size_t)le * 2048 * 1024 : WSP(unsigned char, WS_W2T) + (size_t)le * 1024 * 1024;
#pragma unroll
        for (int j = 0; j < 4; ++j) { const int n = (tid >> 3) + 64 * j, c8 = tid & 7, sw = (n >> 2) & 31;
            u32x4 o; o.x = T[n * 32 + ((4 * c8 + 0) ^ sw)]; o.y = T[n * 32 + ((4 * c8 + 1) ^ sw)]; o.z = T[n * 32 + ((4 * c8 + 2) ^ sw)]; o.w = T[n * 32 + ((4 * c8 + 3) ^ sw)];
            const int rc = nb * 256 + n; int vrow = rc;
            if (is1) { const int half = rc >> 10, c = rc & 1023; vrow = (c >> 7) * 256 + ((c >> 6) & 1) * 128 + ((c >> 2) & 15) * 8 + 4 * half + (c & 3); }
            __builtin_nontemporal_store(o, (u32x4*)(WT + (size_t)vrow * 1024 + kt * 128 + 16 * c8)); }
        buf ^= 1;
#pragma unroll
        for (int i = 0; i < 16; ++i) v[i] = vn[i];
    }
#undef P0M_DECODE
    __syncthreads();
}
__device__ __forceinline__ void p0_prologue(Frame& F) {
    PHASE_BEGIN();
    const int tid = F.tid, lane = (F.tid & 63);
    {
        LAS float* cond = (LAS float*)F.lds;
        LAS float* part = (LAS float*)(F.lds + 32768);
        bool staged = false;
        for (int it = blockIdx.x; it < 2 * 96; it += GRIDN) {
            if (!staged) { for (int i = tid; i < 8 * 1024; i += NTHREADS) { const float v = KIN(I_C)[i]; cond[i] = v / (1.f + __expf(-v)); } staged = true; }
            __syncthreads();
            const int l = it / 96, cb = it % 96, ks = tid >> 6, col = tid & 63, n = cb * 64 + col;
            const float* w = KIN(I_WADA) + (size_t)l * 1024 * 6144 + n;
            float a[8];
#pragma unroll
            for (int b = 0; b < 8; ++b) a[b] = 0.f;
            for (int k = ks * 128; k < ks * 128 + 128; ++k) { const float wv = w[(size_t)k * 6144];
#pragma unroll
                for (int b = 0; b < 8; ++b) a[b] += cond[b * 1024 + k] * wv; }
#pragma unroll
            for (int b = 0; b < 8; ++b) part[(ks * 8 + b) * 64 + col] = a[b];
            __syncthreads();
            { const int b = tid >> 6; float s = 0.f;
#pragma unroll
              for (int q = 0; q < 8; ++q) s += part[(q * 8 + b) * 64 + col];
              WSP(float, WS_MOD)[((size_t)l * 8 + b) * 6144 + n] = s + KIN(I_BADA)[l * 6144 + n]; }
        }
        __syncthreads();
    }
    {
        LAS float* As = (LAS float*)F.lds;
        LAS float* Us = (LAS float*)(F.lds + 64 * 129 * 4);
        for (int it = blockIdx.x; it < 128; it += GRIDN) {
            const int l = it >> 6, h = (it >> 4) & 3, kb = it & 15, k0 = kb * 64;
            __syncthreads();
            for (int i = tid; i < 64 * 128; i += NTHREADS) { const int k = i >> 7, d = i & 127; As[k * 129 + d] = KIN(I_WIN)[((size_t)l * 1024 + k0 + k) * D_IN + 1544 + h * 128 + d]; }
            for (int i = tid; i < 128 * 128; i += NTHREADS) { const int c = i >> 7, d = i & 127; Us[c * 129 + d] = KIN(I_WUK)[(((size_t)l * 4 + h) * 128 + c) * 128 + d]; }
            __syncthreads();
            const int c = tid & 127, kq = tid >> 7; float a[16];
#pragma unroll
            for (int i = 0; i < 16; ++i) a[i] = 0.f;
            for (int d = 0; d < 128; ++d) { const float u = Us[c * 129 + d];
#pragma unroll
                for (int i = 0; i < 16; ++i) a[i] += u * As[(kq * 16 + i) * 129 + d]; }
            const float sc = 0.08838834764831845f;
            bf16* dst = WSP(bf16, WS_WIN_T) + ((size_t)l * NV + 1536 + h * 128 + c) * 1024 + k0 + kq * 16;
            u32x4 o0, o1; o0.x = pk2(a[0] * sc, a[1] * sc); o0.y = pk2(a[2] * sc, a[3] * sc); o0.z = pk2(a[4] * sc, a[5] * sc); o0.w = pk2(a[6] * sc, a[7] * sc);
            o1.x = pk2(a[8] * sc, a[9] * sc); o1.y = pk2(a[10] * sc, a[11] * sc); o1.z = pk2(a[12] * sc, a[13] * sc); o1.w = pk2(a[14] * sc, a[15] * sc);
            *(u32x4*)dst = o0; *(u32x4*)(dst + 8) = o1;
            if (kb == 0 && kq == 0) { float s = 0.f; for (int d = 0; d < 128; ++d) s += Us[c * 129 + d] * KIN(I_BIN)[l * D_IN + 1544 + h * 128 + d];
                WSP(float, WS_BINP)[l * NV + 1536 + h * 128 + c] = s * sc; }
        }
        __syncthreads();
    }
    {
        LAS float* Us = (LAS float*)F.lds;
        LAS float* Bs = (LAS float*)(F.lds + 128 * 129 * 4);
        for (int it = blockIdx.x; it < 128; it += GRIDN) {
            const int l = it >> 6, h = (it >> 4) & 3, nb = it & 15, n0 = nb * 64;
            __syncthreads();
            for (int i = tid; i < 128 * 128; i += NTHREADS) { const int c = i >> 7, d = i & 127; Us[c * 129 + d] = KIN(I_WUV)[(((size_t)l * 4 + h) * 128 + c) * 128 + d]; }
            for (int i = tid; i < 128 * 64; i += NTHREADS) { const int d = i >> 6, n = i & 63; Bs[d * 65 + n] = KIN(I_WBRDSA)[((size_t)l * 512 + h * 128 + d) * 1024 + n0 + n]; }
            __syncthreads();
            const int c = tid & 127, nq = tid >> 7; float a[16];
#pragma unroll
            for (int i = 0; i < 16; ++i) a[i] = 0.f;
            for (int d = 0; d < 128; ++d) { const float u = Us[c * 129 + d];
#pragma unroll
                for (int i = 0; i < 16; ++i) a[i] += u * Bs[d * 65 + nq * 16 + i]; }
#pragma unroll
            for (int i = 0; i < 16; ++i) WSP(bf16, WS_WBR_T)[((size_t)l * 3072 + 1024 + n0 + nq * 16 + i) * 512 + h * 128 + c] = (bf16)f2bf(a[i]);
        }
        __syncthreads();
    }
    for (int i = blockIdx.x * NTHREADS + tid; i < 2 * 32 * 1024; i += GRIDN * NTHREADS) { const int l = i >> 15, e = (i >> 10) & 31, k = i & 1023;
        const float w = KIN(I_WR)[((size_t)l * 1024 + k) * 32 + e]; const unsigned hi = f2bf(w), lo = f2bf(w - bf2f(hi));
        WSP(bf16, WS_WRT)[((size_t)l * 2 + 0) * 32768 + e * 1024 + k] = (bf16)hi; WSP(bf16, WS_WRT)[((size_t)l * 2 + 1) * 32768 + e * 1024 + k] = (bf16)lo; }
    for (int i = blockIdx.x * NTHREADS + tid; i < 2 * NV; i += GRIDN * NTHREADS) { const int l = i / NV, v = i % NV; const int r = vcol_real(v);
        if (!(v >= 1536 && v < 2048)) WSP(float, WS_BINP)[i] = r >= 0 ? KIN(I_BIN)[l * D_IN + r] : 0.f; }
    LAS float* scr = (LAS float*)(F.lds + F.wave * 16384);
    const int gw = vcu_id() * NWAVES + F.wave, NGW = GRIDN * NWAVES;
    constexpr int IT_IN = 16 * (NV / 32), IT_BR = 8 * 32, IT_OUT = 16 * 32;
    constexpr int N_IN = 2 * IT_IN, N_BR = 2 * 2 * IT_BR, N_OUT = 2 * IT_OUT;
    constexpr int IT_IN8 = 16 * (24 * 8), N_IN8 = 2 * IT_IN8;
    constexpr int N_ALL = N_IN + N_BR + N_OUT + N_IN8;
    auto decode = [&](int it) -> P0Item {
        P0Item d; d.fp8 = false; d.valid = it < N_ALL; d.W = nullptr; d.WT = nullptr; d.ldw = 0; d.K = 0; d.destrow0 = 0; d.k0 = 0; d.srccol4 = -1;
        if (!d.valid) return d;
        int r = it;
        if (r < N_IN) { const int l = r / IT_IN, q = r % IT_IN, kb = q / (NV / 32), nb = q % (NV / 32), v = nb * 32 + 4 * (lane & 7);
            if (nb < 48 || nb >= 80) { d.valid = false; return d; }
            if (nb * 32 >= 1536 && nb * 32 < 2048) { d.valid = false; return d; }
            d.W = KIN(I_WIN) + (size_t)l * 1024 * D_IN; d.ldw = D_IN; d.K = 1024; d.WT = WSP(bf16, WS_WIN_T) + (size_t)l * NV * 1024; d.destrow0 = nb * 32; d.k0 = kb * 64; d.srccol4 = vcol_real(v); return d; }
        r -= N_IN;
        if (r < N_BR) { const int l = r / (2 * IT_BR), q = r % (2 * IT_BR), which = q / IT_BR, q2 = q % IT_BR, kb = q2 / 32, nb = q2 % 32;
            d.W = (which ? KIN(I_WBRFOX) : KIN(I_WBRML)) + (size_t)l * 512 * 1024; d.ldw = 1024; d.K = 512; d.WT = WSP(bf16, WS_WBR_T) + (size_t)l * 3072 * 512; d.destrow0 = (which ? 2048 : 0) + nb * 32; d.k0 = kb * 64; d.srccol4 = nb * 32 + 4 * (lane & 7); return d; }
        r -= N_BR;
        if (r < N_OUT) { const int l = r / IT_OUT, q = r % IT_OUT, kb = q / 32, nb = q % 32;
            d.fp8 = true; d.W = KIN(I_WOUT) + (size_t)l * 1024 * 1024; d.ldw = 1024; d.K = 1024; d.WT = (bf16*)(WSP(unsigned char, WS_WOUT8_) + (size_t)l * 1024 * 1024); d.destrow0 = nb * 32; d.k0 = kb * 64; d.srccol4 = nb * 32 + 4 * (lane & 7); return d; }
        r -= N_OUT;
        if (r < N_IN8) { const int l = r / IT_IN8, q = r % IT_IN8, kb = q / 192, nv = q % 192, tv = nv >> 3, nb = (tv < 6 ? tv : tv + 4) * 8 + (nv & 7), v = nb * 32 + 4 * (lane & 7);
            d.fp8 = true; d.W = KIN(I_WIN) + (size_t)l * 1024 * D_IN; d.ldw = D_IN; d.K = 1024; d.WT = (bf16*)(WSP(unsigned char, WS_WIN8_) + (size_t)l * NV * 1024); d.destrow0 = nb * 32; d.k0 = kb * 64; d.srccol4 = vcol_real(v); return d; }
        d.valid = false; return d;
    };
    P0Item cur = decode(gw); f32x4 vc[8], vn[8]; p0_load(cur, vc, lane);
    for (int it = gw; it < N_ALL; it += NGW) {
        const P0Item nxt = decode(it + NGW); p0_load(nxt, vn, lane);
        p0_finish(cur, vc, scr, lane);
        cur = nxt;
#pragma unroll
        for (int i = 0; i < 8; ++i) vc[i] = vn[i];
    }
}

__device__ __forceinline__ void norm_rows(Frame& F, const float* xsrc, int l, int shoff, int scoff) {
    PHASE_BEGIN();
    const int gw = blockIdx.x * NWAVES + F.wave, lane = (F.tid & 63), c0 = 16 * lane, m0 = gw * 8;
    const float* mo = WSP(float, WS_MOD) + (size_t)l * 8 * 6144 + (size_t)(m0 >> 11) * 6144; bf16* XN = WSP(bf16, WS_XN);
    f32x4 sh[4], sc[4];
#pragma unroll
    for (int q = 0; q < 4; ++q) { sh[q] = *(const f32x4*)(mo + shoff + c0 + 4 * q); sc[q] = *(const f32x4*)(mo + scoff + c0 + 4 * q); }
    for (int t = 0; t < 8; ++t) {
        const int m = m0 + t;
        f32x4 v[4]; float s = 0.f;
#pragma unroll
        for (int q = 0; q < 4; ++q) { v[q] = *(const f32x4*)(xsrc + (size_t)m * D + c0 + 4 * q); s += (v[q].x * v[q].x + v[q].y * v[q].y) + (v[q].z * v[q].z + v[q].w * v[q].w); }
        const float r = 1.0f / sqrtf(wave_sum(s) * (1.0f / D) + EPS);
        unsigned wb[8], w8[4];
#pragma unroll
        for (int q = 0; q < 4; ++q) { const f32x4 h = v[q] * r * (1.0f + sc[q]) + sh[q]; wb[2 * q] = pk2(h.x, h.y); wb[2 * q + 1] = pk2(h.z, h.w); w8[q] = pk4_fp8(h.x, h.y, h.z, h.w); }
        *(u32x4*)(XN + (size_t)m * D + c0) = (u32x4){wb[0], wb[1], wb[2], wb[3]}; *(u32x4*)(XN + (size_t)m * D + c0 + 8) = (u32x4){wb[4], wb[5], wb[6], wb[7]};
        *(u32x4*)(WSP(unsigned char, WS_XN1_8_) + (size_t)m * D + c0) = (u32x4){w8[0], w8[1], w8[2], w8[3]};
    }
}
__device__ __forceinline__ void route_phase(Frame& F, int l, const float* xsrc, bool dry = false) {
    PHASE_BEGIN();
    LAS int* lcnt = (LAS int*)F.lds;
    LAS float* lg = (LAS float*)(F.lds + 1024);
    const int tid = F.tid, lane = (F.tid & 63), w = F.wave;
    if (tid < 32) lcnt[tid] = 0;
    const float* modl = WSP(float, WS_MOD) + (size_t)l * 8 * 6144;
    bf16* XN = dry ? WSP(bf16, WS_DRY) : WSP(bf16, WS_XN); bf16* XNL = dry ? WSP(bf16, WS_DRY + 32 * MiB) : WSP(bf16, WS_XNL);
    const bf16* WH = WSP(bf16, WS_WRT) + (size_t)l * 2 * 32768; const bf16* WL = WH + 32768;
    for (int rb = blockIdx.x; rb < M / 64; rb += GRIDN) {
        __syncthreads();
        {
            const int c0 = 16 * lane; const float* mo = modl + (size_t)((rb * 64) >> 11) * 6144;
            f32x4 sh[4], sc[4];
#pragma unroll
            for (int q = 0; q < 4; ++q) { sh[q] = *(const f32x4*)(mo + 3072 + c0 + 4 * q); sc[q] = *(const f32x4*)(mo + 4096 + c0 + 4 * q); }
            unsigned char* XN8 = dry ? WSP(unsigned char, WS_DRY + 100 * MiB) : WSP(unsigned char, WS_XN8);
            for (int i0 = 0; i0 < 8; i0 += 4) {
              f32x4 vv[4][4];
#pragma unroll
              for (int i = 0; i < 4; ++i)
#pragma unroll
                for (int q = 0; q < 4; ++q) vv[i][q] = *(const f32x4*)(xsrc + (size_t)(rb * 64 + w * 8 + i0 + i) * D + c0 + 4 * q);
#pragma unroll
              for (int i = 0; i < 4; ++i) {
                const int m = rb * 64 + w * 8 + i0 + i;
                f32x4 v[4]; float s = 0.f;
#pragma unroll
                for (int q = 0; q < 4; ++q) { v[q] = vv[i][q]; s += (v[q].x * v[q].x + v[q].y * v[q].y) + (v[q].z * v[q].z + v[q].w * v[q].w); }
                const float r = 1.0f / sqrtf(wave_sum(s) * (1.0f / D) + EPS);
                unsigned wh[8], wl[8], w8[4];
#pragma unroll
                for (int q = 0; q < 4; ++q) { const f32x4 h = v[q] * r * (1.0f + sc[q]) + sh[q];
                    const unsigned h0 = f2bf(h.x), h1 = f2bf(h.y), h2 = f2bf(h.z), h3 = f2bf(h.w);
                    wh[2 * q] = h0 | (h1 << 16); wh[2 * q + 1] = h2 | (h3 << 16);
                    wl[2 * q] = pk2(h.x - bf2f(h0), h.y - bf2f(h1)); wl[2 * q + 1] = pk2(h.z - bf2f(h2), h.w - bf2f(h3)); w8[q] = pk4_fp8(h.x, h.y, h.z, h.w); }
                *(u32x4*)(XN + (size_t)m * D + c0) = (u32x4){wh[0], wh[1], wh[2], wh[3]}; *(u32x4*)(XN + (size_t)m * D + c0 + 8) = (u32x4){wh[4], wh[5], wh[6], wh[7]};
                *(u32x4*)(XNL + (size_t)m * D + c0) = (u32x4){wl[0], wl[1], wl[2], wl[3]}; *(u32x4*)(XNL + (size_t)m * D + c0 + 8) = (u32x4){wl[4], wl[5], wl[6], wl[7]};
                *(u32x4*)(XN8 + (size_t)m * D + c0) = (u32x4){w8[0], w8[1], w8[2], w8[3]};
              }
            }
        }
        VM_WAIT(); __builtin_amdgcn_fence(__ATOMIC_ACQUIRE, "agent"); VM_WAIT(); __syncthreads();
        {
            f32x4 acc[4][2];
#pragma unroll
            for (int rt = 0; rt < 4; ++rt) { acc[rt][0] = ozero4(); acc[rt][1] = acc[rt][0]; }
            const int fr = lane & 15, kq = lane >> 4, kb = 128 * w + 8 * kq;
            const bf16* pa = XN + (size_t)(rb * 64 + fr) * D + kb; const bf16* pal = XNL + (size_t)(rb * 64 + fr) * D + kb;
            const bf16* pbh = WH + (size_t)fr * 1024 + kb; const bf16* pbl = WL + (size_t)fr * 1024 + kb;
#pragma unroll
            for (int ks = 0; ks < 4; ++ks) {
                bf16x8 ah[4], al[4], bh[2], bl[2];
#pragma unroll
                for (int rt = 0; rt < 4; ++rt) { ah[rt] = *(const bf16x8*)(pa + (size_t)rt * 16 * D + ks * 32); al[rt] = *(const bf16x8*)(pal + (size_t)rt * 16 * D + ks * 32); }
#pragma unroll
                for (int et = 0; et < 2; ++et) { bh[et] = *(const bf16x8*)(pbh + et * 16 * 1024 + ks * 32); bl[et] = *(const bf16x8*)(pbl + et * 16 * 1024 + ks * 32); }
#pragma unroll
                for (int rt = 0; rt < 4; ++rt)
#pragma unroll
                    for (int et = 0; et < 2; ++et) {
                        acc[rt][et] = __builtin_amdgcn_mfma_f32_16x16x32_bf16(ah[rt], bh[et], acc[rt][et], 0, 0, 0);
                        acc[rt][et] = __builtin_amdgcn_mfma_f32_16x16x32_bf16(ah[rt], bl[et], acc[rt][et], 0, 0, 0);
                        acc[rt][et] = __builtin_amdgcn_mfma_f32_16x16x32_bf16(al[rt], bh[et], acc[rt][et], 0, 0, 0); }
            }
            LAS float* part = (LAS float*)(F.lds + 16384);
#pragma unroll
            for (int rt = 0; rt < 4; ++rt)
#pragma unroll
                for (int et = 0; et < 2; ++et)
#pragma unroll
                    for (int rg = 0; rg < 4; ++rg) part[(w * 64 + rt * 16 + 4 * kq + rg) * 33 + et * 16 + fr] = acc[rt][et][rg];
            __syncthreads();
            {   const int row = tid >> 3, e4 = (tid & 7) * 4;
#pragma unroll
                for (int j = 0; j < 4; ++j) { float sum = 0.f;
#pragma unroll
                    for (int ww = 0; ww < 8; ++ww) sum += part[(ww * 64 + row) * 33 + e4 + j];
                    lg[row * 33 + e4 + j] = sum + KIN(I_BR)[l * 32 + e4 + j]; } }
        }
        __syncthreads();
        if (w == 0) {
            float v[32];
#pragma unroll
            for (int e = 0; e < 32; ++e) v[e] = lg[lane * 33 + e];
            int idx[4]; float val[4];
#pragma unroll
            for (int k = 0; k < 4; ++k) { float best = v[0]; int bi = 0;
#pragma unroll
                for (int e = 1; e < 32; ++e) { const bool g = v[e] > best; best = g ? v[e] : best; bi = g ? e : bi; }
                val[k] = best; idx[k] = bi;
#pragma unroll
                for (int e = 0; e < 32; ++e) v[e] = (e == bi) ? -__builtin_inff() : v[e]; }
            const float p1 = __expf(val[1] - val[0]), p2 = __expf(val[2] - val[0]), p3 = __expf(val[3] - val[0]), inv = 1.0f / (1.0f + p1 + p2 + p3);
            const float gt[4] = {inv, p1 * inv, p2 * inv, p3 * inv};
            const int m = rb * 64 + lane;
#pragma unroll
            for (int k = 0; k < 4; ++k) { const int lr = __hip_atomic_fetch_add(lcnt + idx[k], 1, __ATOMIC_RELAXED, __HIP_MEMORY_SCOPE_WORKGROUP);
                int* eo = dry ? WSP(int, WS_DRY + 96 * MiB) : WSP(int, WS_EIDX); float* go = dry ? WSP(float, WS_DRY + 97 * MiB) : WSP(float, WS_GATE); int* lo_ = dry ? WSP(int, WS_DRY + 98 * MiB) : WSP(int, WS_LRANK);
                eo[m * 4 + k] = idx[k]; go[m * 4 + k] = gt[k]; lo_[m * 4 + k] = lr; }
        }
    }
    __syncthreads();
    if (tid < 32 && !dry) { const int base = (int)__hip_atomic_fetch_add(KCTL + CW_GCNT + l * 64 + tid, (unsigned)lcnt[tid], __ATOMIC_RELAXED, __HIP_MEMORY_SCOPE_AGENT);
        WSP(int, WS_BASE)[blockIdx.x * 32 + tid] = base; }
    __syncthreads();
}
__device__ __forceinline__ void gather_phase(Frame& F, int l) {
    PHASE_BEGIN();
    LAS int* tst = (LAS int*)(F.lds + LDSCTL_OFF);
    LAS int* tmp = (LAS int*)F.lds;
    if (F.tid < 32) tmp[F.tid] = (int)((__hip_atomic_load(KCTL + CW_GCNT + l * 64 + F.tid, __ATOMIC_RELAXED, __HIP_MEMORY_SCOPE_AGENT) + 255u) >> 8);
    __syncthreads();
    if (F.tid == 0) { int a = 0; for (int e = 0; e < 32; ++e) { tst[e] = a; a += tmp[e]; } tst[32] = a; }
    __syncthreads();
    const int gw = blockIdx.x * NWAVES + F.wave, lane = (F.tid & 63), p0 = gw * 32;
    const unsigned char* XN = WSP(unsigned char, WS_XN8); unsigned char* AS = WSP(unsigned char, WS_AS8);
    int dest = 0;
    if (lane < 32) { const int p = p0 + lane, tok = p >> 2, e = WSP(int, WS_EIDX)[p];
        dest = tst[e] * 256 + WSP(int, WS_BASE)[((tok >> 6) % GRIDN) * 32 + e] + WSP(int, WS_LRANK)[p];
        WSP(int, WS_PPOS)[p] = dest; }
    u32x4 rows[8];
#pragma unroll
    for (int t = 0; t < 8; ++t) rows[t] = *((const u32x4*)(XN + (size_t)(gw * 8 + t) * D) + lane);
#pragma unroll
    for (int i = 0; i < 32; ++i) { const int d = __builtin_amdgcn_readlane(dest, i); *((u32x4*)(AS + (size_t)d * D) + lane) = rows[i >> 2]; }
}
__device__ __forceinline__ void combine_phase(Frame& F, int l, const float* xsrc, bool last, bool dry = false) {
    PHASE_BEGIN();
    const int gw = blockIdx.x * NWAVES + F.wave, lane = (F.tid & 63), c0 = 16 * lane;
    const float* modl = WSP(float, WS_MOD) + (size_t)l * 8 * 6144; const float* modn = WSP(float, WS_MOD) + (size_t)(l + 1) * 8 * 6144;
    const unsigned char* YP = WSP(unsigned char, WS_ASORT); float* X = dry ? WSP(float, WS_DRY) : WSP(float, WS_X); bf16* XN = dry ? WSP(bf16, WS_DRY + 64 * MiB) : WSP(bf16, WS_XN);
    unsigned char* XN8 = dry ? WSP(unsigned char, WS_DRY + 96 * MiB) : WSP(unsigned char, WS_XN1_8_);
    const int m0 = gw * 8, b = m0 >> 11;
    f32x4 g2[4], sh[4], sc[4];
#pragma unroll
    for (int q = 0; q < 4; ++q) { g2[q] = *(const f32x4*)(modl + (size_t)b * 6144 + 5120 + c0 + 4 * q);
        if (last) { sh[q] = *(const f32x4*)(KIN(I_FG) + c0 + 4 * q); sc[q] = sh[q]; }
        else { sh[q] = *(const f32x4*)(modn + (size_t)b * 6144 + c0 + 4 * q); sc[q] = *(const f32x4*)(modn + (size_t)b * 6144 + 1024 + c0 + 4 * q); } }
    typedef int i32x4_t __attribute__((ext_vector_type(4)));
    i32x4_t posn = *(const i32x4_t*)(WSP(int, WS_PPOS) + (size_t)m0 * 4); f32x4 gkn = *(const f32x4*)(WSP(float, WS_GATE) + (size_t)m0 * 4);
    u32x4 yqn[4]; f32x4 vn[4]; f32x4 gk1 = gkn;
#pragma unroll
    for (int k = 0; k < 4; ++k) yqn[k] = *(const u32x4*)(YP + (size_t)posn[k] * D + c0);
#pragma unroll
    for (int q = 0; q < 4; ++q) vn[q] = *(const f32x4*)(xsrc + (size_t)m0 * D + c0 + 4 * q);
    posn = *(const i32x4_t*)(WSP(int, WS_PPOS) + (size_t)(m0 + 1) * 4); gkn = *(const f32x4*)(WSP(float, WS_GATE) + (size_t)(m0 + 1) * 4);
    for (int t = 0; t < 8; ++t) {
        const int m = m0 + t;
        const f32x4 gk = gk1 * 0.0625f;
        u32x4 yq[4]; f32x4 v[4];
#pragma unroll
        for (int k = 0; k < 4; ++k) yq[k] = yqn[k];
#pragma unroll
        for (int q = 0; q < 4; ++q) v[q] = vn[q];
        if (t < 7) {
#pragma unroll
            for (int k = 0; k < 4; ++k) yqn[k] = *(const u32x4*)(YP + (size_t)posn[k] * D + c0);
#pragma unroll
            for (int q = 0; q < 4; ++q) vn[q] = *(const f32x4*)(xsrc + (size_t)(m + 1) * D + c0 + 4 * q);
            gk1 = gkn;
            const int m2 = (t < 6) ? m + 2 : m + 1;
            posn = *(const i32x4_t*)(WSP(int, WS_PPOS) + (size_t)m2 * 4); gkn = *(const f32x4*)(WSP(float, WS_GATE) + (size_t)m2 * 4); }
        float s = 0.f;
#pragma unroll
        for (int q = 0; q < 4; ++q) { f32x4 y = {0.f, 0.f, 0.f, 0.f};
#pragma unroll
            for (int k = 0; k < 4; ++k) { const f32x2 lo = __builtin_amdgcn_cvt_pk_f32_fp8((int)yq[k][q], false), hi = __builtin_amdgcn_cvt_pk_f32_fp8((int)yq[k][q], true);
                y.x += gk[k] * lo[0]; y.y += gk[k] * lo[1]; y.z += gk[k] * hi[0]; y.w += gk[k] * hi[1]; }
            v[q] = v[q] + g2[q] * y; s += (v[q].x * v[q].x + v[q].y * v[q].y) + (v[q].z * v[q].z + v[q].w * v[q].w); }
        const float r = 1.0f / sqrtf(wave_sum(s) * (1.0f / D) + EPS);
        if (last) {
#pragma unroll
            for (int q = 0; q < 4; ++q) *(f32x4*)(KOUT + (size_t)m * D + c0 + 4 * q) = v[q] * r * sh[q];
        } else {
            unsigned w8[4]; unsigned wb[8];
#pragma unroll
            for (int q = 0; q < 4; ++q) { *(f32x4*)(X + (size_t)m * D + c0 + 4 * q) = v[q];
                const f32x4 h = v[q] * r * (1.0f + sc[q]) + sh[q]; wb[2 * q] = pk2(h.x, h.y); wb[2 * q + 1] = pk2(h.z, h.w); w8[q] = pk4_fp8(h.x, h.y, h.z, h.w); }
            *(u32x4*)(XN + (size_t)m * D + c0) = (u32x4){wb[0], wb[1], wb[2], wb[3]}; *(u32x4*)(XN + (size_t)m * D + c0 + 8) = (u32x4){wb[4], wb[5], wb[6], wb[7]};
            *(u32x4*)(XN8 + (size_t)m * D + c0) = (u32x4){w8[0], w8[1], w8[2], w8[3]};
        }
    }
}

template <int NTN> struct MoeSched {
    const LAS int* tst; int total, G, c; int deg = 0;
    __device__ __forceinline__ bool next(int i, pg8::Unit& u) const {
        const int L = i * G + c; if (L >= total) return false;
        const int rt = L / NTN, j = L - rt * NTN; int e = 0;
#pragma unroll
        for (int k = 1; k < 32; ++k) e += (rt >= tst[k]) ? 1 : 0;
        u.pm = rt; u.pn = e * NTN + j;
        if (DUP_MASK && deg) { u.pm = 0; u.pn = j; }
        return true;
    }
    __device__ __forceinline__ void a_ready(const pg8::Unit&) const {}
    __device__ __forceinline__ void done(const pg8::Unit&) const {}
};
struct EpiMoe1 {
    static constexpr bool PERM = true, AFTER_DRAIN = false;
    bf16* ACT; const float* b1;
    __device__ __forceinline__ void operator()(const f32x4 (&acc)[2][2][4][2], const pg8::Unit& u, int wr, int wc, int fr, int fq) const {
        asm volatile("" : "+v"(fr), "+v"(fq));
        const int e = u.pn >> 3, j = u.pn & 7, row0 = u.pm * 256 + wr * 64 + fr, c0 = j * 128 + 32 * wc + 8 * fq;
        f32x4 bg[2], bl[2];
#pragma unroll
        for (int n = 0; n < 2; ++n) { bg[n] = *(const f32x4*)(b1 + (size_t)e * 2048 + c0 + 4 * n); bl[n] = *(const f32x4*)(b1 + (size_t)e * 2048 + 1024 + c0 + 4 * n); }
#pragma unroll
        for (int ai = 0; ai < 2; ++ai)
#pragma unroll
            for (int m = 0; m < 4; ++m) { unsigned w[4];
#pragma unroll
                for (int n = 0; n < 2; ++n) { const f32x4 g = acc[ai][0][m][n] + bg[n], li = acc[ai][1][m][n] + bl[n]; float o[4];
#pragma unroll
                    for (int q = 0; q < 4; ++q) { const float gl = fminf(g[q], 7.0f), ln = fminf(fmaxf(li[q], -7.0f), 7.0f);
                        o[q] = gl * (ln + 1.0f) * __builtin_amdgcn_rcpf(1.0f + __builtin_amdgcn_exp2f(-2.4554669595930156f * gl)); }
                    w[2 * n] = pg8::cvt_pk_bf16(o[0], o[1]); w[2 * n + 1] = pg8::cvt_pk_bf16(o[2], o[3]); }
                *(u32x4*)(ACT + (size_t)(row0 + ai * 128 + m * 16) * D + c0) = (u32x4){w[0], w[1], w[2], w[3]}; }
    }
};
struct EpiMoe2 {
    static constexpr bool PERM = true, AFTER_DRAIN = false;
    bf16* YP; const float* b2; const float* rowgate;
    __device__ __forceinline__ void operator()(const f32x4 (&acc)[2][2][4][2], const pg8::Unit& u, int wr, int wc, int fr, int fq) const {
        asm volatile("" : "+v"(fr), "+v"(fq));
        const int e = u.pn >> 2, row0 = u.pm * 256 + wr * 64 + fr, c0 = (u.pn & 3) * 256 + 32 * wc + 8 * fq;
        f32x4 bv[2][2];
#pragma unroll
        for (int bj = 0; bj < 2; ++bj)
#pragma unroll
            for (int n = 0; n < 2; ++n) bv[bj][n] = *(const f32x4*)(b2 + (size_t)e * 1024 + c0 + bj * 128 + 4 * n);
#pragma unroll
        for (int ai = 0; ai < 2; ++ai)
#pragma unroll
            for (int m = 0; m < 4; ++m) { const int row = row0 + ai * 128 + m * 16; const float g = rowgate[row];
#pragma unroll
                for (int bj = 0; bj < 2; ++bj) { const f32x4 v0 = (acc[ai][bj][m][0] + bv[bj][0]) * g, v1 = (acc[ai][bj][m][1] + bv[bj][1]) * g;
                    *(u32x4*)(YP + (size_t)row * D + c0 + bj * 128) = (u32x4){pg8::cvt_pk_bf16(v0[0], v0[1]), pg8::cvt_pk_bf16(v0[2], v0[3]), pg8::cvt_pk_bf16(v1[0], v1[1]), pg8::cvt_pk_bf16(v1[2], v1[3])}; } }
    }
};

struct EpiW1 {
    unsigned char* ACT8; const float* b1;
    __device__ __forceinline__ void operator()(const f32x4 (&acc)[4][8], const pg8::Unit& u, int wr, int wc, int fr, int fq) const {
        asm volatile("" : "+v"(fr), "+v"(fq));
        const int e = u.pn >> 3, j = u.pn & 7, row0 = u.pm * 256 + wr * 64 + fr, c0 = j * 128 + wc * 64 + 4 * fq;
#pragma unroll
        for (int n = 0; n < 4; ++n) { const f32x4 bg = *(const f32x4*)(b1 + (size_t)e * 2048 + c0 + 16 * n), bl = *(const f32x4*)(b1 + (size_t)e * 2048 + 1024 + c0 + 16 * n);
#pragma unroll
            for (int m = 0; m < 4; ++m) { const f32x4 g = acc[m][n] + bg, li = acc[m][4 + n] + bl; float o[4];
#pragma unroll
                for (int q = 0; q < 4; ++q) { const float gl = fminf(g[q], 7.0f), ln = fminf(fmaxf(li[q], -7.0f), 7.0f);
                    o[q] = gl * (ln + 1.0f) * __builtin_amdgcn_rcpf(1.0f + __builtin_amdgcn_exp2f(-2.4554669595930156f * gl)); }
                *(unsigned*)(ACT8 + (size_t)(row0 + 16 * m) * D + c0 + 16 * n) = pk4_fp8(o[0], o[1], o[2], o[3]); } }
    }
};
struct EpiW2 {
    bf16* YP; const float* b2; const float* rowgate;
    __device__ __forceinline__ void operator()(const f32x4 (&acc)[4][8], const pg8::Unit& u, int wr, int wc, int fr, int fq) const {
        asm volatile("" : "+v"(fr), "+v"(fq));
        const int e = u.pn >> 2, row0 = u.pm * 256 + wr * 64 + fr, c0 = (u.pn & 3) * 256 + wc * 128 + 4 * fq;
        float gt[4];
#pragma unroll
        for (int m = 0; m < 4; ++m) gt[m] = rowgate[row0 + 16 * m];
#pragma unroll
        for (int n = 0; n < 8; ++n) { const f32x4 bv = *(const f32x4*)(b2 + (size_t)e * 1024 + c0 + 16 * n);
#pragma unroll
            for (int m = 0; m < 4; ++m) { const f32x4 v = (acc[m][n] + bv) * gt[m];
                *(u32x2*)(YP + (size_t)(row0 + 16 * m) * D + c0 + 16 * n) = (u32x2){pg8::cvt_pk_bf16(v[0], v[1]), pg8::cvt_pk_bf16(v[2], v[3])}; } }
    }
};
typedef __bf16 bf16x2_nt __attribute__((ext_vector_type(2)));
__device__ __forceinline__ unsigned cvtpk_c(float lo, float hi) { f32x2 v = {lo, hi}; bf16x2_nt b = __builtin_convertvector(v, bf16x2_nt); return __builtin_bit_cast(unsigned, b); }
struct EpiP1 {
    static constexpr bool PERM = true, AFTER_DRAIN = false, BIAS_INIT = true;
    unsigned char* ACT8; const float* b1;
    static constexpr int NSTORE = 16;
    __device__ __forceinline__ const float* bias_src(const pg8::Unit& u, int q) const { return b1 + (size_t)(u.pn >> 3) * 2048 + (q >> 5) * 1024 + (u.pn & 7) * 128 + 4 * (q & 31); }
    __device__ __forceinline__ void load_bias(f32x4 (&nb)[4], const PG8_LAS float* sl, int wc, int fq) const {
        const PG8_LAS float* bp = sl + 16 * wc + 4 * fq;
        nb[0] = *(const PG8_LAS f32x4*)bp; nb[1] = *(const PG8_LAS f32x4*)(bp + 128); nb[2] = *(const PG8_LAS f32x4*)(bp + 64); nb[3] = *(const PG8_LAS f32x4*)(bp + 128 + 64);
    }
    __device__ __forceinline__ void set_bias(f32x4 (&acc)[2][2][4][2], const f32x4 (&nb)[4]) const {
#pragma unroll
        for (int bj = 0; bj < 2; ++bj)
#pragma unroll
            for (int ai = 0; ai < 2; ++ai)
#pragma unroll
                for (int m = 0; m < 4; ++m) { acc[ai][bj][m][0] = nb[2 * bj]; acc[ai][bj][m][1] = nb[2 * bj + 1]; }
    }
    __device__ __forceinline__ void operator()(const f32x4 (&acc)[2][2][4][2], const pg8::Unit& u, int wr, int wc, int fr, int fq) const {
        asm volatile("" : "+v"(fr), "+v"(fq));
        const int j = u.pn & 7, row0 = u.pm * 256 + wr * 64 + fr, c0 = j * 128 + 16 * wc + 4 * fq;
#pragma unroll
        for (int ai = 0; ai < 2; ++ai)
#pragma unroll
            for (int m = 0; m < 4; ++m) { const int row = row0 + ai * 128 + m * 16;
#pragma unroll
                for (int bj = 0; bj < 2; ++bj) { const f32x4 g = acc[ai][bj][m][0], li = acc[ai][bj][m][1]; float o[4];
#pragma unroll
                    for (int q = 0; q < 4; ++q) { const float gl = fminf(g[q], 7.0f), ln = fminf(fmaxf(li[q], -7.0f), 7.0f);
                        o[q] = gl * (ln + 1.0f) * __builtin_amdgcn_rcpf(1.0f + __builtin_amdgcn_exp2f(-2.4554669595930156f * gl)); }
                    *(unsigned*)(ACT8 + (size_t)row * D + c0 + bj * 64) = pk4_fp8(o[0], o[1], o[2], o[3]); } }
    }
};
struct EpiP2 {
    static constexpr bool PERM = true, AFTER_DRAIN = false, BIAS_INIT = true;
    bf16* YP; const float* b2; int skip = 0;
    static constexpr int NSTORE = 16;
    __device__ __forceinline__ const float* bias_src(const pg8::Unit& u, int q) const { return b2 + (size_t)(u.pn >> 2) * 1024 + (u.pn & 3) * 256 + 4 * q; }
    __device__ __forceinline__ void load_bias(f32x4 (&nb)[4], const PG8_LAS float* sl, int wc, int fq) const {
        const PG8_LAS float* bp = sl + 32 * wc + 8 * fq;
        nb[0] = *(const PG8_LAS f32x4*)bp; nb[1] = *(const PG8_LAS f32x4*)(bp + 4); nb[2] = *(const PG8_LAS f32x4*)(bp + 128); nb[3] = *(const PG8_LAS f32x4*)(bp + 128 + 4);
    }
    __device__ __forceinline__ void set_bias(f32x4 (&acc)[2][2][4][2], const f32x4 (&nb)[4]) const {
#pragma unroll
        for (int bj = 0; bj < 2; ++bj)
#pragma unroll
            for (int ai = 0; ai < 2; ++ai)
#pragma unroll
                for (int m = 0; m < 4; ++m) { acc[ai][bj][m][0] = nb[2 * bj]; acc[ai][bj][m][1] = nb[2 * bj + 1]; }
    }
    __device__ __forceinline__ void operator()(const f32x4 (&acc)[2][2][4][2], const pg8::Unit& u, int wr, int wc, int fr, int fq) const {
        if (DUP_MASK != 0 && skip == 1) return;
        asm volatile("" : "+v"(fr), "+v"(fq));
        const int row0 = u.pm * 256 + wr * 64 + fr, c0 = (u.pn & 3) * 256 + 32 * wc + 8 * fq;
#pragma unroll
        for (int ai = 0; ai < 2; ++ai)
#pragma unroll
            for (int m = 0; m < 4; ++m) { const int row = row0 + ai * 128 + m * 16;
#pragma unroll
                for (int bj = 0; bj < 2; ++bj) { const f32x4 v0 = acc[ai][bj][m][0], v1 = acc[ai][bj][m][1];
                    *(u32x2*)((unsigned char*)YP + (size_t)row * D + c0 + bj * 128) = (u32x2){pk4_fp8(16.f * v0[0], 16.f * v0[1], 16.f * v0[2], 16.f * v0[3]), pk4_fp8(16.f * v1[0], 16.f * v1[1], 16.f * v1[2], 16.f * v1[3])}; } }
    }
};
struct EpiF8Moe1 {
    unsigned char* ACT8; const float* b1;
    __device__ __forceinline__ void operator()(const f32x4 (&acc)[4][4], const pg8::Unit& u, int wr, int wc, int fr, int fq) const {
        asm volatile("" : "+v"(fr), "+v"(fq));
        const int e = u.pn >> 4, j = u.pn & 15, row0 = u.pm * 256 + wr * 64 + fr, c0 = j * 64 + wc * 32 + 4 * fq;
        f32x4 bg[2], bl[2];
#pragma unroll
        for (int n = 0; n < 2; ++n) { bg[n] = *(const f32x4*)(b1 + (size_t)e * 2048 + c0 + 16 * n); bl[n] = *(const f32x4*)(b1 + (size_t)e * 2048 + 1024 + c0 + 16 * n); }
#pragma unroll
        for (int m = 0; m < 4; ++m)
#pragma unroll
            for (int n = 0; n < 2; ++n) { const f32x4 g = acc[m][n] + bg[n], li = acc[m][2 + n] + bl[n]; float o[4];
#pragma unroll
                for (int q = 0; q < 4; ++q) { const float gl = fminf(g[q], 7.0f), ln = fminf(fmaxf(li[q], -7.0f), 7.0f);
                    o[q] = gl * (ln + 1.0f) * __builtin_amdgcn_rcpf(1.0f + __builtin_amdgcn_exp2f(-2.4554669595930156f * gl)); }
                *(unsigned*)(ACT8 + (size_t)(row0 + 16 * m) * D + c0 + 16 * n) = pk4_fp8(o[0], o[1], o[2], o[3]); }
    }
};
struct EpiF8Moe2 {
    bf16* YP; const float* b2; const float* rowgate;
    __device__ __forceinline__ void operator()(const f32x4 (&acc)[4][4], const pg8::Unit& u, int wr, int wc, int fr, int fq) const {
        asm volatile("" : "+v"(fr), "+v"(fq));
        const int e = u.pn >> 3, row0 = u.pm * 256 + wr * 64 + fr, c0 = (u.pn & 7) * 128 + wc * 64 + 4 * fq;
        f32x4 bv[4];
#pragma unroll
        for (int n = 0; n < 4; ++n) bv[n] = *(const f32x4*)(b2 + (size_t)e * 1024 + c0 + 16 * n);
#pragma unroll
        for (int m = 0; m < 4; ++m) { const int row = row0 + 16 * m; const float g = rowgate[row];
#pragma unroll
            for (int n = 0; n < 4; ++n) { const f32x4 v = (acc[m][n] + bv[n]) * g;
                *(u32x2*)(YP + (size_t)row * D + c0 + 16 * n) = (u32x2){pg8::cvt_pk_bf16(v[0], v[1]), pg8::cvt_pk_bf16(v[2], v[3])}; } }
    }
};
namespace att {
typedef short s16x4 __attribute__((ext_vector_type(4)));
typedef float f32x16 __attribute__((ext_vector_type(16)));
constexpr int DH = 128, NW = 8, QBLK = 32, KVBLK = 64, QB = NW * QBLK;
constexpr int SHM_V = KVBLK * DH * 2, SHM_K = KVBLK * DH * 2;
constexpr int BODY_LDS = 2 * SHM_V + 2 * SHM_K + NW * 64 * 4;
constexpr int LDS_KB = BODY_LDS;
constexpr int LDS_BM = LDS_KB + 8192;
constexpr int LDS_SCAN = LDS_BM + 16384;
constexpr int LDS_GN = LDS_SCAN + 256;
constexpr float THR = 8.f;
#define KSWZ(row, colB) ((row) * 256 + ((colB) ^ (((row) & 7) << 4)))
#define SBAR() __builtin_amdgcn_sched_barrier(0)
__device__ __forceinline__ int v_st(int k, int c) { const int kk = (k & ~0xC) | ((k & 4) << 1) | ((k & 8) >> 1); return ((kk >> 3) * 4 + (c >> 5)) * 512 + ((kk & 7) * 32 + (c & 31)) * 2; }
__device__ __forceinline__ int v_rd_base(int lane) { return ((lane & 3) << 3) | (((lane >> 2) & 3) << 6) | (((lane >> 4) & 1) << 5) | (((lane >> 5) & 1) << 8); }
constexpr int v_rd_off(int d0, int ks, int half) { return d0 * 512 + ks * 4096 + half * 2048; }
__device__ __forceinline__ int crow(int r, int hi) { return (r & 3) + 8 * (r >> 2) + 4 * hi; }
__device__ __forceinline__ unsigned cvtpk(float lo, float hi) { unsigned r; asm volatile("v_cvt_pk_bf16_f32 %0, %1, %2" : "=v"(r) : "v"(lo), "v"(hi)); return r; }
__device__ __forceinline__ bf16x8 load8(const bf16* p) { return *reinterpret_cast<const bf16x8*>(p); }
__device__ __forceinline__ void mask_tile(f32x16& p0, f32x16& p1, int dq, unsigned W) {
    const float NEG = -__builtin_inff();
#pragma unroll
    for (int r = 0; r < 16; ++r) { const int c = (r & 3) + 8 * (r >> 2);
        if ((unsigned)(dq - c) >= W) p0[r] = NEG;
        if ((unsigned)(dq - c - 32) >= W) p1[r] = NEG; }
}
template <int MODE> __device__ __forceinline__ void partialSM(f32x16& p0, f32x16& p1, float& m_reg, float& mn, float& alpha) {
    constexpr float SCALE = MODE == 0 ? 0.08838834764831845f : 1.0f;
    float pmax = p0[0]; for (int r = 1; r < 16; ++r) pmax = fmaxf(pmax, p0[r]); for (int r = 0; r < 16; ++r) pmax = fmaxf(pmax, p1[r]);
    { auto rr = __builtin_amdgcn_permlane32_swap(__float_as_uint(pmax), __float_as_uint(pmax), false, false);
      pmax = fmaxf(__uint_as_float(rr[0]), __uint_as_float(rr[1])); }
    constexpr float C2 = 1.4426950408889634f * SCALE;
    if (__builtin_expect(__all((pmax - m_reg) * SCALE <= THR), 1)) { mn = m_reg; alpha = 1.f; }
    else { mn = fmaxf(m_reg, pmax); alpha = __builtin_amdgcn_exp2f((m_reg - mn) * C2); m_reg = mn; }
    const float mnL = -mn * C2;
    for (int r = 0; r < 16; ++r) p0[r] = fmaf(p0[r], C2, mnL); for (int r = 0; r < 16; ++r) p1[r] = fmaf(p1[r], C2, mnL);
    for (int r = 0; r < 16; ++r) p0[r] = __builtin_amdgcn_exp2f(p0[r]);
}
__device__ __forceinline__ void finishSM(f32x16& p0, f32x16& p1, float alpha, float& l_reg, bf16x8& pa0, bf16x8& pa1, bf16x8& pa2, bf16x8& pa3) {
    for (int r = 0; r < 16; ++r) p1[r] = __builtin_amdgcn_exp2f(p1[r]);
    float ps = 0; for (int r = 0; r < 16; ++r) ps += p0[r]; for (int r = 0; r < 16; ++r) ps += p1[r];
    { auto rr = __builtin_amdgcn_permlane32_swap(__float_as_uint(ps), __float_as_uint(ps), false, false);
      ps = __uint_as_float(rr[0]) + __uint_as_float(rr[1]); }
    l_reg = l_reg * alpha + ps;
#define PK4(P, B_, OUT) do { unsigned a0 = cvtpk(P[B_+0], P[B_+1]), a1 = cvtpk(P[B_+2], P[B_+3]);                          \
        unsigned b0 = cvtpk(P[B_+4], P[B_+5]), b1 = cvtpk(P[B_+6], P[B_+7]);                                             \
        auto r0 = __builtin_amdgcn_permlane32_swap(a0, b0, false, false); auto r1 = __builtin_amdgcn_permlane32_swap(a1, b1, false, false); \
        u32x4 w = {r0[0], r1[0], r0[1], r1[1]}; OUT = *reinterpret_cast<bf16x8*>(&w); } while (0)
    PK4(p0, 0, pa0); PK4(p0, 8, pa1); PK4(p1, 0, pa2); PK4(p1, 8, pa3);
}
template <int MODE> __device__ __forceinline__ void cinit(f32x16& p0, f32x16& p1, const char* lds, int kbase, int hi, int tq, int t) {
    if constexpr (MODE == 0) {
        const float* kb = (const float*)(lds + LDS_KB) + kbase + 4 * hi;
#pragma unroll
        for (int g = 0; g < 4; ++g) { const f32x4 a = *(const f32x4*)(kb + 8 * g), b = *(const f32x4*)(kb + 32 + 8 * g);
            p0[4 * g] = a[0]; p0[4 * g + 1] = a[1]; p0[4 * g + 2] = a[2]; p0[4 * g + 3] = a[3]; p1[4 * g] = b[0]; p1[4 * g + 1] = b[1]; p1[4 * g + 2] = b[2]; p1[4 * g + 3] = b[3]; }
    } else {
        const u32x2 w = *(const u32x2*)((const unsigned*)(lds + LDS_BM) + tq * 64 + 2 * t);
        const unsigned lo = w.x >> (4 * hi), hh = w.y >> (4 * hi);
        const float NEG = -__builtin_inff();
#pragma unroll
        for (int r = 0; r < 16; ++r) { const int c = (r & 3) + 8 * (r >> 2); p0[r] = ((lo >> c) & 1u) ? 0.f : NEG; p1[r] = ((hh >> c) & 1u) ? 0.f : NEG; }
    }
}
template <int KB>
__device__ __forceinline__ void qkt(f32x16& p0, f32x16& p1, const char* K_lds, int r32, int hi, const bf16x8* qr) {
    const char* kb[4];
#pragma unroll
    for (int dd = 0; dd < 4; ++dd) kb[dd] = K_lds + KB * SHM_K + KSWZ(r32, (dd * 16 + hi * 8) * 2);
#pragma unroll
    for (int d0 = 0; d0 < 8; ++d0) { const char* a = kb[d0 & 3] + (d0 >> 2) * 128;
        bf16x8 b0 = *reinterpret_cast<const bf16x8*>(a);
        bf16x8 b1 = *reinterpret_cast<const bf16x8*>(a + 32 * 256);
        p0 = __builtin_amdgcn_mfma_f32_32x32x16_bf16(b0, qr[d0], p0, 0, 0, 0);
        p1 = __builtin_amdgcn_mfma_f32_32x32x16_bf16(b1, qr[d0], p1, 0, 0, 0); }
}
template <int VB>
__device__ __forceinline__ void pv_tile(f32x16* o, int vb0, bf16x8 pa0, bf16x8 pa1, bf16x8 pa2, bf16x8 pa3) {
#define TRRD(dst, off) asm volatile("ds_read_b64_tr_b16 %0, %1 offset:%2" : "=&v"(dst) : "v"(vb0), "i"(off) : "memory")
#define PV_D0(d0) do { s16x4 l0, l1, l2, l3, h0, h1, h2, h3; constexpr int b_ = VB * SHM_V + v_rd_off(d0, 0, 0); \
        TRRD(l0, b_); TRRD(h0, b_ + 2048); TRRD(l1, b_ + 4096); TRRD(h1, b_ + 6144); TRRD(l2, b_ + 8192); TRRD(h2, b_ + 10240); TRRD(l3, b_ + 12288); TRRD(h3, b_ + 14336); \
        asm volatile("s_waitcnt lgkmcnt(0)" ::: "memory"); SBAR();   \
        o[d0] = __builtin_amdgcn_mfma_f32_32x32x16_bf16(pa0, (bf16x8){l0[0], l0[1], l0[2], l0[3], h0[0], h0[1], h0[2], h0[3]}, o[d0], 0, 0, 0);   \
        o[d0] = __builtin_amdgcn_mfma_f32_32x32x16_bf16(pa1, (bf16x8){l1[0], l1[1], l1[2], l1[3], h1[0], h1[1], h1[2], h1[3]}, o[d0], 0, 0, 0);   \
        o[d0] = __builtin_amdgcn_mfma_f32_32x32x16_bf16(pa2, (bf16x8){l2[0], l2[1], l2[2], l2[3], h2[0], h2[1], h2[2], h2[3]}, o[d0], 0, 0, 0);   \
        o[d0] = __builtin_amdgcn_mfma_f32_32x32x16_bf16(pa3, (bf16x8){l3[0], l3[1], l3[2], l3[3], h3[0], h3[1], h3[2], h3[3]}, o[d0], 0, 0, 0); } while (0)
    PV_D0(0); PV_D0(1); PV_D0(2); PV_D0(3);
#undef PV_D0
}
struct BlockRef { const bf16* Q; const bf16* K; const bf16* V; bf16* O; int ldo; int P0; int NT; const float* g; };
struct Seam { bf16x8 qr[8]; bf16x8 st_v0, st_v1, st_k0, st_k1; };
__device__ __forceinline__ bf16x8 nrm8(bf16x8 x, const float* gl) {
    const f32x4 g0 = *(const f32x4*)gl, g1 = *(const f32x4*)(gl + 4);
    float f[8]; float ss = 0.f;
#pragma unroll
    for (int i = 0; i < 8; ++i) { f[i] = bf2f((unsigned short)x[i]); ss += f[i] * f[i]; }
    ss += __builtin_bit_cast(float, __builtin_amdgcn_update_dpp(0, __builtin_bit_cast(int, ss), 0x128, 0xf, 0xf, false));
    ss += __builtin_bit_cast(float, __builtin_amdgcn_update_dpp(0, __builtin_bit_cast(int, ss), 0x124, 0xf, 0xf, false));
    ss += __builtin_bit_cast(float, __builtin_amdgcn_update_dpp(0, __builtin_bit_cast(int, ss), 0x122, 0xf, 0xf, false));
    ss += __builtin_bit_cast(float, __builtin_amdgcn_update_dpp(0, __builtin_bit_cast(int, ss), 0x121, 0xf, 0xf, false));
    const float r = __builtin_amdgcn_rsqf(ss * (1.0f / 128.0f) + EPS);
    u32x4 w = {cvtpk(f[0] * r * g0[0], f[1] * r * g0[1]), cvtpk(f[2] * r * g0[2], f[3] * r * g0[3]), cvtpk(f[4] * r * g1[0], f[5] * r * g1[1]), cvtpk(f[6] * r * g1[2], f[7] * r * g1[3])};
    return *reinterpret_cast<bf16x8*>(&w);
}
#define ROW(p, k0, rr) ((p) + (size_t)((k0) + (rr)) * DH + sc)
#define VMW() asm volatile("s_waitcnt vmcnt(0)" ::: "memory")
#define VMWN(n) asm volatile("s_waitcnt vmcnt(%0)" :: "i"(n) : "memory")
#define STG_IDS() int tid_s = tid; asm volatile("" : "+v"(tid_s)); const int sr = tid_s >> 4, sc = (tid_s & 15) * 8
#define SLOAD_H(Kp, Vp, k0) do { STG_IDS(); if constexpr (MODE == 0) { S.st_v0 = load8(ROW(Vp, k0, sr)); S.st_v1 = load8(ROW(Vp, k0, 32 + sr)); }             \
                         S.st_k0 = load8(ROW(Kp, k0, sr)); S.st_k1 = load8(ROW(Kp, k0, 32 + sr)); } while (0)
#define NORMKV() do { if constexpr (MODE == 1) { STG_IDS(); (void)sr; const float* glp = (const float*)(lds + LDS_GN) + sc; S.st_k0 = nrm8(S.st_k0, glp); S.st_k1 = nrm8(S.st_k1, glp); S.st_v0 = S.st_k0; S.st_v1 = S.st_k1; } } while (0)
#define SWRITE_HK(bf) do { STG_IDS(); const int kws = KSWZ(sr, sc * 2); *(bf16x8*)(K_lds + (bf) * SHM_K + kws) = S.st_k0; *(bf16x8*)(K_lds + (bf) * SHM_K + kws + 32 * 256) = S.st_k1; } while (0)
#define SWRITE_HV(bf) do { STG_IDS(); const int vst0 = v_st(sr, sc), vst1 = v_st(32 + sr, sc); *(bf16x8*)(V_lds + (bf) * SHM_V + vst0) = S.st_v0; *(bf16x8*)(V_lds + (bf) * SHM_V + vst1) = S.st_v1; } while (0)
#define SWRITE_H(bf) do { SWRITE_HV(bf); SWRITE_HK(bf); } while (0)
template <int MODE>
__device__ __forceinline__ void prime(const BlockRef& cur, char* lds, Seam& S, const int tid) {
    const int wid = __builtin_amdgcn_readfirstlane(tid >> 6), lane = tid & 63, r32 = lane & 31, hi = lane >> 5;
    char* K_lds = lds + 2 * SHM_V;
    for (int d0 = 0; d0 < 8; ++d0) S.qr[d0] = load8(cur.Q + (size_t)(wid * QBLK + r32) * DH + d0 * 16 + hi * 8);
    SLOAD_H(cur.K, cur.V, 0); VMW(); NORMKV(); SWRITE_HK(0);
    __syncthreads();
}
template <int MODE>
__device__ __forceinline__ void block(const BlockRef& cur, const BlockRef& nxt, char* lds, Seam& S, const int tid) {
    const int wid = __builtin_amdgcn_readfirstlane(tid >> 6), lane = tid & 63, r32 = lane & 31, hi = lane >> 5;
    const int NT = cur.NT;
    const int qlo = cur.P0 + wid * QBLK, qm = qlo + r32 - 4 * hi;
    const int tq = wid * 8 + (r32 >> 2);
    constexpr unsigned W = 1u << 30;
    char* V_lds = lds; char* K_lds = lds + 2 * SHM_V;
    float* ws = (float*)(lds + 2 * SHM_V + 2 * SHM_K) + wid * 64; float* li_l = ws, * al_l = ws + 32;
    float m_reg = -1e30f, l_reg = 0; f32x16 o[4]; { const f32x16 z16 = ozero16(); o[0] = z16; o[1] = z16; o[2] = z16; o[3] = z16; }
    const int vb0 = (int)(uintptr_t)V_lds + v_rd_base(lane);
    const bf16* Kh = cur.K; const bf16* Vh = cur.V;
#define RESC(a) do { if (__any((a) < 1.f)) { if (hi == 0) al_l[r32] = (a); asm volatile("s_waitcnt lgkmcnt(0)" ::: "memory");              \
                     for (int d_ = 0; d_ < 4; ++d_) for (int r = 0; r < 16; ++r) o[d_][r] *= al_l[crow(r, hi)]; } } while (0)
#define KBASE(t) ((t) * KVBLK)
#define MASKT(P0_, P1_, t) do { if constexpr (MODE == 0) { const int kb_ = KBASE(t); if (kb_ + KVBLK - 1 > qlo) mask_tile(P0_, P1_, qm - kb_, W); } } while (0)
    constexpr int NQL = 8;
#define SEAM_K0() do { VMWN(NQL); NORMKV(); SWRITE_HK(0); SBAR(); } while (0)
    f32x16 pA0, pA1, pB0, pB1; float mnA, mnB, alA, alB; bf16x8 pa0, pa1, pa2, pa3;
    SWRITE_HV(0); SBAR();
    if (NT > 1) { SLOAD_H(Kh, Vh, KBASE(1)); }
    SBAR(); cinit<MODE>(pA0, pA1, lds, KBASE(0), hi, tq, 0); qkt<0>(pA0, pA1, K_lds, r32, hi, S.qr);
    MASKT(pA0, pA1, 0); partialSM<MODE>(pA0, pA1, m_reg, mnA, alA);
    if (NT > 1) { VMW(); NORMKV(); SWRITE_H(1); }
    __syncthreads();
#define HALF_STEP(PX0, PX1, mnX, alX, PY0, PY1, alY, t, KB, VB, SB) do {                                                      \
        SBAR(); cinit<MODE>(PX0, PX1, lds, KBASE(t), hi, tq, (t)); qkt<KB>(PX0, PX1, K_lds, r32, hi, S.qr);                     \
        finishSM(PY0, PY1, alY, l_reg, pa0, pa1, pa2, pa3); SBAR();                                                           \
        if ((t) + 1 < NT) { SLOAD_H(Kh, Vh, KBASE((t) + 1)); SBAR(); }                                                        \
        pv_tile<VB>(o, vb0, pa0, pa1, pa2, pa3); MASKT(PX0, PX1, (t)); partialSM<MODE>(PX0, PX1, m_reg, mnX, alX);             \
        __syncthreads();                                                                                                      \
        if ((t) + 1 < NT) { VMW(); NORMKV(); SWRITE_H(SB); }                                                                  \
        RESC(alX); __syncthreads(); } while (0)
    for (int t = 1; t + 1 < NT; t += 2) {
        HALF_STEP(pB0, pB1, mnB, alB, pA0, pA1, alA, t, 1, 0, 0);
        HALF_STEP(pA0, pA1, mnA, alA, pB0, pB1, alB, t + 1, 0, 1, 1);
    }
    const bool even = (NT & 1) == 0;
    if (even) { SBAR(); cinit<MODE>(pB0, pB1, lds, KBASE(NT - 1), hi, tq, NT - 1); qkt<1>(pB0, pB1, K_lds, r32, hi, S.qr); SBAR(); }
    SBAR();
    finishSM(pA0, pA1, alA, l_reg, pa0, pa1, pa2, pa3); SBAR();
    pv_tile<0>(o, vb0, pa0, pa1, pa2, pa3);
    if (even) { MASKT(pB0, pB1, NT - 1); partialSM<MODE>(pB0, pB1, m_reg, mnB, alB); __syncthreads(); RESC(alB);
        finishSM(pB0, pB1, alB, l_reg, pa0, pa1, pa2, pa3); SBAR(); pv_tile<1>(o, vb0, pa0, pa1, pa2, pa3); }
    SBAR();
    if (hi == 0) li_l[r32] = l_reg; asm volatile("s_waitcnt lgkmcnt(0)" ::: "memory");
    float rli[16];
#pragma unroll
    for (int r = 0; r < 16; ++r) rli[r] = __builtin_amdgcn_rcpf(li_l[crow(r, hi)]);
    constexpr int LDO = MODE == 0 ? 512 : 128;
    bf16* Ow = cur.O + (size_t)(wid * QBLK) * LDO;
#pragma unroll
    for (int r = 0; r < 16; ++r) { const int orow = crow(r, hi);
#pragma unroll
        for (int d0 = 0; d0 < 4; ++d0) { const float v = o[d0][r] * rli[r];
            const float vn = qxor1(v);
            if ((r32 & 1) == 0) *(unsigned*)(Ow + (size_t)orow * LDO + d0 * 32 + r32) = cvtpk(v, vn); } }
    __syncthreads();
#undef RESC
#undef KBASE
#undef MASKT
#undef SEAM_K0
#undef HALF_STEP
}
#undef ROW
#undef VMWN
#undef SLOAD_H
#undef STG_IDS
#undef NORMKV
#undef SWRITE_HK
#undef SWRITE_HV
#undef SWRITE_H
#undef PK4
#undef TRRD
}

constexpr size_t WS_MLQK = 848 * MiB, WS_MLV = 864 * MiB, WS_MLO = 880 * MiB, WS_QABS = 896 * MiB, WS_CKV = 912 * MiB, WS_IK = 916 * MiB, WS_SCAL = 918 * MiB, WS_IQ = 920 * MiB;
constexpr size_t WS_FXQ = 928 * MiB, WS_FXK = 944 * MiB, WS_FXV = 960 * MiB, WS_GATES = 976 * MiB, WS_YCAT = 1072 * MiB, WS_MERGED = 1120 * MiB;
constexpr size_t WS_CLOC = 1152 * MiB, WS_CPREV = 1184 * MiB, WS_MLST = 1200 * MiB, WS_SCORE = 1208 * MiB, WS_XN1_8 = 1352 * MiB  , WS_WIN8 = 1368 * MiB  , WS_MERGED8 = 1384 * MiB  , WS_WOUT8 = 1400 * MiB  , WS_END2 = 1402 * MiB;
constexpr int CW_Q = 512;

struct EpiInProj {
    static constexpr bool PERM = true, AFTER_DRAIN = false;
    const float* bias; unsigned char* ws;
    __device__ __forceinline__ void operator()(const f32x4 (&acc)[2][2][4][2], const pg8::Unit& u, int wr, int wc, int fr, int fq) const {
        asm volatile("" : "+v"(fr), "+v"(fq));
        const int pn = u.pn, row0 = u.pm * 256 + wr * 64 + fr, b = u.pm >> 3;
#pragma unroll
        for (int bj = 0; bj < 2; ++bj) {
            const int c8 = 128 * bj + 32 * wc + 8 * fq;
            bf16* base = nullptr; int pitch = 0; float* fbase = nullptr;
            if (pn < 2) { base = (bf16*)(ws + WS_MLQK) + pn * 256 + c8; pitch = 512; }
            else if (pn < 4) { base = (bf16*)(ws + WS_MLV) + (pn - 2) * 256 + c8; pitch = 512; }
            else if (pn < 6) { base = (bf16*)(ws + WS_MLO) + (pn - 4) * 256 + c8; pitch = 512; }
            else if (pn < 8) { base = (bf16*)(ws + WS_QABS) + (pn - 6) * 256 + c8; pitch = 512; }
            else if (pn == 8) { if (c8 < 128) { base = (bf16*)(ws + WS_CKV) + c8; pitch = 128; } else if (c8 < 192) { base = (bf16*)(ws + WS_IK) + (c8 - 128); pitch = 64; }
                                else if (c8 < 208) { fbase = (float*)(ws + WS_SCAL) + (c8 - 192); } }
            else if (pn == 9) { base = (bf16*)(ws + WS_IQ) + c8; pitch = 256; }
            else if (pn < 16) { const int t = (pn - 10) >> 1, hh = ((pn - 10) & 1) * 2 + bj;
                base = (bf16*)(ws + WS_FXQ + (size_t)t * (WS_FXK - WS_FXQ)) + (size_t)(b * 3 + hh) * 2048 * 128 + 32 * wc + 8 * fq; pitch = 128; }
            else { base = (bf16*)(ws + WS_GATES) + (pn - 16) * 256 + c8; pitch = 3072; }
            const f32x4 bv0 = *(const f32x4*)(bias + pn * 256 + c8), bv1 = *(const f32x4*)(bias + pn * 256 + c8 + 4);
            if (base) {
#pragma unroll
                for (int ai = 0; ai < 2; ++ai)
#pragma unroll
                    for (int m = 0; m < 4; ++m) { const int row = row0 + ai * 128 + m * 16; const f32x4 v0 = acc[ai][bj][m][0] + bv0, v1 = acc[ai][bj][m][1] + bv1;
                        *(u32x4*)(base + (size_t)row * pitch) = (u32x4){pg8::cvt_pk_bf16(v0[0], v0[1]), pg8::cvt_pk_bf16(v0[2], v0[3]), pg8::cvt_pk_bf16(v1[0], v1[1]), pg8::cvt_pk_bf16(v1[2], v1[3])}; }
            } else if (fbase) {
#pragma unroll
                for (int ai = 0; ai < 2; ++ai)
#pragma unroll
                    for (int m = 0; m < 4; ++m) { const int row = row0 + ai * 128 + m * 16; *(f32x4*)(fbase + (size_t)row * 16) = acc[ai][bj][m][0] + bv0; *(f32x4*)(fbase + (size_t)row * 16 + 4) = acc[ai][bj][m][1] + bv1; }
            }
        }
    }
};
struct InProjSched {
    pg8::StaticOrder so; int f8;
    __device__ __forceinline__ bool next(int i, pg8::Unit& u) const { if (!so.next(i, u)) return false; u.pn = f8 ? (u.pn < 6 ? u.pn : u.pn + 4) : u.pn + 6; return true; }
    __device__ __forceinline__ void a_ready(const pg8::Unit&) const {}
    __device__ __forceinline__ void done(const pg8::Unit&) const {}
};
struct EpiInProj8 {
    static constexpr bool PERM = true, AFTER_DRAIN = false;
    const float* bias; unsigned char* ws;
    __device__ __forceinline__ void operator()(const f32x4 (&acc)[2][2][4][2], const pg8::Unit& u, int wr, int wc, int fr, int fq) const {
        asm volatile("" : "+v"(fr), "+v"(fq));
        const int pn = u.pn, row0 = u.pm * 256 + wr * 64 + fr, b = u.pm >> 3;
#pragma unroll
        for (int bj = 0; bj < 2; ++bj) {
            const int c8 = 128 * bj + 32 * wc + 8 * fq;
            bf16* base; int pitch;
            if (pn < 2) { base = (bf16*)(ws + WS_MLQK) + pn * 256 + c8; pitch = 512; }
            else if (pn < 4) { base = (bf16*)(ws + WS_MLV) + (pn - 2) * 256 + c8; pitch = 512; }
            else if (pn < 6) { base = (bf16*)(ws + WS_MLO) + (pn - 4) * 256 + c8; pitch = 512; }
            else if (pn < 16) { const int t = (pn - 10) >> 1, hh = ((pn - 10) & 1) * 2 + bj;
                base = (bf16*)(ws + WS_FXQ + (size_t)t * (WS_FXK - WS_FXQ)) + (size_t)(b * 3 + hh) * 2048 * 128 + 32 * wc + 8 * fq; pitch = 128; }
            else { base = (bf16*)(ws + WS_GATES) + (pn - 16) * 256 + c8; pitch = 3072; }
            const f32x4 bv0 = *(const f32x4*)(bias + pn * 256 + c8), bv1 = *(const f32x4*)(bias + pn * 256 + c8 + 4);
#pragma unroll
            for (int ai = 0; ai < 2; ++ai)
#pragma unroll
                for (int m = 0; m < 4; ++m) { const int row = row0 + ai * 128 + m * 16; const f32x4 v0 = acc[ai][bj][m][0] + bv0, v1 = acc[ai][bj][m][1] + bv1;
                    *(u32x4*)(base + (size_t)row * pitch) = (u32x4){pg8::cvt_pk_bf16(v0[0], v0[1]), pg8::cvt_pk_bf16(v0[2], v0[3]), pg8::cvt_pk_bf16(v1[0], v1[1]), pg8::cvt_pk_bf16(v1[2], v1[3])}; }
        }
    }
};
struct BranchSched {
    int G, c, brpack, nbr;
    __device__ __forceinline__ bool next(int i, pg8::Unit& u) const {
        const int tile = (i / nbr) * G + c, br = (brpack >> (2 * (i % nbr))) & 3; if (tile >= 256) return false;
        u.pm = br * 64 + (tile >> 2); u.pn = br * 4 + (tile & 3); return true;
    }
    __device__ __forceinline__ void a_ready(const pg8::Unit&) const {}
    __device__ __forceinline__ void done(const pg8::Unit&) const {}
};
struct EpiBranch {
    static constexpr bool PERM = true, AFTER_DRAIN = false;
    const bf16* gates; bf16* merged; int br0; unsigned char* merged8;
    __device__ __forceinline__ void operator()(const f32x4 (&acc)[2][2][4][2], const pg8::Unit& u, int wr, int wc, int fr, int fq) const {
        asm volatile("" : "+v"(fr), "+v"(fq));
        const int br = u.pm >> 6, row0 = (u.pm & 63) * 256 + wr * 64 + fr, col0 = (u.pn & 3) * 256 + 32 * wc + 8 * fq;
#pragma unroll
        for (int ai = 0; ai < 2; ++ai)
#pragma unroll
            for (int m = 0; m < 4; ++m) { const int row = row0 + ai * 128 + m * 16;
#pragma unroll
                for (int bj = 0; bj < 2; ++bj) { const int col = col0 + bj * 128;
                    const u32x4 gq = *(const u32x4*)(gates + (size_t)row * 3072 + br * 1024 + col);
                    float v[8];
#pragma unroll
                    for (int q = 0; q < 4; ++q) { const float g0 = bf2f(gq[q] & 0xffffu), g1 = bf2f(gq[q] >> 16);
                        v[2 * q] = acc[ai][bj][m][q >> 1][(2 * q) & 3] * __builtin_amdgcn_rcpf(1.0f + __builtin_amdgcn_exp2f(-1.4426950408889634f * g0));
                        v[2 * q + 1] = acc[ai][bj][m][q >> 1][(2 * q + 1) & 3] * __builtin_amdgcn_rcpf(1.0f + __builtin_amdgcn_exp2f(-1.4426950408889634f * g1)); }
                    bf16* dst = merged + (size_t)row * 1024 + col;
                    if (br != br0) { const u32x4 old = *(const u32x4*)dst;
#pragma unroll
                        for (int q = 0; q < 4; ++q) { v[2 * q] += bf2f(old[q] & 0xffffu); v[2 * q + 1] += bf2f(old[q] >> 16); } }
                    if (br == 2) *(u32x2*)(merged8 + (size_t)row * 1024 + col) = (u32x2){pk4_fp8(v[0], v[1], v[2], v[3]), pk4_fp8(v[4], v[5], v[6], v[7])};
                    else *(u32x4*)dst = (u32x4){pg8::cvt_pk_bf16(v[0], v[1]), pg8::cvt_pk_bf16(v[2], v[3]), pg8::cvt_pk_bf16(v[4], v[5]), pg8::cvt_pk_bf16(v[6], v[7])}; }
                asm volatile("" ::: "memory"); }
    }
};
struct EpiOutProj {
    static constexpr bool PERM = false, AFTER_DRAIN = false;
    const float* xsrc; float* X; const float* modl;
    __device__ __forceinline__ void operator()(const f32x4 (&acc)[2][2][4][2], const pg8::Unit& u, int wr, int wc, int fr, int fq) const {
        asm volatile("" : "+v"(fr), "+v"(fq));
        const int row0 = u.pm * 256 + wr * 64 + fr, col0 = u.pn * 256 + wc * 32 + 4 * fq; const float* g1 = modl + (size_t)(u.pm >> 3) * 6144 + 2048;
        f32x4 gv[2][2];
#pragma unroll
        for (int bj = 0; bj < 2; ++bj)
#pragma unroll
            for (int n = 0; n < 2; ++n) gv[bj][n] = *(const f32x4*)(g1 + col0 + bj * 128 + n * 16);
#pragma unroll
        for (int ai = 0; ai < 2; ++ai)
#pragma unroll
            for (int m = 0; m < 4; ++m) { const size_t off = (size_t)(row0 + ai * 128 + m * 16) * 1024 + col0;
#pragma unroll
                for (int bj = 0; bj < 2; ++bj)
#pragma unroll
                    for (int n = 0; n < 2; ++n) *(f32x4*)(X + off + bj * 128 + n * 16) = *(const f32x4*)(xsrc + off + bj * 128 + n * 16) + gv[bj][n] * acc[ai][bj][m][n];
                if (m & 1) asm volatile("" ::: "memory"); }
    }
};

__device__ __forceinline__ float logsigf(float f) { return fminf(f, 0.f) - __logf(1.0f + __expf(-fabsf(f))); }
__device__ __forceinline__ void fox_unit(Frame& F, int b, int h, int qb) {
    char* lds = (char*)F.lds; const int tid = F.tid, lane = (F.tid & 63), wid = F.wave;
    const int n = (qb + 1) * 256;
    {   const float* fsrc = WSP(float, WS_SCAL) + (size_t)b * 2048 * 16 + 12 + h;
        float ls[4], run = 0.f;
#pragma unroll
        for (int q = 0; q < 4; ++q) { const int s = 4 * tid + q; const float v = (s < n) ? logsigf(fsrc[(size_t)s * 16]) : 0.f; run += v; ls[q] = run; }
        float incl = run;
#pragma unroll
        for (int off = 1; off < 64; off <<= 1) { const float t = lshfl(incl, (lane - off) & 63); if (lane >= off) incl += t; }
        float* scan = (float*)(lds + att::LDS_SCAN);
        if (lane == 63) scan[wid] = incl;
        __syncthreads();
        float base = 0.f;
        for (int w2 = 0; w2 < wid; ++w2) base += scan[w2];
        const float excl = base + incl - run;
        *(f32x4*)((float*)(lds + att::LDS_KB) + 4 * tid) = (f32x4){-(excl + ls[0]) * 11.313708498984761f, -(excl + ls[1]) * 11.313708498984761f, -(excl + ls[2]) * 11.313708498984761f, -(excl + ls[3]) * 11.313708498984761f};
        __syncthreads();
    }
    const size_t hb = (size_t)(b * 4 + h) * 2048 * 128;
    att::BlockRef r{WSP(bf16, WS_FXQ) + hb + (size_t)qb * 256 * 128, WSP(bf16, WS_FXK) + hb, WSP(bf16, WS_FXV) + hb,
                    WSP(bf16, WS_YCAT) + (size_t)2 * M * 512 + (size_t)(b * 2048 + qb * 256) * 512 + h * 128, 512, qb * 256, 4 * (qb + 1), nullptr};
    att::Seam S;
    att::prime<0>(r, lds, S, tid); att::block<0>(r, r, lds, S, tid);
}
constexpr size_t WS_NLOC = WS_MLST, WS_NPREV = WS_MLST + 262144, WS_MLOC = WS_MLST + 524288, WS_BLAST = WS_MLOC + 4096, WS_MPREV = WS_BLAST + 4096;
namespace ml {
using att::f32x16; using att::s16x4;
constexpr int L_Q = 0, L_K = 8192, L_V = 16384, L_HID = 32768, L_G = L_HID + 64 * 132 * 4, L_WS = L_G + 2048;
__device__ __forceinline__ void stage_conv(char* tile, const bf16* X, const float* cw, const float* cb, int row0, int spos0, int ch0, float scale, int tid) {
    const int s = tid >> 3, ch = ch0 + (tid & 7) * 8;
    float a[8];
    { const f32x4 b0 = *(const f32x4*)(cb + ch), b1 = *(const f32x4*)(cb + ch + 4); a[0] = b0[0]; a[1] = b0[1]; a[2] = b0[2]; a[3] = b0[3]; a[4] = b1[0]; a[5] = b1[1]; a[6] = b1[2]; a[7] = b1[3]; }
#pragma unroll
    for (int j = 0; j < 4; ++j) { if (spos0 + s - 3 + j >= 0) {
            const bf16x8 x = *(const bf16x8*)(X + (size_t)(row0 + s - 3 + j) * 512 + ch);
            const f32x4 w0 = *(const f32x4*)(cw + j * 512 + ch), w1 = *(const f32x4*)(cw + j * 512 + ch + 4);
#pragma unroll
            for (int i = 0; i < 4; ++i) { a[i] += w0[i] * bf2f((unsigned short)x[i]); a[4 + i] += w1[i] * bf2f((unsigned short)x[4 + i]); } } }
#pragma unroll
    for (int i = 0; i < 8; ++i) a[i] = a[i] * scale / (1.0f + __expf(-a[i]));
    *(u32x4*)(tile + (s * 64 + (tid & 7) * 8) * 2) = (u32x4){att::cvtpk(a[0], a[1]), att::cvtpk(a[2], a[3]), att::cvtpk(a[4], a[5]), att::cvtpk(a[6], a[7])};
}
__device__ __forceinline__ void stage_conv4(char* tile0, const bf16* X, const float* cw, const float* cb, int row0, int spos0, int ch0, float scale, int tid) {
    const int s = tid >> 3, ch = ch0 + (tid & 7) * 8;
    bf16x8 x[4][4];
#pragma unroll
    for (int c = 0; c < 4; ++c)
#pragma unroll
        for (int j = 0; j < 4; ++j) { const int sp = spos0 + 64 * c + s - 3 + j; x[c][j] = *(const bf16x8*)(X + (size_t)(row0 + 64 * c + s - 3 + j + (sp < 0 ? 3 : 0)) * 512 + ch); }
    f32x4 w0[4], w1[4];
#pragma unroll
    for (int j = 0; j < 4; ++j) { w0[j] = *(const f32x4*)(cw + j * 512 + ch); w1[j] = *(const f32x4*)(cw + j * 512 + ch + 4); }
    const f32x4 b0 = *(const f32x4*)(cb + ch), b1 = *(const f32x4*)(cb + ch + 4);
#pragma unroll
    for (int c = 0; c < 4; ++c) { float a[8] = {b0[0], b0[1], b0[2], b0[3], b1[0], b1[1], b1[2], b1[3]};
#pragma unroll
        for (int j = 0; j < 4; ++j) { const float msk = (spos0 + 64 * c + s - 3 + j >= 0) ? 1.0f : 0.0f;
#pragma unroll
            for (int i = 0; i < 4; ++i) { a[i] += msk * w0[j][i] * bf2f((unsigned short)x[c][j][i]); a[4 + i] += msk * w1[j][i] * bf2f((unsigned short)x[c][j][4 + i]); } }
#pragma unroll
        for (int i = 0; i < 8; ++i) a[i] = a[i] * scale / (1.0f + __expf(-a[i]));
        *(u32x4*)(tile0 + c * 8192 + (s * 64 + (tid & 7) * 8) * 2) = (u32x4){att::cvtpk(a[0], a[1]), att::cvtpk(a[2], a[3]), att::cvtpk(a[4], a[5]), att::cvtpk(a[6], a[7])}; }
}
__device__ __forceinline__ void stage_v(char* V_lds, const bf16* Vg, int row0, int h, int tid) {
    const int sr = tid >> 4, sc = (tid & 15) * 8;
    const bf16x8 v0 = *(const bf16x8*)(Vg + (size_t)(row0 + sr) * 512 + h * 128 + sc), v1 = *(const bf16x8*)(Vg + (size_t)(row0 + 32 + sr) * 512 + h * 128 + sc);
    *(bf16x8*)(V_lds + att::v_st(sr, sc)) = v0; *(bf16x8*)(V_lds + att::v_st(32 + sr, sc)) = v1;
}
__device__ __forceinline__ void stage_gates(float* G, const float* scal, int row0, int h, int lane, float& b_last, float& m_loc) {
    const float ig = scal[(size_t)(row0 + lane) * 16 + h], f = logsigf(scal[(size_t)(row0 + lane) * 16 + 4 + h]);
    float b = f;
#pragma unroll
    for (int off = 1; off < 64; off <<= 1) { const float t = lshfl(b, (lane - off) & 63); if (lane >= off) b += t; }
    b_last = __builtin_bit_cast(float, __builtin_amdgcn_readlane(__builtin_bit_cast(int, b), 63));
    const float wst = b_last - b + ig; float mx = wst;
#pragma unroll
    for (int off = 1; off < 64; off <<= 1) mx = fmaxf(mx, lshfl(mx, lane ^ off));
    m_loc = mx;
    G[lane] = b; G[64 + lane] = ig - b; G[128 + lane] = __expf(wst - mx);
}
#define TRRD(dst, off) asm volatile("ds_read_b64_tr_b16 %0, %1 offset:%2" : "=&v"(dst) : "v"(vb), "i"(off) : "memory")
#define VFRAG(l_, h_) (bf16x8){l_[0], l_[1], l_[2], l_[3], h_[0], h_[1], h_[2], h_[3]}
__device__ __forceinline__ void mma_v(f32x16& acc, int vb, bf16x8 pa0, bf16x8 pa1, bf16x8 pa2, bf16x8 pa3) {
    s16x4 l0, l1, l2, l3, h0, h1, h2, h3;
    TRRD(l0, 0); TRRD(h0, 2048); TRRD(l1, 4096); TRRD(h1, 6144); TRRD(l2, 8192); TRRD(h2, 10240); TRRD(l3, 12288); TRRD(h3, 14336);
    asm volatile("s_waitcnt lgkmcnt(0)" ::: "memory"); __builtin_amdgcn_sched_barrier(0);
    acc = __builtin_amdgcn_mfma_f32_32x32x16_bf16(pa0, VFRAG(l0, h0), acc, 0, 0, 0);
    acc = __builtin_amdgcn_mfma_f32_32x32x16_bf16(pa1, VFRAG(l1, h1), acc, 0, 0, 0);
    acc = __builtin_amdgcn_mfma_f32_32x32x16_bf16(pa2, VFRAG(l2, h2), acc, 0, 0, 0);
    acc = __builtin_amdgcn_mfma_f32_32x32x16_bf16(pa3, VFRAG(l3, h3), acc, 0, 0, 0);
}
#undef TRRD
#undef VFRAG
__device__ __forceinline__ void unit_local(Frame& F, int l, int u) {
    char* lds = (char*)F.lds; const int tid = F.tid, lane = tid & 63, wid = F.wave, r32 = lane & 31, hi = lane >> 5;
    const int bh = u >> 5, c = u & 31, b = bh >> 2, h = bh & 3, row0 = b * 2048 + c * 64;
    float* G = (float*)(lds + L_G);
    stage_conv(lds + L_K, WSP(bf16, WS_MLQK), KIN(I_CONVW) + (size_t)l * 2048, KIN(I_CONVB) + (size_t)l * 512, row0, c * 64, 256 + h * 64, 1.0f, tid);
    stage_v(lds + L_V, WSP(bf16, WS_MLV), row0, h, tid);
    if (wid == 0) { float bl, mlc; stage_gates(G, WSP(float, WS_SCAL), row0, h, lane, bl, mlc); if (lane == 0) { WSP(float, WS_MLOC)[u] = mlc; WSP(float, WS_BLAST)[u] = bl; } }
    __syncthreads();
    const int kblk = wid >> 2, vblk = wid & 3;
    bf16x8 pa[4];
    const unsigned short* Kc = (const unsigned short*)(lds + L_K);
#pragma unroll
    for (int ks = 0; ks < 4; ++ks) { float w[8];
#pragma unroll
        for (int j = 0; j < 8; ++j) { const int s = 16 * ks + 8 * hi + j; w[j] = bf2f(Kc[s * 64 + kblk * 32 + r32]) * G[128 + s]; }
        u32x4 q = {att::cvtpk(w[0], w[1]), att::cvtpk(w[2], w[3]), att::cvtpk(w[4], w[5]), att::cvtpk(w[6], w[7])}; pa[ks] = *reinterpret_cast<bf16x8*>(&q); }
    f32x16 acc = ozero16();
    mma_v(acc, (int)(uintptr_t)(lds + L_V) + att::v_rd_base(lane) + vblk * 512, pa[0], pa[1], pa[2], pa[3]);
    float* cl = WSP(float, WS_CLOC) + (size_t)u * 8192 + (size_t)(vblk * 32 + r32) * 64 + kblk * 32 + 4 * hi;
#pragma unroll
    for (int g = 0; g < 4; ++g) *(f32x4*)(cl + 8 * g) = (f32x4){acc[4 * g], acc[4 * g + 1], acc[4 * g + 2], acc[4 * g + 3]};
    if (tid < 64) { float s_ = 0.f; for (int s = 0; s < 64; ++s) s_ += G[128 + s] * bf2f(Kc[s * 64 + tid]); WSP(float, WS_NLOC)[(size_t)u * 64 + tid] = s_; }
    __syncthreads();
}
__device__ __forceinline__ void scan_item(Frame& F, int it) {
    const int tid = F.tid;
    float* dec_l = (float*)F.lds; float* scl_l = dec_l + 32; float* mpr_l = dec_l + 64;
    {
        const int bh = it / 5, seg = it % 5;
        __syncthreads();
        if (tid < 32) { dec_l[96 + tid] = WSP(float, WS_MLOC)[bh * 32 + tid]; dec_l[128 + tid] = WSP(float, WS_BLAST)[bh * 32 + tid]; }
        __syncthreads();
        if (tid == 0) { float m = -__builtin_inff();
            for (int c = 0; c < 32; ++c) { const float ml_ = dec_l[96 + c], bl = dec_l[128 + c], mn = fmaxf(bl + m, ml_);
                mpr_l[c] = m; dec_l[c] = __expf(bl + m - mn); scl_l[c] = __expf(ml_ - mn); m = mn; } }
        __syncthreads();
        if (seg < 4) { const int e = seg * 2048 + tid * 4; const float* cl = WSP(float, WS_CLOC) + (size_t)bh * 32 * 8192 + e; bf16* cp = WSP(bf16, WS_CPREV) + (size_t)bh * 32 * 8192 + e;
            f32x4 v[32];
#pragma unroll
            for (int c = 0; c < 32; ++c) v[c] = *(const f32x4*)(cl + (size_t)c * 8192);
            f32x4 st = ozero4();
#pragma unroll
            for (int c = 0; c < 32; ++c) { *(u32x2*)(cp + (size_t)c * 8192) = (u32x2){pk2(st[0], st[1]), pk2(st[2], st[3])}; st = dec_l[c] * st + scl_l[c] * v[c]; }
        } else if (tid < 64) { const float* nl = WSP(float, WS_NLOC) + (size_t)bh * 32 * 64 + tid; float* np = WSP(float, WS_NPREV) + (size_t)bh * 32 * 64 + tid;
            float v[32];
#pragma unroll
            for (int c = 0; c < 32; ++c) v[c] = nl[(size_t)c * 64];
            float st = 0.f;
#pragma unroll
            for (int c = 0; c < 32; ++c) { np[(size_t)c * 64] = st; if (tid == 0) WSP(float, WS_MPREV)[bh * 32 + c] = mpr_l[c]; st = dec_l[c] * st + scl_l[c] * v[c]; }
        }
    }
}
__device__ __forceinline__ void unit_out(Frame& F, int l, int u) {
    char* lds = (char*)F.lds; const int tid = F.tid, lane = tid & 63, wid = F.wave, r32 = lane & 31, hi = lane >> 5;
    const int bh = u >> 5, c = u & 31, b = bh >> 2, h = bh & 3, row0 = b * 2048 + c * 64;
    float* G = (float*)(lds + L_G);
    stage_conv(lds + L_Q, WSP(bf16, WS_MLQK), KIN(I_CONVW) + (size_t)l * 2048, KIN(I_CONVB) + (size_t)l * 512, row0, c * 64, h * 64, 0.125f, tid);
    stage_conv(lds + L_K, WSP(bf16, WS_MLQK), KIN(I_CONVW) + (size_t)l * 2048, KIN(I_CONVB) + (size_t)l * 512, row0, c * 64, 256 + h * 64, 1.0f, tid);
    stage_v(lds + L_V, WSP(bf16, WS_MLV), row0, h, tid);
    if (wid == 0) { float bl, mlc; stage_gates(G, WSP(float, WS_SCAL), row0, h, lane, bl, mlc); G[192 + lane] = WSP(float, WS_NPREV)[(size_t)u * 64 + lane]; }
    __syncthreads();
    const int rb = wid >> 2, vblk = wid & 3, t = rb * 32 + r32;
    bf16x8 qf[4];
#pragma unroll
    for (int ks = 0; ks < 4; ++ks) qf[ks] = *(const bf16x8*)(lds + L_Q + t * 128 + (16 * ks + 8 * hi) * 2);
    f32x16 p0 = ozero16(), p1 = p0;
#pragma unroll
    for (int ks = 0; ks < 4; ++ks) { const bf16x8 k0 = *(const bf16x8*)(lds + L_K + r32 * 128 + (16 * ks + 8 * hi) * 2), k1 = *(const bf16x8*)(lds + L_K + (32 + r32) * 128 + (16 * ks + 8 * hi) * 2);
        p0 = __builtin_amdgcn_mfma_f32_32x32x16_bf16(k0, qf[ks], p0, 0, 0, 0); p1 = __builtin_amdgcn_mfma_f32_32x32x16_bf16(k1, qf[ks], p1, 0, 0, 0); }
    const float bt = G[t], inter = bt + WSP(float, WS_MPREV)[u];
    const float NEG = -__builtin_inff();
    f32x16 d0, d1; float mo = inter;
#pragma unroll
    for (int r = 0; r < 16; ++r) { const int s0 = att::crow(r, hi), s1 = 32 + s0; d0[r] = (s0 <= t) ? bt + G[64 + s0] : NEG; d1[r] = (s1 <= t) ? bt + G[64 + s1] : NEG; mo = fmaxf(mo, fmaxf(d0[r], d1[r])); }
    { auto rr = __builtin_amdgcn_permlane32_swap(__float_as_uint(mo), __float_as_uint(mo), false, false); mo = fmaxf(__uint_as_float(rr[0]), __uint_as_float(rr[1])); }
    float den = 0.f;
#pragma unroll
    for (int r = 0; r < 16; ++r) { p0[r] *= __expf(d0[r] - mo); p1[r] *= __expf(d1[r] - mo); den += p0[r] + p1[r]; }
    const float a_int = __expf(inter - mo);
    float nd = 0.f;
#pragma unroll
    for (int ks = 0; ks < 4; ++ks)
#pragma unroll
        for (int j = 0; j < 8; ++j) nd += G[192 + 16 * ks + 8 * hi + j] * bf2f((unsigned short)qf[ks][j]);
    den += a_int * nd;
    { auto rr = __builtin_amdgcn_permlane32_swap(__float_as_uint(den), __float_as_uint(den), false, false); den = __uint_as_float(rr[0]) + __uint_as_float(rr[1]); }
    float* wsl = (float*)(lds + L_WS) + wid * 64;
    if (hi == 0) wsl[r32] = 1.0f / fmaxf(fabsf(den), __expf(-mo));
    bf16x8 pa0, pa1, pa2, pa3;
#define PK4(P, B_, OUT) do { unsigned a0 = att::cvtpk(P[B_+0], P[B_+1]), a1 = att::cvtpk(P[B_+2], P[B_+3]);                          \
        unsigned b0 = att::cvtpk(P[B_+4], P[B_+5]), b1 = att::cvtpk(P[B_+6], P[B_+7]);                                             \
        auto r0 = __builtin_amdgcn_permlane32_swap(a0, b0, false, false); auto r1 = __builtin_amdgcn_permlane32_swap(a1, b1, false, false); \
        u32x4 w = {r0[0], r1[0], r0[1], r1[1]}; OUT = *reinterpret_cast<bf16x8*>(&w); } while (0)
    PK4(p0, 0, pa0); PK4(p0, 8, pa1); PK4(p1, 0, pa2); PK4(p1, 8, pa3);
#undef PK4
    f32x16 o = ozero16();
    mma_v(o, (int)(uintptr_t)(lds + L_V) + att::v_rd_base(lane) + vblk * 512, pa0, pa1, pa2, pa3);
    const bf16* cp = WSP(bf16, WS_CPREV) + (size_t)u * 8192 + (size_t)(vblk * 32 + r32) * 64 + 8 * hi;
#pragma unroll
    for (int ks = 0; ks < 4; ++ks) { float w[8];
#pragma unroll
        for (int j = 0; j < 8; ++j) w[j] = a_int * bf2f((unsigned short)qf[ks][j]);
        u32x4 q = {att::cvtpk(w[0], w[1]), att::cvtpk(w[2], w[3]), att::cvtpk(w[4], w[5]), att::cvtpk(w[6], w[7])};
        o = __builtin_amdgcn_mfma_f32_32x32x16_bf16(*reinterpret_cast<bf16x8*>(&q), *(const bf16x8*)(cp + 16 * ks), o, 0, 0, 0); }
    asm volatile("s_waitcnt lgkmcnt(0)" ::: "memory");
    float* hid = (float*)(lds + L_HID);
#pragma unroll
    for (int r = 0; r < 16; ++r) { const int tr = att::crow(r, hi); hid[(rb * 32 + tr) * 132 + vblk * 32 + r32] = o[r] * wsl[tr]; }
    __syncthreads();
    {   const int row = tid >> 3, seg = (tid & 7) * 16; const float* hr = hid + row * 132 + seg;
        float v[16], ss = 0.f;
#pragma unroll
        for (int i = 0; i < 4; ++i) { const f32x4 q = *(const f32x4*)(hr + 4 * i); v[4 * i] = q[0]; v[4 * i + 1] = q[1]; v[4 * i + 2] = q[2]; v[4 * i + 3] = q[3]; ss += (q[0] * q[0] + q[1] * q[1]) + (q[2] * q[2] + q[3] * q[3]); }
        ss += qxor1(ss); ss += qxor2(ss); ss += hmirror(ss);
        const float rn = 1.0f / sqrtf(ss * (1.0f / 128.0f) + EPS);
        const float* gn = KIN(I_MLG) + (size_t)l * 512 + h * 128 + seg;
        const bf16* og = WSP(bf16, WS_MLO) + (size_t)(row0 + row) * 512 + h * 128 + seg;
        const u32x4 o0 = *(const u32x4*)og, o1 = *(const u32x4*)(og + 8); unsigned w[8];
#pragma unroll
        for (int i = 0; i < 8; ++i) { const unsigned oo = i < 4 ? o0[i] : o1[i - 4]; const float g0 = bf2f(oo & 0xffffu), g1 = bf2f(oo >> 16);
            const float y0 = v[2 * i] * rn * gn[2 * i] / (1.0f + __expf(-g0)), y1 = v[2 * i + 1] * rn * gn[2 * i + 1] / (1.0f + __expf(-g1));
            w[i] = att::cvtpk(y0, y1); }
        bf16* yo = WSP(bf16, WS_YCAT) + (size_t)(row0 + row) * 512 + h * 128 + seg;
        *(u32x4*)yo = (u32x4){w[0], w[1], w[2], w[3]}; *(u32x4*)(yo + 8) = (u32x4){w[4], w[5], w[6], w[7]};
    }
    __syncthreads();
}
__device__ __forceinline__ void unit_out4(Frame& F, int l, int u4) {
    char* lds = (char*)F.lds; const int tid = F.tid, lane = tid & 63, wid = F.wave, r32 = lane & 31, hi = lane >> 5;
    const int bh = u4 >> 3, g4 = u4 & 7, b = bh >> 2, h = bh & 3, row00 = b * 2048 + g4 * 256;
    constexpr int O_Q = 0, O_K = 32768, O_V = 65536, O_G = LDSCTL_OFF + 1024, O_WS = O_G + 4096;
    const float* cw = KIN(I_CONVW) + (size_t)l * 2048; const float* cb = KIN(I_CONVB) + (size_t)l * 512;
    stage_conv4(lds + O_Q, WSP(bf16, WS_MLQK), cw, cb, row00, g4 * 256, h * 64, 0.125f, tid);
    stage_conv4(lds + O_K, WSP(bf16, WS_MLQK), cw, cb, row00, g4 * 256, 256 + h * 64, 1.0f, tid);
#pragma unroll
    for (int c = 0; c < 4; ++c) stage_v(lds + O_V + c * 16384, WSP(bf16, WS_MLV), row00 + 64 * c, h, tid);
    if (wid < 4) { float bl, mlc; float* G = (float*)(lds + O_G) + wid * 256; stage_gates(G, WSP(float, WS_SCAL), row00 + 64 * wid, h, lane, bl, mlc);
        G[192 + lane] = WSP(float, WS_NPREV)[((size_t)bh * 32 + g4 * 4 + wid) * 64 + lane]; }
    __syncthreads();
    const int c = wid >> 1, t = 32 * (wid & 1) + r32; const size_t u = (size_t)bh * 32 + g4 * 4 + c;
    const float* G = (const float*)(lds + O_G) + c * 256;
    bf16x8 qf[4];
#pragma unroll
    for (int ks = 0; ks < 4; ++ks) qf[ks] = *(const bf16x8*)(lds + O_Q + c * 8192 + t * 128 + (16 * ks + 8 * hi) * 2);
    f32x16 p0 = ozero16(), p1 = p0;
#pragma unroll
    for (int ks = 0; ks < 4; ++ks) { const bf16x8 k0 = *(const bf16x8*)(lds + O_K + c * 8192 + r32 * 128 + (16 * ks + 8 * hi) * 2), k1 = *(const bf16x8*)(lds + O_K + c * 8192 + (32 + r32) * 128 + (16 * ks + 8 * hi) * 2);
        p0 = __builtin_amdgcn_mfma_f32_32x32x16_bf16(k0, qf[ks], p0, 0, 0, 0); p1 = __builtin_amdgcn_mfma_f32_32x32x16_bf16(k1, qf[ks], p1, 0, 0, 0); }
    const float bt = G[t], inter = bt + WSP(float, WS_MPREV)[u];
    const float NEG = -__builtin_inff();
    float mo = inter;
    {   f32x16 d0, d1;
#pragma unroll
        for (int r = 0; r < 16; ++r) { const int s0 = att::crow(r, hi), s1 = 32 + s0; d0[r] = (s0 <= t) ? bt + G[64 + s0] : NEG; d1[r] = (s1 <= t) ? bt + G[64 + s1] : NEG; mo = fmaxf(mo, fmaxf(d0[r], d1[r])); }
        { auto rr = __builtin_amdgcn_permlane32_swap(__float_as_uint(mo), __float_as_uint(mo), false, false); mo = fmaxf(__uint_as_float(rr[0]), __uint_as_float(rr[1])); }
#pragma unroll
        for (int r = 0; r < 16; ++r) { p0[r] *= __expf(d0[r] - mo); p1[r] *= __expf(d1[r] - mo); }
    }
    float den = 0.f;
#pragma unroll
    for (int r = 0; r < 16; ++r) den += p0[r] + p1[r];
    const float a_int = __expf(inter - mo);
    float nd = 0.f;
#pragma unroll
    for (int ks = 0; ks < 4; ++ks)
#pragma unroll
        for (int j = 0; j < 8; ++j) nd += G[192 + 16 * ks + 8 * hi + j] * bf2f((unsigned short)qf[ks][j]);
    den += a_int * nd;
    { auto rr = __builtin_amdgcn_permlane32_swap(__float_as_uint(den), __float_as_uint(den), false, false); den = __uint_as_float(rr[0]) + __uint_as_float(rr[1]); }
    float* wsl = (float*)(lds + O_WS) + wid * 64;
    if (hi == 0) wsl[r32] = 1.0f / fmaxf(fabsf(den), __expf(-mo));
    bf16x8 pa0, pa1, pa2, pa3;
#define PK4(P, B_, OUT) do { unsigned a0 = att::cvtpk(P[B_+0], P[B_+1]), a1 = att::cvtpk(P[B_+2], P[B_+3]);                          \
        unsigned b0 = att::cvtpk(P[B_+4], P[B_+5]), b1 = att::cvtpk(P[B_+6], P[B_+7]);                                             \
        auto r0 = __builtin_amdgcn_permlane32_swap(a0, b0, false, false); auto r1 = __builtin_amdgcn_permlane32_swap(a1, b1, false, false); \
        u32x4 w = {r0[0], r1[0], r0[1], r1[1]}; OUT = *reinterpret_cast<bf16x8*>(&w); } while (0)
    PK4(p0, 0, pa0); PK4(p0, 8, pa1); PK4(p1, 0, pa2); PK4(p1, 8, pa3);
#undef PK4
    bf16x8 qa[4];
#pragma unroll
    for (int ks = 0; ks < 4; ++ks) { float w[8];
#pragma unroll
        for (int j = 0; j < 8; ++j) w[j] = a_int * bf2f((unsigned short)qf[ks][j]);
        u32x4 q = {att::cvtpk(w[0], w[1]), att::cvtpk(w[2], w[3]), att::cvtpk(w[4], w[5]), att::cvtpk(w[6], w[7])}; qa[ks] = *reinterpret_cast<bf16x8*>(&q); }
    f32x16 o[4];
    const int vbase = (int)(uintptr_t)(lds + O_V + c * 16384) + att::v_rd_base(lane);
#pragma unroll
    for (int d0 = 0; d0 < 4; ++d0) { o[d0] = ozero16();
        mma_v(o[d0], vbase + d0 * 512, pa0, pa1, pa2, pa3);
        const bf16* cp = WSP(bf16, WS_CPREV) + u * 8192 + (size_t)(d0 * 32 + r32) * 64 + 8 * hi;
#pragma unroll
        for (int ks = 0; ks < 4; ++ks) o[d0] = __builtin_amdgcn_mfma_f32_32x32x16_bf16(qa[ks], *(const bf16x8*)(cp + 16 * ks), o[d0], 0, 0, 0); }
    asm volatile("s_waitcnt lgkmcnt(0)" ::: "memory");
    float rinv[16];
#pragma unroll
    for (int r = 0; r < 16; ++r) rinv[r] = wsl[att::crow(r, hi)];
    __syncthreads();
    unsigned short* ht = (unsigned short*)(lds + wid * 8704);
#pragma unroll
    for (int r = 0; r < 16; ++r) { const int tr = att::crow(r, hi);
#pragma unroll
        for (int d0 = 0; d0 < 4; ++d0) ht[tr * 136 + d0 * 32 + r32] = (unsigned short)f2bf(o[d0][r] * rinv[r]); }
    asm volatile("s_waitcnt lgkmcnt(0)" ::: "memory");
    {   const int row = lane >> 1, seg = (lane & 1) * 64; const unsigned short* hr = ht + row * 136 + seg;
        u32x4 hv[8]; float ss = 0.f;
#pragma unroll
        for (int i = 0; i < 8; ++i) { hv[i] = *(const u32x4*)(hr + 8 * i);
#pragma unroll
            for (int q = 0; q < 4; ++q) { const float a = bf2f(hv[i][q] & 0xffffu), b2 = bf2f(hv[i][q] >> 16); ss += a * a + b2 * b2; } }
        ss += __builtin_bit_cast(float, __builtin_amdgcn_update_dpp(0, __builtin_bit_cast(int, ss), 0xB1, 0xf, 0xf, false));
        const float rn = 1.0f / sqrtf(ss * (1.0f / 128.0f) + EPS);
        const int grow = row00 + 64 * c + 32 * (wid & 1) + row;
        const float* gn = KIN(I_MLG) + (size_t)l * 512 + h * 128 + seg;
        const bf16* og = WSP(bf16, WS_MLO) + (size_t)grow * 512 + h * 128 + seg;
        bf16* yo = WSP(bf16, WS_YCAT) + (size_t)grow * 512 + h * 128 + seg;
#pragma unroll
        for (int i = 0; i < 8; ++i) { const u32x4 oo = *(const u32x4*)(og + 8 * i); const f32x4 g0 = *(const f32x4*)(gn + 8 * i), g1 = *(const f32x4*)(gn + 8 * i + 4); unsigned w[4];
#pragma unroll
            for (int q = 0; q < 4; ++q) { const float a = bf2f(hv[i][q] & 0xffffu), b2 = bf2f(hv[i][q] >> 16), ga = bf2f(oo[q] & 0xffffu), gb = bf2f(oo[q] >> 16);
                const float wa = q < 2 ? g0[2 * q] : g1[2 * q - 4], wb = q < 2 ? g0[2 * q + 1] : g1[2 * q - 3];
                w[q] = att::cvtpk(a * rn * wa / (1.0f + __expf(-ga)), b2 * rn * wb / (1.0f + __expf(-gb))); }
            *(u32x4*)(yo + 8 * i) = (u32x4){w[0], w[1], w[2], w[3]}; }
    }
    __syncthreads();
}
__device__ __forceinline__ void unit_local4(Frame& F, int l, int u4) {
    char* lds = (char*)F.lds; const int tid = F.tid, lane = tid & 63, wid = F.wave, r32 = lane & 31, hi = lane >> 5;
    const int bh = u4 >> 3, g4 = u4 & 7, b = bh >> 2, h = bh & 3, row00 = b * 2048 + g4 * 256;
    constexpr int O_K = 32768, O_V = 65536, O_G = LDSCTL_OFF + 1024;
    stage_conv4(lds + O_K, WSP(bf16, WS_MLQK), KIN(I_CONVW) + (size_t)l * 2048, KIN(I_CONVB) + (size_t)l * 512, row00, g4 * 256, 256 + h * 64, 1.0f, tid);
#pragma unroll
    for (int c = 0; c < 4; ++c) stage_v(lds + O_V + c * 16384, WSP(bf16, WS_MLV), row00 + 64 * c, h, tid);
    if (wid < 4) { float bl, mlc; stage_gates((float*)(lds + O_G) + wid * 256, WSP(float, WS_SCAL), row00 + 64 * wid, h, lane, bl, mlc);
        if (lane == 0) { WSP(float, WS_MLOC)[bh * 32 + g4 * 4 + wid] = mlc; WSP(float, WS_BLAST)[bh * 32 + g4 * 4 + wid] = bl; } }
    __syncthreads();
    const int c = wid >> 1, kblk = wid & 1; const size_t u = (size_t)bh * 32 + g4 * 4 + c;
    const float* G = (const float*)(lds + O_G) + c * 256;
    const unsigned short* Kc = (const unsigned short*)(lds + O_K + c * 8192);
    bf16x8 pa[4];
#pragma unroll
    for (int ks = 0; ks < 4; ++ks) { float w[8];
#pragma unroll
        for (int j = 0; j < 8; ++j) { const int s = 16 * ks + 8 * hi + j; w[j] = bf2f(Kc[s * 64 + kblk * 32 + r32]) * G[128 + s]; }
        u32x4 q = {att::cvtpk(w[0], w[1]), att::cvtpk(w[2], w[3]), att::cvtpk(w[4], w[5]), att::cvtpk(w[6], w[7])}; pa[ks] = *reinterpret_cast<bf16x8*>(&q); }
    const int vbase = (int)(uintptr_t)(lds + O_V + c * 16384) + att::v_rd_base(lane);
#pragma unroll
    for (int vblk = 0; vblk < 4; ++vblk) { f32x16 acc = ozero16();
        mma_v(acc, vbase + vblk * 512, pa[0], pa[1], pa[2], pa[3]);
        float* cl = WSP(float, WS_CLOC) + u * 8192 + (size_t)(vblk * 32 + r32) * 64 + kblk * 32 + 4 * hi;
#pragma unroll
        for (int g = 0; g < 4; ++g) *(f32x4*)(cl + 8 * g) = (f32x4){acc[4 * g], acc[4 * g + 1], acc[4 * g + 2], acc[4 * g + 3]}; }
    if (tid < 256) { const int c2 = tid >> 6, k = tid & 63; const float* G2 = (const float*)(lds + O_G) + c2 * 256; const unsigned short* K2 = (const unsigned short*)(lds + O_K + c2 * 8192);
        float s_ = 0.f; for (int s = 0; s < 64; ++s) s_ += G2[128 + s] * bf2f(K2[s * 64 + k]); WSP(float, WS_NLOC)[((size_t)bh * 32 + g4 * 4 + c2) * 64 + k] = s_; }
    __syncthreads();
}
}
__device__ __forceinline__ int wave_sum_i(int v) {
    v += __builtin_amdgcn_update_dpp(0, v, 0x128, 0xf, 0xf, false);
    v += __builtin_amdgcn_update_dpp(0, v, 0x124, 0xf, 0xf, false);
    v += __builtin_amdgcn_update_dpp(0, v, 0x122, 0xf, 0xf, false);
    v += __builtin_amdgcn_update_dpp(0, v, 0x121, 0xf, 0xf, false);
    return __builtin_amdgcn_readlane(v, 0) + __builtin_amdgcn_readlane(v, 16) + __builtin_amdgcn_readlane(v, 32) + __builtin_amdgcn_readlane(v, 48);
}
__device__ __forceinline__ unsigned sortkey(float f) { unsigned u = __float_as_uint(f); u = (u == 0x80000000u) ? 0u : u; return (u & 0x80000000u) ? ~u : (u | 0x80000000u); }
__device__ __forceinline__ void transpose32(unsigned (&A)[32]) {
    unsigned m = 0x0000FFFFu;
#pragma unroll
    for (int j = 16; j != 0; j >>= 1, m ^= (m << j)) {
#pragma unroll
        for (int k = 0; k < 32; k = (k + j + 1) & ~j) { const unsigned t = (A[k] ^ (A[k + j] >> j)) & m; A[k] ^= t; A[k + j] ^= (t << j); }
    }
}
__device__ __forceinline__ void dsa_select_pair(const float* SC, unsigned* bm, int q0, int nt, int lane) {
    unsigned ka[32], kb[32], A[32], B[32];
#pragma unroll
    for (int j = 0; j < 32; ++j) { if (j < nt) { ka[j] = sortkey(SC[(size_t)q0 * 2048 + 64 * j + lane]); kb[j] = sortkey(SC[(size_t)(q0 + 1) * 2048 + 64 * j + lane]); } else { ka[j] = 0u; kb[j] = 0u; } A[j] = ka[j]; B[j] = kb[j]; }
    transpose32(A); transpose32(B);
    unsigned pa = 0u, pb = 0u; int npa = 1 << 30, npb = 1 << 30;
    for (int rep_ = 0; rep_ < 1 + ((DUP_MASK >> 12) & 1); ++rep_) { pa = 0u; pb = 0u; npa = 1 << 30; npb = 1 << 30; asm volatile("" : "+s"(pa), "+s"(pb));
    unsigned alA = 0xffffffffu, alB = 0xffffffffu; int abA = 0, abB = 0;
#pragma unroll
    for (int bit = 31; bit >= 0; --bit) {
        const unsigned tA = alA & A[31 - bit], tB = alB & B[31 - bit];
        const int cA = __builtin_popcount(tA) + abA, cB = __builtin_popcount(tB) + abB;
        const int nA = wave_sum_i(cA), nB = wave_sum_i(cB);
        if (nA >= 256) { alA = tA; pa |= 1u << bit; npa = nA; } else { alA ^= tA; abA = cA; }
        if (nB >= 256) { alB = tB; pb |= 1u << bit; npb = nB; } else { alB ^= tB; abB = cB; }
        if (npa == 256 && npb == 256) break;
    } }
#pragma unroll
    for (int which = 0; which < 2; ++which) {
        const unsigned prefix = which ? pb : pa; const int np = which ? npb : npa;
        int ngt = 0;
        if (np != 256) {
#pragma unroll
            for (int j = 0; j < 32; ++j) ngt += ((which ? kb[j] : ka[j]) > prefix) ? 1 : 0;
            ngt = wave_sum_i(ngt);
        }
        const int need = 256 - ngt; int running = 0; unsigned keep0 = 0u, keep1 = 0u;
#pragma unroll
        for (int j = 0; j < 32; ++j) { if (j < nt) { const unsigned k_ = which ? kb[j] : ka[j];
                bool sel;
                if (np == 256) sel = k_ >= prefix;
                else { const bool eq = k_ == prefix; const unsigned long long e = __ballot(eq);
                    const int rank = running + (int)__builtin_amdgcn_mbcnt_hi((unsigned)(e >> 32), __builtin_amdgcn_mbcnt_lo((unsigned)e, 0u));
                    sel = (k_ > prefix) || (eq && rank < need); running += __builtin_popcountll(e); }
                const unsigned long long m = __ballot(sel);
                if (lane == j) { keep0 = (unsigned)m; keep1 = (unsigned)(m >> 32); } } }
        if (lane < nt) *(u32x2*)(bm + (q0 + which) * 64 + 2 * lane) = (u32x2){keep0, keep1};
    }
}
__device__ __forceinline__ void dsa_unit(Frame& F, int l, int b, int cq) {
    char* lds = (char*)F.lds; const int tid = F.tid, lane = tid & 63, wid = F.wave, r32 = lane & 31, hi = lane >> 5;
    const int m0 = b * 2048 + cq * 64, nvis = 64 * (cq + 1);
    float* SC = WSP(float, WS_SCORE) + (size_t)blockIdx.x * 64 * 2048;
    for (int rep_ = 0; rep_ < 1 + ((DUP_MASK >> 11) & 1); ++rep_)
    {
        bf16x8 af[4];
        const bf16* qa = WSP(bf16, WS_IQ) + ((size_t)(m0 + 8 * wid) * 4 + r32) * 64 + 8 * hi;
#pragma unroll
        for (int ks = 0; ks < 4; ++ks) af[ks] = *(const bf16x8*)(qa + 16 * ks);
        float wq[4][4];
#pragma unroll
        for (int g = 0; g < 4; ++g) { const f32x4 w4 = *(const f32x4*)(WSP(float, WS_SCAL) + (size_t)(m0 + 8 * wid + 2 * g + hi) * 16 + 8);
            wq[g][0] = w4[0] * 0.0625f; wq[g][1] = w4[1] * 0.0625f; wq[g][2] = w4[2] * 0.0625f; wq[g][3] = w4[3] * 0.0625f; }
        const bf16* kg = WSP(bf16, WS_IK) + ((size_t)b * 2048 + (tid >> 3)) * 64 + (tid & 7) * 8;
        const int kw = (tid >> 3) * 144 + (tid & 7) * 16;
        bf16x8 stg = *(const bf16x8*)kg;
        *(bf16x8*)(lds + kw) = stg;
        __syncthreads();
        const int ntile = cq + 1;
        for (int t = 0; t < ntile; ++t) {
            const char* kb_ = lds + (t & 1) * 9216;
            if (t + 1 < ntile) stg = *(const bf16x8*)(kg + (size_t)(t + 1) * 64 * 64);
#pragma unroll
            for (int kb = 0; kb < 2; ++kb) {
                att::f32x16 d = ozero16();
#pragma unroll
                for (int ks = 0; ks < 4; ++ks) d = __builtin_amdgcn_mfma_f32_32x32x16_bf16(af[ks], *(const bf16x8*)(kb_ + (32 * kb + r32) * 144 + (16 * ks + 8 * hi) * 2), d, 0, 0, 0);
#pragma unroll
                for (int g = 0; g < 4; ++g) { const float sc = wq[g][0] * fmaxf(d[4 * g], 0.f) + wq[g][1] * fmaxf(d[4 * g + 1], 0.f) + wq[g][2] * fmaxf(d[4 * g + 2], 0.f) + wq[g][3] * fmaxf(d[4 * g + 3], 0.f);
                    SC[(size_t)(8 * wid + 2 * g + hi) * 2048 + t * 64 + kb * 32 + r32] = sc; }
            }
            if (t + 1 < ntile) *(bf16x8*)(lds + ((t + 1) & 1) * 9216 + kw) = stg;
            asm volatile("s_waitcnt lgkmcnt(0)" ::: "memory"); __builtin_amdgcn_s_barrier(); asm volatile("" ::: "memory");
        }
    }
    asm volatile("s_waitcnt vmcnt(0)" ::: "memory"); __builtin_amdgcn_fence(__ATOMIC_ACQUIRE, "agent"); asm volatile("s_waitcnt vmcnt(0)" ::: "memory");
    {
        unsigned* bm = (unsigned*)(lds + att::LDS_BM);
        const int nt = cq + 1;
        if (nvis <= 256) {
            for (int ql = 0; ql < 8; ++ql) if (32 * lane < nvis) bm[(8 * wid + ql) * 64 + lane] = 0xffffffffu;
        } else {
            for (int qp = 0; qp < 4; ++qp) dsa_select_pair(SC, bm, 8 * wid + 2 * qp, nt, lane);
        }
    }
    __syncthreads();
    att::BlockRef r{WSP(bf16, WS_QABS) + (size_t)m0 * 512, WSP(bf16, WS_CKV) + (size_t)b * 2048 * 128, WSP(bf16, WS_CKV) + (size_t)b * 2048 * 128,
                    WSP(bf16, WS_YCAT) + (size_t)M * 512 + (size_t)m0 * 512, 128, 0, cq + 1, KIN(I_KVG) + (size_t)l * 128};
    if (tid < 128) ((float*)(lds + att::LDS_GN))[tid] = r.g[tid];
    __syncthreads();
    att::Seam S;
    for (int rep_ = 0; rep_ < 1 + ((DUP_MASK >> 13) & 1); ++rep_) { att::prime<1>(r, lds, S, tid); att::block<1>(r, r, lds, S, tid); }
}
constexpr int CW_DEP = 8192;
__device__ __forceinline__ unsigned* dep_word(int l, int kind, int bh) { return (unsigned*)KCTL + CW_DEP + 64 * (l * 64 + kind * 32 + bh); }
__device__ __forceinline__ void dep_signal(Frame& F, unsigned* w) {
    asm volatile("s_waitcnt vmcnt(0)" ::: "memory");
    __syncthreads();
    if (F.wave == 0 && hw_lane() == 0) { __builtin_amdgcn_fence(__ATOMIC_RELEASE, "agent"); asm volatile("s_waitcnt vmcnt(0)" ::: "memory"); (void)xb_add(w, 1u); }
}
__device__ __forceinline__ void dep_wait(Frame& F, unsigned* w, unsigned target) {
    if (F.wave == 0 && hw_lane() == 0) { unsigned sp = 0u; while (xb_ld(w) < target) { __builtin_amdgcn_s_sleep(2); if (++sp > (1u << 24)) break; }
        __builtin_amdgcn_fence(__ATOMIC_ACQUIRE, "agent"); asm volatile("s_waitcnt vmcnt(0)" ::: "memory"); }
    __syncthreads();
}
__device__ __forceinline__ void mixer_queue(Frame& F, int l, int qidx) {
    PHASE_BEGIN();
    volatile LAS int* qslot = (volatile LAS int*)(F.lds + LDSCTL_OFF + 192);
    unsigned* head = (unsigned*)KCTL + CW_Q + 64 * qidx;
    constexpr int N_DSA = 256, N_FOX = 256, N_ML = 256, N_SCAN = 32 * 5, N_OUT = 256;
    for (;;) {
        __syncthreads();
        if (F.tid == 0) *qslot = (int)__hip_atomic_fetch_add(head, 1u, __ATOMIC_RELAXED, __HIP_MEMORY_SCOPE_AGENT);
        __syncthreads();
        int item = *qslot;
        const int dup = (l == 0) ? 1 : 0;
        const int R_DSA = N_DSA << (dup & (DUP_MASK >> 8)), R_FOX = N_FOX << (dup & (DUP_MASK >> 9)), R_ML = N_ML << (dup & (DUP_MASK >> 10)), R_SCAN = N_SCAN << (dup & (DUP_MASK >> 11)), R_OUT = N_OUT << (dup & (DUP_MASK >> 12));
        if (item >= R_DSA + R_FOX + R_ML + R_SCAN + R_OUT) break;
        PHASE_BEGIN();
        if (item < R_DSA) { item %= N_DSA; dsa_unit(F, l, item & 7, 31 - (item >> 3)); continue; }
        item -= R_DSA;
        if (item < R_FOX) { item %= N_FOX; fox_unit(F, (item & 31) >> 2, item & 3, 7 - (item >> 5)); continue; }
        item -= R_FOX;
        if (item < R_ML) { item %= N_ML; ml::unit_local4(F, l, item); dep_signal(F, dep_word(l, 0, item >> 3)); continue; }
        item -= R_ML;
        if (item < R_SCAN) { item %= N_SCAN; dep_wait(F, dep_word(l, 0, item / 5), 8u); ml::scan_item(F, item); dep_signal(F, dep_word(l, 1, item / 5)); continue; }
        item -= R_SCAN;
        item %= N_OUT; dep_wait(F, dep_word(l, 1, item >> 3), 5u);
        ml::unit_out4(F, l, item);
    }
}


__global__ void __launch_bounds__(NTHREADS, 2) fwd_kernel(Args args) {
    extern __shared__ __attribute__((aligned(16))) unsigned char lds[];
    cg::grid_group grid = cg::this_grid();
    Frame F;
    F.lds = (LAS unsigned char*)lds;
    F.wave = __builtin_amdgcn_readfirstlane((int)threadIdx.x >> 6); F.tid = F.wave * 64 + hw_lane();
    volatile LAS unsigned* MISC = (volatile LAS unsigned*)(F.lds + MISC_OFF);
    for (int u = F.tid; u < (LDS_BYTES - LDSCTL_OFF) / 4; u += NTHREADS) ((LAS unsigned*)(F.lds + LDSCTL_OFF))[u] = 0u;
    __syncthreads();
    (void)xcd_barrier_post((unsigned*)KCTL + CW_BAR, MISC + 8, F.tid == 0);
    grid.sync();
#define GRID_BAR() do { XcdBarrier bar_; bar_.bar = (unsigned*)KCTL + CW_BAR; bar_.x = xb_xcc_id(); bar_.st = (volatile LAS unsigned*)(F.lds + MISC_OFF) + 8; bar_.t0 = (F.wave == 0) && (hw_lane() == 0); xcd_barrier(bar_); } while (0)
#define REPS(k) (((DUP_MASK >> (k)) & 1) && l == 0 ? 2 : 1)
    for (int rep = 0; rep < ((DUP_MASK & 1) ? 2 : 1); ++rep) { p0_prologue(F); p0_moe_weights(F); GRID_BAR(); }
    norm_rows(F, KIN(I_X), 0, 0, 1024); GRID_BAR();
    for (int l = 0; l < DEPTH; ++l) {
        const float* xsrc = (l == 0) ? KIN(I_X) : WSP(float, WS_X);
        for (int rep = 0; rep < REPS(1); ++rep) {
            {   PHASE_BEGIN(); pg8::Gemm g{WSP(bf16, WS_XN), WSP(bf16, WS_WIN_T) + (size_t)l * NV * 1024, M, NV, 1024};
                InProjSched Sc; Sc.so.init(M, 4 * 256, GRIDN, (int)blockIdx.x); Sc.f8 = 0; EpiInProj E{WSP(float, WS_BINP) + (size_t)l * NV, (unsigned char*)KWS};
                pg8::gemm_phase<EpiInProj, InProjSched, true, true>(F.lds, g, Sc, E, F.tid); }
            {   PHASE_BEGIN(); pg8::Gemm g{(const bf16*)WSP(unsigned char, WS_XN1_8), (const bf16*)(WSP(unsigned char, WS_WIN8) + (size_t)l * NV * 1024), M, NV, 512};
                InProjSched Sc; Sc.so.init(M, 24 * 256, GRIDN, (int)blockIdx.x); Sc.f8 = 1; EpiInProj8 E{WSP(float, WS_BINP) + (size_t)l * NV, (unsigned char*)KWS};
                pg8::gemm_phase<EpiInProj8, InProjSched, false, true, true>(F.lds, g, Sc, E, F.tid); }
            GRID_BAR(); }
        mixer_queue(F, l, l); GRID_BAR();
        for (int rep = 0; rep < REPS(4); ++rep) {
            {   PHASE_BEGIN(); pg8::Gemm g{WSP(bf16, WS_YCAT), WSP(bf16, WS_WBR_T) + (size_t)l * 3072 * 512, 3 * M, 3072, 512};
                BranchSched Sc{GRIDN, vcu_id(), 0 | (1 << 2) | (2 << 4), 3}; EpiBranch E{WSP(bf16, WS_GATES), WSP(bf16, WS_MERGED), 0, WSP(unsigned char, WS_MERGED8)};
                pg8::gemm_phase<EpiBranch, BranchSched, true, true>(F.lds, g, Sc, E, F.tid); }
            GRID_BAR();
            {   PHASE_BEGIN(); pg8::Gemm g{(const bf16*)WSP(unsigned char, WS_MERGED8), (const bf16*)(WSP(unsigned char, WS_WOUT8) + (size_t)l * 1024 * 1024), M, 1024, 512};
                pg8::StaticOrder Sc; Sc.init(M, 1024, GRIDN, (int)blockIdx.x); EpiOutProj E{xsrc, WSP(float, WS_X), WSP(float, WS_MOD) + (size_t)l * 8 * 6144};
                pg8::gemm_phase<EpiOutProj, pg8::StaticOrder, false, true, true>(F.lds, g, Sc, E, F.tid); }
            GRID_BAR(); }
        xsrc = WSP(float, WS_X);
        if (((DUP_MASK >> 16) & 1) && l == 0) { route_phase(F, l, xsrc, true); GRID_BAR(); }
        route_phase(F, l, xsrc); GRID_BAR();
        for (int rep = 0; rep < REPS(5); ++rep) { gather_phase(F, l); GRID_BAR(); }
        const LAS int* tst = (const LAS int*)(F.lds + LDSCTL_OFF);
        for (int rep = 0; rep < REPS(6); ++rep) {
            {   PHASE_BEGIN(); pg8::Gemm gp{(const bf16*)WSP(unsigned char, WS_AS8), (const bf16*)(WSP(unsigned char, WS_W1T) + (size_t)l * 32 * 2048 * 1024), MP, 32 * 2048, 512};
                MoeSched<8> Sc{tst, tst[32] * 8, GRIDN, vcu_id()}; EpiP1 E{WSP(unsigned char, WS_ACT8), KIN(I_B1) + (size_t)l * 32 * 2048};
                pg8::gemm_phase<EpiP1, MoeSched<8>, false, true, true>(F.lds, gp, Sc, E, F.tid); }
            GRID_BAR(); }
        for (int rep = 0; rep < REPS(18); ++rep) {
        {   PHASE_BEGIN(); f8::Gemm g{WSP(unsigned char, WS_ACT8), WSP(unsigned char, WS_W2T) + (size_t)l * 32 * 1024 * 1024, 1024};
            MoeSched<4> Sc{tst, tst[32] * 4, GRIDN, vcu_id(), (DUP_MASK >> 24) & 1 & ((rep == 0 && l == 0) ? 1 : 0)}; EpiP2 E{WSP(bf16, WS_ASORT), KIN(I_B2) + (size_t)l * 32 * 1024, (((DUP_MASK >> 22) & 3) && rep == 0 && l == 0) ? ((DUP_MASK >> 22) & 3) : 0};
            pg8::Gemm gp{(const bf16*)g.A, (const bf16*)g.Bt, MP, 32 * 1024, 512, (((DUP_MASK >> 21) & 1) && rep == 0 && l == 0) ? 2 : 0};
            {
                const int nmax = (Sc.total + GRIDN - 1) / GRIDN, nmine = (Sc.total - Sc.c + GRIDN - 1) / GRIDN;
                if (nmine < nmax) { __builtin_amdgcn_s_sleep(100); __builtin_amdgcn_s_sleep(100); } }
            pg8::gemm_phase<EpiP2, MoeSched<4>, false, true, true>(F.lds, gp, Sc, E, F.tid); }
        GRID_BAR(); }
        if (((DUP_MASK >> 17) & 1) && l == 0) { combine_phase(F, l, xsrc, false, true); GRID_BAR(); }
        combine_phase(F, l, xsrc, l == DEPTH - 1); GRID_BAR();
    }
}

extern "C" void kernel_launch(void* const* d_in, const int* in_sizes, int n_in, void* d_out, int out_size, void* d_ws, size_t ws_size, hipStream_t stream) {
    static int grid = 0;
    if (grid == 0) {
        if (n_in != 23 || out_size != M * D || ws_size < WS_END2) { fprintf(stderr, "kernel_launch: unexpected shapes (n_in %d out %d ws %zu)\n", n_in, out_size, ws_size); grid = -1; return; }
        int dev = 0, cus = 0, per_cu = 0;
        (void)hipGetDevice(&dev);
        (void)hipDeviceGetAttribute(&cus, hipDeviceAttributeMultiprocessorCount, dev);
        (void)hipFuncSetAttribute((const void*)fwd_kernel, hipFuncAttributeMaxDynamicSharedMemorySize, LDS_BYTES);
        (void)hipOccupancyMaxActiveBlocksPerMultiprocessor(&per_cu, (const void*)fwd_kernel, NTHREADS, LDS_BYTES);
        if (per_cu < 1) { fprintf(stderr, "kernel_launch: occupancy query says %d blocks/CU\n", per_cu); per_cu = 1; }
        grid = cus;
    }
    if (grid < 0) return;
    (void)hipMemsetAsync((char*)d_ws + WS_CTL, 0, CTL_ZERO_BYTES, stream);
    Args a{};
    for (int i = 0; i < 23; ++i) a.in[i] = (const float*)d_in[i];
    a.out = (float*)d_out; a.ws = (unsigned char*)d_ws;
    void* kargs[] = {&a};
    hipError_t e = hipLaunchCooperativeKernel((const void*)fwd_kernel, dim3(grid), dim3(NTHREADS), kargs, LDS_BYTES, stream);
    if (e != hipSuccess) fprintf(stderr, "cooperative launch failed: %s (grid %d)\n", hipGetErrorString(e), grid);
}
```

```cpp
#include <hip/hip_runtime.h>
#include <hip/hip_cooperative_groups.h>
#include <cstdio>
#include <cstdint>
namespace cg = cooperative_groups;
#define DUP_MASK 0
__device__ __forceinline__ int hw_lane() { int x; asm volatile("v_mbcnt_lo_u32_b32 %0, -1, 0\n\tv_mbcnt_hi_u32_b32 %0, -1, %0" : "=v"(x)); return x; }
typedef float ozf4_t __attribute__((ext_vector_type(4)));
typedef float ozf16_t __attribute__((ext_vector_type(16)));
__device__ __forceinline__ float ozero() { float z; asm volatile("v_mov_b32 %0, 0" : "=v"(z)); return z; }
__device__ __forceinline__ ozf4_t ozero4() { const float z = ozero(); return (ozf4_t){z, z, z, z}; }
__device__ __forceinline__ ozf16_t ozero16() { const float z = ozero(); return (ozf16_t){z, z, z, z, z, z, z, z, z, z, z, z, z, z, z, z}; }
__device__ __forceinline__ float lshfl(float x, int srclane) { return __builtin_bit_cast(float, __builtin_amdgcn_ds_bpermute(srclane << 2, __builtin_bit_cast(int, x))); }
__device__ __forceinline__ float qxor1(float x) { return __builtin_bit_cast(float, __builtin_amdgcn_mov_dpp(__builtin_bit_cast(int, x), 0xB1, 0xf, 0xf, true)); }
__device__ __forceinline__ float qxor2(float x) { return __builtin_bit_cast(float, __builtin_amdgcn_mov_dpp(__builtin_bit_cast(int, x), 0x4E, 0xf, 0xf, true)); }
__device__ __forceinline__ float hmirror(float x) { return __builtin_bit_cast(float, __builtin_amdgcn_mov_dpp(__builtin_bit_cast(int, x), 0x141, 0xf, 0xf, true)); }
namespace pg8 {
#define PG8_LAS __attribute__((address_space(3)))
typedef unsigned short bf16_t;
typedef short bf16x8 __attribute__((ext_vector_type(8)));
typedef float f32x4 __attribute__((ext_vector_type(4)));
typedef unsigned u32x4 __attribute__((ext_vector_type(4)));
constexpr int BM = 256, BK = 64, HALF = 128, HTB = HALF * BK * 2  , STAGE_BYTES = 8 * HTB, NXCD = 8, WGM = 8;

__host__ __device__ __forceinline__ int lds_byte(int r, int c) { const int st = (r >> 4) * 2 + (c >> 5), rr = r & 15, cc = c & 31, ob = rr * 64 + cc * 2; return st * 1024 + (ob ^ (((ob >> 9) & 1) << 5)); }
__host__ __device__ __forceinline__ void stage_rc(int b, int& R, int& C) { const int st = b / 1024, sb = b % 1024, swz = sb ^ (((sb >> 9) & 1) << 5); R = (st >> 1) * 16 + swz / 64; C = (st & 1) * 32 + (swz % 64) / 2; }
__host__ __device__ __forceinline__ int perm32(int rho) { const int n = rho >> 4, i = rho & 15; return 8 * (i >> 2) + 4 * n + (i & 3); }

struct Unit { int pm, pn; };
struct Gemm { const bf16_t* A; const bf16_t* Bt; int M, N, K; int nt_probe = 0; };

struct StaticOrder {
    int nM, nN, nwg, G, c;
    __host__ __device__ void init(int M, int N, int G_, int c_) { nM = M / BM; nN = N / BM; nwg = nM * nN; G = G_; c = c_; }
    __host__ __device__ bool next(int i, Unit& u) const {
        const long L = (long)i * G + c; if (L >= nwg) return false;
        int wgid = (int)L; { const int q = nwg / NXCD, r = nwg % NXCD, xcd = wgid % NXCD, off = wgid / NXCD; wgid = (xcd < r ? xcd * (q + 1) : r * (q + 1) + (xcd - r) * q) + off; }
        const int nig = WGM * nN, gid = wgid / nig, fm = gid * WGM, gsz = (nM - fm) < WGM ? (nM - fm) : WGM;
        u.pm = fm + ((wgid % nig) % gsz); u.pn = (wgid % nig) / gsz; return true;
    }
    __device__ __forceinline__ void a_ready(const Unit&) const {}
    __device__ __forceinline__ void done(const Unit&) const {}
};

__device__ __forceinline__ unsigned cvt_pk_bf16(float lo, float hi) { unsigned r; asm volatile("v_cvt_pk_bf16_f32 %0, %1, %2" : "=v"(r) : "v"(lo), "v"(hi)); return r; }
__device__ __forceinline__ void glds16s(const void* sbase, unsigned voff, unsigned lds_dst) { unsigned keep;
    asm volatile("s_mov_b32 %0, m0\n\ts_mov_b32 m0, %3\n\ts_nop 0\n\tglobal_load_lds_dwordx4 %1, %2\n\ts_mov_b32 m0, %0" : "=&s"(keep) : "v"(voff), "s"(sbase), "s"(lds_dst) : "memory"); }
typedef int v8i_t __attribute__((ext_vector_type(8)));
typedef int v4i_t __attribute__((ext_vector_type(4)));
template <class T, class = void> struct epi_bias_init { static constexpr bool value = false; };
template <class T> struct epi_bias_init<T, decltype((void)T::BIAS_INIT)> { static constexpr bool value = T::BIAS_INIT; };
template <class T, class = void> struct epi_nstore { static constexpr int value = 0; };
template <class T> struct epi_nstore<T, decltype((void)T::NSTORE)> { static constexpr int value = T::NSTORE; };
template <class Epi, class Sched, bool ALIGN_EPI = false, bool SP2 = false, bool FP8 = false>
__device__ __forceinline__ void gemm_phase(PG8_LAS unsigned char* lds, const Gemm g, const Sched& S, const Epi& E, const int tid) {
    const int wid = __builtin_amdgcn_readfirstlane(tid >> 6), lane = tid & 63, wr = wid >> 2, wc = wid & 3, fr = lane & 15, fq = lane >> 4;
    const int K = g.K, nt = (DUP_MASK != 0 && g.nt_probe) ? g.nt_probe : K / BK;
    unsigned voffA[2], voffB[2];
#pragma unroll
    for (int i = 0; i < 2; ++i) { int R, C; stage_rc(tid * 16 + i * 8192, R, C); const int Rb = Epi::PERM ? ((R & ~31) + perm32(R & 31)) : R;
        voffA[i] = (unsigned)(R * K + C) * 2u; voffB[i] = (unsigned)(Rb * K + C) * 2u; }
    const size_t kstep = (size_t)(BK * 2);
    const size_t hstep = (size_t)HALF * K * 2;
    const size_t tstep = 2 * hstep;
    const unsigned ldsw = (unsigned)wid * 1024u, ldsbase = (unsigned)(uintptr_t)lds;
    const int aoff0 = lds_byte(wr * 64 + fr, fq * 8), aoff1 = aoff0 + 1024;
    const int boff0 = lds_byte(wc * 32 + fr, fq * 8), boff1 = boff0 + 1024;
#define PG8_SA(b, h) (((b) * 2 + (h)) * HTB)
#define PG8_SB(b, h) ((4 + (b) * 2 + (h)) * HTB)
#define PG8_STAGE(bufoff, gbase, voff) do { _Pragma("unroll") for (int _i = 0; _i < 2; ++_i) \
        glds16s((const void*)(gbase), (voff)[_i], (unsigned)__builtin_amdgcn_readfirstlane((int)(ldsbase + (bufoff) + ldsw + _i * 8192))); } while (0)
#define PG8_LDA(dst, b, h) do { _Pragma("unroll") for (int m = 0; m < 4; ++m) { if constexpr (FP8) { \
        const v4i_t lo_ = *(const PG8_LAS v4i_t*)(lds + PG8_SA(b, h) + aoff0 + m * 2048), hi_ = *(const PG8_LAS v4i_t*)(lds + PG8_SA(b, h) + aoff1 + m * 2048); dst##8[m] = __builtin_shufflevector(lo_, hi_, 0, 1, 2, 3, 4, 5, 6, 7); } \
        else { dst[m][0] = *(const PG8_LAS bf16x8*)(lds + PG8_SA(b, h) + aoff0 + m * 2048); dst[m][1] = *(const PG8_LAS bf16x8*)(lds + PG8_SA(b, h) + aoff1 + m * 2048); } } } while (0)
#define PG8_LDB(dst, b, h) do { _Pragma("unroll") for (int n = 0; n < 2; ++n) { if constexpr (FP8) { \
        const v4i_t lo_ = *(const PG8_LAS v4i_t*)(lds + PG8_SB(b, h) + boff0 + n * 2048), hi_ = *(const PG8_LAS v4i_t*)(lds + PG8_SB(b, h) + boff1 + n * 2048); dst##8[n] = __builtin_shufflevector(lo_, hi_, 0, 1, 2, 3, 4, 5, 6, 7); } \
        else { dst[n][0] = *(const PG8_LAS bf16x8*)(lds + PG8_SB(b, h) + boff0 + n * 2048); dst[n][1] = *(const PG8_LAS bf16x8*)(lds + PG8_SB(b, h) + boff1 + n * 2048); } } } while (0)
#define PG8_MMA(ai, bj, At, Bt) do { __builtin_amdgcn_s_setprio(1); _Pragma("unroll") for (int m = 0; m < 4; ++m) _Pragma("unroll") for (int n = 0; n < 2; ++n) { \
        if constexpr (FP8) { asm volatile("v_mfma_scale_f32_16x16x128_f8f6f4 %0, %1, %2, %0, %3, %4 op_sel_hi:[0,0,0]" : "+v"(acc[ai][bj][m][n]) : "v"(Bt##8[n]), "v"(At##8[m]), "v"(sclW), "v"(sclX)); } \
        else { _Pragma("unroll") for (int k = 0; k < 2; ++k) acc[ai][bj][m][n] = __builtin_amdgcn_mfma_f32_16x16x32_bf16(Bt[n][k], At[m][k], acc[ai][bj][m][n], 0, 0, 0); } } __builtin_amdgcn_s_setprio(0); } while (0)
#define PG8_WAIT_V(n) asm volatile("s_waitcnt vmcnt(" #n ")" ::: "memory")
#define PG8_WAIT_VN(n) asm volatile("s_waitcnt vmcnt(%0)" :: "n"(n) : "memory")
#define PG8_WAIT_L(n) asm volatile("s_waitcnt lgkmcnt(" #n ")" ::: "memory")
#define PG8_BAR __builtin_amdgcn_s_barrier()
#define PG8_SCHED __builtin_amdgcn_sched_barrier(0)
    Unit cur, nxt; int ui = 0;
    if (!S.next(0, cur)) return;
    const int sclW = 0x7a7a7a7a, sclX = 0x7f7f7f7f;
    cur.pm = __builtin_amdgcn_readfirstlane(cur.pm); cur.pn = __builtin_amdgcn_readfirstlane(cur.pn);
    f32x4 acc[2][2][4][2];
    constexpr int NST = epi_nstore<Epi>::value;
    f32x4 nb[4];
    if constexpr (epi_bias_init<Epi>::value) {
#pragma unroll
        for (int p = 0; p < 2; ++p) { Unit bu; const int bi = p * 8 + wid;
            if (S.next(bi, bu)) *(PG8_LAS f32x4*)(lds + STAGE_BYTES + bi * 1024 + lane * 16) = *(const f32x4*)E.bias_src(bu, lane); }
        __syncthreads();
        E.load_bias(nb, (const PG8_LAS float*)(lds + STAGE_BYTES), wc, fq); E.set_bias(acc, nb); }
    else {
#pragma unroll
    for (int a = 0; a < 2; ++a)
#pragma unroll
        for (int b = 0; b < 2; ++b)
#pragma unroll
            for (int m = 0; m < 4; ++m)
#pragma unroll
                for (int n = 0; n < 2; ++n) acc[a][b][m][n] = ozero4();
    }
    bf16x8 At[4][2], B0[2][2], B1[2][2]; v8i_t At8[4], B08[2], B18[2];
    const char* cA = (const char*)g.A + (size_t)cur.pm * tstep; const char* cB = (const char*)g.Bt + (size_t)cur.pn * tstep;
    S.a_ready(cur);
    if constexpr (SP2) {
        PG8_STAGE(PG8_SB(0, 0), cB, voffB); PG8_STAGE(PG8_SB(0, 1), cB + hstep, voffB); PG8_STAGE(PG8_SA(0, 0), cA, voffA); PG8_STAGE(PG8_SA(0, 1), cA + hstep, voffA);
        if (wr == 1) PG8_BAR;
        PG8_WAIT_V(2); PG8_BAR;
        PG8_STAGE(PG8_SB(1, 0), cB + kstep, voffB); PG8_STAGE(PG8_SA(1, 0), cA + kstep, voffA); PG8_STAGE(PG8_SB(1, 1), cB + hstep + kstep, voffB);
        PG8_WAIT_V(6); PG8_BAR;
    } else {
        PG8_STAGE(PG8_SB(0, 0), cB, voffB); PG8_STAGE(PG8_SA(0, 0), cA, voffA); PG8_STAGE(PG8_SB(0, 1), cB + hstep, voffB); PG8_STAGE(PG8_SA(0, 1), cA + hstep, voffA);
        if (wr == 1) PG8_BAR;
        PG8_WAIT_V(4); PG8_BAR;
        PG8_STAGE(PG8_SB(1, 0), cB + kstep, voffB); PG8_STAGE(PG8_SA(1, 0), cA + kstep, voffA); PG8_STAGE(PG8_SB(1, 1), cB + hstep + kstep, voffB);
        PG8_WAIT_V(6); PG8_BAR;
    }
    for (;;) {
        const bool has_next = S.next(ui + 1, nxt);
        nxt.pm = __builtin_amdgcn_readfirstlane(nxt.pm); nxt.pn = __builtin_amdgcn_readfirstlane(nxt.pn);
        const char* nA = has_next ? (const char*)g.A + (size_t)nxt.pm * tstep : cA; const char* nB = has_next ? (const char*)g.Bt + (size_t)nxt.pn * tstep : cB;
        for (int t = 0; t < nt; t += 2) {
            const bool last = (t == nt - 2);
            const bool rl = NST > 0 && t == 0 && ui > 0;
            const char* a1 = cA + (size_t)(t + 1) * kstep;
            const char* a2 = last ? nA : cA + (size_t)(t + 2) * kstep; const char* b2 = last ? nB : cB + (size_t)(t + 2) * kstep;
            const char* a3 = a2 + kstep; const char* b3 = b2 + kstep;
            if (last && has_next) S.a_ready(nxt);
            if constexpr (SP2) {
            PG8_LDB(B0, 0, 0); PG8_LDB(B1, 0, 1); PG8_SCHED; PG8_LDA(At, 0, 0); PG8_STAGE(PG8_SA(1, 1), a1 + hstep, voffA);
            if (rl) PG8_WAIT_VN(NST + 2); else PG8_WAIT_V(8);
            PG8_WAIT_L(0); PG8_BAR; PG8_MMA(0, 0, At, B0); PG8_MMA(0, 1, At, B1); PG8_BAR; PG8_SCHED;
            PG8_LDA(At, 0, 1); PG8_STAGE(PG8_SB(0, 0), b2, voffB); PG8_STAGE(PG8_SB(0, 1), b2 + hstep, voffB); PG8_STAGE(PG8_SA(0, 0), a2, voffA);
            if (rl) PG8_WAIT_VN(NST + 8); else PG8_WAIT_V(8);
            PG8_WAIT_L(0); PG8_BAR; PG8_MMA(1, 0, At, B0); PG8_MMA(1, 1, At, B1); PG8_BAR; PG8_SCHED;
            PG8_LDB(B0, 1, 0); PG8_LDB(B1, 1, 1); PG8_SCHED; PG8_LDA(At, 1, 0); PG8_STAGE(PG8_SA(0, 1), a2 + hstep, voffA);
            if (rl) PG8_WAIT_VN(NST + 10); else PG8_WAIT_V(8);
            PG8_WAIT_L(0); PG8_BAR; PG8_MMA(0, 0, At, B0); PG8_MMA(0, 1, At, B1); PG8_BAR; PG8_SCHED;
            PG8_LDA(At, 1, 1); PG8_STAGE(PG8_SB(1, 0), b3, voffB); PG8_STAGE(PG8_SB(1, 1), b3 + hstep, voffB); PG8_STAGE(PG8_SA(1, 0), a3, voffA);
            PG8_WAIT_V(8); PG8_WAIT_L(0); PG8_BAR; PG8_MMA(1, 0, At, B0); PG8_MMA(1, 1, At, B1); PG8_BAR; PG8_SCHED;
            } else {
            PG8_LDB(B0, 0, 0); PG8_SCHED; PG8_LDA(At, 0, 0); PG8_STAGE(PG8_SA(1, 1), a1 + hstep, voffA);
            PG8_WAIT_L(8); PG8_BAR; PG8_WAIT_L(0); PG8_MMA(0, 0, At, B0); PG8_BAR; PG8_SCHED;
            PG8_LDB(B1, 0, 1); PG8_STAGE(PG8_SB(0, 0), b2, voffB);
            PG8_BAR; PG8_WAIT_L(0); PG8_MMA(0, 1, At, B1); PG8_BAR;
            PG8_LDA(At, 0, 1); PG8_STAGE(PG8_SA(0, 0), a2, voffA);
            PG8_BAR; PG8_WAIT_L(0); PG8_MMA(1, 0, At, B0); PG8_BAR; PG8_SCHED;
            PG8_STAGE(PG8_SB(0, 1), b2 + hstep, voffB);
            PG8_WAIT_V(6); PG8_BAR; PG8_MMA(1, 1, At, B1); PG8_BAR;
            PG8_LDB(B0, 1, 0); PG8_SCHED; PG8_LDA(At, 1, 0); PG8_STAGE(PG8_SA(0, 1), a2 + hstep, voffA);
            PG8_WAIT_L(8); PG8_BAR; PG8_WAIT_L(0); PG8_MMA(0, 0, At, B0); PG8_BAR; PG8_SCHED;
            PG8_LDB(B1, 1, 1); PG8_STAGE(PG8_SB(1, 0), b3, voffB);
            PG8_BAR; PG8_WAIT_L(0); PG8_MMA(0, 1, At, B1); PG8_BAR;
            PG8_LDA(At, 1, 1); PG8_STAGE(PG8_SA(1, 0), a3, voffA);
            PG8_BAR; PG8_WAIT_L(0); PG8_MMA(1, 0, At, B0); PG8_BAR; PG8_SCHED;
            PG8_STAGE(PG8_SB(1, 1), b3 + hstep, voffB);
            PG8_WAIT_V(6); PG8_BAR; PG8_MMA(1, 1, At, B1); PG8_BAR;
            }
        }
        if constexpr (FP8) asm volatile("s_nop 15\n\ts_nop 15" ::: "memory");
        if constexpr (ALIGN_EPI) { if (wr == 0) PG8_BAR; }
        if constexpr (epi_bias_init<Epi>::value) { if (has_next) E.load_bias(nb, (const PG8_LAS float*)(lds + STAGE_BYTES + (ui + 1) * 1024), wc, hw_lane() >> 4); }
        if constexpr (!Epi::AFTER_DRAIN) { const int el = hw_lane(); E(acc, cur, wr, wc, el & 15, el >> 4); S.done(cur); }
        if (!has_next) break;
        if constexpr (epi_bias_init<Epi>::value) E.set_bias(acc, nb);
        else {
#pragma unroll
        for (int a = 0; a < 2; ++a)
#pragma unroll
            for (int b = 0; b < 2; ++b)
#pragma unroll
                for (int m = 0; m < 4; ++m)
#pragma unroll
                    for (int n = 0; n < 2; ++n) acc[a][b][m][n] = ozero4();
        }
        cur = nxt; cA = nA; cB = nB; ++ui;
        if constexpr (ALIGN_EPI) { if (wr == 1) PG8_BAR; }
    }
    PG8_WAIT_V(0);
    if constexpr (!ALIGN_EPI) { if (wr == 0) PG8_BAR; }
    PG8_BAR;
    if constexpr (Epi::AFTER_DRAIN) { E.fused(acc, cur, wr, wc, fr, fq, lds, wid, lane); S.done(cur); }
#undef PG8_SA
#undef PG8_SB
#undef PG8_STAGE
#undef PG8_LDA
#undef PG8_LDB
#undef PG8_MMA
#undef PG8_WAIT_V
#undef PG8_WAIT_L
#undef PG8_BAR
#undef PG8_SCHED
}
}
typedef float f32x4 __attribute__((ext_vector_type(4)));
#define LAS __attribute__((address_space(3)))

namespace f8 {
typedef int v8i_t __attribute__((ext_vector_type(8)));
typedef int v4i_t __attribute__((ext_vector_type(4)));
constexpr int STG = 49152;
struct Gemm { const unsigned char* A; const unsigned char* Bt; int K; };
template <class Epi, class Sched>
__device__ __forceinline__ void gemm_phase(LAS unsigned char* lds, const Gemm g, const Sched& S, const Epi& E, const int tid) {
    const int wid = __builtin_amdgcn_readfirstlane(tid >> 6), lane = tid & 63, wr = wid >> 1, wc = wid & 1, fr = lane & 15, fq = lane >> 4;
    const int K = g.K, nt = K >> 7;
    unsigned voff[2];
#pragma unroll
    for (int i = 0; i < 2; ++i) { int R, C; pg8::stage_rc(tid * 16 + i * 8192, R, C); voff[i] = (unsigned)(R * K + C * 2); }
    const unsigned ldsbase = (unsigned)(uintptr_t)lds, ldsw = (unsigned)wid * 1024u;
    const int aoff0 = (wr >> 1) * 16384 + pg8::lds_byte((wr & 1) * 64 + fr, fq * 16), aoff1 = (wr >> 1) * 16384 + pg8::lds_byte((wr & 1) * 64 + fr, fq * 16 + 8);
    const int boff0 = 32768 + pg8::lds_byte(wc * 64 + fr, fq * 16), boff1 = 32768 + pg8::lds_byte(wc * 64 + fr, fq * 16 + 8);
#define F8_STAGE(s, pa, pb, kt) do { const size_t ko_ = (size_t)(kt) * 128; _Pragma("unroll") for (int _i = 0; _i < 2; ++_i) { \
        pg8::glds16s((const void*)((pa) + ko_), voff[_i], (unsigned)__builtin_amdgcn_readfirstlane((int)(ldsbase + (s) * STG + ldsw + _i * 8192))); \
        pg8::glds16s((const void*)((pa) + (size_t)128 * K + ko_), voff[_i], (unsigned)__builtin_amdgcn_readfirstlane((int)(ldsbase + (s) * STG + 16384 + ldsw + _i * 8192))); \
        pg8::glds16s((const void*)((pb) + ko_), voff[_i], (unsigned)__builtin_amdgcn_readfirstlane((int)(ldsbase + (s) * STG + 32768 + ldsw + _i * 8192))); } } while (0)
    pg8::Unit cur, nxt; int ui = 0;
    if (!S.next(0, cur)) return;
    cur.pm = __builtin_amdgcn_readfirstlane(cur.pm); cur.pn = __builtin_amdgcn_readfirstlane(cur.pn);
    const unsigned char* cA = g.A + (size_t)cur.pm * 256 * K; const unsigned char* cB = g.Bt + (size_t)cur.pn * 128 * K;
    bool has_next = S.next(1, nxt);
    nxt.pm = __builtin_amdgcn_readfirstlane(nxt.pm); nxt.pn = __builtin_amdgcn_readfirstlane(nxt.pn);
    const unsigned char* nA = has_next ? g.A + (size_t)nxt.pm * 256 * K : cA; const unsigned char* nB = has_next ? g.Bt + (size_t)nxt.pn * 128 * K : cB;
    F8_STAGE(0, cA, cB, 0);
    if (nt > 1) F8_STAGE(1, cA, cB, 1); else F8_STAGE(1, nA, nB, 0);
    asm volatile("s_waitcnt vmcnt(6)" ::: "memory"); __builtin_amdgcn_s_barrier(); asm volatile("" ::: "memory");
    int st = 0;
    for (;;) {
        f32x4 acc[4][4];
#pragma unroll
        for (int m = 0; m < 4; ++m)
#pragma unroll
            for (int n = 0; n < 4; ++n) acc[m][n] = ozero4();
        for (int t = 0; t < nt; ++t) {
            const int s2 = st >= 1 ? st - 1 : 2;
            if (t + 2 < nt) F8_STAGE(s2, cA, cB, t + 2); else F8_STAGE(s2, nA, nB, t + 2 - nt);
            v8i_t af[4], bfr[4];
            const LAS unsigned char* sb = lds + st * STG;
#pragma unroll
            for (int m = 0; m < 4; ++m) { const v4i_t lo_ = *(const LAS v4i_t*)(sb + aoff0 + m * 2048), hi_ = *(const LAS v4i_t*)(sb + aoff1 + m * 2048); af[m] = __builtin_shufflevector(lo_, hi_, 0, 1, 2, 3, 4, 5, 6, 7); }
#pragma unroll
            for (int n = 0; n < 4; ++n) { const v4i_t lo_ = *(const LAS v4i_t*)(sb + boff0 + n * 2048), hi_ = *(const LAS v4i_t*)(sb + boff1 + n * 2048); bfr[n] = __builtin_shufflevector(lo_, hi_, 0, 1, 2, 3, 4, 5, 6, 7); }
            asm volatile("s_waitcnt lgkmcnt(0)" ::: "memory"); __builtin_amdgcn_sched_barrier(0);
            __builtin_amdgcn_s_setprio(1);
#pragma unroll
            for (int m = 0; m < 4; ++m)
#pragma unroll
                for (int n = 0; n < 4; ++n) acc[m][n] = __builtin_amdgcn_mfma_scale_f32_16x16x128_f8f6f4(bfr[n], af[m], acc[m][n], 0, 0, 0, 0x7a7a7a7a, 0, 0x7f7f7f7f);
            __builtin_amdgcn_s_setprio(0);
            __builtin_amdgcn_sched_barrier(0);
            asm volatile("s_waitcnt vmcnt(6)" ::: "memory"); __builtin_amdgcn_s_barrier(); asm volatile("" ::: "memory");
            st = st == 2 ? 0 : st + 1;
        }
        E(acc, cur, wr, wc, fr, fq);
        if (!has_next) break;
        cur = nxt; cA = nA; cB = nB; ++ui;
        has_next = S.next(ui + 1, nxt);
        nxt.pm = __builtin_amdgcn_readfirstlane(nxt.pm); nxt.pn = __builtin_amdgcn_readfirstlane(nxt.pn);
        nA = has_next ? g.A + (size_t)nxt.pm * 256 * K : cA; nB = has_next ? g.Bt + (size_t)nxt.pn * 128 * K : cB;
    }
    asm volatile("s_waitcnt vmcnt(0)" ::: "memory"); __builtin_amdgcn_s_barrier(); asm volatile("" ::: "memory");
#undef F8_STAGE
}
constexpr int STGW = 65536;
template <class Epi, class Sched>
__device__ __forceinline__ void gemm_phase_w(LAS unsigned char* lds, const Gemm g, const Sched& S, const Epi& E, const int tid) {
    const int wid = __builtin_amdgcn_readfirstlane(tid >> 6), lane = tid & 63, wr = wid >> 1, wc = wid & 1, fr = lane & 15, fq = lane >> 4;
    const int K = g.K, nt = K >> 7;
    unsigned voff[2];
#pragma unroll
    for (int i = 0; i < 2; ++i) { int R, C; pg8::stage_rc(tid * 16 + i * 8192, R, C); voff[i] = (unsigned)(R * K + C * 2); }
    const unsigned ldsbase = (unsigned)(uintptr_t)lds, ldsw = (unsigned)wid * 1024u;
    const int aoff0 = (wr >> 1) * 16384 + pg8::lds_byte((wr & 1) * 64 + fr, fq * 16), aoff1 = (wr >> 1) * 16384 + pg8::lds_byte((wr & 1) * 64 + fr, fq * 16 + 8);
    const int boff0 = 32768 + wc * 16384 + pg8::lds_byte(fr, fq * 16), boff1 = 32768 + wc * 16384 + pg8::lds_byte(fr, fq * 16 + 8);
#define F8W_STAGE(s, pa, pb, kt) do { const size_t ko_ = (size_t)(kt) * 128; _Pragma("unroll") for (int _i = 0; _i < 2; ++_i) { \
        pg8::glds16s((const void*)((pa) + ko_), voff[_i], (unsigned)__builtin_amdgcn_readfirstlane((int)(ldsbase + (s) * STGW + ldsw + _i * 8192))); \
        pg8::glds16s((const void*)((pa) + (size_t)128 * K + ko_), voff[_i], (unsigned)__builtin_amdgcn_readfirstlane((int)(ldsbase + (s) * STGW + 16384 + ldsw + _i * 8192))); \
        pg8::glds16s((const void*)((pb) + ko_), voff[_i], (unsigned)__builtin_amdgcn_readfirstlane((int)(ldsbase + (s) * STGW + 32768 + ldsw + _i * 8192))); \
        pg8::glds16s((const void*)((pb) + (size_t)128 * K + ko_), voff[_i], (unsigned)__builtin_amdgcn_readfirstlane((int)(ldsbase + (s) * STGW + 49152 + ldsw + _i * 8192))); } } while (0)
    pg8::Unit cur, nxt; int ui = 0;
    if (!S.next(0, cur)) return;
    cur.pm = __builtin_amdgcn_readfirstlane(cur.pm); cur.pn = __builtin_amdgcn_readfirstlane(cur.pn);
    const unsigned char* cA = g.A + (size_t)cur.pm * 256 * K; const unsigned char* cB = g.Bt + (size_t)cur.pn * 256 * K;
    bool has_next = S.next(1, nxt);
    nxt.pm = __builtin_amdgcn_readfirstlane(nxt.pm); nxt.pn = __builtin_amdgcn_readfirstlane(nxt.pn);
    const unsigned char* nA = has_next ? g.A + (size_t)nxt.pm * 256 * K : cA; const unsigned char* nB = has_next ? g.Bt + (size_t)nxt.pn * 256 * K : cB;
    F8W_STAGE(0, cA, cB, 0);
    asm volatile("s_waitcnt vmcnt(0)" ::: "memory"); __builtin_amdgcn_s_barrier(); asm volatile("" ::: "memory");
    int st = 0;
    for (;;) {
        f32x4 acc[4][8];
#pragma unroll
        for (int m = 0; m < 4; ++m)
#pragma unroll
            for (int n = 0; n < 8; ++n) acc[m][n] = ozero4();
        for (int t = 0; t < nt; ++t) {
            if (t + 1 < nt) F8W_STAGE(st ^ 1, cA, cB, t + 1); else F8W_STAGE(st ^ 1, nA, nB, 0);
            v8i_t af[4];
            const LAS unsigned char* sb = lds + st * STGW;
#pragma unroll
            for (int m = 0; m < 4; ++m) { const v4i_t lo_ = *(const LAS v4i_t*)(sb + aoff0 + m * 2048), hi_ = *(const LAS v4i_t*)(sb + aoff1 + m * 2048); af[m] = __builtin_shufflevector(lo_, hi_, 0, 1, 2, 3, 4, 5, 6, 7); }
#pragma unroll
            for (int h2 = 0; h2 < 4; ++h2) {
                v8i_t bfr[2];
#pragma unroll
                for (int n = 0; n < 2; ++n) { const v4i_t lo_ = *(const LAS v4i_t*)(sb + boff0 + (2 * h2 + n) * 2048), hi_ = *(const LAS v4i_t*)(sb + boff1 + (2 * h2 + n) * 2048); bfr[n] = __builtin_shufflevector(lo_, hi_, 0, 1, 2, 3, 4, 5, 6, 7); }
                asm volatile("s_waitcnt lgkmcnt(0)" ::: "memory"); __builtin_amdgcn_sched_barrier(0);
                __builtin_amdgcn_s_setprio(1);
#pragma unroll
                for (int m = 0; m < 4; ++m)
#pragma unroll
                    for (int n = 0; n < 2; ++n) acc[m][2 * h2 + n] = __builtin_amdgcn_mfma_scale_f32_16x16x128_f8f6f4(bfr[n], af[m], acc[m][2 * h2 + n], 0, 0, 0, 0x7a7a7a7a, 0, 0x7f7f7f7f);
                __builtin_amdgcn_s_setprio(0);
                __builtin_amdgcn_sched_barrier(0);
            }
            asm volatile("s_waitcnt vmcnt(0)" ::: "memory"); __builtin_amdgcn_s_barrier(); asm volatile("" ::: "memory");
            st ^= 1;
        }
        E(acc, cur, wr, wc, fr, fq);
        if (!has_next) break;
        cur = nxt; cA = nA; cB = nB; ++ui;
        has_next = S.next(ui + 1, nxt);
        nxt.pm = __builtin_amdgcn_readfirstlane(nxt.pm); nxt.pn = __builtin_amdgcn_readfirstlane(nxt.pn);
        nA = has_next ? g.A + (size_t)nxt.pm * 256 * K : cA; nB = has_next ? g.Bt + (size_t)nxt.pn * 256 * K : cB;
    }
    asm volatile("s_waitcnt vmcnt(0)" ::: "memory"); __builtin_amdgcn_s_barrier(); asm volatile("" ::: "memory");
#undef F8W_STAGE
}
}

#define GAS __attribute__((address_space(1)))
#define LAS __attribute__((address_space(3)))
typedef unsigned short bf16;
typedef float f32x4 __attribute__((ext_vector_type(4)));
typedef float f32x2 __attribute__((ext_vector_type(2)));
typedef unsigned u32x4 __attribute__((ext_vector_type(4)));
typedef unsigned u32x2 __attribute__((ext_vector_type(2)));
typedef short bf16x8 __attribute__((ext_vector_type(8)));
typedef GAS unsigned gu32;

constexpr int NTHREADS = 512, NWAVES = 8;
constexpr int D = 1024, NB = 8, S = 2048, M = NB * S, DEPTH = 2;
constexpr int D_IN = 7120, NV = 7168;
constexpr int NE = 32, TOPK = 4, NPAIR = M * TOPK, MP = NPAIR + NE * 256;
constexpr float EPS = 1e-6f;
enum { I_X = 0, I_C, I_WADA, I_BADA, I_WIN, I_BIN, I_CONVW, I_CONVB, I_MLG, I_KVG, I_WUK, I_WUV, I_WBRML, I_WBRDSA, I_WBRFOX, I_WOUT, I_WR, I_BR, I_W1, I_B1, I_W2, I_B2, I_FG };

constexpr size_t MiB = 1u << 20;
constexpr size_t WS_CTL = 0, CTL_ZERO_BYTES = 1 * MiB;
constexpr size_t WS_MOD = 1 * MiB;
constexpr size_t WS_BINP = 2 * MiB;
constexpr size_t WS_WRT = 3 * MiB;
constexpr size_t WS_EIDX = 4 * MiB, WS_GATE = WS_EIDX + 256 * 1024, WS_LRANK = WS_GATE + 256 * 1024, WS_PPOS = WS_LRANK + 256 * 1024, WS_BASE = WS_PPOS + 256 * 1024;
constexpr size_t WS_ROWGATE = 6 * MiB;
constexpr size_t WS_WOUT_T = 8 * MiB;
constexpr size_t WS_WBR_T = 12 * MiB;
constexpr size_t WS_WIN_T = 18 * MiB;
constexpr size_t WS_W1T = 48 * MiB;
constexpr size_t WS_W2T = 304 * MiB;
constexpr size_t WS_X = 432 * MiB;
constexpr size_t WS_XN = 496 * MiB;
constexpr size_t WS_XNL = 528 * MiB;
constexpr size_t WS_ASORT = 560 * MiB;
constexpr size_t WS_ACT = 704 * MiB;
constexpr size_t WS_END = 848 * MiB;
constexpr size_t WS_XN1_8_ = 1352 * MiB, WS_WIN8_ = 1368 * MiB, WS_WOUT8_ = 1400 * MiB;
constexpr size_t WS_XN8 = 1336 * MiB;
constexpr size_t WS_AS8 = WS_ACT, WS_ACT8 = WS_ACT + 72 * MiB;
constexpr size_t WS_DRY = 1208 * MiB;
constexpr int CW_GCNT = 64;
constexpr int CW_BAR = 4096;

constexpr int RING_BYTES = 147456;
constexpr int LDSCTL_OFF = RING_BYTES, MISC_OFF = LDSCTL_OFF + 320;
constexpr int LDS_BYTES = 163840;

__device__ __forceinline__ unsigned f2bf(float f) { unsigned u = __builtin_bit_cast(unsigned, f); return (u + 0x7fffu + ((u >> 16) & 1u)) >> 16; }
__device__ __forceinline__ float bf2f(unsigned b) { return __builtin_bit_cast(float, b << 16); }
__device__ __forceinline__ unsigned pk2(float lo, float hi) { return f2bf(lo) | (f2bf(hi) << 16); }
__device__ __forceinline__ unsigned pk4_fp8(float a, float b, float c, float d) { int w = 0; w = __builtin_amdgcn_cvt_pk_fp8_f32(a, b, w, false); w = __builtin_amdgcn_cvt_pk_fp8_f32(c, d, w, true); return (unsigned)w; }
#define LDS_WAIT() asm volatile("s_waitcnt lgkmcnt(0)" ::: "memory")
#define VM_WAIT() asm volatile("s_waitcnt vmcnt(0)" ::: "memory")

#define XB_TMO      128
#define XB_XCNT(j)  (256  + 64 * (j))
#define XB_XSUB(j)  (1280 + 64 * (j))
#define XB_XGEN(j)  (2304 + 64 * (j))
#define XB_TOP      3328
#define XB_TOPGEN   3392
#define XCD_BAR_WORDS 3456
#define XB_SPIN_CAP (1u << 22)
__device__ __forceinline__ unsigned xb_ld(unsigned* p)              { return __hip_atomic_load(p, __ATOMIC_RELAXED, __HIP_MEMORY_SCOPE_AGENT); }
__device__ __forceinline__ unsigned xb_add(unsigned* p, unsigned v) { return __hip_atomic_fetch_add(p, v, __ATOMIC_RELAXED, __HIP_MEMORY_SCOPE_AGENT); }
__device__ __forceinline__ unsigned xb_xcc_id() { return (unsigned)__builtin_amdgcn_s_getreg((3 << 11) | 20) & 0xFu; }
#define XB_SPIN(cond, bar) do { unsigned _sp = 0; while (cond) { __builtin_amdgcn_s_sleep(1); \
    if ((++_sp & 255u) == 0u) { if (xb_ld(&(bar)[XB_TMO])) break; if (_sp > XB_SPIN_CAP) { atomicAdd(&(bar)[XB_TMO], 1u); break; } } } } while (0)
struct XcdBarrier { unsigned* bar; unsigned x; volatile LAS unsigned* st; bool t0; };
__device__ __forceinline__ XcdBarrier xcd_barrier_post(unsigned* bar, volatile LAS unsigned* st, bool t0) {
    XcdBarrier b; b.bar = bar; b.x = xb_xcc_id(); b.st = st; b.t0 = t0;
    if (t0) (void)xb_add(&bar[XB_XCNT(b.x)], 1u);
    return b;
}
__device__ __forceinline__ void xcd_barrier_complete(unsigned* bar, unsigned x, unsigned& nloc, unsigned& nx) {
    const unsigned G = gridDim.x * gridDim.y * gridDim.z;
    unsigned sum, cnt, mine, sp = 0u;
    for (;;) {
        sum = 0u; cnt = 0u; mine = 0u;
#pragma unroll
        for (unsigned j = 0; j < 16; ++j) { const unsigned c = xb_ld(&bar[XB_XCNT(j)]); sum += c; cnt += (c > 0u) ? 1u : 0u; mine = (j == x) ? c : mine; }
        if (sum == G) break;
        __builtin_amdgcn_s_sleep(1);
        if ((++sp & 255u) == 0u) { if (xb_ld(&bar[XB_TMO])) break; if (sp > XB_SPIN_CAP) { atomicAdd(&bar[XB_TMO], 1u); break; } }
    }
    nloc = mine > 0u ? mine : 1u; nx = cnt > 0u ? cnt : 1u;
}
__device__ __forceinline__ void xcd_barrier(const XcdBarrier& b) {
    asm volatile("s_waitcnt vmcnt(0)" ::: "memory");
    __syncthreads();
    if (b.t0) {
        unsigned* bar = b.bar;
        __builtin_amdgcn_s_waitcnt(0);
        unsigned nloc = b.st[0], nx = b.st[1];
        if (nloc == 0u) { xcd_barrier_complete(bar, b.x, nloc, nx); b.st[0] = nloc; b.st[1] = nx; }
        const unsigned old = xb_add(&bar[XB_XSUB(b.x)], 1u);
        const unsigned gen = old / nloc;
        if (old + 1u == (gen + 1u) * nloc) {
            __builtin_amdgcn_fence(__ATOMIC_RELEASE, "agent");
            asm volatile("s_waitcnt vmcnt(0)" ::: "memory");
            const unsigned og = xb_add(&bar[XB_TOP], 1u);
            const unsigned tg = og / nx;
            if (og + 1u == (tg + 1u) * nx) xb_add(&bar[XB_TOPGEN], 1u);
            else XB_SPIN(xb_ld(&bar[XB_TOPGEN]) == tg, bar);
            __builtin_amdgcn_fence(__ATOMIC_ACQUIRE, "agent");
            xb_add(&bar[XB_XGEN(b.x)], 1u);
            asm volatile("s_waitcnt vmcnt(0)" ::: "memory");
        } else {
            XB_SPIN(xb_ld(&bar[XB_XGEN(b.x)]) == gen, bar);
            __builtin_amdgcn_fence(__ATOMIC_ACQUIRE, "agent");
            asm volatile("s_waitcnt vmcnt(0)" ::: "memory");
        }
    }
    __syncthreads();
}

__device__ __forceinline__ float wave_sum(float v) {
    v += __builtin_bit_cast(float, __builtin_amdgcn_update_dpp(0, __builtin_bit_cast(int, v), 0x128, 0xf, 0xf, false));
    v += __builtin_bit_cast(float, __builtin_amdgcn_update_dpp(0, __builtin_bit_cast(int, v), 0x124, 0xf, 0xf, false));
    v += __builtin_bit_cast(float, __builtin_amdgcn_update_dpp(0, __builtin_bit_cast(int, v), 0x122, 0xf, 0xf, false));
    v += __builtin_bit_cast(float, __builtin_amdgcn_update_dpp(0, __builtin_bit_cast(int, v), 0x121, 0xf, 0xf, false));
    const int b = __builtin_bit_cast(int, v);
    return (__builtin_bit_cast(float, __builtin_amdgcn_readlane(b, 0)) + __builtin_bit_cast(float, __builtin_amdgcn_readlane(b, 16))) + (__builtin_bit_cast(float, __builtin_amdgcn_readlane(b, 32)) + __builtin_bit_cast(float, __builtin_amdgcn_readlane(b, 48)));
}

struct Args { const float* in[23]; float* out; unsigned char* ws; };
struct Frame { LAS unsigned char* lds; int tid, wave; };
#define KARGS ((const __attribute__((address_space(4))) Args*)__builtin_amdgcn_kernarg_segment_ptr())
#define KWS ((GAS unsigned char*)KARGS->ws)
#define KOUT ((GAS float*)KARGS->out)
#define KCTL ((GAS unsigned*)(KWS + WS_CTL))
#define GRIDN ((int)gridDim.x)
__device__ __forceinline__ int vcu_id() { const int G = gridDim.x, bx = blockIdx.x; return (G % 8 == 0) ? (bx % 8) * (G / 8) + bx / 8 : bx; }
#define WSP(T, off) ((T*)(KWS + (off)))
#define KIN(i) ((const float*)(((const __attribute__((address_space(4))) Args*)__builtin_amdgcn_kernarg_segment_ptr())->in[i]))
#define PHASE_BEGIN() do { asm volatile("" : "+s"(F.wave)); F.tid = F.wave * 64 + hw_lane(); } while (0)

__device__ __forceinline__ int vcol_real(int v) {
    if (v < 1536) return v;
    if (v < 2048) return -1;
    if (v < 2176) return 2056 + (v - 2048);
    if (v < 2240) return 2440 + (v - 2176);
    if (v < 2244) return 1536 + (v - 2240);
    if (v < 2248) return 1540 + (v - 2244);
    if (v < 2252) return 2504 + (v - 2248);
    if (v < 2256) return 4044 + (v - 2252);
    if (v < 2304) return -1;
    if (v < 2560) return 2184 + (v - 2304);
    if (v < 4096) return 2508 + (v - 2560);
    return 4048 + (v - 4096);
}
struct P0Item { const float* W; bf16* WT; int ldw, K, destrow0, k0, srccol4; bool valid, fp8; };
__device__ __forceinline__ void p0_load(const P0Item& d, f32x4 (&v)[8], int lane) {
    const int kr = lane >> 3;
#pragma unroll
    for (int i = 0; i < 8; ++i) v[i] = (d.valid && d.srccol4 >= 0) ? *(const f32x4*)(d.W + (size_t)(d.k0 + 8 * i + kr) * d.ldw + d.srccol4) : (f32x4){0.f, 0.f, 0.f, 0.f};
}
__device__ __forceinline__ void p0_finish(const P0Item& d, const f32x4 (&v)[8], LAS float* scr, int lane) {
    if (!d.valid) return;
    const int kr = lane >> 3, n4 = 4 * (lane & 7);
#pragma unroll
    for (int i = 0; i < 8; ++i) *(LAS f32x4*)(scr + (8 * i + kr) * 36 + n4) = v[i];
    LDS_WAIT(); asm volatile("" ::: "memory");
    const int c = lane & 7;
#pragma unroll
    for (int j = 0; j < 4; ++j) { const int n = (lane >> 3) + 8 * j; const LAS float* s = scr + (8 * c) * 36 + n;
        if (d.fp8) { u32x2 o; o.x = pk4_fp8(32.f * s[0 * 36], 32.f * s[1 * 36], 32.f * s[2 * 36], 32.f * s[3 * 36]); o.y = pk4_fp8(32.f * s[4 * 36], 32.f * s[5 * 36], 32.f * s[6 * 36], 32.f * s[7 * 36]);
            *(u32x2*)((unsigned char*)d.WT + (size_t)(d.destrow0 + n) * d.K + d.k0 + 8 * c) = o; }
        else { u32x4 o; o.x = pk2(s[0 * 36], s[1 * 36]); o.y = pk2(s[2 * 36], s[3 * 36]); o.z = pk2(s[4 * 36], s[5 * 36]); o.w = pk2(s[6 * 36], s[7 * 36]);
            *(u32x4*)(d.WT + (size_t)(d.destrow0 + n) * d.K + d.k0 + 8 * c) = o; } }
    LDS_WAIT(); asm volatile("" ::: "memory");
}
__device__ __forceinline__ void p0_moe_weights(Frame& F) {
    PHASE_BEGIN();
    const int tid = F.tid, lane = tid & 63, w = F.wave;
    constexpr int NI1 = 64 * 8 * 8, NI2 = 64 * 8 * 4;
    __syncthreads();
    int buf = 0;
#define P0M_DECODE(it_, is1_, le_, kt_, nb_, Wp_) const bool is1_ = (it_) < NI1; const int r_##it_ = is1_ ? (it_) : (it_) - NI1; \
        const int le_ = is1_ ? r_##it_ >> 6 : r_##it_ >> 5, kt_ = is1_ ? (r_##it_ >> 3) & 7 : (r_##it_ >> 2) & 7, nb_ = is1_ ? r_##it_ & 7 : r_##it_ & 3, ldw_##it_ = is1_ ? 2048 : 1024; \
        const float* Wp_ = (is1_ ? KIN(I_W1) + (size_t)le_ * 1024 * 2048 : KIN(I_W2) + (size_t)le_ * 1024 * 1024) + (size_t)(kt_ * 128 + 16 * w) * ldw_##it_ + nb_ * 256 + 4 * lane;
    f32x4 v[16], vn[16];
    { const int it0 = blockIdx.x; if (it0 < NI1 + NI2) { P0M_DECODE(it0, a_, b_, c_, d_, Wq)
#pragma unroll
        for (int i = 0; i < 16; ++i) v[i] = __builtin_nontemporal_load((const f32x4*)(Wq + (size_t)i * ldw_it0)); } }
    for (int it = blockIdx.x; it < NI1 + NI2; it += GRIDN) {
        P0M_DECODE(it, is1, le, kt, nb, W)
        (void)W;
        { const int itn = it + GRIDN; if (itn < NI1 + NI2) { P0M_DECODE(itn, a_, b_, c_, d_, Wq)
#pragma unroll
            for (int i = 0; i < 16; ++i) vn[i] = __builtin_nontemporal_load((const f32x4*)(Wq + (size_t)i * ldw_itn)); } }
        LAS unsigned* T = (LAS unsigned*)(F.lds + buf * 32768);
#pragma unroll
        for (int g = 0; g < 4; ++g) {
            unsigned d[4];
#pragma unroll
            for (int q = 0; q < 4; ++q) d[q] = pk4_fp8(32.f * v[4 * g + q].x, 32.f * v[4 * g + q].y, 32.f * v[4 * g + q].z, 32.f * v[4 * g + q].w);
            const unsigned x0 = __builtin_amdgcn_perm(d[1], d[0], 0x05010400u), x1 = __builtin_amdgcn_perm(d[1], d[0], 0x07030602u), y0 = __builtin_amdgcn_perm(d[3], d[2], 0x05010400u), y1 = __builtin_amdgcn_perm(d[3], d[2], 0x07030602u);
            const unsigned t[4] = {__builtin_amdgcn_perm(y0, x0, 0x05040100u), __builtin_amdgcn_perm(y0, x0, 0x07060302u), __builtin_amdgcn_perm(y1, x1, 0x05040100u), __builtin_amdgcn_perm(y1, x1, 0x07060302u)};
#pragma unroll
            for (int c = 0; c < 4; ++c) T[(4 * lane + c) * 32 + ((4 * w + g) ^ (lane & 31))] = t[c];
        }
        __syncthreads();
        unsigned char* WT = is1 ? WSP(unsigned char, WS_W1T) + (size_t)le * 2048 * 1024 : WSP(unsigned char, WS_W2T) + (size_t)le * 1024 * 1024;
#pragma unroll
        for (int j = 0; j < 4; ++j) { const int n = (tid >> 3) + 64 * j, c8 = tid & 7, sw = (n >> 2) & 31;
            u32x4 o; o.x = T[n * 32 + ((4 * c8 + 0) ^ sw)]; o.y = T[n * 32 + ((4 * c8 + 1) ^ sw)]; o.z = T[n * 32 + ((4 * c8 + 2) ^ sw)]; o.w = T[n * 32 + ((4 * c8 + 3) ^ sw)];
            const int rc = nb * 256 + n; int vrow = rc;
            if (is1) { const int half = rc >> 10, c = rc & 1023; vrow = (c >> 7) * 256 + ((c >> 6) & 1) * 128 + ((c >> 2) & 15) * 8 + 4 * half + (c & 3); }
            __builtin_nontemporal_store(o, (u32x4*)(WT + (size_t)vrow * 1024 + kt * 128 + 16 * c8)); }
        buf ^= 1;
#pragma unroll
        for (int i = 0; i < 16; ++i) v[i] = vn[i];
    }
#undef P0M_DECODE
    __syncthreads();
}
__device__ __forceinline__ void p0_prologue(Frame& F) {
    PHASE_BEGIN();
    const int tid = F.tid, lane = (F.tid & 63);
    {
        LAS float* cond = (LAS float*)F.lds;
        LAS float* part = (LAS float*)(F.lds + 32768);
        bool staged = false;
        for (int it = blockIdx.x; it < 2 * 96; it += GRIDN) {
            if (!staged) { for (int i = tid; i < 8 * 1024; i += NTHREADS) { const float v = KIN(I_C)[i]; cond[i] = v / (1.f + __expf(-v)); } staged = true; }
            __syncthreads();
            const int l = it / 96, cb = it % 96, ks = tid >> 6, col = tid & 63, n = cb * 64 + col;
            const float* w = KIN(I_WADA) + (size_t)l * 1024 * 6144 + n;
            float a[8];
#pragma unroll
            for (int b = 0; b < 8; ++b) a[b] = 0.f;
            for (int k = ks * 128; k < ks * 128 + 128; ++k) { const float wv = w[(size_t)k * 6144];
#pragma unroll
                for (int b = 0; b < 8; ++b) a[b] += cond[b * 1024 + k] * wv; }
#pragma unroll
            for (int b = 0; b < 8; ++b) part[(ks * 8 + b) * 64 + col] = a[b];
            __syncthreads();
            { const int b = tid >> 6; float s = 0.f;
#pragma unroll
              for (int q = 0; q < 8; ++q) s += part[(q * 8 + b) * 64 + col];
              WSP(float, WS_MOD)[((size_t)l * 8 + b) * 6144 + n] = s + KIN(I_BADA)[l * 6144 + n]; }
        }
        __syncthreads();
    }
    {
        LAS float* As = (LAS float*)F.lds;
        LAS float* Us = (LAS float*)(F.lds + 64 * 129 * 4);
        for (int it = blockIdx.x; it < 128; it += GRIDN) {
            const int l = it >> 6, h = (it >> 4) & 3, kb = it & 15, k0 = kb * 64;
            __syncthreads();
            for (int i = tid; i < 64 * 128; i += NTHREADS) { const int k = i >> 7, d = i & 127; As[k * 129 + d] = KIN(I_WIN)[((size_t)l * 1024 + k0 + k) * D_IN + 1544 + h * 128 + d]; }
            for (int i = tid; i < 128 * 128; i += NTHREADS) { const int c = i >> 7, d = i & 127; Us[c * 129 + d] = KIN(I_WUK)[(((size_t)l * 4 + h) * 128 + c) * 128 + d]; }
            __syncthreads();
            const int c = tid & 127, kq = tid >> 7; float a[16];
#pragma unroll
            for (int i = 0; i < 16; ++i) a[i] = 0.f;
            for (int d = 0; d < 128; ++d) { const float u = Us[c * 129 + d];
#pragma unroll
                for (int i = 0; i < 16; ++i) a[i] += u * As[(kq * 16 + i) * 129 + d]; }
            const float sc = 0.08838834764831845f;
            bf16* dst = WSP(bf16, WS_WIN_T) + ((size_t)l * NV + 1536 + h * 128 + c) * 1024 + k0 + kq * 16;
            u32x4 o0, o1; o0.x = pk2(a[0] * sc, a[1] * sc); o0.y = pk2(a[2] * sc, a[3] * sc); o0.z = pk2(a[4] * sc, a[5] * sc); o0.w = pk2(a[6] * sc, a[7] * sc);
            o1.x = pk2(a[8] * sc, a[9] * sc); o1.y = pk2(a[10] * sc, a[11] * sc); o1.z = pk2(a[12] * sc, a[13] * sc); o1.w = pk2(a[14] * sc, a[15] * sc);
            *(u32x4*)dst = o0; *(u32x4*)(dst + 8) = o1;
            if (kb == 0 && kq == 0) { float s = 0.f; for (int d = 0; d < 128; ++d) s += Us[c * 129 + d] * KIN(I_BIN)[l * D_IN + 1544 + h * 128 + d];
                WSP(float, WS_BINP)[l * NV + 1536 + h * 128 + c] = s * sc; }
        }
        __syncthreads();
    }
    {
        LAS float* Us = (LAS float*)F.lds;
        LAS float* Bs = (LAS float*)(F.lds + 128 * 129 * 4);
        for (int it = blockIdx.x; it < 128; it += GRIDN) {
            const int l = it >> 6, h = (it >> 4) & 3, nb = it & 15, n0 = nb * 64;
            __syncthreads();
            for (int i = tid; i < 128 * 128; i += NTHREADS) { const int c = i >> 7, d = i & 127; Us[c * 129 + d] = KIN(I_WUV)[(((size_t)l * 4 + h) * 128 + c) * 128 + d]; }
            for (int i = tid; i < 128 * 64; i += NTHREADS) { const int d = i >> 6, n = i & 63; Bs[d * 65 + n] = KIN(I_WBRDSA)[((size_t)l * 512 + h * 128 + d) * 1024 + n0 + n]; }
            __syncthreads();
            const int c = tid & 127, nq = tid >> 7; float a[16];
#pragma unroll
            for (int i = 0; i < 16; ++i) a[i] = 0.f;
            for (int d = 0; d < 128; ++d) { const float u = Us[c * 129 + d];
#pragma unroll
                for (int i = 0; i < 16; ++i) a[i] += u * Bs[d * 65 + nq * 16 + i]; }
#pragma unroll
            for (int i = 0; i < 16; ++i) WSP(bf16, WS_WBR_T)[((size_t)l * 3072 + 1024 + n0 + nq * 16 + i) * 512 + h * 128 + c] = (bf16)f2bf(a[i]);
        }
        __syncthreads();
    }
    for (int i = blockIdx.x * NTHREADS + tid; i < 2 * 32 * 1024; i += GRIDN * NTHREADS) { const int l = i >> 15, e = (i >> 10) & 31, k = i & 1023;
        const float w = KIN(I_WR)[((size_t)l * 1024 + k) * 32 + e]; const unsigned hi = f2bf(w), lo = f2bf(w - bf2f(hi));
        WSP(bf16, WS_WRT)[((size_t)l * 2 + 0) * 32768 + e * 1024 + k] = (bf16)hi; WSP(bf16, WS_WRT)[((size_t)l * 2 + 1) * 32768 + e * 1024 + k] = (bf16)lo; }
    for (int i = blockIdx.x * NTHREADS + tid; i < 2 * NV; i += GRIDN * NTHREADS) { const int l = i / NV, v = i % NV; const int r = vcol_real(v);
        if (!(v >= 1536 && v < 2048)) WSP(float, WS_BINP)[i] = r >= 0 ? KIN(I_BIN)[l * D_IN + r] : 0.f; }
    LAS float* scr = (LAS float*)(F.lds + F.wave * 16384);
    const int gw = vcu_id() * NWAVES + F.wave, NGW = GRIDN * NWAVES;
    constexpr int IT_IN = 16 * (NV / 32), IT_BR = 8 * 32, IT_OUT = 16 * 32;
    constexpr int N_IN = 2 * IT_IN, N_BR = 2 * 2 * IT_BR, N_OUT = 2 * IT_OUT;
    constexpr int IT_IN8 = 16 * (24 * 8), N_IN8 = 2 * IT_IN8;
    constexpr int N_ALL = N_IN + N_BR + N_OUT + N_IN8;
    auto decode = [&](int it) -> P0Item {
        P0Item d; d.fp8 = false; d.valid = it < N_ALL; d.W = nullptr; d.WT = nullptr; d.ldw = 0; d.K = 0; d.destrow0 = 0; d.k0 = 0; d.srccol4 = -1;
        if (!d.valid) return d;
        int r = it;
        if (r < N_IN) { const int l = r / IT_IN, q = r % IT_IN, kb = q / (NV / 32), nb = q % (NV / 32), v = nb * 32 + 4 * (lane & 7);
            if (nb < 48 || nb >= 80) { d.valid = false; return d; }
            if (nb * 32 >= 1536 && nb * 32 < 2048) { d.valid = false; return d; }
            d.W = KIN(I_WIN) + (size_t)l * 1024 * D_IN; d.ldw = D_IN; d.K = 1024; d.WT = WSP(bf16, WS_WIN_T) + (size_t)l * NV * 1024; d.destrow0 = nb * 32; d.k0 = kb * 64; d.srccol4 = vcol_real(v); return d; }
        r -= N_IN;
        if (r < N_BR) { const int l = r / (2 * IT_BR), q = r % (2 * IT_BR), which = q / IT_BR, q2 = q % IT_BR, kb = q2 / 32, nb = q2 % 32;
            d.W = (which ? KIN(I_WBRFOX) : KIN(I_WBRML)) + (size_t)l * 512 * 1024; d.ldw = 1024; d.K = 512; d.WT = WSP(bf16, WS_WBR_T) + (size_t)l * 3072 * 512; d.destrow0 = (which ? 2048 : 0) + nb * 32; d.k0 = kb * 64; d.srccol4 = nb * 32 + 4 * (lane & 7); return d; }
        r -= N_BR;
        if (r < N_OUT) { const int l = r / IT_OUT, q = r % IT_OUT, kb = q / 32, nb = q % 32;
            d.fp8 = true; d.W = KIN(I_WOUT) + (size_t)l * 1024 * 1024; d.ldw = 1024; d.K = 1024; d.WT = (bf16*)(WSP(unsigned char, WS_WOUT8_) + (size_t)l * 1024 * 1024); d.destrow0 = nb * 32; d.k0 = kb * 64; d.srccol4 = nb * 32 + 4 * (lane & 7); return d; }
        r -= N_OUT;
        if (r < N_IN8) { const int l = r / IT_IN8, q = r % IT_IN8, kb = q / 192, nv = q % 192, tv = nv >> 3, nb = (tv < 6 ? tv : tv + 4) * 8 + (nv & 7), v = nb * 32 + 4 * (lane & 7);
            d.fp8 = true; d.W = KIN(I_WIN) + (size_t)l * 1024 * D_IN; d.ldw = D_IN; d.K = 1024; d.WT = (bf16*)(WSP(unsigned char, WS_WIN8_) + (size_t)l * NV * 1024); d.destrow0 = nb * 32; d.k0 = kb * 64; d.srccol4 = vcol_real(v); return d; }
        d.valid = false; return d;
    };
    P0Item cur = decode(gw); f32x4 vc[8], vn[8]; p0_load(cur, vc, lane);
    for (int it = gw; it < N_ALL; it += NGW) {
        const P0Item nxt = decode(it + NGW); p0_load(nxt, vn, lane);
        p0_finish(cur, vc, scr, lane);
        cur = nxt;
#pragma unroll
        for (int i = 0; i < 8; ++i) vc[i] = vn[i];
    }
}

__device__ __forceinline__ void norm_rows(Frame& F, const float* xsrc, int l, int shoff, int scoff) {
    PHASE_BEGIN();
    const int gw = blockIdx.x * NWAVES + F.wave, lane = (F.tid & 63), c0 = 16 * lane, m0 = gw * 8;
    const float* mo = WSP(float, WS_MOD) + (size_t)l * 8 * 6144 + (size_t)(m0 >> 11) * 6144; bf16* XN = WSP(bf16, WS_XN);
    f32x4 sh[4], sc[4];
#pragma unroll
    for (int q = 0; q < 4; ++q) { sh[q] = *(const f32x4*)(mo + shoff + c0 + 4 * q); sc[q] = *(const f32x4*)(mo + scoff + c0 + 4 * q); }
    for (int t = 0; t < 8; ++t) {
        const int m = m0 + t;
        f32x4 v[4]; float s = 0.f;
#pragma unroll
        for (int q = 0; q < 4; ++q) { v[q] = *(const f32x4*)(xsrc + (size_t)m * D + c0 + 4 * q); s += (v[q].x * v[q].x + v[q].y * v[q].y) + (v[q].z * v[q].z + v[q].w * v[q].w); }
        const float r = 1.0f / sqrtf(wave_sum(s) * (1.0f / D) + EPS);
        unsigned wb[8], w8[4];
#pragma unroll
        for (int q = 0; q < 4; ++q) { const f32x4 h = v[q] * r * (1.0f + sc[q]) + sh[q]; wb[2 * q] = pk2(h.x, h.y); wb[2 * q + 1] = pk2(h.z, h.w); w8[q] = pk4_fp8(h.x, h.y, h.z, h.w); }
        *(u32x4*)(XN + (size_t)m * D + c0) = (u32x4){wb[0], wb[1], wb[2], wb[3]}; *(u32x4*)(XN + (size_t)m * D + c0 + 8) = (u32x4){wb[4], wb[5], wb[6], wb[7]};
        *(u32x4*)(WSP(unsigned char, WS_XN1_8_) + (size_t)m * D + c0) = (u32x4){w8[0], w8[1], w8[2], w8[3]};
    }
}
__device__ __forceinline__ void route_phase(Frame& F, int l, const float* xsrc, bool dry = false) {
    PHASE_BEGIN();
    LAS int* lcnt = (LAS int*)F.lds;
    LAS float* lg = (LAS float*)(F.lds + 1024);
    const int tid = F.tid, lane = (F.tid & 63), w = F.wave;
    if (tid < 32) lcnt[tid] = 0;
    const float* modl = WSP(float, WS_MOD) + (size_t)l * 8 * 6144;
    bf16* XN = dry ? WSP(bf16, WS_DRY) : WSP(bf16, WS_XN); bf16* XNL = dry ? WSP(bf16, WS_DRY + 32 * MiB) : WSP(bf16, WS_XNL);
    const bf16* WH = WSP(bf16, WS_WRT) + (size_t)l * 2 * 32768; const bf16* WL = WH + 32768;
    for (int rb = blockIdx.x; rb < M / 64; rb += GRIDN) {
        __syncthreads();
        {
            const int c0 = 16 * lane; const float* mo = modl + (size_t)((rb * 64) >> 11) * 6144;
            f32x4 sh[4], sc[4];
#pragma unroll
            for (int q = 0; q < 4; ++q) { sh[q] = *(const f32x4*)(mo + 3072 + c0 + 4 * q); sc[q] = *(const f32x4*)(mo + 4096 + c0 + 4 * q); }
            unsigned char* XN8 = dry ? WSP(unsigned char, WS_DRY + 100 * MiB) : WSP(unsigned char, WS_XN8);
            for (int i0 = 0; i0 < 8; i0 += 4) {
              f32x4 vv[4][4];
#pragma unroll
              for (int i = 0; i < 4; ++i)
#pragma unroll
                for (int q = 0; q < 4; ++q) vv[i][q] = *(const f32x4*)(xsrc + (size_t)(rb * 64 + w * 8 + i0 + i) * D + c0 + 4 * q);
#pragma unroll
              for (int i = 0; i < 4; ++i) {
                const int m = rb * 64 + w * 8 + i0 + i;
                f32x4 v[4]; float s = 0.f;
#pragma unroll
                for (int q = 0; q < 4; ++q) { v[q] = vv[i][q]; s += (v[q].x * v[q].x + v[q].y * v[q].y) + (v[q].z * v[q].z + v[q].w * v[q].w); }
                const float r = 1.0f / sqrtf(wave_sum(s) * (1.0f / D) + EPS);
                unsigned wh[8], wl[8], w8[4];
#pragma unroll
                for (int q = 0; q < 4; ++q) { const f32x4 h = v[q] * r * (1.0f + sc[q]) + sh[q];
                    const unsigned h0 = f2bf(h.x), h1 = f2bf(h.y), h2 = f2bf(h.z), h3 = f2bf(h.w);
                    wh[2 * q] = h0 | (h1 << 16); wh[2 * q + 1] = h2 | (h3 << 16);
                    wl[2 * q] = pk2(h.x - bf2f(h0), h.y - bf2f(h1)); wl[2 * q + 1] = pk2(h.z - bf2f(h2), h.w - bf2f(h3)); w8[q] = pk4_fp8(h.x, h.y, h.z, h.w); }
                *(u32x4*)(XN + (size_t)m * D + c0) = (u32x4){wh[0], wh[1], wh[2], wh[3]}; *(u32x4*)(XN + (size_t)m * D + c0 + 8) = (u32x4){wh[4], wh[5], wh[6], wh[7]};
                *(u32x4*)(XNL + (size_t)m * D + c0) = (u32x4){wl[0], wl[1], wl[2], wl[3]}; *(u32x4*)(XNL + (size_t)m * D + c0 + 8) = (u32x4){wl[4], wl[5], wl[6], wl[7]};
                *(u32x4*)(XN8 + (size_t)m * D + c0) = (u32x4){w8[0], w8[1], w8[2], w8[3]};
              }
            }
        }
        VM_WAIT(); __builtin_amdgcn_fence(__ATOMIC_ACQUIRE, "agent"); VM_WAIT(); __syncthreads();
        {
            f32x4 acc[4][2];
#pragma unroll
            for (int rt = 0; rt < 4; ++rt) { acc[rt][0] = ozero4(); acc[rt][1] = acc[rt][0]; }
            const int fr = lane & 15, kq = lane >> 4, kb = 128 * w + 8 * kq;
            const bf16* pa = XN + (size_t)(rb * 64 + fr) * D + kb; const bf16* pal = XNL + (size_t)(rb * 64 + fr) * D + kb;
            const bf16* pbh = WH + (size_t)fr * 1024 + kb; const bf16* pbl = WL + (size_t)fr * 1024 + kb;
#pragma unroll
            for (int ks = 0; ks < 4; ++ks) {
                bf16x8 ah[4], al[4], bh[2], bl[2];
#pragma unroll
                for (int rt = 0; rt < 4; ++rt) { ah[rt] = *(const bf16x8*)(pa + (size_t)rt * 16 * D + ks * 32); al[rt] = *(const bf16x8*)(pal + (size_t)rt * 16 * D + ks * 32); }
#pragma unroll
                for (int et = 0; et < 2; ++et) { bh[et] = *(const bf16x8*)(pbh + et * 16 * 1024 + ks * 32); bl[et] = *(const bf16x8*)(pbl + et * 16 * 1024 + ks * 32); }
#pragma unroll
                for (int rt = 0; rt < 4; ++rt)
#pragma unroll
                    for (int et = 0; et < 2; ++et) {
                        acc[rt][et] = __builtin_amdgcn_mfma_f32_16x16x32_bf16(ah[rt], bh[et], acc[rt][et], 0, 0, 0);
                        acc[rt][et] = __builtin_amdgcn_mfma_f32_16x16x32_bf16(ah[rt], bl[et], acc[rt][et], 0, 0, 0);
                        acc[rt][et] = __builtin_amdgcn_mfma_f32_16x16x32_bf16(al[rt], bh[et], acc[rt][et], 0, 0, 0); }
            }
            LAS float* part = (LAS float*)(F.lds + 16384);
#pragma unroll
            for (int rt = 0; rt < 4; ++rt)
#pragma unroll
                for (int et = 0; et < 2; ++et)
#pragma unroll
                    for (int rg = 0; rg < 4; ++rg) part[(w * 64 + rt * 16 + 4 * kq + rg) * 33 + et * 16 + fr] = acc[rt][et][rg];
            __syncthreads();
            {   const int row = tid >> 3, e4 = (tid & 7) * 4;
#pragma unroll
                for (int j = 0; j < 4; ++j) { float sum = 0.f;
#pragma unroll
                    for (int ww = 0; ww < 8; ++ww) sum += part[(ww * 64 + row) * 33 + e4 + j];
                    lg[row * 33 + e4 + j] = sum + KIN(I_BR)[l * 32 + e4 + j]; } }
        }
        __syncthreads();
        if (w == 0) {
            float v[32];
#pragma unroll
            for (int e = 0; e < 32; ++e) v[e] = lg[lane * 33 + e];
            int idx[4]; float val[4];
#pragma unroll
            for (int k = 0; k < 4; ++k) { float best = v[0]; int bi = 0;
#pragma unroll
                for (int e = 1; e < 32; ++e) { const bool g = v[e] > best; best = g ? v[e] : best; bi = g ? e : bi; }
                val[k] = best; idx[k] = bi;
#pragma unroll
                for (int e = 0; e < 32; ++e) v[e] = (e == bi) ? -__builtin_inff() : v[e]; }
            const float p1 = __expf(val[1] - val[0]), p2 = __expf(val[2] - val[0]), p3 = __expf(val[3] - val[0]), inv = 1.0f / (1.0f + p1 + p2 + p3);
            const float gt[4] = {inv, p1 * inv, p2 * inv, p3 * inv};
            const int m = rb * 64 + lane;
#pragma unroll
            for (int k = 0; k < 4; ++k) { const int lr = __hip_atomic_fetch_add(lcnt + idx[k], 1, __ATOMIC_RELAXED, __HIP_MEMORY_SCOPE_WORKGROUP);
                int* eo = dry ? WSP(int, WS_DRY + 96 * MiB) : WSP(int, WS_EIDX); float* go = dry ? WSP(float, WS_DRY + 97 * MiB) : WSP(float, WS_GATE); int* lo_ = dry ? WSP(int, WS_DRY + 98 * MiB) : WSP(int, WS_LRANK);
                eo[m * 4 + k] = idx[k]; go[m * 4 + k] = gt[k]; lo_[m * 4 + k] = lr; }
        }
    }
    __syncthreads();
    if (tid < 32 && !dry) { const int base = (int)__hip_atomic_fetch_add(KCTL + CW_GCNT + l * 64 + tid, (unsigned)lcnt[tid], __ATOMIC_RELAXED, __HIP_MEMORY_SCOPE_AGENT);
        WSP(int, WS_BASE)[blockIdx.x * 32 + tid] = base; }
    __syncthreads();
}
__device__ __forceinline__ void gather_phase(Frame& F, int l) {
    PHASE_BEGIN();
    LAS int* tst = (LAS int*)(F.lds + LDSCTL_OFF);
    LAS int* tmp = (LAS int*)F.lds;
    if (F.tid < 32) tmp[F.tid] = (int)((__hip_atomic_load(KCTL + CW_GCNT + l * 64 + F.tid, __ATOMIC_RELAXED, __HIP_MEMORY_SCOPE_AGENT) + 255u) >> 8);
    __syncthreads();
    if (F.tid == 0) { int a = 0; for (int e = 0; e < 32; ++e) { tst[e] = a; a += tmp[e]; } tst[32] = a; }
    __syncthreads();
    const int gw = blockIdx.x * NWAVES + F.wave, lane = (F.tid & 63), p0 = gw * 32;
    const unsigned char* XN = WSP(unsigned char, WS_XN8); unsigned char* AS = WSP(unsigned char, WS_AS8);
    int dest = 0;
    if (lane < 32) { const int p = p0 + lane, tok = p >> 2, e = WSP(int, WS_EIDX)[p];
        dest = tst[e] * 256 + WSP(int, WS_BASE)[((tok >> 6) % GRIDN) * 32 + e] + WSP(int, WS_LRANK)[p];
        WSP(int, WS_PPOS)[p] = dest; }
    u32x4 rows[8];
#pragma unroll
    for (int t = 0; t < 8; ++t) rows[t] = *((const u32x4*)(XN + (size_t)(gw * 8 + t) * D) + lane);
#pragma unroll
    for (int i = 0; i < 32; ++i) { const int d = __builtin_amdgcn_readlane(dest, i); *((u32x4*)(AS + (size_t)d * D) + lane) = rows[i >> 2]; }
}
__device__ __forceinline__ void combine_phase(Frame& F, int l, const float* xsrc, bool last, bool dry = false) {
    PHASE_BEGIN();
    const int gw = blockIdx.x * NWAVES + F.wave, lane = (F.tid & 63), c0 = 16 * lane;
    const float* modl = WSP(float, WS_MOD) + (size_t)l * 8 * 6144; const float* modn = WSP(float, WS_MOD) + (size_t)(l + 1) * 8 * 6144;
    const unsigned char* YP = WSP(unsigned char, WS_ASORT); float* X = dry ? WSP(float, WS_DRY) : WSP(float, WS_X); bf16* XN = dry ? WSP(bf16, WS_DRY + 64 * MiB) : WSP(bf16, WS_XN);
    unsigned char* XN8 = dry ? WSP(unsigned char, WS_DRY + 96 * MiB) : WSP(unsigned char, WS_XN1_8_);
    const int m0 = gw * 8, b = m0 >> 11;
    f32x4 g2[4], sh[4], sc[4];
#pragma unroll
    for (int q = 0; q < 4; ++q) { g2[q] = *(const f32x4*)(modl + (size_t)b * 6144 + 5120 + c0 + 4 * q);
        if (last) { sh[q] = *(const f32x4*)(KIN(I_FG) + c0 + 4 * q); sc[q] = sh[q]; }
        else { sh[q] = *(const f32x4*)(modn + (size_t)b * 6144 + c0 + 4 * q); sc[q] = *(const f32x4*)(modn + (size_t)b * 6144 + 1024 + c0 + 4 * q); } }
    typedef int i32x4_t __attribute__((ext_vector_type(4)));
    i32x4_t posn = *(const i32x4_t*)(WSP(int, WS_PPOS) + (size_t)m0 * 4); f32x4 gkn = *(const f32x4*)(WSP(float, WS_GATE) + (size_t)m0 * 4);
    u32x4 yqn[4]; f32x4 vn[4]; f32x4 gk1 = gkn;
#pragma unroll
    for (int k = 0; k < 4; ++k) yqn[k] = *(const u32x4*)(YP + (size_t)posn[k] * D + c0);
#pragma unroll
    for (int q = 0; q < 4; ++q) vn[q] = *(const f32x4*)(xsrc + (size_t)m0 * D + c0 + 4 * q);
    posn = *(const i32x4_t*)(WSP(int, WS_PPOS) + (size_t)(m0 + 1) * 4); gkn = *(const f32x4*)(WSP(float, WS_GATE) + (size_t)(m0 + 1) * 4);
    for (int t = 0; t < 8; ++t) {
        const int m = m0 + t;
        const f32x4 gk = gk1 * 0.0625f;
        u32x4 yq[4]; f32x4 v[4];
#pragma unroll
        for (int k = 0; k < 4; ++k) yq[k] = yqn[k];
#pragma unroll
        for (int q = 0; q < 4; ++q) v[q] = vn[q];
        if (t < 7) {
#pragma unroll
            for (int k = 0; k < 4; ++k) yqn[k] = *(const u32x4*)(YP + (size_t)posn[k] * D + c0);
#pragma unroll
            for (int q = 0; q < 4; ++q) vn[q] = *(const f32x4*)(xsrc + (size_t)(m + 1) * D + c0 + 4 * q);
            gk1 = gkn;
            const int m2 = (t < 6) ? m + 2 : m + 1;
            posn = *(const i32x4_t*)(WSP(int, WS_PPOS) + (size_t)m2 * 4); gkn = *(const f32x4*)(WSP(float, WS_GATE) + (size_t)m2 * 4); }
        float s = 0.f;
#pragma unroll
        for (int q = 0; q < 4; ++q) { f32x4 y = {0.f, 0.f, 0.f, 0.f};
#pragma unroll
            for (int k = 0; k < 4; ++k) { const f32x2 lo = __builtin_amdgcn_cvt_pk_f32_fp8((int)yq[k][q], false), hi = __builtin_amdgcn_cvt_pk_f32_fp8((int)yq[k][q], true);
                y.x += gk[k] * lo[0]; y.y += gk[k] * lo[1]; y.z += gk[k] * hi[0]; y.w += gk[k] * hi[1]; }
            v[q] = v[q] + g2[q] * y; s += (v[q].x * v[q].x + v[q].y * v[q].y) + (v[q].z * v[q].z + v[q].w * v[q].w); }
        const float r = 1.0f / sqrtf(wave_sum(s) * (1.0f / D) + EPS);
        if (last) {
#pragma unroll
            for (int q = 0; q < 4; ++q) *(f32x4*)(KOUT + (size_t)m * D + c0 + 4 * q) = v[q] * r * sh[q];
        } else {
            unsigned w8[4]; unsigned wb[8];
#pragma unroll
            for (int q = 0; q < 4; ++q) { *(f32x4*)(X + (size_t)m * D + c0 + 4 * q) = v[q];
                const f32x4 h = v[q] * r * (1.0f + sc[q]) + sh[q]; wb[2 * q] = pk2(h.x, h.y); wb[2 * q + 1] = pk2(h.z, h.w); w8[q] = pk4_fp8(h.x, h.y, h.z, h.w); }
            *(u32x4*)(XN + (size_t)m * D + c0) = (u32x4){wb[0], wb[1], wb[2], wb[3]}; *(u32x4*)(XN + (size_t)m * D + c0 + 8) = (u32x4){wb[4], wb[5], wb[6], wb[7]};
            *(u32x4*)(XN8 + (size_t)m * D + c0) = (u32x4){w8[0], w8[1], w8[2], w8[3]};
        }
    }
}

template <int NTN> struct MoeSched {
    const LAS int* tst; int total, G, c; int deg = 0;
    __device__ __forceinline__ bool next(int i, pg8::Unit& u) const {
        const int L = i * G + c; if (L >= total) return false;
        const int rt = L / NTN, j = L - rt * NTN; int e = 0;
#pragma unroll
        for (int k = 1; k < 32; ++k) e += (rt >= tst[k]) ? 1 : 0;
        u.pm = rt; u.pn = e * NTN + j;
        if (DUP_MASK && deg) { u.pm = 0; u.pn = j; }
        return true;
    }
    __device__ __forceinline__ void a_ready(const pg8::Unit&) const {}
    __device__ __forceinline__ void done(const pg8::Unit&) const {}
};
struct EpiMoe1 {
    static constexpr bool PERM = true, AFTER_DRAIN = false;
    bf16* ACT; const float* b1;
    __device__ __forceinline__ void operator()(const f32x4 (&acc)[2][2][4][2], const pg8::Unit& u, int wr, int wc, int fr, int fq) const {
        asm volatile("" : "+v"(fr), "+v"(fq));
        const int e = u.pn >> 3, j = u.pn & 7, row0 = u.pm * 256 + wr * 64 + fr, c0 = j * 128 + 32 * wc + 8 * fq;
        f32x4 bg[2], bl[2];
#pragma unroll
        for (int n = 0; n < 2; ++n) { bg[n] = *(const f32x4*)(b1 + (size_t)e * 2048 + c0 + 4 * n); bl[n] = *(const f32x4*)(b1 + (size_t)e * 2048 + 1024 + c0 + 4 * n); }
#pragma unroll
        for (int ai = 0; ai < 2; ++ai)
#pragma unroll
            for (int m = 0; m < 4; ++m) { unsigned w[4];
#pragma unroll
                for (int n = 0; n < 2; ++n) { const f32x4 g = acc[ai][0][m][n] + bg[n], li = acc[ai][1][m][n] + bl[n]; float o[4];
#pragma unroll
                    for (int q = 0; q < 4; ++q) { const float gl = fminf(g[q], 7.0f), ln = fminf(fmaxf(li[q], -7.0f), 7.0f);
                        o[q] = gl * (ln + 1.0f) * __builtin_amdgcn_rcpf(1.0f + __builtin_amdgcn_exp2f(-2.4554669595930156f * gl)); }
                    w[2 * n] = pg8::cvt_pk_bf16(o[0], o[1]); w[2 * n + 1] = pg8::cvt_pk_bf16(o[2], o[3]); }
                *(u32x4*)(ACT + (size_t)(row0 + ai * 128 + m * 16) * D + c0) = (u32x4){w[0], w[1], w[2], w[3]}; }
    }
};
struct EpiMoe2 {
    static constexpr bool PERM = true, AFTER_DRAIN = false;
    bf16* YP; const float* b2; const float* rowgate;
    __device__ __forceinline__ void operator()(const f32x4 (&acc)[2][2][4][2], const pg8::Unit& u, int wr, int wc, int fr, int fq) const {
        asm volatile("" : "+v"(fr), "+v"(fq));
        const int e = u.pn >> 2, row0 = u.pm * 256 + wr * 64 + fr, c0 = (u.pn & 3) * 256 + 32 * wc + 8 * fq;
        f32x4 bv[2][2];
#pragma unroll
        for (int bj = 0; bj < 2; ++bj)
#pragma unroll
            for (int n = 0; n < 2; ++n) bv[bj][n] = *(const f32x4*)(b2 + (size_t)e * 1024 + c0 + bj * 128 + 4 * n);
#pragma unroll
        for (int ai = 0; ai < 2; ++ai)
#pragma unroll
            for (int m = 0; m < 4; ++m) { const int row = row0 + ai * 128 + m * 16; const float g = rowgate[row];
#pragma unroll
                for (int bj = 0; bj < 2; ++bj) { const f32x4 v0 = (acc[ai][bj][m][0] + bv[bj][0]) * g, v1 = (acc[ai][bj][m][1] + bv[bj][1]) * g;
                    *(u32x4*)(YP + (size_t)row * D + c0 + bj * 128) = (u32x4){pg8::cvt_pk_bf16(v0[0], v0[1]), pg8::cvt_pk_bf16(v0[2], v0[3]), pg8::cvt_pk_bf16(v1[0], v1[1]), pg8::cvt_pk_bf16(v1[2], v1[3])}; } }
    }
};

struct EpiW1 {
    unsigned char* ACT8; const float* b1;
    __device__ __forceinline__ void operator()(const f32x4 (&acc)[4][8], const pg8::Unit& u, int wr, int wc, int fr, int fq) const {
        asm volatile("" : "+v"(fr), "+v"(fq));
        const int e = u.pn >> 3, j = u.pn & 7, row0 = u.pm * 256 + wr * 64 + fr, c0 = j * 128 + wc * 64 + 4 * fq;
#pragma unroll
        for (int n = 0; n < 4; ++n) { const f32x4 bg = *(const f32x4*)(b1 + (size_t)e * 2048 + c0 + 16 * n), bl = *(const f32x4*)(b1 + (size_t)e * 2048 + 1024 + c0 + 16 * n);
#pragma unroll
            for (int m = 0; m < 4; ++m) { const f32x4 g = acc[m][n] + bg, li = acc[m][4 + n] + bl; float o[4];
#pragma unroll
                for (int q = 0; q < 4; ++q) { const float gl = fminf(g[q], 7.0f), ln = fminf(fmaxf(li[q], -7.0f), 7.0f);
                    o[q] = gl * (ln + 1.0f) * __builtin_amdgcn_rcpf(1.0f + __builtin_amdgcn_exp2f(-2.4554669595930156f * gl)); }
                *(unsigned*)(ACT8 + (size_t)(row0 + 16 * m) * D + c0 + 16 * n) = pk4_fp8(o[0], o[1], o[2], o[3]); } }
    }
};
struct EpiW2 {
    bf16* YP; const float* b2; const float* rowgate;
    __device__ __forceinline__ void operator()(const f32x4 (&acc)[4][8], const pg8::Unit& u, int wr, int wc, int fr, int fq) const {
        asm volatile("" : "+v"(fr), "+v"(fq));
        const int e = u.pn >> 2, row0 = u.pm * 256 + wr * 64 + fr, c0 = (u.pn & 3) * 256 + wc * 128 + 4 * fq;
        float gt[4];
#pragma unroll
        for (int m = 0; m < 4; ++m) gt[m] = rowgate[row0 + 16 * m];
#pragma unroll
        for (int n = 0; n < 8; ++n) { const f32x4 bv = *(const f32x4*)(b2 + (size_t)e * 1024 + c0 + 16 * n);
#pragma unroll
            for (int m = 0; m < 4; ++m) { const f32x4 v = (acc[m][n] + bv) * gt[m];
                *(u32x2*)(YP + (size_t)(row0 + 16 * m) * D + c0 + 16 * n) = (u32x2){pg8::cvt_pk_bf16(v[0], v[1]), pg8::cvt_pk_bf16(v[2], v[3])}; } }
    }
};
typedef __bf16 bf16x2_nt __attribute__((ext_vector_type(2)));
__device__ __forceinline__ unsigned cvtpk_c(float lo, float hi) { f32x2 v = {lo, hi}; bf16x2_nt b = __builtin_convertvector(v, bf16x2_nt); return __builtin_bit_cast(unsigned, b); }
struct EpiP1 {
    static constexpr bool PERM = true, AFTER_DRAIN = false, BIAS_INIT = true;
    unsigned char* ACT8; const float* b1;
    static constexpr int NSTORE = 16;
    __device__ __forceinline__ const float* bias_src(const pg8::Unit& u, int q) const { return b1 + (size_t)(u.pn >> 3) * 2048 + (q >> 5) * 1024 + (u.pn & 7) * 128 + 4 * (q & 31); }
    __device__ __forceinline__ void load_bias(f32x4 (&nb)[4], const PG8_LAS float* sl, int wc, int fq) const {
        const PG8_LAS float* bp = sl + 16 * wc + 4 * fq;
        nb[0] = *(const PG8_LAS f32x4*)bp; nb[1] = *(const PG8_LAS f32x4*)(bp + 128); nb[2] = *(const PG8_LAS f32x4*)(bp + 64); nb[3] = *(const PG8_LAS f32x4*)(bp + 128 + 64);
    }
    __device__ __forceinline__ void set_bias(f32x4 (&acc)[2][2][4][2], const f32x4 (&nb)[4]) const {
#pragma unroll
        for (int bj = 0; bj < 2; ++bj)
#pragma unroll
            for (int ai = 0; ai < 2; ++ai)
#pragma unroll
                for (int m = 0; m < 4; ++m) { acc[ai][bj][m][0] = nb[2 * bj]; acc[ai][bj][m][1] = nb[2 * bj + 1]; }
    }
    __device__ __forceinline__ void operator()(const f32x4 (&acc)[2][2][4][2], const pg8::Unit& u, int wr, int wc, int fr, int fq) const {
        asm volatile("" : "+v"(fr), "+v"(fq));
        const int j = u.pn & 7, row0 = u.pm * 256 + wr * 64 + fr, c0 = j * 128 + 16 * wc + 4 * fq;
#pragma unroll
        for (int ai = 0; ai < 2; ++ai)
#pragma unroll
            for (int m = 0; m < 4; ++m) { const int row = row0 + ai * 128 + m * 16;
#pragma unroll
                for (int bj = 0; bj < 2; ++bj) { const f32x4 g = acc[ai][bj][m][0], li = acc[ai][bj][m][1]; float o[4];
#pragma unroll
                    for (int q = 0; q < 4; ++q) { const float gl = fminf(g[q], 7.0f), ln = fminf(fmaxf(li[q], -7.0f), 7.0f);
                        o[q] = gl * (ln + 1.0f) * __builtin_amdgcn_rcpf(1.0f + __builtin_amdgcn_exp2f(-2.4554669595930156f * gl)); }
                    *(unsigned*)(ACT8 + (size_t)row * D + c0 + bj * 64) = pk4_fp8(o[0], o[1], o[2], o[3]); } }
    }
};
struct EpiP2 {
    static constexpr bool PERM = true, AFTER_DRAIN = false, BIAS_INIT = true;
    bf16* YP; const float* b2; int skip = 0;
    static constexpr int NSTORE = 16;
    __device__ __forceinline__ const float* bias_src(const pg8::Unit& u, int q) const { return b2 + (size_t)(u.pn >> 2) * 1024 + (u.pn & 3) * 256 + 4 * q; }
    __device__ __forceinline__ void load_bias(f32x4 (&nb)[4], const PG8_LAS float* sl, int wc, int fq) const {
        const PG8_LAS float* bp = sl + 32 * wc + 8 * fq;
        nb[0] = *(const PG8_LAS f32x4*)bp; nb[1] = *(const PG8_LAS f32x4*)(bp + 4); nb[2] = *(const PG8_LAS f32x4*)(bp + 128); nb[3] = *(const PG8_LAS f32x4*)(bp + 128 + 4);
    }
    __device__ __forceinline__ void set_bias(f32x4 (&acc)[2][2][4][2], const f32x4 (&nb)[4]) const {
#pragma unroll
        for (int bj = 0; bj < 2; ++bj)
#pragma unroll
            for (int ai = 0; ai < 2; ++ai)
#pragma unroll
                for (int m = 0; m < 4; ++m) { acc[ai][bj][m][0] = nb[2 * bj]; acc[ai][bj][m][1] = nb[2 * bj + 1]; }
    }
    __device__ __forceinline__ void operator()(const f32x4 (&acc)[2][2][4][2], const pg8::Unit& u, int wr, int wc, int fr, int fq) const {
        if (DUP_MASK != 0 && skip == 1) return;
        asm volatile("" : "+v"(fr), "+v"(fq));
        const int row0 = u.pm * 256 + wr * 64 + fr, c0 = (u.pn & 3) * 256 + 32 * wc + 8 * fq;
#pragma unroll
        for (int ai = 0; ai < 2; ++ai)
#pragma unroll
            for (int m = 0; m < 4; ++m) { const int row = row0 + ai * 128 + m * 16;
#pragma unroll
                for (int bj = 0; bj < 2; ++bj) { const f32x4 v0 = acc[ai][bj][m][0], v1 = acc[ai][bj][m][1];
                    *(u32x2*)((unsigned char*)YP + (size_t)row * D + c0 + bj * 128) = (u32x2){pk4_fp8(16.f * v0[0], 16.f * v0[1], 16.f * v0[2], 16.f * v0[3]), pk4_fp8(16.f * v1[0], 16.f * v1[1], 16.f * v1[2], 16.f * v1[3])}; } }
    }
};
struct EpiF8Moe1 {
    unsigned char* ACT8; const float* b1;
    __device__ __forceinline__ void operator()(const f32x4 (&acc)[4][4], const pg8::Unit& u, int wr, int wc, int fr, int fq) const {
        asm volatile("" : "+v"(fr), "+v"(fq));
        const int e = u.pn >> 4, j = u.pn & 15, row0 = u.pm * 256 + wr * 64 + fr, c0 = j * 64 + wc * 32 + 4 * fq;
        f32x4 bg[2], bl[2];
#pragma unroll
        for (int n = 0; n < 2; ++n) { bg[n] = *(const f32x4*)(b1 + (size_t)e * 2048 + c0 + 16 * n); bl[n] = *(const f32x4*)(b1 + (size_t)e * 2048 + 1024 + c0 + 16 * n); }
#pragma unroll
        for (int m = 0; m < 4; ++m)
#pragma unroll
            for (int n = 0; n < 2; ++n) { const f32x4 g = acc[m][n] + bg[n], li = acc[m][2 + n] + bl[n]; float o[4];
#pragma unroll
                for (int q = 0; q < 4; ++q) { const float gl = fminf(g[q], 7.0f), ln = fminf(fmaxf(li[q], -7.0f), 7.0f);
                    o[q] = gl * (ln + 1.0f) * __builtin_amdgcn_rcpf(1.0f + __builtin_amdgcn_exp2f(-2.4554669595930156f * gl)); }
                *(unsigned*)(ACT8 + (size_t)(row0 + 16 * m) * D + c0 + 16 * n) = pk4_fp8(o[0], o[1], o[2], o[3]); }
    }
};
struct EpiF8Moe2 {
    bf16* YP; const float* b2; const float* rowgate;
    __device__ __forceinline__ void operator()(const f32x4 (&acc)[4][4], const pg8::Unit& u, int wr, int wc, int fr, int fq) const {
        asm volatile("" : "+v"(fr), "+v"(fq));
        const int e = u.pn >> 3, row0 = u.pm * 256 + wr * 64 + fr, c0 = (u.pn & 7) * 128 + wc * 64 + 4 * fq;
        f32x4 bv[4];
#pragma unroll
        for (int n = 0; n < 4; ++n) bv[n] = *(const f32x4*)(b2 + (size_t)e * 1024 + c0 + 16 * n);
#pragma unroll
        for (int m = 0; m < 4; ++m) { const int row = row0 + 16 * m; const float g = rowgate[row];
#pragma unroll
            for (int n = 0; n < 4; ++n) { const f32x4 v = (acc[m][n] + bv[n]) * g;
                *(u32x2*)(YP + (size_t)row * D + c0 + 16 * n) = (u32x2){pg8::cvt_pk_bf16(v[0], v[1]), pg8::cvt_pk_bf16(v[2], v[3])}; } }
    }
};
namespace att {
typedef short s16x4 __attribute__((ext_vector_type(4)));
typedef float f32x16 __attribute__((ext_vector_type(16)));
constexpr int DH = 128, NW = 8, QBLK = 32, KVBLK = 64, QB = NW * QBLK;
constexpr int SHM_V = KVBLK * DH * 2, SHM_K = KVBLK * DH * 2;
constexpr int BODY_LDS = 2 * SHM_V + 2 * SHM_K + NW * 64 * 4;
constexpr int LDS_KB = BODY_LDS;
constexpr int LDS_BM = LDS_KB + 8192;
constexpr int LDS_SCAN = LDS_BM + 16384;
constexpr int LDS_GN = LDS_SCAN + 256;
constexpr float THR = 8.f;
#define KSWZ(row, colB) ((row) * 256 + ((colB) ^ (((row) & 7) << 4)))
#define SBAR() __builtin_amdgcn_sched_barrier(0)
__device__ __forceinline__ int v_st(int k, int c) { const int kk = (k & ~0xC) | ((k & 4) << 1) | ((k & 8) >> 1); return ((kk >> 3) * 4 + (c >> 5)) * 512 + ((kk & 7) * 32 + (c & 31)) * 2; }
__device__ __forceinline__ int v_rd_base(int lane) { return ((lane & 3) << 3) | (((lane >> 2) & 3) << 6) | (((lane >> 4) & 1) << 5) | (((lane >> 5) & 1) << 8); }
constexpr int v_rd_off(int d0, int ks, int half) { return d0 * 512 + ks * 4096 + half * 2048; }
__device__ __forceinline__ int crow(int r, int hi) { return (r & 3) + 8 * (r >> 2) + 4 * hi; }
__device__ __forceinline__ unsigned cvtpk(float lo, float hi) { unsigned r; asm volatile("v_cvt_pk_bf16_f32 %0, %1, %2" : "=v"(r) : "v"(lo), "v"(hi)); return r; }
__device__ __forceinline__ bf16x8 load8(const bf16* p) { return *reinterpret_cast<const bf16x8*>(p); }
__device__ __forceinline__ void mask_tile(f32x16& p0, f32x16& p1, int dq, unsigned W) {
    const float NEG = -__builtin_inff();
#pragma unroll
    for (int r = 0; r < 16; ++r) { const int c = (r & 3) + 8 * (r >> 2);
        if ((unsigned)(dq - c) >= W) p0[r] = NEG;
        if ((unsigned)(dq - c - 32) >= W) p1[r] = NEG; }
}
template <int MODE> __device__ __forceinline__ void partialSM(f32x16& p0, f32x16& p1, float& m_reg, float& mn, float& alpha) {
    constexpr float SCALE = MODE == 0 ? 0.08838834764831845f : 1.0f;
    float pmax = p0[0]; for (int r = 1; r < 16; ++r) pmax = fmaxf(pmax, p0[r]); for (int r = 0; r < 16; ++r) pmax = fmaxf(pmax, p1[r]);
    { auto rr = __builtin_amdgcn_permlane32_swap(__float_as_uint(pmax), __float_as_uint(pmax), false, false);
      pmax = fmaxf(__uint_as_float(rr[0]), __uint_as_float(rr[1])); }
    constexpr float C2 = 1.4426950408889634f * SCALE;
    if (__builtin_expect(__all((pmax - m_reg) * SCALE <= THR), 1)) { mn = m_reg; alpha = 1.f; }
    else { mn = fmaxf(m_reg, pmax); alpha = __builtin_amdgcn_exp2f((m_reg - mn) * C2); m_reg = mn; }
    const float mnL = -mn * C2;
    for (int r = 0; r < 16; ++r) p0[r] = fmaf(p0[r], C2, mnL); for (int r = 0; r < 16; ++r) p1[r] = fmaf(p1[r], C2, mnL);
    for (int r = 0; r < 16; ++r) p0[r] = __builtin_amdgcn_exp2f(p0[r]);
}
__device__ __forceinline__ void finishSM(f32x16& p0, f32x16& p1, float alpha, float& l_reg, bf16x8& pa0, bf16x8& pa1, bf16x8& pa2, bf16x8& pa3) {
    for (int r = 0; r < 16; ++r) p1[r] = __builtin_amdgcn_exp2f(p1[r]);
    float ps = 0; for (int r = 0; r < 16; ++r) ps += p0[r]; for (int r = 0; r < 16; ++r) ps += p1[r];
    { auto rr = __builtin_amdgcn_permlane32_swap(__float_as_uint(ps), __float_as_uint(ps), false, false);
      ps = __uint_as_float(rr[0]) + __uint_as_float(rr[1]); }
    l_reg = l_reg * alpha + ps;
#define PK4(P, B_, OUT) do { unsigned a0 = cvtpk(P[B_+0], P[B_+1]), a1 = cvtpk(P[B_+2], P[B_+3]);                          \
        unsigned b0 = cvtpk(P[B_+4], P[B_+5]), b1 = cvtpk(P[B_+6], P[B_+7]);                                             \
        auto r0 = __builtin_amdgcn_permlane32_swap(a0, b0, false, false); auto r1 = __builtin_amdgcn_permlane32_swap(a1, b1, false, false); \
        u32x4 w = {r0[0], r1[0], r0[1], r1[1]}; OUT = *reinterpret_cast<bf16x8*>(&w); } while (0)
    PK4(p0, 0, pa0); PK4(p0, 8, pa1); PK4(p1, 0, pa2); PK4(p1, 8, pa3);
}
template <int MODE> __device__ __forceinline__ void cinit(f32x16& p0, f32x16& p1, const char* lds, int kbase, int hi, int tq, int t) {
    if constexpr (MODE == 0) {
        const float* kb = (const float*)(lds + LDS_KB) + kbase + 4 * hi;
#pragma unroll
        for (int g = 0; g < 4; ++g) { const f32x4 a = *(const f32x4*)(kb + 8 * g), b = *(const f32x4*)(kb + 32 + 8 * g);
            p0[4 * g] = a[0]; p0[4 * g + 1] = a[1]; p0[4 * g + 2] = a[2]; p0[4 * g + 3] = a[3]; p1[4 * g] = b[0]; p1[4 * g + 1] = b[1]; p1[4 * g + 2] = b[2]; p1[4 * g + 3] = b[3]; }
    } else {
        const u32x2 w = *(const u32x2*)((const unsigned*)(lds + LDS_BM) + tq * 64 + 2 * t);
        const unsigned lo = w.x >> (4 * hi), hh = w.y >> (4 * hi);
        const float NEG = -__builtin_inff();
#pragma unroll
        for (int r = 0; r < 16; ++r) { const int c = (r & 3) + 8 * (r >> 2); p0[r] = ((lo >> c) & 1u) ? 0.f : NEG; p1[r] = ((hh >> c) & 1u) ? 0.f : NEG; }
    }
}
template <int KB>
__device__ __forceinline__ void qkt(f32x16& p0, f32x16& p1, const char* K_lds, int r32, int hi, const bf16x8* qr) {
    const char* kb[4];
#pragma unroll
    for (int dd = 0; dd < 4; ++dd) kb[dd] = K_lds + KB * SHM_K + KSWZ(r32, (dd * 16 + hi * 8) * 2);
#pragma unroll
    for (int d0 = 0; d0 < 8; ++d0) { const char* a = kb[d0 & 3] + (d0 >> 2) * 128;
        bf16x8 b0 = *reinterpret_cast<const bf16x8*>(a);
        bf16x8 b1 = *reinterpret_cast<const bf16x8*>(a + 32 * 256);
        p0 = __builtin_amdgcn_mfma_f32_32x32x16_bf16(b0, qr[d0], p0, 0, 0, 0);
        p1 = __builtin_amdgcn_mfma_f32_32x32x16_bf16(b1, qr[d0], p1, 0, 0, 0); }
}
template <int VB>
__device__ __forceinline__ void pv_tile(f32x16* o, int vb0, bf16x8 pa0, bf16x8 pa1, bf16x8 pa2, bf16x8 pa3) {
#define TRRD(dst, off) asm volatile("ds_read_b64_tr_b16 %0, %1 offset:%2" : "=&v"(dst) : "v"(vb0), "i"(off) : "memory")
#define PV_D0(d0) do { s16x4 l0, l1, l2, l3, h0, h1, h2, h3; constexpr int b_ = VB * SHM_V + v_rd_off(d0, 0, 0); \
        TRRD(l0, b_); TRRD(h0, b_ + 2048); TRRD(l1, b_ + 4096); TRRD(h1, b_ + 6144); TRRD(l2, b_ + 8192); TRRD(h2, b_ + 10240); TRRD(l3, b_ + 12288); TRRD(h3, b_ + 14336); \
        asm volatile("s_waitcnt lgkmcnt(0)" ::: "memory"); SBAR();   \
        o[d0] = __builtin_amdgcn_mfma_f32_32x32x16_bf16(pa0, (bf16x8){l0[0], l0[1], l0[2], l0[3], h0[0], h0[1], h0[2], h0[3]}, o[d0], 0, 0, 0);   \
        o[d0] = __builtin_amdgcn_mfma_f32_32x32x16_bf16(pa1, (bf16x8){l1[0], l1[1], l1[2], l1[3], h1[0], h1[1], h1[2], h1[3]}, o[d0], 0, 0, 0);   \
        o[d0] = __builtin_amdgcn_mfma_f32_32x32x16_bf16(pa2, (bf16x8){l2[0], l2[1], l2[2], l2[3], h2[0], h2[1], h2[2], h2[3]}, o[d0], 0, 0, 0);   \
        o[d0] = __builtin_amdgcn_mfma_f32_32x32x16_bf16(pa3, (bf16x8){l3[0], l3[1], l3[2], l3[3], h3[0], h3[1], h3[2], h3[3]}, o[d0], 0, 0, 0); } while (0)
    PV_D0(0); PV_D0(1); PV_D0(2); PV_D0(3);
#undef PV_D0
}
struct BlockRef { const bf16* Q; const bf16* K; const bf16* V; bf16* O; int ldo; int P0; int NT; const float* g; };
struct Seam { bf16x8 qr[8]; bf16x8 st_v0, st_v1, st_k0, st_k1; };
__device__ __forceinline__ bf16x8 nrm8(bf16x8 x, const float* gl) {
    const f32x4 g0 = *(const f32x4*)gl, g1 = *(const f32x4*)(gl + 4);
    float f[8]; float ss = 0.f;
#pragma unroll
    for (int i = 0; i < 8; ++i) { f[i] = bf2f((unsigned short)x[i]); ss += f[i] * f[i]; }
    ss += __builtin_bit_cast(float, __builtin_amdgcn_update_dpp(0, __builtin_bit_cast(int, ss), 0x128, 0xf, 0xf, false));
    ss += __builtin_bit_cast(float, __builtin_amdgcn_update_dpp(0, __builtin_bit_cast(int, ss), 0x124, 0xf, 0xf, false));
    ss += __builtin_bit_cast(float, __builtin_amdgcn_update_dpp(0, __builtin_bit_cast(int, ss), 0x122, 0xf, 0xf, false));
    ss += __builtin_bit_cast(float, __builtin_amdgcn_update_dpp(0, __builtin_bit_cast(int, ss), 0x121, 0xf, 0xf, false));
    const float r = __builtin_amdgcn_rsqf(ss * (1.0f / 128.0f) + EPS);
    u32x4 w = {cvtpk(f[0] * r * g0[0], f[1] * r * g0[1]), cvtpk(f[2] * r * g0[2], f[3] * r * g0[3]), cvtpk(f[4] * r * g1[0], f[5] * r * g1[1]), cvtpk(f[6] * r * g1[2], f[7] * r * g1[3])};
    return *reinterpret_cast<bf16x8*>(&w);
}
#define ROW(p, k0, rr) ((p) + (size_t)((k0) + (rr)) * DH + sc)
#define VMW() asm volatile("s_waitcnt vmcnt(0)" ::: "memory")
#define VMWN(n) asm volatile("s_waitcnt vmcnt(%0)" :: "i"(n) : "memory")
#define STG_IDS() int tid_s = tid; asm volatile("" : "+v"(tid_s)); const int sr = tid_s >> 4, sc = (tid_s & 15) * 8
#define SLOAD_H(Kp, Vp, k0) do { STG_IDS(); if constexpr (MODE == 0) { S.st_v0 = load8(ROW(Vp, k0, sr)); S.st_v1 = load8(ROW(Vp, k0, 32 + sr)); }             \
                         S.st_k0 = load8(ROW(Kp, k0, sr)); S.st_k1 = load8(ROW(Kp, k0, 32 + sr)); } while (0)
#define NORMKV() do { if constexpr (MODE == 1) { S.st_v0 = S.st_k0; S.st_v1 = S.st_k1; } } while (0)
#define SWRITE_HK(bf) do { STG_IDS(); const int kws = KSWZ(sr, sc * 2); *(bf16x8*)(K_lds + (bf) * SHM_K + kws) = S.st_k0; *(bf16x8*)(K_lds + (bf) * SHM_K + kws + 32 * 256) = S.st_k1; } while (0)
#define SWRITE_HV(bf) do { STG_IDS(); const int vst0 = v_st(sr, sc), vst1 = v_st(32 + sr, sc); *(bf16x8*)(V_lds + (bf) * SHM_V + vst0) = S.st_v0; *(bf16x8*)(V_lds + (bf) * SHM_V + vst1) = S.st_v1; } while (0)
#define SWRITE_H(bf) do { SWRITE_HV(bf); SWRITE_HK(bf); } while (0)
template <int MODE>
__device__ __forceinline__ void prime(const BlockRef& cur, char* lds, Seam& S, const int tid) {
    const int wid = __builtin_amdgcn_readfirstlane(tid >> 6), lane = tid & 63, r32 = lane & 31, hi = lane >> 5;
    char* K_lds = lds + 2 * SHM_V;
    for (int d0 = 0; d0 < 8; ++d0) S.qr[d0] = load8(cur.Q + (size_t)(wid * QBLK + r32) * DH + d0 * 16 + hi * 8);
    SLOAD_H(cur.K, cur.V, 0); VMW(); NORMKV(); SWRITE_HK(0);
    __syncthreads();
}
template <int MODE>
__device__ __forceinline__ void block(const BlockRef& cur, const BlockRef& nxt, char* lds, Seam& S, const int tid) {
    const int wid = __builtin_amdgcn_readfirstlane(tid >> 6), lane = tid & 63, r32 = lane & 31, hi = lane >> 5;
    const int NT = cur.NT;
    const int qlo = cur.P0 + wid * QBLK, qm = qlo + r32 - 4 * hi;
    const int tq = wid * 8 + (r32 >> 2);
    constexpr unsigned W = 1u << 30;
    char* V_lds = lds; char* K_lds = lds + 2 * SHM_V;
    float* ws = (float*)(lds + 2 * SHM_V + 2 * SHM_K) + wid * 64; float* li_l = ws, * al_l = ws + 32;
    float m_reg = -1e30f, l_reg = 0; f32x16 o[4]; { const f32x16 z16 = ozero16(); o[0] = z16; o[1] = z16; o[2] = z16; o[3] = z16; }
    const int vb0 = (int)(uintptr_t)V_lds + v_rd_base(lane);
    const bf16* Kh = cur.K; const bf16* Vh = cur.V;
#define RESC(a) do { if (__any((a) < 1.f)) { if (hi == 0) al_l[r32] = (a); asm volatile("s_waitcnt lgkmcnt(0)" ::: "memory");              \
                     for (int d_ = 0; d_ < 4; ++d_) for (int r = 0; r < 16; ++r) o[d_][r] *= al_l[crow(r, hi)]; } } while (0)
#define KBASE(t) ((t) * KVBLK)
#define MASKT(P0_, P1_, t) do { if constexpr (MODE == 0) { const int kb_ = KBASE(t); if (kb_ + KVBLK - 1 > qlo) mask_tile(P0_, P1_, qm - kb_, W); } } while (0)
    constexpr int NQL = 8;
#define SEAM_K0() do { VMWN(NQL); NORMKV(); SWRITE_HK(0); SBAR(); } while (0)
    f32x16 pA0, pA1, pB0, pB1; float mnA, mnB, alA, alB; bf16x8 pa0, pa1, pa2, pa3;
    SWRITE_HV(0); SBAR();
    if (NT > 1) { SLOAD_H(Kh, Vh, KBASE(1)); }
    SBAR(); cinit<MODE>(pA0, pA1, lds, KBASE(0), hi, tq, 0); qkt<0>(pA0, pA1, K_lds, r32, hi, S.qr);
    MASKT(pA0, pA1, 0); partialSM<MODE>(pA0, pA1, m_reg, mnA, alA);
    if (NT > 1) { VMW(); NORMKV(); SWRITE_H(1); }
    __syncthreads();
#define HALF_STEP(PX0, PX1, mnX, alX, PY0, PY1, alY, t, KB, VB, SB) do {                                                      \
        SBAR(); cinit<MODE>(PX0, PX1, lds, KBASE(t), hi, tq, (t)); qkt<KB>(PX0, PX1, K_lds, r32, hi, S.qr);                     \
        finishSM(PY0, PY1, alY, l_reg, pa0, pa1, pa2, pa3); SBAR();                                                           \
        if ((t) + 1 < NT) { SLOAD_H(Kh, Vh, KBASE((t) + 1)); SBAR(); }                                                        \
        pv_tile<VB>(o, vb0, pa0, pa1, pa2, pa3); MASKT(PX0, PX1, (t)); partialSM<MODE>(PX0, PX1, m_reg, mnX, alX);             \
        __syncthreads();                                                                                                      \
        if ((t) + 1 < NT) { VMW(); NORMKV(); SWRITE_H(SB); }                                                                  \
        RESC(alX); __syncthreads(); } while (0)
    for (int t = 1; t + 1 < NT; t += 2) {
        HALF_STEP(pB0, pB1, mnB, alB, pA0, pA1, alA, t, 1, 0, 0);
        HALF_STEP(pA0, pA1, mnA, alA, pB0, pB1, alB, t + 1, 0, 1, 1);
    }
    const bool even = (NT & 1) == 0;
    if (even) { SBAR(); cinit<MODE>(pB0, pB1, lds, KBASE(NT - 1), hi, tq, NT - 1); qkt<1>(pB0, pB1, K_lds, r32, hi, S.qr); SBAR(); }
    SBAR();
    finishSM(pA0, pA1, alA, l_reg, pa0, pa1, pa2, pa3); SBAR();
    pv_tile<0>(o, vb0, pa0, pa1, pa2, pa3);
    if (even) { MASKT(pB0, pB1, NT - 1); partialSM<MODE>(pB0, pB1, m_reg, mnB, alB); __syncthreads(); RESC(alB);
        finishSM(pB0, pB1, alB, l_reg, pa0, pa1, pa2, pa3); SBAR(); pv_tile<1>(o, vb0, pa0, pa1, pa2, pa3); }
    SBAR();
    if (hi == 0) li_l[r32] = l_reg; asm volatile("s_waitcnt lgkmcnt(0)" ::: "memory");
    float rli[16];
#pragma unroll
    for (int r = 0; r < 16; ++r) rli[r] = __builtin_amdgcn_rcpf(li_l[crow(r, hi)]);
    constexpr int LDO = MODE == 0 ? 512 : 128;
    bf16* Ow = cur.O + (size_t)(wid * QBLK) * LDO;
#pragma unroll
    for (int r = 0; r < 16; ++r) { const int orow = crow(r, hi);
#pragma unroll
        for (int d0 = 0; d0 < 4; ++d0) { const float v = o[d0][r] * rli[r];
            const float vn = qxor1(v);
            if ((r32 & 1) == 0) *(unsigned*)(Ow + (size_t)orow * LDO + d0 * 32 + r32) = cvtpk(v, vn); } }
    __syncthreads();
#undef RESC
#undef KBASE
#undef MASKT
#undef SEAM_K0
#undef HALF_STEP
}
#undef ROW
#undef VMWN
#undef SLOAD_H
#undef STG_IDS
#undef NORMKV
#undef SWRITE_HK
#undef SWRITE_HV
#undef SWRITE_H
#undef PK4
#undef TRRD
}

constexpr size_t WS_MLQK = 848 * MiB, WS_MLV = 864 * MiB, WS_MLO = 880 * MiB, WS_QABS = 896 * MiB, WS_CKV = 912 * MiB, WS_IK = 916 * MiB, WS_SCAL = 918 * MiB, WS_IQ = 920 * MiB;
constexpr size_t WS_FXQ = 928 * MiB, WS_FXK = 944 * MiB, WS_FXV = 960 * MiB, WS_GATES = 976 * MiB, WS_YCAT = 1072 * MiB, WS_MERGED = 1120 * MiB;
constexpr size_t WS_CLOC = 1152 * MiB, WS_CPREV = 1184 * MiB, WS_MLST = 1200 * MiB, WS_SCORE = 1208 * MiB, WS_XN1_8 = 1352 * MiB  , WS_WIN8 = 1368 * MiB  , WS_MERGED8 = 1384 * MiB  , WS_WOUT8 = 1400 * MiB  , WS_CKVN = 1402 * MiB  , WS_END2 = 1406 * MiB;
constexpr int CW_Q = 512;

struct EpiInProj {
    static constexpr bool PERM = true, AFTER_DRAIN = false;
    const float* bias; unsigned char* ws;
    __device__ __forceinline__ void operator()(const f32x4 (&acc)[2][2][4][2], const pg8::Unit& u, int wr, int wc, int fr, int fq) const {
        asm volatile("" : "+v"(fr), "+v"(fq));
        const int pn = u.pn, row0 = u.pm * 256 + wr * 64 + fr, b = u.pm >> 3;
#pragma unroll
        for (int bj = 0; bj < 2; ++bj) {
            const int c8 = 128 * bj + 32 * wc + 8 * fq;
            bf16* base = nullptr; int pitch = 0; float* fbase = nullptr;
            if (pn < 2) { base = (bf16*)(ws + WS_MLQK) + pn * 256 + c8; pitch = 512; }
            else if (pn < 4) { base = (bf16*)(ws + WS_MLV) + (pn - 2) * 256 + c8; pitch = 512; }
            else if (pn < 6) { base = (bf16*)(ws + WS_MLO) + (pn - 4) * 256 + c8; pitch = 512; }
            else if (pn < 8) { base = (bf16*)(ws + WS_QABS) + (pn - 6) * 256 + c8; pitch = 512; }
            else if (pn == 8) { if (c8 < 128) { base = (bf16*)(ws + WS_CKV) + c8; pitch = 128; } else if (c8 < 192) { base = (bf16*)(ws + WS_IK) + (c8 - 128); pitch = 64; }
                                else if (c8 < 208) { fbase = (float*)(ws + WS_SCAL) + (c8 - 192); } }
            else if (pn == 9) { base = (bf16*)(ws + WS_IQ) + c8; pitch = 256; }
            else if (pn < 16) { const int t = (pn - 10) >> 1, hh = ((pn - 10) & 1) * 2 + bj;
                base = (bf16*)(ws + WS_FXQ + (size_t)t * (WS_FXK - WS_FXQ)) + (size_t)(b * 3 + hh) * 2048 * 128 + 32 * wc + 8 * fq; pitch = 128; }
            else { base = (bf16*)(ws + WS_GATES) + (pn - 16) * 256 + c8; pitch = 3072; }
            const f32x4 bv0 = *(const f32x4*)(bias + pn * 256 + c8), bv1 = *(const f32x4*)(bias + pn * 256 + c8 + 4);
            if (base) {
#pragma unroll
                for (int ai = 0; ai < 2; ++ai)
#pragma unroll
                    for (int m = 0; m < 4; ++m) { const int row = row0 + ai * 128 + m * 16; const f32x4 v0 = acc[ai][bj][m][0] + bv0, v1 = acc[ai][bj][m][1] + bv1;
                        *(u32x4*)(base + (size_t)row * pitch) = (u32x4){pg8::cvt_pk_bf16(v0[0], v0[1]), pg8::cvt_pk_bf16(v0[2], v0[3]), pg8::cvt_pk_bf16(v1[0], v1[1]), pg8::cvt_pk_bf16(v1[2], v1[3])}; }
            } else if (fbase) {
#pragma unroll
                for (int ai = 0; ai < 2; ++ai)
#pragma unroll
                    for (int m = 0; m < 4; ++m) { const int row = row0 + ai * 128 + m * 16; *(f32x4*)(fbase + (size_t)row * 16) = acc[ai][bj][m][0] + bv0; *(f32x4*)(fbase + (size_t)row * 16 + 4) = acc[ai][bj][m][1] + bv1; }
            }
        }
    }
};
struct InProjSched {
    pg8::StaticOrder so; int f8;
    __device__ __forceinline__ bool next(int i, pg8::Unit& u) const { if (!so.next(i, u)) return false; u.pn = f8 ? (u.pn < 6 ? u.pn : u.pn + 4) : u.pn + 6; return true; }
    __device__ __forceinline__ void a_ready(const pg8::Unit&) const {}
    __device__ __forceinline__ void done(const pg8::Unit&) const {}
};
struct EpiInProj8 {
    static constexpr bool PERM = true, AFTER_DRAIN = false;
    const float* bias; unsigned char* ws;
    __device__ __forceinline__ void operator()(const f32x4 (&acc)[2][2][4][2], const pg8::Unit& u, int wr, int wc, int fr, int fq) const {
        asm volatile("" : "+v"(fr), "+v"(fq));
        const int pn = u.pn, row0 = u.pm * 256 + wr * 64 + fr, b = u.pm >> 3;
#pragma unroll
        for (int bj = 0; bj < 2; ++bj) {
            const int c8 = 128 * bj + 32 * wc + 8 * fq;
            bf16* base; int pitch;
            if (pn < 2) { base = (bf16*)(ws + WS_MLQK) + pn * 256 + c8; pitch = 512; }
            else if (pn < 4) { base = (bf16*)(ws + WS_MLV) + (pn - 2) * 256 + c8; pitch = 512; }
            else if (pn < 6) { base = (bf16*)(ws + WS_MLO) + (pn - 4) * 256 + c8; pitch = 512; }
            else if (pn < 16) { const int t = (pn - 10) >> 1, hh = ((pn - 10) & 1) * 2 + bj;
                base = (bf16*)(ws + WS_FXQ + (size_t)t * (WS_FXK - WS_FXQ)) + (size_t)(b * 3 + hh) * 2048 * 128 + 32 * wc + 8 * fq; pitch = 128; }
            else { base = (bf16*)(ws + WS_GATES) + (pn - 16) * 256 + c8; pitch = 3072; }
            const f32x4 bv0 = *(const f32x4*)(bias + pn * 256 + c8), bv1 = *(const f32x4*)(bias + pn * 256 + c8 + 4);
#pragma unroll
            for (int ai = 0; ai < 2; ++ai)
#pragma unroll
                for (int m = 0; m < 4; ++m) { const int row = row0 + ai * 128 + m * 16; const f32x4 v0 = acc[ai][bj][m][0] + bv0, v1 = acc[ai][bj][m][1] + bv1;
                    *(u32x4*)(base + (size_t)row * pitch) = (u32x4){pg8::cvt_pk_bf16(v0[0], v0[1]), pg8::cvt_pk_bf16(v0[2], v0[3]), pg8::cvt_pk_bf16(v1[0], v1[1]), pg8::cvt_pk_bf16(v1[2], v1[3])}; }
        }
    }
};
struct BranchSched {
    int G, c, brpack, nbr;
    __device__ __forceinline__ bool next(int i, pg8::Unit& u) const {
        const int tile = (i / nbr) * G + c, br = (brpack >> (2 * (i % nbr))) & 3; if (tile >= 256) return false;
        u.pm = br * 64 + (tile >> 2); u.pn = br * 4 + (tile & 3); return true;
    }
    __device__ __forceinline__ void a_ready(const pg8::Unit&) const {}
    __device__ __forceinline__ void done(const pg8::Unit&) const {}
};
struct EpiBranch {
    static constexpr bool PERM = true, AFTER_DRAIN = false;
    const bf16* gates; bf16* merged; int br0; unsigned char* merged8;
    __device__ __forceinline__ void operator()(const f32x4 (&acc)[2][2][4][2], const pg8::Unit& u, int wr, int wc, int fr, int fq) const {
        asm volatile("" : "+v"(fr), "+v"(fq));
        const int br = u.pm >> 6, row0 = (u.pm & 63) * 256 + wr * 64 + fr, col0 = (u.pn & 3) * 256 + 32 * wc + 8 * fq;
        u32x4 gqn[2], oldn[2];
#pragma unroll
        for (int bj = 0; bj < 2; ++bj) { gqn[bj] = *(const u32x4*)(gates + (size_t)row0 * 3072 + br * 1024 + col0 + bj * 128);
            oldn[bj] = (br != br0) ? *(const u32x4*)(merged + (size_t)row0 * 1024 + col0 + bj * 128) : (u32x4){0u, 0u, 0u, 0u}; }
#pragma unroll
        for (int gi = 0; gi < 8; ++gi) { const int ai = gi >> 2, m = gi & 3, row = row0 + ai * 128 + m * 16;
            u32x4 gq[2], old[2];
#pragma unroll
            for (int bj = 0; bj < 2; ++bj) { gq[bj] = gqn[bj]; old[bj] = oldn[bj]; }
            if (gi < 7) { const int rown = row0 + ((gi + 1) >> 2) * 128 + ((gi + 1) & 3) * 16;
#pragma unroll
                for (int bj = 0; bj < 2; ++bj) { gqn[bj] = *(const u32x4*)(gates + (size_t)rown * 3072 + br * 1024 + col0 + bj * 128);
                    if (br != br0) oldn[bj] = *(const u32x4*)(merged + (size_t)rown * 1024 + col0 + bj * 128); } }
#pragma unroll
            for (int bj = 0; bj < 2; ++bj) { const int col = col0 + bj * 128;
                float v[8];
#pragma unroll
                for (int q = 0; q < 4; ++q) { const float g0 = bf2f(gq[bj][q] & 0xffffu), g1 = bf2f(gq[bj][q] >> 16);
                    v[2 * q] = acc[ai][bj][m][q >> 1][(2 * q) & 3] * __builtin_amdgcn_rcpf(1.0f + __builtin_amdgcn_exp2f(-1.4426950408889634f * g0));
                    v[2 * q + 1] = acc[ai][bj][m][q >> 1][(2 * q + 1) & 3] * __builtin_amdgcn_rcpf(1.0f + __builtin_amdgcn_exp2f(-1.4426950408889634f * g1)); }
                if (br != br0) {
#pragma unroll
                    for (int q = 0; q < 4; ++q) { v[2 * q] += bf2f(old[bj][q] & 0xffffu); v[2 * q + 1] += bf2f(old[bj][q] >> 16); } }
                if (br == 2) *(u32x2*)(merged8 + (size_t)row * 1024 + col) = (u32x2){pk4_fp8(v[0], v[1], v[2], v[3]), pk4_fp8(v[4], v[5], v[6], v[7])};
                else *(u32x4*)(merged + (size_t)row * 1024 + col) = (u32x4){pg8::cvt_pk_bf16(v[0], v[1]), pg8::cvt_pk_bf16(v[2], v[3]), pg8::cvt_pk_bf16(v[4], v[5]), pg8::cvt_pk_bf16(v[6], v[7])}; }
            asm volatile("" ::: "memory"); }
    }
};
struct EpiOutProj {
    static constexpr bool PERM = false, AFTER_DRAIN = false;
    const float* xsrc; float* X; const float* modl;
    __device__ __forceinline__ void operator()(const f32x4 (&acc)[2][2][4][2], const pg8::Unit& u, int wr, int wc, int fr, int fq) const {
        asm volatile("" : "+v"(fr), "+v"(fq));
        const int row0 = u.pm * 256 + wr * 64 + fr, col0 = u.pn * 256 + wc * 32 + 4 * fq; const float* g1 = modl + (size_t)(u.pm >> 3) * 6144 + 2048;
        f32x4 gv[2][2];
#pragma unroll
        for (int bj = 0; bj < 2; ++bj)
#pragma unroll
            for (int n = 0; n < 2; ++n) gv[bj][n] = *(const f32x4*)(g1 + col0 + bj * 128 + n * 16);
        f32x4 xn[2][2];
#pragma unroll
        for (int bj = 0; bj < 2; ++bj)
#pragma unroll
            for (int n = 0; n < 2; ++n) xn[bj][n] = *(const f32x4*)(xsrc + (size_t)row0 * 1024 + col0 + bj * 128 + n * 16);
#pragma unroll
        for (int gi = 0; gi < 8; ++gi) { const int ai = gi >> 2, m = gi & 3; const size_t off = (size_t)(row0 + ai * 128 + m * 16) * 1024 + col0;
            f32x4 xc[2][2];
#pragma unroll
            for (int bj = 0; bj < 2; ++bj)
#pragma unroll
                for (int n = 0; n < 2; ++n) xc[bj][n] = xn[bj][n];
            if (gi < 7) { const size_t offn = (size_t)(row0 + ((gi + 1) >> 2) * 128 + ((gi + 1) & 3) * 16) * 1024 + col0;
#pragma unroll
                for (int bj = 0; bj < 2; ++bj)
#pragma unroll
                    for (int n = 0; n < 2; ++n) xn[bj][n] = *(const f32x4*)(xsrc + offn + bj * 128 + n * 16); }
#pragma unroll
            for (int bj = 0; bj < 2; ++bj)
#pragma unroll
                for (int n = 0; n < 2; ++n) *(f32x4*)(X + off + bj * 128 + n * 16) = xc[bj][n] + gv[bj][n] * acc[ai][bj][m][n];
            asm volatile("" ::: "memory"); }
    }
};

__device__ __forceinline__ float logsigf(float f) { return fminf(f, 0.f) - __logf(1.0f + __expf(-fabsf(f))); }
__device__ __forceinline__ void fox_unit(Frame& F, int b, int h, int qb) {
    char* lds = (char*)F.lds; const int tid = F.tid, lane = (F.tid & 63), wid = F.wave;
    const int n = (qb + 1) * 256;
    {   const float* fsrc = WSP(float, WS_SCAL) + (size_t)b * 2048 * 16 + 12 + h;
        float ls[4], run = 0.f;
#pragma unroll
        for (int q = 0; q < 4; ++q) { const int s = 4 * tid + q; const float v = (s < n) ? logsigf(fsrc[(size_t)s * 16]) : 0.f; run += v; ls[q] = run; }
        float incl = run;
#pragma unroll
        for (int off = 1; off < 64; off <<= 1) { const float t = lshfl(incl, (lane - off) & 63); if (lane >= off) incl += t; }
        float* scan = (float*)(lds + att::LDS_SCAN);
        if (lane == 63) scan[wid] = incl;
        __syncthreads();
        float base = 0.f;
        for (int w2 = 0; w2 < wid; ++w2) base += scan[w2];
        const float excl = base + incl - run;
        *(f32x4*)((float*)(lds + att::LDS_KB) + 4 * tid) = (f32x4){-(excl + ls[0]) * 11.313708498984761f, -(excl + ls[1]) * 11.313708498984761f, -(excl + ls[2]) * 11.313708498984761f, -(excl + ls[3]) * 11.313708498984761f};
        __syncthreads();
    }
    const size_t hb = (size_t)(b * 4 + h) * 2048 * 128;
    att::BlockRef r{WSP(bf16, WS_FXQ) + hb + (size_t)qb * 256 * 128, WSP(bf16, WS_FXK) + hb, WSP(bf16, WS_FXV) + hb,
                    WSP(bf16, WS_YCAT) + (size_t)2 * M * 512 + (size_t)(b * 2048 + qb * 256) * 512 + h * 128, 512, qb * 256, 4 * (qb + 1), nullptr};
    att::Seam S;
    att::prime<0>(r, lds, S, tid); att::block<0>(r, r, lds, S, tid);
}
constexpr size_t WS_NLOC = WS_MLST, WS_NPREV = WS_MLST + 262144, WS_MLOC = WS_MLST + 524288, WS_BLAST = WS_MLOC + 4096, WS_MPREV = WS_BLAST + 4096;
namespace ml {
using att::f32x16; using att::s16x4;
constexpr int L_Q = 0, L_K = 8192, L_V = 16384, L_HID = 32768, L_G = L_HID + 64 * 132 * 4, L_WS = L_G + 2048;
__device__ __forceinline__ void stage_conv(char* tile, const bf16* X, const float* cw, const float* cb, int row0, int spos0, int ch0, float scale, int tid) {
    const int s = tid >> 3, ch = ch0 + (tid & 7) * 8;
    float a[8];
    { const f32x4 b0 = *(const f32x4*)(cb + ch), b1 = *(const f32x4*)(cb + ch + 4); a[0] = b0[0]; a[1] = b0[1]; a[2] = b0[2]; a[3] = b0[3]; a[4] = b1[0]; a[5] = b1[1]; a[6] = b1[2]; a[7] = b1[3]; }
#pragma unroll
    for (int j = 0; j < 4; ++j) { if (spos0 + s - 3 + j >= 0) {
            const bf16x8 x = *(const bf16x8*)(X + (size_t)(row0 + s - 3 + j) * 512 + ch);
            const f32x4 w0 = *(const f32x4*)(cw + j * 512 + ch), w1 = *(const f32x4*)(cw + j * 512 + ch + 4);
#pragma unroll
            for (int i = 0; i < 4; ++i) { a[i] += w0[i] * bf2f((unsigned short)x[i]); a[4 + i] += w1[i] * bf2f((unsigned short)x[4 + i]); } } }
#pragma unroll
    for (int i = 0; i < 8; ++i) a[i] = a[i] * scale / (1.0f + __expf(-a[i]));
    *(u32x4*)(tile + (s * 64 + (tid & 7) * 8) * 2) = (u32x4){att::cvtpk(a[0], a[1]), att::cvtpk(a[2], a[3]), att::cvtpk(a[4], a[5]), att::cvtpk(a[6], a[7])};
}
__device__ __forceinline__ void stage_conv4(char* tile0, const bf16* X, const float* cw, const float* cb, int row0, int spos0, int ch0, float scale, int tid) {
    const int s = tid >> 3, ch = ch0 + (tid & 7) * 8;
    bf16x8 x[4][4];
#pragma unroll
    for (int c = 0; c < 4; ++c)
#pragma unroll
        for (int j = 0; j < 4; ++j) { const int sp = spos0 + 64 * c + s - 3 + j; x[c][j] = *(const bf16x8*)(X + (size_t)(row0 + 64 * c + s - 3 + j + (sp < 0 ? 3 : 0)) * 512 + ch); }
    f32x4 w0[4], w1[4];
#pragma unroll
    for (int j = 0; j < 4; ++j) { w0[j] = *(const f32x4*)(cw + j * 512 + ch); w1[j] = *(const f32x4*)(cw + j * 512 + ch + 4); }
    const f32x4 b0 = *(const f32x4*)(cb + ch), b1 = *(const f32x4*)(cb + ch + 4);
#pragma unroll
    for (int c = 0; c < 4; ++c) { float a[8] = {b0[0], b0[1], b0[2], b0[3], b1[0], b1[1], b1[2], b1[3]};
#pragma unroll
        for (int j = 0; j < 4; ++j) { const float msk = (spos0 + 64 * c + s - 3 + j >= 0) ? 1.0f : 0.0f;
#pragma unroll
            for (int i = 0; i < 4; ++i) { a[i] += msk * w0[j][i] * bf2f((unsigned short)x[c][j][i]); a[4 + i] += msk * w1[j][i] * bf2f((unsigned short)x[c][j][4 + i]); } }
#pragma unroll
        for (int i = 0; i < 8; ++i) a[i] = a[i] * scale / (1.0f + __expf(-a[i]));
        *(u32x4*)(tile0 + c * 8192 + (s * 64 + (tid & 7) * 8) * 2) = (u32x4){att::cvtpk(a[0], a[1]), att::cvtpk(a[2], a[3]), att::cvtpk(a[4], a[5]), att::cvtpk(a[6], a[7])}; }
}
__device__ __forceinline__ void stage_v(char* V_lds, const bf16* Vg, int row0, int h, int tid) {
    const int sr = tid >> 4, sc = (tid & 15) * 8;
    const bf16x8 v0 = *(const bf16x8*)(Vg + (size_t)(row0 + sr) * 512 + h * 128 + sc), v1 = *(const bf16x8*)(Vg + (size_t)(row0 + 32 + sr) * 512 + h * 128 + sc);
    *(bf16x8*)(V_lds + att::v_st(sr, sc)) = v0; *(bf16x8*)(V_lds + att::v_st(32 + sr, sc)) = v1;
}
__device__ __forceinline__ void stage_gates(float* G, const float* scal, int row0, int h, int lane, float& b_last, float& m_loc) {
    const float ig = scal[(size_t)(row0 + lane) * 16 + h], f = logsigf(scal[(size_t)(row0 + lane) * 16 + 4 + h]);
    float b = f;
#pragma unroll
    for (int off = 1; off < 64; off <<= 1) { const float t = lshfl(b, (lane - off) & 63); if (lane >= off) b += t; }
    b_last = __builtin_bit_cast(float, __builtin_amdgcn_readlane(__builtin_bit_cast(int, b), 63));
    const float wst = b_last - b + ig; float mx = wst;
#pragma unroll
    for (int off = 1; off < 64; off <<= 1) mx = fmaxf(mx, lshfl(mx, lane ^ off));
    m_loc = mx;
    G[lane] = b; G[64 + lane] = ig - b; G[128 + lane] = __expf(wst - mx);
}
#define TRRD(dst, off) asm volatile("ds_read_b64_tr_b16 %0, %1 offset:%2" : "=&v"(dst) : "v"(vb), "i"(off) : "memory")
#define VFRAG(l_, h_) (bf16x8){l_[0], l_[1], l_[2], l_[3], h_[0], h_[1], h_[2], h_[3]}
__device__ __forceinline__ void mma_v(f32x16& acc, int vb, bf16x8 pa0, bf16x8 pa1, bf16x8 pa2, bf16x8 pa3) {
    s16x4 l0, l1, l2, l3, h0, h1, h2, h3;
    TRRD(l0, 0); TRRD(h0, 2048); TRRD(l1, 4096); TRRD(h1, 6144); TRRD(l2, 8192); TRRD(h2, 10240); TRRD(l3, 12288); TRRD(h3, 14336);
    asm volatile("s_waitcnt lgkmcnt(0)" ::: "memory"); __builtin_amdgcn_sched_barrier(0);
    acc = __builtin_amdgcn_mfma_f32_32x32x16_bf16(pa0, VFRAG(l0, h0), acc, 0, 0, 0);
    acc = __builtin_amdgcn_mfma_f32_32x32x16_bf16(pa1, VFRAG(l1, h1), acc, 0, 0, 0);
    acc = __builtin_amdgcn_mfma_f32_32x32x16_bf16(pa2, VFRAG(l2, h2), acc, 0, 0, 0);
    acc = __builtin_amdgcn_mfma_f32_32x32x16_bf16(pa3, VFRAG(l3, h3), acc, 0, 0, 0);
}
#undef TRRD
#undef VFRAG
__device__ __forceinline__ void unit_local(Frame& F, int l, int u) {
    char* lds = (char*)F.lds; const int tid = F.tid, lane = tid & 63, wid = F.wave, r32 = lane & 31, hi = lane >> 5;
    const int bh = u >> 5, c = u & 31, b = bh >> 2, h = bh & 3, row0 = b * 2048 + c * 64;
    float* G = (float*)(lds + L_G);
    stage_conv(lds + L_K, WSP(bf16, WS_MLQK), KIN(I_CONVW) + (size_t)l * 2048, KIN(I_CONVB) + (size_t)l * 512, row0, c * 64, 256 + h * 64, 1.0f, tid);
    stage_v(lds + L_V, WSP(bf16, WS_MLV), row0, h, tid);
    if (wid == 0) { float bl, mlc; stage_gates(G, WSP(float, WS_SCAL), row0, h, lane, bl, mlc); if (lane == 0) { WSP(float, WS_MLOC)[u] = mlc; WSP(float, WS_BLAST)[u] = bl; } }
    __syncthreads();
    const int kblk = wid >> 2, vblk = wid & 3;
    bf16x8 pa[4];
    const unsigned short* Kc = (const unsigned short*)(lds + L_K);
#pragma unroll
    for (int ks = 0; ks < 4; ++ks) { float w[8];
#pragma unroll
        for (int j = 0; j < 8; ++j) { const int s = 16 * ks + 8 * hi + j; w[j] = bf2f(Kc[s * 64 + kblk * 32 + r32]) * G[128 + s]; }
        u32x4 q = {att::cvtpk(w[0], w[1]), att::cvtpk(w[2], w[3]), att::cvtpk(w[4], w[5]), att::cvtpk(w[6], w[7])}; pa[ks] = *reinterpret_cast<bf16x8*>(&q); }
    f32x16 acc = ozero16();
    mma_v(acc, (int)(uintptr_t)(lds + L_V) + att::v_rd_base(lane) + vblk * 512, pa[0], pa[1], pa[2], pa[3]);
    float* cl = WSP(float, WS_CLOC) + (size_t)u * 8192 + (size_t)(vblk * 32 + r32) * 64 + kblk * 32 + 4 * hi;
#pragma unroll
    for (int g = 0; g < 4; ++g) *(f32x4*)(cl + 8 * g) = (f32x4){acc[4 * g], acc[4 * g + 1], acc[4 * g + 2], acc[4 * g + 3]};
    if (tid < 64) { float s_ = 0.f; for (int s = 0; s < 64; ++s) s_ += G[128 + s] * bf2f(Kc[s * 64 + tid]); WSP(float, WS_NLOC)[(size_t)u * 64 + tid] = s_; }
    __syncthreads();
}
__device__ __forceinline__ void scan_item(Frame& F, int it) {
    const int tid = F.tid;
    float* dec_l = (float*)F.lds; float* scl_l = dec_l + 32; float* mpr_l = dec_l + 64;
    {
        const int bh = it / 5, seg = it % 5;
        __syncthreads();
        if (tid < 32) { dec_l[96 + tid] = WSP(float, WS_MLOC)[bh * 32 + tid]; dec_l[128 + tid] = WSP(float, WS_BLAST)[bh * 32 + tid]; }
        __syncthreads();
        if (tid == 0) { float m = -__builtin_inff();
            for (int c = 0; c < 32; ++c) { const float ml_ = dec_l[96 + c], bl = dec_l[128 + c], mn = fmaxf(bl + m, ml_);
                mpr_l[c] = m; dec_l[c] = __expf(bl + m - mn); scl_l[c] = __expf(ml_ - mn); m = mn; } }
        __syncthreads();
        if (seg < 4) { const int e = seg * 2048 + tid * 4; const float* cl = WSP(float, WS_CLOC) + (size_t)bh * 32 * 8192 + e; bf16* cp = WSP(bf16, WS_CPREV) + (size_t)bh * 32 * 8192 + e;
            f32x4 v[32];
#pragma unroll
            for (int c = 0; c < 32; ++c) v[c] = *(const f32x4*)(cl + (size_t)c * 8192);
            f32x4 st = ozero4();
#pragma unroll
            for (int c = 0; c < 32; ++c) { *(u32x2*)(cp + (size_t)c * 8192) = (u32x2){pk2(st[0], st[1]), pk2(st[2], st[3])}; st = dec_l[c] * st + scl_l[c] * v[c]; }
        } else if (tid < 64) { const float* nl = WSP(float, WS_NLOC) + (size_t)bh * 32 * 64 + tid; float* np = WSP(float, WS_NPREV) + (size_t)bh * 32 * 64 + tid;
            float v[32];
#pragma unroll
            for (int c = 0; c < 32; ++c) v[c] = nl[(size_t)c * 64];
            float st = 0.f;
#pragma unroll
            for (int c = 0; c < 32; ++c) { np[(size_t)c * 64] = st; if (tid == 0) WSP(float, WS_MPREV)[bh * 32 + c] = mpr_l[c]; st = dec_l[c] * st + scl_l[c] * v[c]; }
        }
    }
}
__device__ __forceinline__ void unit_out(Frame& F, int l, int u) {
    char* lds = (char*)F.lds; const int tid = F.tid, lane = tid & 63, wid = F.wave, r32 = lane & 31, hi = lane >> 5;
    const int bh = u >> 5, c = u & 31, b = bh >> 2, h = bh & 3, row0 = b * 2048 + c * 64;
    float* G = (float*)(lds + L_G);
    stage_conv(lds + L_Q, WSP(bf16, WS_MLQK), KIN(I_CONVW) + (size_t)l * 2048, KIN(I_CONVB) + (size_t)l * 512, row0, c * 64, h * 64, 0.125f, tid);
    stage_conv(lds + L_K, WSP(bf16, WS_MLQK), KIN(I_CONVW) + (size_t)l * 2048, KIN(I_CONVB) + (size_t)l * 512, row0, c * 64, 256 + h * 64, 1.0f, tid);
    stage_v(lds + L_V, WSP(bf16, WS_MLV), row0, h, tid);
    if (wid == 0) { float bl, mlc; stage_gates(G, WSP(float, WS_SCAL), row0, h, lane, bl, mlc); G[192 + lane] = WSP(float, WS_NPREV)[(size_t)u * 64 + lane]; }
    __syncthreads();
    const int rb = wid >> 2, vblk = wid & 3, t = rb * 32 + r32;
    bf16x8 qf[4];
#pragma unroll
    for (int ks = 0; ks < 4; ++ks) qf[ks] = *(const bf16x8*)(lds + L_Q + t * 128 + (16 * ks + 8 * hi) * 2);
    f32x16 p0 = ozero16(), p1 = p0;
#pragma unroll
    for (int ks = 0; ks < 4; ++ks) { const bf16x8 k0 = *(const bf16x8*)(lds + L_K + r32 * 128 + (16 * ks + 8 * hi) * 2), k1 = *(const bf16x8*)(lds + L_K + (32 + r32) * 128 + (16 * ks + 8 * hi) * 2);
        p0 = __builtin_amdgcn_mfma_f32_32x32x16_bf16(k0, qf[ks], p0, 0, 0, 0); p1 = __builtin_amdgcn_mfma_f32_32x32x16_bf16(k1, qf[ks], p1, 0, 0, 0); }
    const float bt = G[t], inter = bt + WSP(float, WS_MPREV)[u];
    const float NEG = -__builtin_inff();
    f32x16 d0, d1; float mo = inter;
#pragma unroll
    for (int r = 0; r < 16; ++r) { const int s0 = att::crow(r, hi), s1 = 32 + s0; d0[r] = (s0 <= t) ? bt + G[64 + s0] : NEG; d1[r] = (s1 <= t) ? bt + G[64 + s1] : NEG; mo = fmaxf(mo, fmaxf(d0[r], d1[r])); }
    { auto rr = __builtin_amdgcn_permlane32_swap(__float_as_uint(mo), __float_as_uint(mo), false, false); mo = fmaxf(__uint_as_float(rr[0]), __uint_as_float(rr[1])); }
    float den = 0.f;
#pragma unroll
    for (int r = 0; r < 16; ++r) { p0[r] *= __expf(d0[r] - mo); p1[r] *= __expf(d1[r] - mo); den += p0[r] + p1[r]; }
    const float a_int = __expf(inter - mo);
    float nd = 0.f;
#pragma unroll
    for (int ks = 0; ks < 4; ++ks)
#pragma unroll
        for (int j = 0; j < 8; ++j) nd += G[192 + 16 * ks + 8 * hi + j] * bf2f((unsigned short)qf[ks][j]);
    den += a_int * nd;
    { auto rr = __builtin_amdgcn_permlane32_swap(__float_as_uint(den), __float_as_uint(den), false, false); den = __uint_as_float(rr[0]) + __uint_as_float(rr[1]); }
    float* wsl = (float*)(lds + L_WS) + wid * 64;
    if (hi == 0) wsl[r32] = 1.0f / fmaxf(fabsf(den), __expf(-mo));
    bf16x8 pa0, pa1, pa2, pa3;
#define PK4(P, B_, OUT) do { unsigned a0 = att::cvtpk(P[B_+0], P[B_+1]), a1 = att::cvtpk(P[B_+2], P[B_+3]);                          \
        unsigned b0 = att::cvtpk(P[B_+4], P[B_+5]), b1 = att::cvtpk(P[B_+6], P[B_+7]);                                             \
        auto r0 = __builtin_amdgcn_permlane32_swap(a0, b0, false, false); auto r1 = __builtin_amdgcn_permlane32_swap(a1, b1, false, false); \
        u32x4 w = {r0[0], r1[0], r0[1], r1[1]}; OUT = *reinterpret_cast<bf16x8*>(&w); } while (0)
    PK4(p0, 0, pa0); PK4(p0, 8, pa1); PK4(p1, 0, pa2); PK4(p1, 8, pa3);
#undef PK4
    f32x16 o = ozero16();
    mma_v(o, (int)(uintptr_t)(lds + L_V) + att::v_rd_base(lane) + vblk * 512, pa0, pa1, pa2, pa3);
    const bf16* cp = WSP(bf16, WS_CPREV) + (size_t)u * 8192 + (size_t)(vblk * 32 + r32) * 64 + 8 * hi;
#pragma unroll
    for (int ks = 0; ks < 4; ++ks) { float w[8];
#pragma unroll
        for (int j = 0; j < 8; ++j) w[j] = a_int * bf2f((unsigned short)qf[ks][j]);
        u32x4 q = {att::cvtpk(w[0], w[1]), att::cvtpk(w[2], w[3]), att::cvtpk(w[4], w[5]), att::cvtpk(w[6], w[7])};
        o = __builtin_amdgcn_mfma_f32_32x32x16_bf16(*reinterpret_cast<bf16x8*>(&q), *(const bf16x8*)(cp + 16 * ks), o, 0, 0, 0); }
    asm volatile("s_waitcnt lgkmcnt(0)" ::: "memory");
    float* hid = (float*)(lds + L_HID);
#pragma unroll
    for (int r = 0; r < 16; ++r) { const int tr = att::crow(r, hi); hid[(rb * 32 + tr) * 132 + vblk * 32 + r32] = o[r] * wsl[tr]; }
    __syncthreads();
    {   const int row = tid >> 3, seg = (tid & 7) * 16; const float* hr = hid + row * 132 + seg;
        float v[16], ss = 0.f;
#pragma unroll
        for (int i = 0; i < 4; ++i) { const f32x4 q = *(const f32x4*)(hr + 4 * i); v[4 * i] = q[0]; v[4 * i + 1] = q[1]; v[4 * i + 2] = q[2]; v[4 * i + 3] = q[3]; ss += (q[0] * q[0] + q[1] * q[1]) + (q[2] * q[2] + q[3] * q[3]); }
        ss += qxor1(ss); ss += qxor2(ss); ss += hmirror(ss);
        const float rn = 1.0f / sqrtf(ss * (1.0f / 128.0f) + EPS);
        const float* gn = KIN(I_MLG) + (size_t)l * 512 + h * 128 + seg;
        const bf16* og = WSP(bf16, WS_MLO) + (size_t)(row0 + row) * 512 + h * 128 + seg;
        const u32x4 o0 = *(const u32x4*)og, o1 = *(const u32x4*)(og + 8); unsigned w[8];
#pragma unroll
        for (int i = 0; i < 8; ++i) { const unsigned oo = i < 4 ? o0[i] : o1[i - 4]; const float g0 = bf2f(oo & 0xffffu), g1 = bf2f(oo >> 16);
            const float y0 = v[2 * i] * rn * gn[2 * i] / (1.0f + __expf(-g0)), y1 = v[2 * i + 1] * rn * gn[2 * i + 1] / (1.0f + __expf(-g1));
            w[i] = att::cvtpk(y0, y1); }
        bf16* yo = WSP(bf16, WS_YCAT) + (size_t)(row0 + row) * 512 + h * 128 + seg;
        *(u32x4*)yo = (u32x4){w[0], w[1], w[2], w[3]}; *(u32x4*)(yo + 8) = (u32x4){w[4], w[5], w[6], w[7]};
    }
    __syncthreads();
}
__device__ __forceinline__ void unit_out4(Frame& F, int l, int u4) {
    char* lds = (char*)F.lds; const int tid = F.tid, lane = tid & 63, wid = F.wave, r32 = lane & 31, hi = lane >> 5;
    const int bh = u4 >> 3, g4 = u4 & 7, b = bh >> 2, h = bh & 3, row00 = b * 2048 + g4 * 256;
    constexpr int O_Q = 0, O_K = 32768, O_V = 65536, O_G = LDSCTL_OFF + 1024, O_WS = O_G + 4096;
    const float* cw = KIN(I_CONVW) + (size_t)l * 2048; const float* cb = KIN(I_CONVB) + (size_t)l * 512;
    stage_conv4(lds + O_Q, WSP(bf16, WS_MLQK), cw, cb, row00, g4 * 256, h * 64, 0.125f, tid);
    stage_conv4(lds + O_K, WSP(bf16, WS_MLQK), cw, cb, row00, g4 * 256, 256 + h * 64, 1.0f, tid);
#pragma unroll
    for (int c = 0; c < 4; ++c) stage_v(lds + O_V + c * 16384, WSP(bf16, WS_MLV), row00 + 64 * c, h, tid);
    if (wid < 4) { float bl, mlc; float* G = (float*)(lds + O_G) + wid * 256; stage_gates(G, WSP(float, WS_SCAL), row00 + 64 * wid, h, lane, bl, mlc);
        G[192 + lane] = WSP(float, WS_NPREV)[((size_t)bh * 32 + g4 * 4 + wid) * 64 + lane]; }
    __syncthreads();
    const int c = wid >> 1, t = 32 * (wid & 1) + r32; const size_t u = (size_t)bh * 32 + g4 * 4 + c;
    const float* G = (const float*)(lds + O_G) + c * 256;
    bf16x8 qf[4];
#pragma unroll
    for (int ks = 0; ks < 4; ++ks) qf[ks] = *(const bf16x8*)(lds + O_Q + c * 8192 + t * 128 + (16 * ks + 8 * hi) * 2);
    f32x16 p0 = ozero16(), p1 = p0;
#pragma unroll
    for (int ks = 0; ks < 4; ++ks) { const bf16x8 k0 = *(const bf16x8*)(lds + O_K + c * 8192 + r32 * 128 + (16 * ks + 8 * hi) * 2), k1 = *(const bf16x8*)(lds + O_K + c * 8192 + (32 + r32) * 128 + (16 * ks + 8 * hi) * 2);
        p0 = __builtin_amdgcn_mfma_f32_32x32x16_bf16(k0, qf[ks], p0, 0, 0, 0); p1 = __builtin_amdgcn_mfma_f32_32x32x16_bf16(k1, qf[ks], p1, 0, 0, 0); }
    const float bt = G[t], inter = bt + WSP(float, WS_MPREV)[u];
    const float NEG = -__builtin_inff();
    float mo = inter;
    {   f32x16 d0, d1;
#pragma unroll
        for (int r = 0; r < 16; ++r) { const int s0 = att::crow(r, hi), s1 = 32 + s0; d0[r] = (s0 <= t) ? bt + G[64 + s0] : NEG; d1[r] = (s1 <= t) ? bt + G[64 + s1] : NEG; mo = fmaxf(mo, fmaxf(d0[r], d1[r])); }
        { auto rr = __builtin_amdgcn_permlane32_swap(__float_as_uint(mo), __float_as_uint(mo), false, false); mo = fmaxf(__uint_as_float(rr[0]), __uint_as_float(rr[1])); }
#pragma unroll
        for (int r = 0; r < 16; ++r) { p0[r] *= __expf(d0[r] - mo); p1[r] *= __expf(d1[r] - mo); }
    }
    float den = 0.f;
#pragma unroll
    for (int r = 0; r < 16; ++r) den += p0[r] + p1[r];
    const float a_int = __expf(inter - mo);
    float nd = 0.f;
#pragma unroll
    for (int ks = 0; ks < 4; ++ks)
#pragma unroll
        for (int j = 0; j < 8; ++j) nd += G[192 + 16 * ks + 8 * hi + j] * bf2f((unsigned short)qf[ks][j]);
    den += a_int * nd;
    { auto rr = __builtin_amdgcn_permlane32_swap(__float_as_uint(den), __float_as_uint(den), false, false); den = __uint_as_float(rr[0]) + __uint_as_float(rr[1]); }
    float* wsl = (float*)(lds + O_WS) + wid * 64;
    if (hi == 0) wsl[r32] = 1.0f / fmaxf(fabsf(den), __expf(-mo));
    bf16x8 pa0, pa1, pa2, pa3;
#define PK4(P, B_, OUT) do { unsigned a0 = att::cvtpk(P[B_+0], P[B_+1]), a1 = att::cvtpk(P[B_+2], P[B_+3]);                          \
        unsigned b0 = att::cvtpk(P[B_+4], P[B_+5]), b1 = att::cvtpk(P[B_+6], P[B_+7]);                                             \
        auto r0 = __builtin_amdgcn_permlane32_swap(a0, b0, false, false); auto r1 = __builtin_amdgcn_permlane32_swap(a1, b1, false, false); \
        u32x4 w = {r0[0], r1[0], r0[1], r1[1]}; OUT = *reinterpret_cast<bf16x8*>(&w); } while (0)
    PK4(p0, 0, pa0); PK4(p0, 8, pa1); PK4(p1, 0, pa2); PK4(p1, 8, pa3);
#undef PK4
    bf16x8 qa[4];
#pragma unroll
    for (int ks = 0; ks < 4; ++ks) { float w[8];
#pragma unroll
        for (int j = 0; j < 8; ++j) w[j] = a_int * bf2f((unsigned short)qf[ks][j]);
        u32x4 q = {att::cvtpk(w[0], w[1]), att::cvtpk(w[2], w[3]), att::cvtpk(w[4], w[5]), att::cvtpk(w[6], w[7])}; qa[ks] = *reinterpret_cast<bf16x8*>(&q); }
    f32x16 o[4];
    const int vbase = (int)(uintptr_t)(lds + O_V + c * 16384) + att::v_rd_base(lane);
#pragma unroll
    for (int d0 = 0; d0 < 4; ++d0) { o[d0] = ozero16();
        mma_v(o[d0], vbase + d0 * 512, pa0, pa1, pa2, pa3);
        const bf16* cp = WSP(bf16, WS_CPREV) + u * 8192 + (size_t)(d0 * 32 + r32) * 64 + 8 * hi;
#pragma unroll
        for (int ks = 0; ks < 4; ++ks) o[d0] = __builtin_amdgcn_mfma_f32_32x32x16_bf16(qa[ks], *(const bf16x8*)(cp + 16 * ks), o[d0], 0, 0, 0); }
    asm volatile("s_waitcnt lgkmcnt(0)" ::: "memory");
    float rinv[16];
#pragma unroll
    for (int r = 0; r < 16; ++r) rinv[r] = wsl[att::crow(r, hi)];
    __syncthreads();
    unsigned short* ht = (unsigned short*)(lds + wid * 8704);
#pragma unroll
    for (int r = 0; r < 16; ++r) { const int tr = att::crow(r, hi);
#pragma unroll
        for (int d0 = 0; d0 < 4; ++d0) ht[tr * 136 + d0 * 32 + r32] = (unsigned short)f2bf(o[d0][r] * rinv[r]); }
    asm volatile("s_waitcnt lgkmcnt(0)" ::: "memory");
    {   const int row = lane >> 1, seg = (lane & 1) * 64; const unsigned short* hr = ht + row * 136 + seg;
        u32x4 hv[8]; float ss = 0.f;
#pragma unroll
        for (int i = 0; i < 8; ++i) { hv[i] = *(const u32x4*)(hr + 8 * i);
#pragma unroll
            for (int q = 0; q < 4; ++q) { const float a = bf2f(hv[i][q] & 0xffffu), b2 = bf2f(hv[i][q] >> 16); ss += a * a + b2 * b2; } }
        ss += __builtin_bit_cast(float, __builtin_amdgcn_update_dpp(0, __builtin_bit_cast(int, ss), 0xB1, 0xf, 0xf, false));
        const float rn = 1.0f / sqrtf(ss * (1.0f / 128.0f) + EPS);
        const int grow = row00 + 64 * c + 32 * (wid & 1) + row;
        const float* gn = KIN(I_MLG) + (size_t)l * 512 + h * 128 + seg;
        const bf16* og = WSP(bf16, WS_MLO) + (size_t)grow * 512 + h * 128 + seg;
        bf16* yo = WSP(bf16, WS_YCAT) + (size_t)grow * 512 + h * 128 + seg;
#pragma unroll
        for (int i = 0; i < 8; ++i) { const u32x4 oo = *(const u32x4*)(og + 8 * i); const f32x4 g0 = *(const f32x4*)(gn + 8 * i), g1 = *(const f32x4*)(gn + 8 * i + 4); unsigned w[4];
#pragma unroll
            for (int q = 0; q < 4; ++q) { const float a = bf2f(hv[i][q] & 0xffffu), b2 = bf2f(hv[i][q] >> 16), ga = bf2f(oo[q] & 0xffffu), gb = bf2f(oo[q] >> 16);
                const float wa = q < 2 ? g0[2 * q] : g1[2 * q - 4], wb = q < 2 ? g0[2 * q + 1] : g1[2 * q - 3];
                w[q] = att::cvtpk(a * rn * wa / (1.0f + __expf(-ga)), b2 * rn * wb / (1.0f + __expf(-gb))); }
            *(u32x4*)(yo + 8 * i) = (u32x4){w[0], w[1], w[2], w[3]}; }
    }
    __syncthreads();
}
__device__ __forceinline__ void unit_local4(Frame& F, int l, int u4) {
    char* lds = (char*)F.lds; const int tid = F.tid, lane = tid & 63, wid = F.wave, r32 = lane & 31, hi = lane >> 5;
    const int bh = u4 >> 3, g4 = u4 & 7, b = bh >> 2, h = bh & 3, row00 = b * 2048 + g4 * 256;
    constexpr int O_K = 32768, O_V = 65536, O_G = LDSCTL_OFF + 1024;
    stage_conv4(lds + O_K, WSP(bf16, WS_MLQK), KIN(I_CONVW) + (size_t)l * 2048, KIN(I_CONVB) + (size_t)l * 512, row00, g4 * 256, 256 + h * 64, 1.0f, tid);
#pragma unroll
    for (int c = 0; c < 4; ++c) stage_v(lds + O_V + c * 16384, WSP(bf16, WS_MLV), row00 + 64 * c, h, tid);
    if (wid < 4) { float bl, mlc; stage_gates((float*)(lds + O_G) + wid * 256, WSP(float, WS_SCAL), row00 + 64 * wid, h, lane, bl, mlc);
        if (lane == 0) { WSP(float, WS_MLOC)[bh * 32 + g4 * 4 + wid] = mlc; WSP(float, WS_BLAST)[bh * 32 + g4 * 4 + wid] = bl; } }
    __syncthreads();
    const int c = wid >> 1, kblk = wid & 1; const size_t u = (size_t)bh * 32 + g4 * 4 + c;
    const float* G = (const float*)(lds + O_G) + c * 256;
    const unsigned short* Kc = (const unsigned short*)(lds + O_K + c * 8192);
    bf16x8 pa[4];
#pragma unroll
    for (int ks = 0; ks < 4; ++ks) { float w[8];
#pragma unroll
        for (int j = 0; j < 8; ++j) { const int s = 16 * ks + 8 * hi + j; w[j] = bf2f(Kc[s * 64 + kblk * 32 + r32]) * G[128 + s]; }
        u32x4 q = {att::cvtpk(w[0], w[1]), att::cvtpk(w[2], w[3]), att::cvtpk(w[4], w[5]), att::cvtpk(w[6], w[7])}; pa[ks] = *reinterpret_cast<bf16x8*>(&q); }
    const int vbase = (int)(uintptr_t)(lds + O_V + c * 16384) + att::v_rd_base(lane);
#pragma unroll
    for (int vblk = 0; vblk < 4; ++vblk) { f32x16 acc = ozero16();
        mma_v(acc, vbase + vblk * 512, pa[0], pa[1], pa[2], pa[3]);
        float* cl = WSP(float, WS_CLOC) + u * 8192 + (size_t)(vblk * 32 + r32) * 64 + kblk * 32 + 4 * hi;
#pragma unroll
        for (int g = 0; g < 4; ++g) *(f32x4*)(cl + 8 * g) = (f32x4){acc[4 * g], acc[4 * g + 1], acc[4 * g + 2], acc[4 * g + 3]}; }
    if (tid < 256) { const int c2 = tid >> 6, k = tid & 63; const float* G2 = (const float*)(lds + O_G) + c2 * 256; const unsigned short* K2 = (const unsigned short*)(lds + O_K + c2 * 8192);
        float s_ = 0.f; for (int s = 0; s < 64; ++s) s_ += G2[128 + s] * bf2f(K2[s * 64 + k]); WSP(float, WS_NLOC)[((size_t)bh * 32 + g4 * 4 + c2) * 64 + k] = s_; }
    __syncthreads();
}
}
__device__ __forceinline__ int wave_sum_i(int v) {
    v += __builtin_amdgcn_update_dpp(0, v, 0x128, 0xf, 0xf, false);
    v += __builtin_amdgcn_update_dpp(0, v, 0x124, 0xf, 0xf, false);
    v += __builtin_amdgcn_update_dpp(0, v, 0x122, 0xf, 0xf, false);
    v += __builtin_amdgcn_update_dpp(0, v, 0x121, 0xf, 0xf, false);
    return __builtin_amdgcn_readlane(v, 0) + __builtin_amdgcn_readlane(v, 16) + __builtin_amdgcn_readlane(v, 32) + __builtin_amdgcn_readlane(v, 48);
}
__device__ __forceinline__ unsigned sortkey(float f) { unsigned u = __float_as_uint(f); u = (u == 0x80000000u) ? 0u : u; return (u & 0x80000000u) ? ~u : (u | 0x80000000u); }
__device__ __forceinline__ void transpose32(unsigned (&A)[32]) {
    unsigned m = 0x0000FFFFu;
#pragma unroll
    for (int j = 16; j != 0; j >>= 1, m ^= (m << j)) {
#pragma unroll
        for (int k = 0; k < 32; k = (k + j + 1) & ~j) { const unsigned t = (A[k] ^ (A[k + j] >> j)) & m; A[k] ^= t; A[k + j] ^= (t << j); }
    }
}
__device__ __forceinline__ void dsa_select_pair(const float* SC, unsigned* bm, int q0, int nt, int lane) {
    unsigned ka[32], kb[32], A[32], B[32];
#pragma unroll
    for (int j = 0; j < 32; ++j) { if (j < nt) { ka[j] = sortkey(SC[(size_t)q0 * 2048 + 64 * j + lane]); kb[j] = sortkey(SC[(size_t)(q0 + 1) * 2048 + 64 * j + lane]); } else { ka[j] = 0u; kb[j] = 0u; } A[j] = ka[j]; B[j] = kb[j]; }
    transpose32(A); transpose32(B);
    unsigned pa = 0u, pb = 0u; int npa = 1 << 30, npb = 1 << 30;
    for (int rep_ = 0; rep_ < 1 + ((DUP_MASK >> 26) & 1); ++rep_) { pa = 0u; pb = 0u; npa = 1 << 30; npb = 1 << 30; asm volatile("" : "+s"(pa), "+s"(pb));
    unsigned alA = 0xffffffffu, alB = 0xffffffffu; int abA = 0, abB = 0;
#pragma unroll
    for (int bit = 31; bit >= 0; --bit) {
        const unsigned tA = alA & A[31 - bit], tB = alB & B[31 - bit];
        const int cA = __builtin_popcount(tA) + abA, cB = __builtin_popcount(tB) + abB;
        const int nA = wave_sum_i(cA), nB = wave_sum_i(cB);
        if (nA >= 256) { alA = tA; pa |= 1u << bit; npa = nA; } else { alA ^= tA; abA = cA; }
        if (nB >= 256) { alB = tB; pb |= 1u << bit; npb = nB; } else { alB ^= tB; abB = cB; }
        if (npa == 256 && npb == 256) break;
    } }
#pragma unroll
    for (int which = 0; which < 2; ++which) {
        const unsigned prefix = which ? pb : pa; const int np = which ? npb : npa;
        int ngt = 0;
        if (np != 256) {
#pragma unroll
            for (int j = 0; j < 32; ++j) ngt += ((which ? kb[j] : ka[j]) > prefix) ? 1 : 0;
            ngt = wave_sum_i(ngt);
        }
        const int need = 256 - ngt; int running = 0; unsigned keep0 = 0u, keep1 = 0u;
#pragma unroll
        for (int j = 0; j < 32; ++j) { if (j < nt) { const unsigned k_ = which ? kb[j] : ka[j];
                bool sel;
                if (np == 256) sel = k_ >= prefix;
                else { const bool eq = k_ == prefix; const unsigned long long e = __ballot(eq);
                    const int rank = running + (int)__builtin_amdgcn_mbcnt_hi((unsigned)(e >> 32), __builtin_amdgcn_mbcnt_lo((unsigned)e, 0u));
                    sel = (k_ > prefix) || (eq && rank < need); running += __builtin_popcountll(e); }
                const unsigned long long m = __ballot(sel);
                if (lane == j) { keep0 = (unsigned)m; keep1 = (unsigned)(m >> 32); } } }
        if (lane < nt) *(u32x2*)(bm + (q0 + which) * 64 + 2 * lane) = (u32x2){keep0, keep1};
    }
}
constexpr int CW_DEP = 8192;
__device__ __forceinline__ unsigned* dep_word(int l, int kind, int bh) { return (unsigned*)KCTL + CW_DEP + 64 * (l * 64 + kind * 32 + bh); }
__device__ __forceinline__ void dep_signal(Frame& F, unsigned* w) {
    asm volatile("s_waitcnt vmcnt(0)" ::: "memory");
    __syncthreads();
    if (F.wave == 0 && hw_lane() == 0) { __builtin_amdgcn_fence(__ATOMIC_RELEASE, "agent"); asm volatile("s_waitcnt vmcnt(0)" ::: "memory"); (void)xb_add(w, 1u); }
}
__device__ __forceinline__ void dep_wait(Frame& F, unsigned* w, unsigned target) {
    if (F.wave == 0 && hw_lane() == 0) { unsigned sp = 0u; while (xb_ld(w) < target) { __builtin_amdgcn_s_sleep(2); if (++sp > (1u << 24)) break; }
        __builtin_amdgcn_fence(__ATOMIC_ACQUIRE, "agent"); asm volatile("s_waitcnt vmcnt(0)" ::: "memory"); }
    __syncthreads();
}
__device__ __forceinline__ unsigned* dep_nrm(int l, int b) { return (unsigned*)KCTL + CW_DEP + 64 * (128 + l * 8 + b); }
__device__ __forceinline__ void ckv_norm_item(Frame& F, int l, int item) {
    const int lane = F.tid & 63, sc = (lane & 15) * 8;
    const float* g = KIN(I_KVG) + (size_t)l * 128 + sc;
#pragma unroll
    for (int i = 0; i < 8; ++i) { const size_t row = (size_t)item * 256 + F.wave * 32 + i * 4 + (lane >> 4);
        const bf16x8 x = *(const bf16x8*)(WSP(bf16, WS_CKV) + row * 128 + sc);
        *(bf16x8*)(WSP(bf16, WS_CKVN) + row * 128 + sc) = att::nrm8(x, g); }
}
__device__ __forceinline__ void dsa_unit(Frame& F, int l, int b, int cq) {
    char* lds = (char*)F.lds; const int tid = F.tid, lane = tid & 63, wid = F.wave, r32 = lane & 31, hi = lane >> 5;
    const int m0 = b * 2048 + cq * 64, nvis = 64 * (cq + 1);
    float* SC = WSP(float, WS_SCORE) + (size_t)blockIdx.x * 64 * 2048;
    for (int rep_ = 0; rep_ < 1 + ((DUP_MASK >> 25) & 1); ++rep_)
    {
        bf16x8 af[4];
        const bf16* qa = WSP(bf16, WS_IQ) + ((size_t)(m0 + 8 * wid) * 4 + r32) * 64 + 8 * hi;
#pragma unroll
        for (int ks = 0; ks < 4; ++ks) af[ks] = *(const bf16x8*)(qa + 16 * ks);
        float wq[4][4];
#pragma unroll
        for (int g = 0; g < 4; ++g) { const f32x4 w4 = *(const f32x4*)(WSP(float, WS_SCAL) + (size_t)(m0 + 8 * wid + 2 * g + hi) * 16 + 8);
            wq[g][0] = w4[0] * 0.0625f; wq[g][1] = w4[1] * 0.0625f; wq[g][2] = w4[2] * 0.0625f; wq[g][3] = w4[3] * 0.0625f; }
        const bf16* kg = WSP(bf16, WS_IK) + ((size_t)b * 2048 + (tid >> 3)) * 64 + (tid & 7) * 8;
        const int kw = (tid >> 3) * 144 + (tid & 7) * 16;
        bf16x8 stg = *(const bf16x8*)kg;
        *(bf16x8*)(lds + kw) = stg;
        __syncthreads();
        const int ntile = cq + 1;
        for (int t = 0; t < ntile; ++t) {
            const char* kb_ = lds + (t & 1) * 9216;
            if (t + 1 < ntile) stg = *(const bf16x8*)(kg + (size_t)(t + 1) * 64 * 64);
#pragma unroll
            for (int kb = 0; kb < 2; ++kb) {
                att::f32x16 d = ozero16();
#pragma unroll
                for (int ks = 0; ks < 4; ++ks) d = __builtin_amdgcn_mfma_f32_32x32x16_bf16(af[ks], *(const bf16x8*)(kb_ + (32 * kb + r32) * 144 + (16 * ks + 8 * hi) * 2), d, 0, 0, 0);
                float sv[4];
#pragma unroll
                for (int g = 0; g < 4; ++g) sv[g] = wq[g][0] * fmaxf(d[4 * g], 0.f) + wq[g][1] * fmaxf(d[4 * g + 1], 0.f) + wq[g][2] * fmaxf(d[4 * g + 2], 0.f) + wq[g][3] * fmaxf(d[4 * g + 3], 0.f);
                {
                    const bool up = (r32 & 2) != 0, od = (r32 & 1) != 0;
                    const float x1 = up ? sv[0] : sv[2], y1 = up ? sv[1] : sv[3]; const float rx1 = qxor2(x1), ry1 = qxor2(y1);
                    if (up) { sv[0] = rx1; sv[1] = ry1; } else { sv[2] = rx1; sv[3] = ry1; }
                    const float x2 = od ? sv[0] : sv[1], y2 = od ? sv[2] : sv[3]; const float rx2 = qxor1(x2), ry2 = qxor1(y2);
                    if (od) { sv[0] = rx2; sv[2] = ry2; } else { sv[1] = rx2; sv[3] = ry2; }
                    *(f32x4*)(SC + (size_t)(8 * wid + 2 * (r32 & 3) + hi) * 2048 + t * 64 + kb * 32 + (r32 & ~3)) = (f32x4){sv[0], sv[1], sv[2], sv[3]}; }
            }
            if (t + 1 < ntile) *(bf16x8*)(lds + ((t + 1) & 1) * 9216 + kw) = stg;
            asm volatile("s_waitcnt lgkmcnt(0)" ::: "memory"); __builtin_amdgcn_s_barrier(); asm volatile("" ::: "memory");
        }
    }
    asm volatile("s_waitcnt vmcnt(0)" ::: "memory"); __builtin_amdgcn_fence(__ATOMIC_ACQUIRE, "agent"); asm volatile("s_waitcnt vmcnt(0)" ::: "memory");
    {
        unsigned* bm = (unsigned*)(lds + att::LDS_BM);
        const int nt = cq + 1;
        if (nvis <= 256) {
            for (int ql = 0; ql < 8; ++ql) if (32 * lane < nvis) bm[(8 * wid + ql) * 64 + lane] = 0xffffffffu;
        } else {
            for (int qp = 0; qp < 4; ++qp) dsa_select_pair(SC, bm, 8 * wid + 2 * qp, nt, lane);
        }
    }
    __syncthreads();
    dep_wait(F, dep_nrm(l, b), 8u);
    att::BlockRef r{WSP(bf16, WS_QABS) + (size_t)m0 * 512, WSP(bf16, WS_CKVN) + (size_t)b * 2048 * 128, WSP(bf16, WS_CKVN) + (size_t)b * 2048 * 128,
                    WSP(bf16, WS_YCAT) + (size_t)M * 512 + (size_t)m0 * 512, 128, 0, cq + 1, KIN(I_KVG) + (size_t)l * 128};
    if (tid < 128) ((float*)(lds + att::LDS_GN))[tid] = r.g[tid];
    __syncthreads();
    att::Seam S;
    for (int rep_ = 0; rep_ < 1 + ((DUP_MASK >> 27) & 1); ++rep_) { att::prime<1>(r, lds, S, tid); att::block<1>(r, r, lds, S, tid); }
}
__device__ __forceinline__ void mixer_queue(Frame& F, int l, int qidx) {
    PHASE_BEGIN();
    volatile LAS int* qslot = (volatile LAS int*)(F.lds + LDSCTL_OFF + 192);
    unsigned* head = (unsigned*)KCTL + CW_Q + 64 * qidx;
    constexpr int N_DSA = 256, N_FOX = 256, N_ML = 256, N_SCAN = 32 * 5, N_OUT = 256;
    for (;;) {
        __syncthreads();
        if (F.tid == 0) *qslot = (int)__hip_atomic_fetch_add(head, 1u, __ATOMIC_RELAXED, __HIP_MEMORY_SCOPE_AGENT);
        __syncthreads();
        int item = *qslot;
        const int dup = (l == 0) ? 1 : 0;
        const int R_DSA = N_DSA << (dup & (DUP_MASK >> 8)), R_FOX = N_FOX << (dup & (DUP_MASK >> 9)), R_ML = N_ML << (dup & (DUP_MASK >> 10)), R_SCAN = N_SCAN << (dup & (DUP_MASK >> 11)), R_OUT = N_OUT << (dup & (DUP_MASK >> 12));
        if (item >= 64 + R_DSA + R_FOX + R_ML + R_SCAN + R_OUT) break;
        PHASE_BEGIN();
        if (item < 64) { ckv_norm_item(F, l, item); dep_signal(F, dep_nrm(l, item >> 3)); continue; }
        item -= 64;
        if (item < R_DSA) { item %= N_DSA; dsa_unit(F, l, item & 7, 31 - (item >> 3)); continue; }
        item -= R_DSA;
        if (item < R_FOX) { item %= N_FOX; fox_unit(F, (item & 31) >> 2, item & 3, 7 - (item >> 5)); continue; }
        item -= R_FOX;
        if (item < R_ML) { item %= N_ML; ml::unit_local4(F, l, item); dep_signal(F, dep_word(l, 0, item >> 3)); continue; }
        item -= R_ML;
        if (item < R_SCAN) { item %= N_SCAN; dep_wait(F, dep_word(l, 0, item / 5), 8u); ml::scan_item(F, item); dep_signal(F, dep_word(l, 1, item / 5)); continue; }
        item -= R_SCAN;
        item %= N_OUT; dep_wait(F, dep_word(l, 1, item >> 3), 5u);
        ml::unit_out4(F, l, item);
    }
}


__global__ void __launch_bounds__(NTHREADS, 2) fwd_kernel(Args args) {
    extern __shared__ __attribute__((aligned(16))) unsigned char lds[];
    cg::grid_group grid = cg::this_grid();
    Frame F;
    F.lds = (LAS unsigned char*)lds;
    F.wave = __builtin_amdgcn_readfirstlane((int)threadIdx.x >> 6); F.tid = F.wave * 64 + hw_lane();
    volatile LAS unsigned* MISC = (volatile LAS unsigned*)(F.lds + MISC_OFF);
    for (int u = F.tid; u < (LDS_BYTES - LDSCTL_OFF) / 4; u += NTHREADS) ((LAS unsigned*)(F.lds + LDSCTL_OFF))[u] = 0u;
    __syncthreads();
    (void)xcd_barrier_post((unsigned*)KCTL + CW_BAR, MISC + 8, F.tid == 0);
    grid.sync();
#define GRID_BAR() do { XcdBarrier bar_; bar_.bar = (unsigned*)KCTL + CW_BAR; bar_.x = xb_xcc_id(); bar_.st = (volatile LAS unsigned*)(F.lds + MISC_OFF) + 8; bar_.t0 = (F.wave == 0) && (hw_lane() == 0); xcd_barrier(bar_); } while (0)
#define REPS(k) (((DUP_MASK >> (k)) & 1) && l == 0 ? 2 : 1)
    for (int rep = 0; rep < ((DUP_MASK & 1) ? 2 : 1); ++rep) { p0_prologue(F); p0_moe_weights(F); GRID_BAR(); }
    norm_rows(F, KIN(I_X), 0, 0, 1024); GRID_BAR();
    for (int l = 0; l < DEPTH; ++l) {
        const float* xsrc = (l == 0) ? KIN(I_X) : WSP(float, WS_X);
        for (int rep = 0; rep < REPS(1); ++rep) {
            {   PHASE_BEGIN(); pg8::Gemm g{WSP(bf16, WS_XN), WSP(bf16, WS_WIN_T) + (size_t)l * NV * 1024, M, NV, 1024};
                InProjSched Sc; Sc.so.init(M, 4 * 256, GRIDN, (int)blockIdx.x); Sc.f8 = 0; EpiInProj E{WSP(float, WS_BINP) + (size_t)l * NV, (unsigned char*)KWS};
                pg8::gemm_phase<EpiInProj, InProjSched, true, true>(F.lds, g, Sc, E, F.tid); }
            {   PHASE_BEGIN(); pg8::Gemm g{(const bf16*)WSP(unsigned char, WS_XN1_8), (const bf16*)(WSP(unsigned char, WS_WIN8) + (size_t)l * NV * 1024), M, NV, 512};
                InProjSched Sc; Sc.so.init(M, 24 * 256, GRIDN, (int)blockIdx.x); Sc.f8 = 1; EpiInProj8 E{WSP(float, WS_BINP) + (size_t)l * NV, (unsigned char*)KWS};
                pg8::gemm_phase<EpiInProj8, InProjSched, false, true, true>(F.lds, g, Sc, E, F.tid); }
            GRID_BAR(); }
        mixer_queue(F, l, l); GRID_BAR();
        for (int rep = 0; rep < REPS(4); ++rep) {
            {   PHASE_BEGIN(); pg8::Gemm g{WSP(bf16, WS_YCAT), WSP(bf16, WS_WBR_T) + (size_t)l * 3072 * 512, 3 * M, 3072, 512};
                BranchSched Sc{GRIDN, vcu_id(), 0 | (1 << 2) | (2 << 4), 3}; EpiBranch E{WSP(bf16, WS_GATES), WSP(bf16, WS_MERGED), 0, WSP(unsigned char, WS_MERGED8)};
                pg8::gemm_phase<EpiBranch, BranchSched, true, true>(F.lds, g, Sc, E, F.tid); }
            GRID_BAR();
            {   PHASE_BEGIN(); pg8::Gemm g{(const bf16*)WSP(unsigned char, WS_MERGED8), (const bf16*)(WSP(unsigned char, WS_WOUT8) + (size_t)l * 1024 * 1024), M, 1024, 512};
                pg8::StaticOrder Sc; Sc.init(M, 1024, GRIDN, (int)blockIdx.x); EpiOutProj E{xsrc, WSP(float, WS_X), WSP(float, WS_MOD) + (size_t)l * 8 * 6144};
                pg8::gemm_phase<EpiOutProj, pg8::StaticOrder, false, true, true>(F.lds, g, Sc, E, F.tid); }
            GRID_BAR(); }
        xsrc = WSP(float, WS_X);
        if (((DUP_MASK >> 16) & 1) && l == 0) { route_phase(F, l, xsrc, true); GRID_BAR(); }
        route_phase(F, l, xsrc); GRID_BAR();
        for (int rep = 0; rep < REPS(5); ++rep) { gather_phase(F, l); GRID_BAR(); }
        const LAS int* tst = (const LAS int*)(F.lds + LDSCTL_OFF);
        for (int rep = 0; rep < REPS(6); ++rep) {
            {   PHASE_BEGIN(); pg8::Gemm gp{(const bf16*)WSP(unsigned char, WS_AS8), (const bf16*)(WSP(unsigned char, WS_W1T) + (size_t)l * 32 * 2048 * 1024), MP, 32 * 2048, 512};
                MoeSched<8> Sc{tst, tst[32] * 8, GRIDN, vcu_id()}; EpiP1 E{WSP(unsigned char, WS_ACT8), KIN(I_B1) + (size_t)l * 32 * 2048};
                pg8::gemm_phase<EpiP1, MoeSched<8>, false, true, true>(F.lds, gp, Sc, E, F.tid); }
            GRID_BAR(); }
        for (int rep = 0; rep < REPS(18); ++rep) {
        {   PHASE_BEGIN(); f8::Gemm g{WSP(unsigned char, WS_ACT8), WSP(unsigned char, WS_W2T) + (size_t)l * 32 * 1024 * 1024, 1024};
            MoeSched<4> Sc{tst, tst[32] * 4, GRIDN, vcu_id(), (DUP_MASK >> 24) & 1 & ((rep == 0 && l == 0) ? 1 : 0)}; EpiP2 E{WSP(bf16, WS_ASORT), KIN(I_B2) + (size_t)l * 32 * 1024, (((DUP_MASK >> 22) & 3) && rep == 0 && l == 0) ? ((DUP_MASK >> 22) & 3) : 0};
            pg8::Gemm gp{(const bf16*)g.A, (const bf16*)g.Bt, MP, 32 * 1024, 512, (((DUP_MASK >> 21) & 1) && rep == 0 && l == 0) ? 2 : 0};
            {
                const int nmax = (Sc.total + GRIDN - 1) / GRIDN, nmine = (Sc.total - Sc.c + GRIDN - 1) / GRIDN;
                if (nmine < nmax) { __builtin_amdgcn_s_sleep(100); __builtin_amdgcn_s_sleep(100); } }
            pg8::gemm_phase<EpiP2, MoeSched<4>, false, true, true>(F.lds, gp, Sc, E, F.tid); }
        GRID_BAR(); }
        if (((DUP_MASK >> 17) & 1) && l == 0) { combine_phase(F, l, xsrc, false, true); GRID_BAR(); }
        combine_phase(F, l, xsrc, l == DEPTH - 1); GRID_BAR();
    }
}

extern "C" void kernel_launch(void* const* d_in, const int* in_sizes, int n_in, void* d_out, int out_size, void* d_ws, size_t ws_size, hipStream_t stream) {
    static int grid = 0;
    if (grid == 0) {
        if (n_in != 23 || out_size != M * D || ws_size < WS_END2) { fprintf(stderr, "kernel_launch: unexpected shapes (n_in %d out %d ws %zu)\n", n_in, out_size, ws_size); grid = -1; return; }
        int dev = 0, cus = 0, per_cu = 0;
        (void)hipGetDevice(&dev);
        (void)hipDeviceGetAttribute(&cus, hipDeviceAttributeMultiprocessorCount, dev);
        (void)hipFuncSetAttribute((const void*)fwd_kernel, hipFuncAttributeMaxDynamicSharedMemorySize, LDS_BYTES);
        (void)hipOccupancyMaxActiveBlocksPerMultiprocessor(&per_cu, (const void*)fwd_kernel, NTHREADS, LDS_BYTES);
        if (per_cu < 1) { fprintf(stderr, "kernel_launch: occupancy query says %d blocks/CU\n", per_cu); per_cu = 1; }
        grid = cus;
    }
    if (grid < 0) return;
    (void)hipMemsetAsync((char*)d_ws + WS_CTL, 0, CTL_ZERO_BYTES, stream);
    Args a{};
    for (int i = 0; i < 23; ++i) a.in[i] = (const float*)d_in[i];
    a.out = (float*)d_out; a.ws = (unsigned char*)d_ws;
    void* kargs[] = {&a};
    hipError_t e = hipLaunchCooperativeKernel((const void*)fwd_kernel, dim3(grid), dim3(NTHREADS), kargs, LDS_BYTES, stream);
    if (e != hipSuccess) fprintf(stderr, "cooperative launch failed: %s (grid %d)\n", hipGetErrorString(e), grid);
}
```

```cpp
#include <hip/hip_runtime.h>
#include <hip/hip_cooperative_groups.h>
#include <cstdio>
#include <cstdint>
namespace cg = cooperative_groups;
#define DUP_MASK 0
__device__ __forceinline__ int hw_lane() { int x; asm volatile("v_mbcnt_lo_u32_b32 %0, -1, 0\n\tv_mbcnt_hi_u32_b32 %0, -1, %0" : "=v"(x)); return x; }
typedef float ozf4_t __attribute__((ext_vector_type(4)));
typedef float ozf16_t __attribute__((ext_vector_type(16)));
__device__ __forceinline__ float ozero() { float z; asm volatile("v_mov_b32 %0, 0" : "=v"(z)); return z; }
__device__ __forceinline__ ozf4_t ozero4() { const float z = ozero(); return (ozf4_t){z, z, z, z}; }
__device__ __forceinline__ ozf16_t ozero16() { const float z = ozero(); return (ozf16_t){z, z, z, z, z, z, z, z, z, z, z, z, z, z, z, z}; }
__device__ __forceinline__ float lshfl(float x, int srclane) { return __builtin_bit_cast(float, __builtin_amdgcn_ds_bpermute(srclane << 2, __builtin_bit_cast(int, x))); }
__device__ __forceinline__ float qxor1(float x) { return __builtin_bit_cast(float, __builtin_amdgcn_mov_dpp(__builtin_bit_cast(int, x), 0xB1, 0xf, 0xf, true)); }
__device__ __forceinline__ float qxor2(float x) { return __builtin_bit_cast(float, __builtin_amdgcn_mov_dpp(__builtin_bit_cast(int, x), 0x4E, 0xf, 0xf, true)); }
__device__ __forceinline__ float hmirror(float x) { return __builtin_bit_cast(float, __builtin_amdgcn_mov_dpp(__builtin_bit_cast(int, x), 0x141, 0xf, 0xf, true)); }
namespace pg8 {
#define PG8_LAS __attribute__((address_space(3)))
typedef unsigned short bf16_t;
typedef short bf16x8 __attribute__((ext_vector_type(8)));
typedef float f32x4 __attribute__((ext_vector_type(4)));
typedef unsigned u32x4 __attribute__((ext_vector_type(4)));
constexpr int BM = 256, BK = 64, HALF = 128, HTB = HALF * BK * 2  , STAGE_BYTES = 8 * HTB, NXCD = 8, WGM = 8;

__host__ __device__ __forceinline__ int lds_byte(int r, int c) { const int st = (r >> 4) * 2 + (c >> 5), rr = r & 15, cc = c & 31, ob = rr * 64 + cc * 2; return st * 1024 + (ob ^ (((ob >> 9) & 1) << 5)); }
__host__ __device__ __forceinline__ void stage_rc(int b, int& R, int& C) { const int st = b / 1024, sb = b % 1024, swz = sb ^ (((sb >> 9) & 1) << 5); R = (st >> 1) * 16 + swz / 64; C = (st & 1) * 32 + (swz % 64) / 2; }
__host__ __device__ __forceinline__ int perm32(int rho) { const int n = rho >> 4, i = rho & 15; return 8 * (i >> 2) + 4 * n + (i & 3); }

struct Unit { int pm, pn; };
struct Gemm { const bf16_t* A; const bf16_t* Bt; int M, N, K; int nt_probe = 0; };

struct StaticOrder {
    int nM, nN, nwg, G, c;
    __host__ __device__ void init(int M, int N, int G_, int c_) { nM = M / BM; nN = N / BM; nwg = nM * nN; G = G_; c = c_; }
    __host__ __device__ bool next(int i, Unit& u) const {
        const long L = (long)i * G + c; if (L >= nwg) return false;
        int wgid = (int)L; { const int q = nwg / NXCD, r = nwg % NXCD, xcd = wgid % NXCD, off = wgid / NXCD; wgid = (xcd < r ? xcd * (q + 1) : r * (q + 1) + (xcd - r) * q) + off; }
        const int nig = WGM * nN, gid = wgid / nig, fm = gid * WGM, gsz = (nM - fm) < WGM ? (nM - fm) : WGM;
        u.pm = fm + ((wgid % nig) % gsz); u.pn = (wgid % nig) / gsz; return true;
    }
    __device__ __forceinline__ void a_ready(const Unit&) const {}
    __device__ __forceinline__ void done(const Unit&) const {}
};

__device__ __forceinline__ unsigned cvt_pk_bf16(float lo, float hi) { unsigned r; asm volatile("v_cvt_pk_bf16_f32 %0, %1, %2" : "=v"(r) : "v"(lo), "v"(hi)); return r; }
__device__ __forceinline__ void glds16s(const void* sbase, unsigned voff, unsigned lds_dst) { unsigned keep;
    asm volatile("s_mov_b32 %0, m0\n\ts_mov_b32 m0, %3\n\ts_nop 0\n\tglobal_load_lds_dwordx4 %1, %2\n\ts_mov_b32 m0, %0" : "=&s"(keep) : "v"(voff), "s"(sbase), "s"(lds_dst) : "memory"); }
typedef int v8i_t __attribute__((ext_vector_type(8)));
typedef int v4i_t __attribute__((ext_vector_type(4)));
template <class T, class = void> struct epi_bias_init { static constexpr bool value = false; };
template <class T> struct epi_bias_init<T, decltype((void)T::BIAS_INIT)> { static constexpr bool value = T::BIAS_INIT; };
template <class T, class = void> struct epi_nstore { static constexpr int value = 0; };
template <class T> struct epi_nstore<T, decltype((void)T::NSTORE)> { static constexpr int value = T::NSTORE; };
template <class Epi, class Sched, bool ALIGN_EPI = false, bool SP2 = false, bool FP8 = false>
__device__ __forceinline__ void gemm_phase(PG8_LAS unsigned char* lds, const Gemm g, const Sched& S, const Epi& E, const int tid) {
    const int wid = __builtin_amdgcn_readfirstlane(tid >> 6), lane = tid & 63, wr = wid >> 2, wc = wid & 3, fr = lane & 15, fq = lane >> 4;
    const int K = g.K, nt = (DUP_MASK != 0 && g.nt_probe) ? g.nt_probe : K / BK;
    unsigned voffA[2], voffB[2];
#pragma unroll
    for (int i = 0; i < 2; ++i) { int R, C; stage_rc(tid * 16 + i * 8192, R, C); const int Rb = Epi::PERM ? ((R & ~31) + perm32(R & 31)) : R;
        voffA[i] = (unsigned)(R * K + C) * 2u; voffB[i] = (unsigned)(Rb * K + C) * 2u; }
    const size_t kstep = (size_t)(BK * 2);
    const size_t hstep = (size_t)HALF * K * 2;
    const size_t tstep = 2 * hstep;
    const unsigned ldsw = (unsigned)wid * 1024u, ldsbase = (unsigned)(uintptr_t)lds;
    const int aoff0 = lds_byte(wr * 64 + fr, fq * 8), aoff1 = aoff0 + 1024;
    const int boff0 = lds_byte(wc * 32 + fr, fq * 8), boff1 = boff0 + 1024;
#define PG8_SA(b, h) (((b) * 2 + (h)) * HTB)
#define PG8_SB(b, h) ((4 + (b) * 2 + (h)) * HTB)
#define PG8_STAGE(bufoff, gbase, voff) do { _Pragma("unroll") for (int _i = 0; _i < 2; ++_i) \
        glds16s((const void*)(gbase), (voff)[_i], (unsigned)__builtin_amdgcn_readfirstlane((int)(ldsbase + (bufoff) + ldsw + _i * 8192))); } while (0)
#define PG8_LDA(dst, b, h) do { _Pragma("unroll") for (int m = 0; m < 4; ++m) { if constexpr (FP8) { \
        const v4i_t lo_ = *(const PG8_LAS v4i_t*)(lds + PG8_SA(b, h) + aoff0 + m * 2048), hi_ = *(const PG8_LAS v4i_t*)(lds + PG8_SA(b, h) + aoff1 + m * 2048); dst##8[m] = __builtin_shufflevector(lo_, hi_, 0, 1, 2, 3, 4, 5, 6, 7); } \
        else { dst[m][0] = *(const PG8_LAS bf16x8*)(lds + PG8_SA(b, h) + aoff0 + m * 2048); dst[m][1] = *(const PG8_LAS bf16x8*)(lds + PG8_SA(b, h) + aoff1 + m * 2048); } } } while (0)
#define PG8_LDB(dst, b, h) do { _Pragma("unroll") for (int n = 0; n < 2; ++n) { if constexpr (FP8) { \
        const v4i_t lo_ = *(const PG8_LAS v4i_t*)(lds + PG8_SB(b, h) + boff0 + n * 2048), hi_ = *(const PG8_LAS v4i_t*)(lds + PG8_SB(b, h) + boff1 + n * 2048); dst##8[n] = __builtin_shufflevector(lo_, hi_, 0, 1, 2, 3, 4, 5, 6, 7); } \
        else { dst[n][0] = *(const PG8_LAS bf16x8*)(lds + PG8_SB(b, h) + boff0 + n * 2048); dst[n][1] = *(const PG8_LAS bf16x8*)(lds + PG8_SB(b, h) + boff1 + n * 2048); } } } while (0)
#define PG8_MMA(ai, bj, At, Bt) do { __builtin_amdgcn_s_setprio(1); _Pragma("unroll") for (int m = 0; m < 4; ++m) _Pragma("unroll") for (int n = 0; n < 2; ++n) { \
        if constexpr (FP8) { asm volatile("v_mfma_scale_f32_16x16x128_f8f6f4 %0, %1, %2, %0, %3, %4 op_sel_hi:[0,0,0]" : "+v"(acc[ai][bj][m][n]) : "v"(Bt##8[n]), "v"(At##8[m]), "v"(sclW), "v"(sclX)); } \
        else { _Pragma("unroll") for (int k = 0; k < 2; ++k) acc[ai][bj][m][n] = __builtin_amdgcn_mfma_f32_16x16x32_bf16(Bt[n][k], At[m][k], acc[ai][bj][m][n], 0, 0, 0); } } __builtin_amdgcn_s_setprio(0); } while (0)
#define PG8_WAIT_V(n) asm volatile("s_waitcnt vmcnt(" #n ")" ::: "memory")
#define PG8_WAIT_VN(n) asm volatile("s_waitcnt vmcnt(%0)" :: "n"(n) : "memory")
#define PG8_WAIT_L(n) asm volatile("s_waitcnt lgkmcnt(" #n ")" ::: "memory")
#define PG8_BAR __builtin_amdgcn_s_barrier()
#define PG8_SCHED __builtin_amdgcn_sched_barrier(0)
    Unit cur, nxt; int ui = 0;
    if (!S.next(0, cur)) return;
    const int sclW = 0x7a7a7a7a, sclX = 0x7f7f7f7f;
    cur.pm = __builtin_amdgcn_readfirstlane(cur.pm); cur.pn = __builtin_amdgcn_readfirstlane(cur.pn);
    f32x4 acc[2][2][4][2];
    constexpr int NST = epi_nstore<Epi>::value;
    f32x4 nb[4];
    if constexpr (epi_bias_init<Epi>::value) {
#pragma unroll
        for (int p = 0; p < 2; ++p) { Unit bu; const int bi = p * 8 + wid;
            if (S.next(bi, bu)) *(PG8_LAS f32x4*)(lds + STAGE_BYTES + bi * 1024 + lane * 16) = *(const f32x4*)E.bias_src(bu, lane); }
        __syncthreads();
        E.load_bias(nb, (const PG8_LAS float*)(lds + STAGE_BYTES), wc, fq); E.set_bias(acc, nb); }
    else {
#pragma unroll
    for (int a = 0; a < 2; ++a)
#pragma unroll
        for (int b = 0; b < 2; ++b)
#pragma unroll
            for (int m = 0; m < 4; ++m)
#pragma unroll
                for (int n = 0; n < 2; ++n) acc[a][b][m][n] = ozero4();
    }
    bf16x8 At[4][2], B0[2][2], B1[2][2]; v8i_t At8[4], B08[2], B18[2];
    const char* cA = (const char*)g.A + (size_t)cur.pm * tstep; const char* cB = (const char*)g.Bt + (size_t)cur.pn * tstep;
    S.a_ready(cur);
    if constexpr (SP2) {
        PG8_STAGE(PG8_SB(0, 0), cB, voffB); PG8_STAGE(PG8_SB(0, 1), cB + hstep, voffB); PG8_STAGE(PG8_SA(0, 0), cA, voffA); PG8_STAGE(PG8_SA(0, 1), cA + hstep, voffA);
        if (wr == 1) PG8_BAR;
        PG8_WAIT_V(2); PG8_BAR;
        PG8_STAGE(PG8_SB(1, 0), cB + kstep, voffB); PG8_STAGE(PG8_SA(1, 0), cA + kstep, voffA); PG8_STAGE(PG8_SB(1, 1), cB + hstep + kstep, voffB);
        PG8_WAIT_V(6); PG8_BAR;
    } else {
        PG8_STAGE(PG8_SB(0, 0), cB, voffB); PG8_STAGE(PG8_SA(0, 0), cA, voffA); PG8_STAGE(PG8_SB(0, 1), cB + hstep, voffB); PG8_STAGE(PG8_SA(0, 1), cA + hstep, voffA);
        if (wr == 1) PG8_BAR;
        PG8_WAIT_V(4); PG8_BAR;
        PG8_STAGE(PG8_SB(1, 0), cB + kstep, voffB); PG8_STAGE(PG8_SA(1, 0), cA + kstep, voffA); PG8_STAGE(PG8_SB(1, 1), cB + hstep + kstep, voffB);
        PG8_WAIT_V(6); PG8_BAR;
    }
    for (;;) {
        const bool has_next = S.next(ui + 1, nxt);
        nxt.pm = __builtin_amdgcn_readfirstlane(nxt.pm); nxt.pn = __builtin_amdgcn_readfirstlane(nxt.pn);
        const char* nA = has_next ? (const char*)g.A + (size_t)nxt.pm * tstep : cA; const char* nB = has_next ? (const char*)g.Bt + (size_t)nxt.pn * tstep : cB;
        for (int t = 0; t < nt; t += 2) {
            const bool last = (t == nt - 2);
            const bool rl = NST > 0 && t == 0 && ui > 0;
            const char* a1 = cA + (size_t)(t + 1) * kstep;
            const char* a2 = last ? nA : cA + (size_t)(t + 2) * kstep; const char* b2 = last ? nB : cB + (size_t)(t + 2) * kstep;
            const char* a3 = a2 + kstep; const char* b3 = b2 + kstep;
            if (last && has_next) S.a_ready(nxt);
            if constexpr (SP2) {
            PG8_LDB(B0, 0, 0); PG8_LDB(B1, 0, 1); PG8_SCHED; PG8_LDA(At, 0, 0); PG8_STAGE(PG8_SA(1, 1), a1 + hstep, voffA);
            if (rl) PG8_WAIT_VN(NST + 2); else PG8_WAIT_V(8);
            PG8_WAIT_L(0); PG8_BAR; PG8_MMA(0, 0, At, B0); PG8_MMA(0, 1, At, B1); PG8_BAR; PG8_SCHED;
            PG8_LDA(At, 0, 1); PG8_STAGE(PG8_SB(0, 0), b2, voffB); PG8_STAGE(PG8_SB(0, 1), b2 + hstep, voffB); PG8_STAGE(PG8_SA(0, 0), a2, voffA);
            if (rl) PG8_WAIT_VN(NST + 8); else PG8_WAIT_V(8);
            PG8_WAIT_L(0); PG8_BAR; PG8_MMA(1, 0, At, B0); PG8_MMA(1, 1, At, B1); PG8_BAR; PG8_SCHED;
            PG8_LDB(B0, 1, 0); PG8_LDB(B1, 1, 1); PG8_SCHED; PG8_LDA(At, 1, 0); PG8_STAGE(PG8_SA(0, 1), a2 + hstep, voffA);
            if (rl) PG8_WAIT_VN(NST + 10); else PG8_WAIT_V(8);
            PG8_WAIT_L(0); PG8_BAR; PG8_MMA(0, 0, At, B0); PG8_MMA(0, 1, At, B1); PG8_BAR; PG8_SCHED;
            PG8_LDA(At, 1, 1); PG8_STAGE(PG8_SB(1, 0), b3, voffB); PG8_STAGE(PG8_SB(1, 1), b3 + hstep, voffB); PG8_STAGE(PG8_SA(1, 0), a3, voffA);
            PG8_WAIT_V(8); PG8_WAIT_L(0); PG8_BAR; PG8_MMA(1, 0, At, B0); PG8_MMA(1, 1, At, B1); PG8_BAR; PG8_SCHED;
            } else {
            PG8_LDB(B0, 0, 0); PG8_SCHED; PG8_LDA(At, 0, 0); PG8_STAGE(PG8_SA(1, 1), a1 + hstep, voffA);
            PG8_WAIT_L(8); PG8_BAR; PG8_WAIT_L(0); PG8_MMA(0, 0, At, B0); PG8_BAR; PG8_SCHED;
            PG8_LDB(B1, 0, 1); PG8_STAGE(PG8_SB(0, 0), b2, voffB);
            PG8_BAR; PG8_WAIT_L(0); PG8_MMA(0, 1, At, B1); PG8_BAR;
            PG8_LDA(At, 0, 1); PG8_STAGE(PG8_SA(0, 0), a2, voffA);
            PG8_BAR; PG8_WAIT_L(0); PG8_MMA(1, 0, At, B0); PG8_BAR; PG8_SCHED;
            PG8_STAGE(PG8_SB(0, 1), b2 + hstep, voffB);
            PG8_WAIT_V(6); PG8_BAR; PG8_MMA(1, 1, At, B1); PG8_BAR;
            PG8_LDB(B0, 1, 0); PG8_SCHED; PG8_LDA(At, 1, 0); PG8_STAGE(PG8_SA(0, 1), a2 + hstep, voffA);
            PG8_WAIT_L(8); PG8_BAR; PG8_WAIT_L(0); PG8_MMA(0, 0, At, B0); PG8_BAR; PG8_SCHED;
            PG8_LDB(B1, 1, 1); PG8_STAGE(PG8_SB(1, 0), b3, voffB);
            PG8_BAR; PG8_WAIT_L(0); PG8_MMA(0, 1, At, B1); PG8_BAR;
            PG8_LDA(At, 1, 1); PG8_STAGE(PG8_SA(1, 0), a3, voffA);
            PG8_BAR; PG8_WAIT_L(0); PG8_MMA(1, 0, At, B0); PG8_BAR; PG8_SCHED;
            PG8_STAGE(PG8_SB(1, 1), b3 + hstep, voffB);
            PG8_WAIT_V(6); PG8_BAR; PG8_MMA(1, 1, At, B1); PG8_BAR;
            }
        }
        if constexpr (FP8) asm volatile("s_nop 15\n\ts_nop 15" ::: "memory");
        if constexpr (ALIGN_EPI) { if (wr == 0) PG8_BAR; }
        if constexpr (epi_bias_init<Epi>::value) { if (has_next) E.load_bias(nb, (const PG8_LAS float*)(lds + STAGE_BYTES + (ui + 1) * 1024), wc, hw_lane() >> 4); }
        if constexpr (!Epi::AFTER_DRAIN) { const int el = hw_lane(); E(acc, cur, wr, wc, el & 15, el >> 4); S.done(cur); }
        if (!has_next) break;
        if constexpr (epi_bias_init<Epi>::value) E.set_bias(acc, nb);
        else {
#pragma unroll
        for (int a = 0; a < 2; ++a)
#pragma unroll
            for (int b = 0; b < 2; ++b)
#pragma unroll
                for (int m = 0; m < 4; ++m)
#pragma unroll
                    for (int n = 0; n < 2; ++n) acc[a][b][m][n] = ozero4();
        }
        cur = nxt; cA = nA; cB = nB; ++ui;
        if constexpr (ALIGN_EPI) { if (wr == 1) PG8_BAR; }
    }
    PG8_WAIT_V(0);
    if constexpr (!ALIGN_EPI) { if (wr == 0) PG8_BAR; }
    PG8_BAR;
    if constexpr (Epi::AFTER_DRAIN) { E.fused(acc, cur, wr, wc, fr, fq, lds, wid, lane); S.done(cur); }
#undef PG8_SA
#undef PG8_SB
#undef PG8_STAGE
#undef PG8_LDA
#undef PG8_LDB
#undef PG8_MMA
#undef PG8_WAIT_V
#undef PG8_WAIT_L
#undef PG8_BAR
#undef PG8_SCHED
}
}
typedef float f32x4 __attribute__((ext_vector_type(4)));
#define LAS __attribute__((address_space(3)))

namespace f8 {
typedef int v8i_t __attribute__((ext_vector_type(8)));
typedef int v4i_t __attribute__((ext_vector_type(4)));
constexpr int STG = 49152;
struct Gemm { const unsigned char* A; const unsigned char* Bt; int K; };
template <class Epi, class Sched>
__device__ __forceinline__ void gemm_phase(LAS unsigned char* lds, const Gemm g, const Sched& S, const Epi& E, const int tid) {
    const int wid = __builtin_amdgcn_readfirstlane(tid >> 6), lane = tid & 63, wr = wid >> 1, wc = wid & 1, fr = lane & 15, fq = lane >> 4;
    const int K = g.K, nt = K >> 7;
    unsigned voff[2];
#pragma unroll
    for (int i = 0; i < 2; ++i) { int R, C; pg8::stage_rc(tid * 16 + i * 8192, R, C); voff[i] = (unsigned)(R * K + C * 2); }
    const unsigned ldsbase = (unsigned)(uintptr_t)lds, ldsw = (unsigned)wid * 1024u;
    const int aoff0 = (wr >> 1) * 16384 + pg8::lds_byte((wr & 1) * 64 + fr, fq * 16), aoff1 = (wr >> 1) * 16384 + pg8::lds_byte((wr & 1) * 64 + fr, fq * 16 + 8);
    const int boff0 = 32768 + pg8::lds_byte(wc * 64 + fr, fq * 16), boff1 = 32768 + pg8::lds_byte(wc * 64 + fr, fq * 16 + 8);
#define F8_STAGE(s, pa, pb, kt) do { const size_t ko_ = (size_t)(kt) * 128; _Pragma("unroll") for (int _i = 0; _i < 2; ++_i) { \
        pg8::glds16s((const void*)((pa) + ko_), voff[_i], (unsigned)__builtin_amdgcn_readfirstlane((int)(ldsbase + (s) * STG + ldsw + _i * 8192))); \
        pg8::glds16s((const void*)((pa) + (size_t)128 * K + ko_), voff[_i], (unsigned)__builtin_amdgcn_readfirstlane((int)(ldsbase + (s) * STG + 16384 + ldsw + _i * 8192))); \
        pg8::glds16s((const void*)((pb) + ko_), voff[_i], (unsigned)__builtin_amdgcn_readfirstlane((int)(ldsbase + (s) * STG + 32768 + ldsw + _i * 8192))); } } while (0)
    pg8::Unit cur, nxt; int ui = 0;
    if (!S.next(0, cur)) return;
    cur.pm = __builtin_amdgcn_readfirstlane(cur.pm); cur.pn = __builtin_amdgcn_readfirstlane(cur.pn);
    const unsigned char* cA = g.A + (size_t)cur.pm * 256 * K; const unsigned char* cB = g.Bt + (size_t)cur.pn * 128 * K;
    bool has_next = S.next(1, nxt);
    nxt.pm = __builtin_amdgcn_readfirstlane(nxt.pm); nxt.pn = __builtin_amdgcn_readfirstlane(nxt.pn);
    const unsigned char* nA = has_next ? g.A + (size_t)nxt.pm * 256 * K : cA; const unsigned char* nB = has_next ? g.Bt + (size_t)nxt.pn * 128 * K : cB;
    F8_STAGE(0, cA, cB, 0);
    if (nt > 1) F8_STAGE(1, cA, cB, 1); else F8_STAGE(1, nA, nB, 0);
    asm volatile("s_waitcnt vmcnt(6)" ::: "memory"); __builtin_amdgcn_s_barrier(); asm volatile("" ::: "memory");
    int st = 0;
    for (;;) {
        f32x4 acc[4][4];
#pragma unroll
        for (int m = 0; m < 4; ++m)
#pragma unroll
            for (int n = 0; n < 4; ++n) acc[m][n] = ozero4();
        for (int t = 0; t < nt; ++t) {
            const int s2 = st >= 1 ? st - 1 : 2;
            if (t + 2 < nt) F8_STAGE(s2, cA, cB, t + 2); else F8_STAGE(s2, nA, nB, t + 2 - nt);
            v8i_t af[4], bfr[4];
            const LAS unsigned char* sb = lds + st * STG;
#pragma unroll
            for (int m = 0; m < 4; ++m) { const v4i_t lo_ = *(const LAS v4i_t*)(sb + aoff0 + m * 2048), hi_ = *(const LAS v4i_t*)(sb + aoff1 + m * 2048); af[m] = __builtin_shufflevector(lo_, hi_, 0, 1, 2, 3, 4, 5, 6, 7); }
#pragma unroll
            for (int n = 0; n < 4; ++n) { const v4i_t lo_ = *(const LAS v4i_t*)(sb + boff0 + n * 2048), hi_ = *(const LAS v4i_t*)(sb + boff1 + n * 2048); bfr[n] = __builtin_shufflevector(lo_, hi_, 0, 1, 2, 3, 4, 5, 6, 7); }
            asm volatile("s_waitcnt lgkmcnt(0)" ::: "memory"); __builtin_amdgcn_sched_barrier(0);
            __builtin_amdgcn_s_setprio(1);
#pragma unroll
            for (int m = 0; m < 4; ++m)
#pragma unroll
                for (int n = 0; n < 4; ++n) acc[m][n] = __builtin_amdgcn_mfma_scale_f32_16x16x128_f8f6f4(bfr[n], af[m], acc[m][n], 0, 0, 0, 0x7a7a7a7a, 0, 0x7f7f7f7f);
            __builtin_amdgcn_s_setprio(0);
            __builtin_amdgcn_sched_barrier(0);
            asm volatile("s_waitcnt vmcnt(6)" ::: "memory"); __builtin_amdgcn_s_barrier(); asm volatile("" ::: "memory");
            st = st == 2 ? 0 : st + 1;
        }
        E(acc, cur, wr, wc, fr, fq);
        if (!has_next) break;
        cur = nxt; cA = nA; cB = nB; ++ui;
        has_next = S.next(ui + 1, nxt);
        nxt.pm = __builtin_amdgcn_readfirstlane(nxt.pm); nxt.pn = __builtin_amdgcn_readfirstlane(nxt.pn);
        nA = has_next ? g.A + (size_t)nxt.pm * 256 * K : cA; nB = has_next ? g.Bt + (size_t)nxt.pn * 128 * K : cB;
    }
    asm volatile("s_waitcnt vmcnt(0)" ::: "memory"); __builtin_amdgcn_s_barrier(); asm volatile("" ::: "memory");
#undef F8_STAGE
}
constexpr int STGW = 65536;
template <class Epi, class Sched>
__device__ __forceinline__ void gemm_phase_w(LAS unsigned char* lds, const Gemm g, const Sched& S, const Epi& E, const int tid) {
    const int wid = __builtin_amdgcn_readfirstlane(tid >> 6), lane = tid & 63, wr = wid >> 1, wc = wid & 1, fr = lane & 15, fq = lane >> 4;
    const int K = g.K, nt = K >> 7;
    unsigned voff[2];
#pragma unroll
    for (int i = 0; i < 2; ++i) { int R, C; pg8::stage_rc(tid * 16 + i * 8192, R, C); voff[i] = (unsigned)(R * K + C * 2); }
    const unsigned ldsbase = (unsigned)(uintptr_t)lds, ldsw = (unsigned)wid * 1024u;
    const int aoff0 = (wr >> 1) * 16384 + pg8::lds_byte((wr & 1) * 64 + fr, fq * 16), aoff1 = (wr >> 1) * 16384 + pg8::lds_byte((wr & 1) * 64 + fr, fq * 16 + 8);
    const int boff0 = 32768 + wc * 16384 + pg8::lds_byte(fr, fq * 16), boff1 = 32768 + wc * 16384 + pg8::lds_byte(fr, fq * 16 + 8);
#define F8W_STAGE(s, pa, pb, kt) do { const size_t ko_ = (size_t)(kt) * 128; _Pragma("unroll") for (int _i = 0; _i < 2; ++_i) { \
        pg8::glds16s((const void*)((pa) + ko_), voff[_i], (unsigned)__builtin_amdgcn_readfirstlane((int)(ldsbase + (s) * STGW + ldsw + _i * 8192))); \
        pg8::glds16s((const void*)((pa) + (size_t)128 * K + ko_), voff[_i], (unsigned)__builtin_amdgcn_readfirstlane((int)(ldsbase + (s) * STGW + 16384 + ldsw + _i * 8192))); \
        pg8::glds16s((const void*)((pb) + ko_), voff[_i], (unsigned)__builtin_amdgcn_readfirstlane((int)(ldsbase + (s) * STGW + 32768 + ldsw + _i * 8192))); \
        pg8::glds16s((const void*)((pb) + (size_t)128 * K + ko_), voff[_i], (unsigned)__builtin_amdgcn_readfirstlane((int)(ldsbase + (s) * STGW + 49152 + ldsw + _i * 8192))); } } while (0)
    pg8::Unit cur, nxt; int ui = 0;
    if (!S.next(0, cur)) return;
    cur.pm = __builtin_amdgcn_readfirstlane(cur.pm); cur.pn = __builtin_amdgcn_readfirstlane(cur.pn);
    const unsigned char* cA = g.A + (size_t)cur.pm * 256 * K; const unsigned char* cB = g.Bt + (size_t)cur.pn * 256 * K;
    bool has_next = S.next(1, nxt);
    nxt.pm = __builtin_amdgcn_readfirstlane(nxt.pm); nxt.pn = __builtin_amdgcn_readfirstlane(nxt.pn);
    const unsigned char* nA = has_next ? g.A + (size_t)nxt.pm * 256 * K : cA; const unsigned char* nB = has_next ? g.Bt + (size_t)nxt.pn * 256 * K : cB;
    F8W_STAGE(0, cA, cB, 0);
    asm volatile("s_waitcnt vmcnt(0)" ::: "memory"); __builtin_amdgcn_s_barrier(); asm volatile("" ::: "memory");
    int st = 0;
    for (;;) {
        f32x4 acc[4][8];
#pragma unroll
        for (int m = 0; m < 4; ++m)
#pragma unroll
            for (int n = 0; n < 8; ++n) acc[m][n] = ozero4();
        for (int t = 0; t < nt; ++t) {
            if (t + 1 < nt) F8W_STAGE(st ^ 1, cA, cB, t + 1); else F8W_STAGE(st ^ 1, nA, nB, 0);
            v8i_t af[4];
            const LAS unsigned char* sb = lds + st * STGW;
#pragma unroll
            for (int m = 0; m < 4; ++m) { const v4i_t lo_ = *(const LAS v4i_t*)(sb + aoff0 + m * 2048), hi_ = *(const LAS v4i_t*)(sb + aoff1 + m * 2048); af[m] = __builtin_shufflevector(lo_, hi_, 0, 1, 2, 3, 4, 5, 6, 7); }
#pragma unroll
            for (int h2 = 0; h2 < 4; ++h2) {
                v8i_t bfr[2];
#pragma unroll
                for (int n = 0; n < 2; ++n) { const v4i_t lo_ = *(const LAS v4i_t*)(sb + boff0 + (2 * h2 + n) * 2048), hi_ = *(const LAS v4i_t*)(sb + boff1 + (2 * h2 + n) * 2048); bfr[n] = __builtin_shufflevector(lo_, hi_, 0, 1, 2, 3, 4, 5, 6, 7); }
                asm volatile("s_waitcnt lgkmcnt(0)" ::: "memory"); __builtin_amdgcn_sched_barrier(0);
                __builtin_amdgcn_s_setprio(1);
#pragma unroll
                for (int m = 0; m < 4; ++m)
#pragma unroll
                    for (int n = 0; n < 2; ++n) acc[m][2 * h2 + n] = __builtin_amdgcn_mfma_scale_f32_16x16x128_f8f6f4(bfr[n], af[m], acc[m][2 * h2 + n], 0, 0, 0, 0x7a7a7a7a, 0, 0x7f7f7f7f);
                __builtin_amdgcn_s_setprio(0);
                __builtin_amdgcn_sched_barrier(0);
            }
            asm volatile("s_waitcnt vmcnt(0)" ::: "memory"); __builtin_amdgcn_s_barrier(); asm volatile("" ::: "memory");
            st ^= 1;
        }
        E(acc, cur, wr, wc, fr, fq);
        if (!has_next) break;
        cur = nxt; cA = nA; cB = nB; ++ui;
        has_next = S.next(ui + 1, nxt);
        nxt.pm = __builtin_amdgcn_readfirstlane(nxt.pm); nxt.pn = __builtin_amdgcn_readfirstlane(nxt.pn);
        nA = has_next ? g.A + (size_t)nxt.pm * 256 * K : cA; nB = has_next ? g.Bt + (size_t)nxt.pn * 256 * K : cB;
    }
    asm volatile("s_waitcnt vmcnt(0)" ::: "memory"); __builtin_amdgcn_s_barrier(); asm volatile("" ::: "memory");
#undef F8W_STAGE
}
}

#define GAS __attribute__((address_space(1)))
#define LAS __attribute__((address_space(3)))
typedef unsigned short bf16;
typedef float f32x4 __attribute__((ext_vector_type(4)));
typedef float f32x2 __attribute__((ext_vector_type(2)));
typedef unsigned u32x4 __attribute__((ext_vector_type(4)));
typedef unsigned u32x2 __attribute__((ext_vector_type(2)));
typedef short bf16x8 __attribute__((ext_vector_type(8)));
typedef GAS unsigned gu32;

constexpr int NTHREADS = 512, NWAVES = 8;
constexpr int D = 1024, NB = 8, S = 2048, M = NB * S, DEPTH = 2;
constexpr int D_IN = 7120, NV = 7168;
constexpr int NE = 32, TOPK = 4, NPAIR = M * TOPK, MP = NPAIR + NE * 256;
constexpr float EPS = 1e-6f;
enum { I_X = 0, I_C, I_WADA, I_BADA, I_WIN, I_BIN, I_CONVW, I_CONVB, I_MLG, I_KVG, I_WUK, I_WUV, I_WBRML, I_WBRDSA, I_WBRFOX, I_WOUT, I_WR, I_BR, I_W1, I_B1, I_W2, I_B2, I_FG };

constexpr size_t MiB = 1u << 20;
constexpr size_t WS_CTL = 0, CTL_ZERO_BYTES = 1 * MiB;
constexpr size_t WS_MOD = 1 * MiB;
constexpr size_t WS_BINP = 2 * MiB;
constexpr size_t WS_WRT = 3 * MiB;
constexpr size_t WS_EIDX = 4 * MiB, WS_GATE = WS_EIDX + 256 * 1024, WS_LRANK = WS_GATE + 256 * 1024, WS_PPOS = WS_LRANK + 256 * 1024, WS_BASE = WS_PPOS + 256 * 1024;
constexpr size_t WS_ROWGATE = 6 * MiB;
constexpr size_t WS_WOUT_T = 8 * MiB;
constexpr size_t WS_WBR_T = 12 * MiB;
constexpr size_t WS_WIN_T = 18 * MiB;
constexpr size_t WS_W1T = 48 * MiB;
constexpr size_t WS_W2T = 304 * MiB;
constexpr size_t WS_X = 432 * MiB;
constexpr size_t WS_XN = 496 * MiB;
constexpr size_t WS_XNL = 528 * MiB;
constexpr size_t WS_ASORT = 560 * MiB;
constexpr size_t WS_ACT = 704 * MiB;
constexpr size_t WS_END = 848 * MiB;
constexpr size_t WS_XN1_8_ = 1352 * MiB, WS_WIN8_ = 1368 * MiB, WS_WOUT8_ = 1400 * MiB;
constexpr size_t WS_XN8 = 1336 * MiB;
constexpr size_t WS_AS8 = WS_ACT, WS_ACT8 = WS_ACT + 72 * MiB;
constexpr size_t WS_DRY = 1208 * MiB;
constexpr int CW_GCNT = 64;
constexpr int CW_BAR = 4096;

constexpr int RING_BYTES = 147456;
constexpr int LDSCTL_OFF = RING_BYTES, MISC_OFF = LDSCTL_OFF + 320;
constexpr int LDS_BYTES = 163840;

__device__ __forceinline__ unsigned f2bf(float f) { unsigned u = __builtin_bit_cast(unsigned, f); return (u + 0x7fffu + ((u >> 16) & 1u)) >> 16; }
__device__ __forceinline__ float bf2f(unsigned b) { return __builtin_bit_cast(float, b << 16); }
__device__ __forceinline__ unsigned pk2(float lo, float hi) { return f2bf(lo) | (f2bf(hi) << 16); }
__device__ __forceinline__ unsigned pk4_fp8(float a, float b, float c, float d) { int w = 0; w = __builtin_amdgcn_cvt_pk_fp8_f32(a, b, w, false); w = __builtin_amdgcn_cvt_pk_fp8_f32(c, d, w, true); return (unsigned)w; }
#define LDS_WAIT() asm volatile("s_waitcnt lgkmcnt(0)" ::: "memory")
#define VM_WAIT() asm volatile("s_waitcnt vmcnt(0)" ::: "memory")

#define XB_TMO      128
#define XB_XCNT(j)  (256  + 64 * (j))
#define XB_XSUB(j)  (1280 + 64 * (j))
#define XB_XGEN(j)  (2304 + 64 * (j))
#define XB_TOP      3328
#define XB_TOPGEN   3392
#define XCD_BAR_WORDS 3456
#define XB_SPIN_CAP (1u << 22)
__device__ __forceinline__ unsigned xb_ld(unsigned* p)              { return __hip_atomic_load(p, __ATOMIC_RELAXED, __HIP_MEMORY_SCOPE_AGENT); }
__device__ __forceinline__ unsigned xb_add(unsigned* p, unsigned v) { return __hip_atomic_fetch_add(p, v, __ATOMIC_RELAXED, __HIP_MEMORY_SCOPE_AGENT); }
__device__ __forceinline__ unsigned xb_xcc_id() { return (unsigned)__builtin_amdgcn_s_getreg((3 << 11) | 20) & 0xFu; }
#define XB_SPIN(cond, bar) do { unsigned _sp = 0; while (cond) { __builtin_amdgcn_s_sleep(1); \
    if ((++_sp & 255u) == 0u) { if (xb_ld(&(bar)[XB_TMO])) break; if (_sp > XB_SPIN_CAP) { atomicAdd(&(bar)[XB_TMO], 1u); break; } } } } while (0)
struct XcdBarrier { unsigned* bar; unsigned x; volatile LAS unsigned* st; bool t0; };
__device__ __forceinline__ XcdBarrier xcd_barrier_post(unsigned* bar, volatile LAS unsigned* st, bool t0) {
    XcdBarrier b; b.bar = bar; b.x = xb_xcc_id(); b.st = st; b.t0 = t0;
    if (t0) (void)xb_add(&bar[XB_XCNT(b.x)], 1u);
    return b;
}
__device__ __forceinline__ void xcd_barrier_complete(unsigned* bar, unsigned x, unsigned& nloc, unsigned& nx) {
    const unsigned G = gridDim.x * gridDim.y * gridDim.z;
    unsigned sum, cnt, mine, sp = 0u;
    for (;;) {
        sum = 0u; cnt = 0u; mine = 0u;
#pragma unroll
        for (unsigned j = 0; j < 16; ++j) { const unsigned c = xb_ld(&bar[XB_XCNT(j)]); sum += c; cnt += (c > 0u) ? 1u : 0u; mine = (j == x) ? c : mine; }
        if (sum == G) break;
        __builtin_amdgcn_s_sleep(1);
        if ((++sp & 255u) == 0u) { if (xb_ld(&bar[XB_TMO])) break; if (sp > XB_SPIN_CAP) { atomicAdd(&bar[XB_TMO], 1u); break; } }
    }
    nloc = mine > 0u ? mine : 1u; nx = cnt > 0u ? cnt : 1u;
}
__device__ __forceinline__ void xcd_barrier(const XcdBarrier& b) {
    asm volatile("s_waitcnt vmcnt(0)" ::: "memory");
    __syncthreads();
    if (b.t0) {
        unsigned* bar = b.bar;
        __builtin_amdgcn_s_waitcnt(0);
        unsigned nloc = b.st[0], nx = b.st[1];
        if (nloc == 0u) { xcd_barrier_complete(bar, b.x, nloc, nx); b.st[0] = nloc; b.st[1] = nx; }
        const unsigned old = xb_add(&bar[XB_XSUB(b.x)], 1u);
        const unsigned gen = old / nloc;
        if (old + 1u == (gen + 1u) * nloc) {
            __builtin_amdgcn_fence(__ATOMIC_RELEASE, "agent");
            asm volatile("s_waitcnt vmcnt(0)" ::: "memory");
            const unsigned og = xb_add(&bar[XB_TOP], 1u);
            const unsigned tg = og / nx;
            if (og + 1u == (tg + 1u) * nx) xb_add(&bar[XB_TOPGEN], 1u);
            else XB_SPIN(xb_ld(&bar[XB_TOPGEN]) == tg, bar);
            __builtin_amdgcn_fence(__ATOMIC_ACQUIRE, "agent");
            xb_add(&bar[XB_XGEN(b.x)], 1u);
            asm volatile("s_waitcnt vmcnt(0)" ::: "memory");
        } else {
            XB_SPIN(xb_ld(&bar[XB_XGEN(b.x)]) == gen, bar);
            __builtin_amdgcn_fence(__ATOMIC_ACQUIRE, "agent");
            asm volatile("s_waitcnt vmcnt(0)" ::: "memory");
        }
    }
    __syncthreads();
}

__device__ __forceinline__ float wave_sum(float v) {
    v += __builtin_bit_cast(float, __builtin_amdgcn_update_dpp(0, __builtin_bit_cast(int, v), 0x128, 0xf, 0xf, false));
    v += __builtin_bit_cast(float, __builtin_amdgcn_update_dpp(0, __builtin_bit_cast(int, v), 0x124, 0xf, 0xf, false));
    v += __builtin_bit_cast(float, __builtin_amdgcn_update_dpp(0, __builtin_bit_cast(int, v), 0x122, 0xf, 0xf, false));
    v += __builtin_bit_cast(float, __builtin_amdgcn_update_dpp(0, __builtin_bit_cast(int, v), 0x121, 0xf, 0xf, false));
    const int b = __builtin_bit_cast(int, v);
    return (__builtin_bit_cast(float, __builtin_amdgcn_readlane(b, 0)) + __builtin_bit_cast(float, __builtin_amdgcn_readlane(b, 16))) + (__builtin_bit_cast(float, __builtin_amdgcn_readlane(b, 32)) + __builtin_bit_cast(float, __builtin_amdgcn_readlane(b, 48)));
}

struct Args { const float* in[23]; float* out; unsigned char* ws; };
struct Frame { LAS unsigned char* lds; int tid, wave; };
#define KARGS ((const __attribute__((address_space(4))) Args*)__builtin_amdgcn_kernarg_segment_ptr())
#define KWS ((GAS unsigned char*)KARGS->ws)
#define KOUT ((GAS float*)KARGS->out)
#define KCTL ((GAS unsigned*)(KWS + WS_CTL))
#define GRIDN ((int)gridDim.x)
__device__ __forceinline__ int vcu_id() { const int G = gridDim.x, bx = blockIdx.x; return (G % 8 == 0) ? (bx % 8) * (G / 8) + bx / 8 : bx; }
#define WSP(T, off) ((T*)(KWS + (off)))
#define KIN(i) ((const float*)(((const __attribute__((address_space(4))) Args*)__builtin_amdgcn_kernarg_segment_ptr())->in[i]))
#define PHASE_BEGIN() do { asm volatile("" : "+s"(F.wave)); F.tid = F.wave * 64 + hw_lane(); } while (0)

__device__ __forceinline__ int vcol_real(int v) {
    if (v < 1536) return v;
    if (v < 2048) return -1;
    if (v < 2176) return 2056 + (v - 2048);
    if (v < 2240) return 2440 + (v - 2176);
    if (v < 2244) return 1536 + (v - 2240);
    if (v < 2248) return 1540 + (v - 2244);
    if (v < 2252) return 2504 + (v - 2248);
    if (v < 2256) return 4044 + (v - 2252);
    if (v < 2304) return -1;
    if (v < 2560) return 2184 + (v - 2304);
    if (v < 4096) return 2508 + (v - 2560);
    return 4048 + (v - 4096);
}
struct P0Item { const float* W; bf16* WT; int ldw, K, destrow0, k0, srccol4; bool valid, fp8; };
__device__ __forceinline__ void p0_load(const P0Item& d, f32x4 (&v)[8], int lane) {
    const int kr = lane >> 3;
#pragma unroll
    for (int i = 0; i < 8; ++i) v[i] = (d.valid && d.srccol4 >= 0) ? *(const f32x4*)(d.W + (size_t)(d.k0 + 8 * i + kr) * d.ldw + d.srccol4) : (f32x4){0.f, 0.f, 0.f, 0.f};
}
__device__ __forceinline__ void p0_finish(const P0Item& d, const f32x4 (&v)[8], LAS float* scr, int lane) {
    if (!d.valid) return;
    const int kr = lane >> 3, n4 = 4 * (lane & 7);
#pragma unroll
    for (int i = 0; i < 8; ++i) *(LAS f32x4*)(scr + (8 * i + kr) * 36 + n4) = v[i];
    LDS_WAIT(); asm volatile("" ::: "memory");
    const int c = lane & 7;
#pragma unroll
    for (int j = 0; j < 4; ++j) { const int n = (lane >> 3) + 8 * j; const LAS float* s = scr + (8 * c) * 36 + n;
        if (d.fp8) { u32x2 o; o.x = pk4_fp8(32.f * s[0 * 36], 32.f * s[1 * 36], 32.f * s[2 * 36], 32.f * s[3 * 36]); o.y = pk4_fp8(32.f * s[4 * 36], 32.f * s[5 * 36], 32.f * s[6 * 36], 32.f * s[7 * 36]);
            *(u32x2*)((unsigned char*)d.WT + (size_t)(d.destrow0 + n) * d.K + d.k0 + 8 * c) = o; }
        else { u32x4 o; o.x = pk2(s[0 * 36], s[1 * 36]); o.y = pk2(s[2 * 36], s[3 * 36]); o.z = pk2(s[4 * 36], s[5 * 36]); o.w = pk2(s[6 * 36], s[7 * 36]);
            *(u32x4*)(d.WT + (size_t)(d.destrow0 + n) * d.K + d.k0 + 8 * c) = o; } }
    LDS_WAIT(); asm volatile("" ::: "memory");
}
__device__ __forceinline__ void p0_moe_weights(Frame& F) {
    PHASE_BEGIN();
    const int tid = F.tid, lane = tid & 63, w = F.wave;
    constexpr int NI1 = 64 * 8 * 8, NI2 = 64 * 8 * 4;
    __syncthreads();
    int buf = 0;
#define P0M_DECODE(it_, is1_, le_, kt_, nb_, Wp_) const bool is1_ = (it_) < NI1; const int r_##it_ = is1_ ? (it_) : (it_) - NI1; \
        const int le_ = is1_ ? r_##it_ >> 6 : r_##it_ >> 5, kt_ = is1_ ? (r_##it_ >> 3) & 7 : (r_##it_ >> 2) & 7, nb_ = is1_ ? r_##it_ & 7 : r_##it_ & 3, ldw_##it_ = is1_ ? 2048 : 1024; \
        const float* Wp_ = (is1_ ? KIN(I_W1) + (size_t)le_ * 1024 * 2048 : KIN(I_W2) + (size_t)le_ * 1024 * 1024) + (size_t)(kt_ * 128 + 16 * w) * ldw_##it_ + nb_ * 256 + 4 * lane;
    f32x4 v[16], vn[16];
    { const int it0 = blockIdx.x; if (it0 < NI1 + NI2) { P0M_DECODE(it0, a_, b_, c_, d_, Wq)
#pragma unroll
        for (int i = 0; i < 16; ++i) v[i] = __builtin_nontemporal_load((const f32x4*)(Wq + (size_t)i * ldw_it0)); } }
    for (int it = blockIdx.x; it < NI1 + NI2; it += GRIDN) {
        P0M_DECODE(it, is1, le, kt, nb, W)
        (void)W;
        { const int itn = it + GRIDN; if (itn < NI1 + NI2) { P0M_DECODE(itn, a_, b_, c_, d_, Wq)
#pragma unroll
            for (int i = 0; i < 16; ++i) vn[i] = __builtin_nontemporal_load((const f32x4*)(Wq + (size_t)i * ldw_itn)); } }
        LAS unsigned* T = (LAS unsigned*)(F.lds + buf * 32768);
#pragma unroll
        for (int g = 0; g < 4; ++g) {
            unsigned d[4];
#pragma unroll
            for (int q = 0; q < 4; ++q) d[q] = pk4_fp8(32.f * v[4 * g + q].x, 32.f * v[4 * g + q].y, 32.f * v[4 * g + q].z, 32.f * v[4 * g + q].w);
            const unsigned x0 = __builtin_amdgcn_perm(d[1], d[0], 0x05010400u), x1 = __builtin_amdgcn_perm(d[1], d[0], 0x07030602u), y0 = __builtin_amdgcn_perm(d[3], d[2], 0x05010400u), y1 = __builtin_amdgcn_perm(d[3], d[2], 0x07030602u);
            const unsigned t[4] = {__builtin_amdgcn_perm(y0, x0, 0x05040100u), __builtin_amdgcn_perm(y0, x0, 0x07060302u), __builtin_amdgcn_perm(y1, x1, 0x05040100u), __builtin_amdgcn_perm(y1, x1, 0x07060302u)};
#pragma unroll
            for (int c = 0; c < 4; ++c) T[(4 * lane + c) * 32 + ((4 * w + g) ^ (lane & 31))] = t[c];
        }
        __syncthreads();
        unsigned char* WT = is1 ? WSP(unsigned char, WS_W1T) + (size_t)le * 2048 * 1024 : WSP(unsigned char, WS_W2T) + (size_t)le * 1024 * 1024;
#pragma unroll
        for (int j = 0; j < 4; ++j) { const int n = (tid >> 3) + 64 * j, c8 = tid & 7, sw = (n >> 2) & 31;
            u32x4 o; o.x = T[n * 32 + ((4 * c8 + 0) ^ sw)]; o.y = T[n * 32 + ((4 * c8 + 1) ^ sw)]; o.z = T[n * 32 + ((4 * c8 + 2) ^ sw)]; o.w = T[n * 32 + ((4 * c8 + 3) ^ sw)];
            const int rc = nb * 256 + n; int vrow = rc;
            if (is1) { const int half = rc >> 10, c = rc & 1023; vrow = (c >> 7) * 256 + ((c >> 6) & 1) * 128 + ((c >> 2) & 15) * 8 + 4 * half + (c & 3); }
            __builtin_nontemporal_store(o, (u32x4*)(WT + (size_t)vrow * 1024 + kt * 128 + 16 * c8)); }
        buf ^= 1;
#pragma unroll
        for (int i = 0; i < 16; ++i) v[i] = vn[i];
    }
#undef P0M_DECODE
    __syncthreads();
}
__device__ __forceinline__ void p0_prologue(Frame& F) {
    PHASE_BEGIN();
    const int tid = F.tid, lane = (F.tid & 63);
    {
        LAS float* cond = (LAS float*)F.lds;
        LAS float* part = (LAS float*)(F.lds + 32768);
        bool staged = false;
        for (int it = blockIdx.x; it < 2 * 96; it += GRIDN) {
            if (!staged) { for (int i = tid; i < 8 * 1024; i += NTHREADS) { const float v = KIN(I_C)[i]; cond[i] = v / (1.f + __expf(-v)); } staged = true; }
            __syncthreads();
            const int l = it / 96, cb = it % 96, ks = tid >> 6, col = tid & 63, n = cb * 64 + col;
            const float* w = KIN(I_WADA) + (size_t)l * 1024 * 6144 + n;
            float a[8];
#pragma unroll
            for (int b = 0; b < 8; ++b) a[b] = 0.f;
            for (int k = ks * 128; k < ks * 128 + 128; ++k) { const float wv = w[(size_t)k * 6144];
#pragma unroll
                for (int b = 0; b < 8; ++b) a[b] += cond[b * 1024 + k] * wv; }
#pragma unroll
            for (int b = 0; b < 8; ++b) part[(ks * 8 + b) * 64 + col] = a[b];
            __syncthreads();
            { const int b = tid >> 6; float s = 0.f;
#pragma unroll
              for (int q = 0; q < 8; ++q) s += part[(q * 8 + b) * 64 + col];
              WSP(float, WS_MOD)[((size_t)l * 8 + b) * 6144 + n] = s + KIN(I_BADA)[l * 6144 + n]; }
        }
        __syncthreads();
    }
    {
        LAS float* As = (LAS float*)F.lds;
        LAS float* Us = (LAS float*)(F.lds + 64 * 129 * 4);
        for (int it = blockIdx.x; it < 128; it += GRIDN) {
            const int l = it >> 6, h = (it >> 4) & 3, kb = it & 15, k0 = kb * 64;
            __syncthreads();
            for (int i = tid; i < 64 * 128; i += NTHREADS) { const int k = i >> 7, d = i & 127; As[k * 129 + d] = KIN(I_WIN)[((size_t)l * 1024 + k0 + k) * D_IN + 1544 + h * 128 + d]; }
            for (int i = tid; i < 128 * 128; i += NTHREADS) { const int c = i >> 7, d = i & 127; Us[c * 129 + d] = KIN(I_WUK)[(((size_t)l * 4 + h) * 128 + c) * 128 + d]; }
            __syncthreads();
            const int c = tid & 127, kq = tid >> 7; float a[16];
#pragma unroll
            for (int i = 0; i < 16; ++i) a[i] = 0.f;
            for (int d = 0; d < 128; ++d) { const float u = Us[c * 129 + d];
#pragma unroll
                for (int i = 0; i < 16; ++i) a[i] += u * As[(kq * 16 + i) * 129 + d]; }
            const float sc = 0.08838834764831845f;
            bf16* dst = WSP(bf16, WS_WIN_T) + ((size_t)l * NV + 1536 + h * 128 + c) * 1024 + k0 + kq * 16;
            u32x4 o0, o1; o0.x = pk2(a[0] * sc, a[1] * sc); o0.y = pk2(a[2] * sc, a[3] * sc); o0.z = pk2(a[4] * sc, a[5] * sc); o0.w = pk2(a[6] * sc, a[7] * sc);
            o1.x = pk2(a[8] * sc, a[9] * sc); o1.y = pk2(a[10] * sc, a[11] * sc); o1.z = pk2(a[12] * sc, a[13] * sc); o1.w = pk2(a[14] * sc, a[15] * sc);
            *(u32x4*)dst = o0; *(u32x4*)(dst + 8) = o1;
            if (kb == 0 && kq == 0) { float s = 0.f; for (int d = 0; d < 128; ++d) s += Us[c * 129 + d] * KIN(I_BIN)[l * D_IN + 1544 + h * 128 + d];
                WSP(float, WS_BINP)[l * NV + 1536 + h * 128 + c] = s * sc; }
        }
        __syncthreads();
    }
    {
        LAS float* Us = (LAS float*)F.lds;
        LAS float* Bs = (LAS float*)(F.lds + 128 * 129 * 4);
        for (int it = blockIdx.x; it < 128; it += GRIDN) {
            const int l = it >> 6, h = (it >> 4) & 3, nb = it & 15, n0 = nb * 64;
            __syncthreads();
            for (int i = tid; i < 128 * 128; i += NTHREADS) { const int c = i >> 7, d = i & 127; Us[c * 129 + d] = KIN(I_WUV)[(((size_t)l * 4 + h) * 128 + c) * 128 + d]; }
            for (int i = tid; i < 128 * 64; i += NTHREADS) { const int d = i >> 6, n = i & 63; Bs[d * 65 + n] = KIN(I_WBRDSA)[((size_t)l * 512 + h * 128 + d) * 1024 + n0 + n]; }
            __syncthreads();
            const int c = tid & 127, nq = tid >> 7; float a[16];
#pragma unroll
            for (int i = 0; i < 16; ++i) a[i] = 0.f;
            for (int d = 0; d < 128; ++d) { const float u = Us[c * 129 + d];
#pragma unroll
                for (int i = 0; i < 16; ++i) a[i] += u * Bs[d * 65 + nq * 16 + i]; }
#pragma unroll
            for (int i = 0; i < 16; ++i) WSP(bf16, WS_WBR_T)[((size_t)l * 3072 + 1024 + n0 + nq * 16 + i) * 512 + h * 128 + c] = (bf16)f2bf(a[i]);
        }
        __syncthreads();
    }
    for (int i = blockIdx.x * NTHREADS + tid; i < 2 * 32 * 1024; i += GRIDN * NTHREADS) { const int l = i >> 15, e = (i >> 10) & 31, k = i & 1023;
        const float w = KIN(I_WR)[((size_t)l * 1024 + k) * 32 + e]; const unsigned hi = f2bf(w), lo = f2bf(w - bf2f(hi));
        WSP(bf16, WS_WRT)[((size_t)l * 2 + 0) * 32768 + e * 1024 + k] = (bf16)hi; WSP(bf16, WS_WRT)[((size_t)l * 2 + 1) * 32768 + e * 1024 + k] = (bf16)lo; }
    for (int i = blockIdx.x * NTHREADS + tid; i < 2 * NV; i += GRIDN * NTHREADS) { const int l = i / NV, v = i % NV; const int r = vcol_real(v);
        if (!(v >= 1536 && v < 2048)) WSP(float, WS_BINP)[i] = r >= 0 ? KIN(I_BIN)[l * D_IN + r] : 0.f; }
    LAS float* scr = (LAS float*)(F.lds + F.wave * 16384);
    const int gw = vcu_id() * NWAVES + F.wave, NGW = GRIDN * NWAVES;
    constexpr int IT_IN = 16 * (NV / 32), IT_BR = 8 * 32, IT_OUT = 16 * 32;
    constexpr int N_IN = 2 * IT_IN, N_BR = 2 * 2 * IT_BR, N_OUT = 2 * IT_OUT;
    constexpr int IT_IN8 = 16 * (24 * 8), N_IN8 = 2 * IT_IN8;
    constexpr int N_ALL = N_IN + N_BR + N_OUT + N_IN8;
    auto decode = [&](int it) -> P0Item {
        P0Item d; d.fp8 = false; d.valid = it < N_ALL; d.W = nullptr; d.WT = nullptr; d.ldw = 0; d.K = 0; d.destrow0 = 0; d.k0 = 0; d.srccol4 = -1;
        if (!d.valid) return d;
        int r = it;
        if (r < N_IN) { const int l = r / IT_IN, q = r % IT_IN, kb = q / (NV / 32), nb = q % (NV / 32), v = nb * 32 + 4 * (lane & 7);
            if (nb < 48 || nb >= 80) { d.valid = false; return d; }
            if (nb * 32 >= 1536 && nb * 32 < 2048) { d.valid = false; return d; }
            d.W = KIN(I_WIN) + (size_t)l * 1024 * D_IN; d.ldw = D_IN; d.K = 1024; d.WT = WSP(bf16, WS_WIN_T) + (size_t)l * NV * 1024; d.destrow0 = nb * 32; d.k0 = kb * 64; d.srccol4 = vcol_real(v); return d; }
        r -= N_IN;
        if (r < N_BR) { const int l = r / (2 * IT_BR), q = r % (2 * IT_BR), which = q / IT_BR, q2 = q % IT_BR, kb = q2 / 32, nb = q2 % 32;
            d.W = (which ? KIN(I_WBRFOX) : KIN(I_WBRML)) + (size_t)l * 512 * 1024; d.ldw = 1024; d.K = 512; d.WT = WSP(bf16, WS_WBR_T) + (size_t)l * 3072 * 512; d.destrow0 = (which ? 2048 : 0) + nb * 32; d.k0 = kb * 64; d.srccol4 = nb * 32 + 4 * (lane & 7); return d; }
        r -= N_BR;
        if (r < N_OUT) { const int l = r / IT_OUT, q = r % IT_OUT, kb = q / 32, nb = q % 32;
            d.fp8 = true; d.W = KIN(I_WOUT) + (size_t)l * 1024 * 1024; d.ldw = 1024; d.K = 1024; d.WT = (bf16*)(WSP(unsigned char, WS_WOUT8_) + (size_t)l * 1024 * 1024); d.destrow0 = nb * 32; d.k0 = kb * 64; d.srccol4 = nb * 32 + 4 * (lane & 7); return d; }
        r -= N_OUT;
        if (r < N_IN8) { const int l = r / IT_IN8, q = r % IT_IN8, kb = q / 192, nv = q % 192, tv = nv >> 3, nb = (tv < 6 ? tv : tv + 4) * 8 + (nv & 7), v = nb * 32 + 4 * (lane & 7);
            d.fp8 = true; d.W = KIN(I_WIN) + (size_t)l * 1024 * D_IN; d.ldw = D_IN; d.K = 1024; d.WT = (bf16*)(WSP(unsigned char, WS_WIN8_) + (size_t)l * NV * 1024); d.destrow0 = nb * 32; d.k0 = kb * 64; d.srccol4 = vcol_real(v); return d; }
        d.valid = false; return d;
    };
    P0Item cur = decode(gw); f32x4 vc[8], vn[8]; p0_load(cur, vc, lane);
    for (int it = gw; it < N_ALL; it += NGW) {
        const P0Item nxt = decode(it + NGW); p0_load(nxt, vn, lane);
        p0_finish(cur, vc, scr, lane);
        cur = nxt;
#pragma unroll
        for (int i = 0; i < 8; ++i) vc[i] = vn[i];
    }
}

__device__ __forceinline__ void norm_rows(Frame& F, const float* xsrc, int l, int shoff, int scoff) {
    PHASE_BEGIN();
    const int gw = blockIdx.x * NWAVES + F.wave, lane = (F.tid & 63), c0 = 16 * lane, m0 = gw * 8;
    const float* mo = WSP(float, WS_MOD) + (size_t)l * 8 * 6144 + (size_t)(m0 >> 11) * 6144; bf16* XN = WSP(bf16, WS_XN);
    f32x4 sh[4], sc[4];
#pragma unroll
    for (int q = 0; q < 4; ++q) { sh[q] = *(const f32x4*)(mo + shoff + c0 + 4 * q); sc[q] = *(const f32x4*)(mo + scoff + c0 + 4 * q); }
    for (int t = 0; t < 8; ++t) {
        const int m = m0 + t;
        f32x4 v[4]; float s = 0.f;
#pragma unroll
        for (int q = 0; q < 4; ++q) { v[q] = *(const f32x4*)(xsrc + (size_t)m * D + c0 + 4 * q); s += (v[q].x * v[q].x + v[q].y * v[q].y) + (v[q].z * v[q].z + v[q].w * v[q].w); }
        const float r = 1.0f / sqrtf(wave_sum(s) * (1.0f / D) + EPS);
        unsigned wb[8], w8[4];
#pragma unroll
        for (int q = 0; q < 4; ++q) { const f32x4 h = v[q] * r * (1.0f + sc[q]) + sh[q]; wb[2 * q] = pk2(h.x, h.y); wb[2 * q + 1] = pk2(h.z, h.w); w8[q] = pk4_fp8(h.x, h.y, h.z, h.w); }
        *(u32x4*)(XN + (size_t)m * D + c0) = (u32x4){wb[0], wb[1], wb[2], wb[3]}; *(u32x4*)(XN + (size_t)m * D + c0 + 8) = (u32x4){wb[4], wb[5], wb[6], wb[7]};
        *(u32x4*)(WSP(unsigned char, WS_XN1_8_) + (size_t)m * D + c0) = (u32x4){w8[0], w8[1], w8[2], w8[3]};
    }
}
__device__ __forceinline__ void route_phase(Frame& F, int l, const float* xsrc, bool dry = false) {
    PHASE_BEGIN();
    LAS int* lcnt = (LAS int*)F.lds;
    LAS float* lg = (LAS float*)(F.lds + 1024);
    const int tid = F.tid, lane = (F.tid & 63), w = F.wave;
    if (tid < 32) lcnt[tid] = 0;
    const float* modl = WSP(float, WS_MOD) + (size_t)l * 8 * 6144;
    bf16* XN = dry ? WSP(bf16, WS_DRY) : WSP(bf16, WS_XN); bf16* XNL = dry ? WSP(bf16, WS_DRY + 32 * MiB) : WSP(bf16, WS_XNL);
    const bf16* WH = WSP(bf16, WS_WRT) + (size_t)l * 2 * 32768; const bf16* WL = WH + 32768;
    for (int rb = blockIdx.x; rb < M / 64; rb += GRIDN) {
        __syncthreads();
        {
            const int c0 = 16 * lane; const float* mo = modl + (size_t)((rb * 64) >> 11) * 6144;
            f32x4 sh[4], sc[4];
#pragma unroll
            for (int q = 0; q < 4; ++q) { sh[q] = *(const f32x4*)(mo + 3072 + c0 + 4 * q); sc[q] = *(const f32x4*)(mo + 4096 + c0 + 4 * q); }
            unsigned char* XN8 = dry ? WSP(unsigned char, WS_DRY + 100 * MiB) : WSP(unsigned char, WS_XN8);
            for (int i0 = 0; i0 < 8; i0 += 4) {
              f32x4 vv[4][4];
#pragma unroll
              for (int i = 0; i < 4; ++i)
#pragma unroll
                for (int q = 0; q < 4; ++q) vv[i][q] = *(const f32x4*)(xsrc + (size_t)(rb * 64 + w * 8 + i0 + i) * D + c0 + 4 * q);
#pragma unroll
              for (int i = 0; i < 4; ++i) {
                const int m = rb * 64 + w * 8 + i0 + i;
                f32x4 v[4]; float s = 0.f;
#pragma unroll
                for (int q = 0; q < 4; ++q) { v[q] = vv[i][q]; s += (v[q].x * v[q].x + v[q].y * v[q].y) + (v[q].z * v[q].z + v[q].w * v[q].w); }
                const float r = 1.0f / sqrtf(wave_sum(s) * (1.0f / D) + EPS);
                unsigned wh[8], wl[8], w8[4];
#pragma unroll
                for (int q = 0; q < 4; ++q) { const f32x4 h = v[q] * r * (1.0f + sc[q]) + sh[q];
                    const unsigned h0 = f2bf(h.x), h1 = f2bf(h.y), h2 = f2bf(h.z), h3 = f2bf(h.w);
                    wh[2 * q] = h0 | (h1 << 16); wh[2 * q + 1] = h2 | (h3 << 16);
                    wl[2 * q] = pk2(h.x - bf2f(h0), h.y - bf2f(h1)); wl[2 * q + 1] = pk2(h.z - bf2f(h2), h.w - bf2f(h3)); w8[q] = pk4_fp8(h.x, h.y, h.z, h.w); }
                *(u32x4*)(XN + (size_t)m * D + c0) = (u32x4){wh[0], wh[1], wh[2], wh[3]}; *(u32x4*)(XN + (size_t)m * D + c0 + 8) = (u32x4){wh[4], wh[5], wh[6], wh[7]};
                *(u32x4*)(XNL + (size_t)m * D + c0) = (u32x4){wl[0], wl[1], wl[2], wl[3]}; *(u32x4*)(XNL + (size_t)m * D + c0 + 8) = (u32x4){wl[4], wl[5], wl[6], wl[7]};
                *(u32x4*)(XN8 + (size_t)m * D + c0) = (u32x4){w8[0], w8[1], w8[2], w8[3]};
              }
            }
        }
        const int fr = lane & 15, kq = lane >> 4, kb = 128 * w + 8 * kq;
        const bf16* pbh = WH + (size_t)fr * 1024 + kb; const bf16* pbl = WL + (size_t)fr * 1024 + kb;
        bf16x8 bhn[2], bln[2];
#pragma unroll
        for (int et = 0; et < 2; ++et) { bhn[et] = *(const bf16x8*)(pbh + et * 16 * 1024); bln[et] = *(const bf16x8*)(pbl + et * 16 * 1024); }
        VM_WAIT(); __builtin_amdgcn_fence(__ATOMIC_ACQUIRE, "agent"); VM_WAIT(); __syncthreads();
        {
            f32x4 acc[4][2];
#pragma unroll
            for (int rt = 0; rt < 4; ++rt) { acc[rt][0] = ozero4(); acc[rt][1] = acc[rt][0]; }
            const bf16* pa = XN + (size_t)(rb * 64 + fr) * D + kb; const bf16* pal = XNL + (size_t)(rb * 64 + fr) * D + kb;
            bf16x8 ahn[4], aln[4];
#pragma unroll
            for (int rt = 0; rt < 4; ++rt) { ahn[rt] = *(const bf16x8*)(pa + (size_t)rt * 16 * D); aln[rt] = *(const bf16x8*)(pal + (size_t)rt * 16 * D); }
#pragma unroll
            for (int ks = 0; ks < 4; ++ks) {
                bf16x8 ah[4], al[4], bh[2], bl[2];
#pragma unroll
                for (int rt = 0; rt < 4; ++rt) { ah[rt] = ahn[rt]; al[rt] = aln[rt]; }
#pragma unroll
                for (int et = 0; et < 2; ++et) { bh[et] = bhn[et]; bl[et] = bln[et]; }
                if (ks < 3) {
#pragma unroll
                    for (int rt = 0; rt < 4; ++rt) { ahn[rt] = *(const bf16x8*)(pa + (size_t)rt * 16 * D + (ks + 1) * 32); aln[rt] = *(const bf16x8*)(pal + (size_t)rt * 16 * D + (ks + 1) * 32); }
#pragma unroll
                    for (int et = 0; et < 2; ++et) { bhn[et] = *(const bf16x8*)(pbh + et * 16 * 1024 + (ks + 1) * 32); bln[et] = *(const bf16x8*)(pbl + et * 16 * 1024 + (ks + 1) * 32); } }
#pragma unroll
                for (int rt = 0; rt < 4; ++rt)
#pragma unroll
                    for (int et = 0; et < 2; ++et) {
                        acc[rt][et] = __builtin_amdgcn_mfma_f32_16x16x32_bf16(ah[rt], bh[et], acc[rt][et], 0, 0, 0);
                        acc[rt][et] = __builtin_amdgcn_mfma_f32_16x16x32_bf16(ah[rt], bl[et], acc[rt][et], 0, 0, 0);
                        acc[rt][et] = __builtin_amdgcn_mfma_f32_16x16x32_bf16(al[rt], bh[et], acc[rt][et], 0, 0, 0); }
            }
            LAS float* part = (LAS float*)(F.lds + 16384);
#pragma unroll
            for (int rt = 0; rt < 4; ++rt)
#pragma unroll
                for (int et = 0; et < 2; ++et)
#pragma unroll
                    for (int rg = 0; rg < 4; ++rg) part[(w * 64 + rt * 16 + 4 * kq + rg) * 33 + et * 16 + fr] = acc[rt][et][rg];
            __syncthreads();
            {   const int row = tid >> 3, e4 = (tid & 7) * 4;
#pragma unroll
                for (int j = 0; j < 4; ++j) { float sum = 0.f;
#pragma unroll
                    for (int ww = 0; ww < 8; ++ww) sum += part[(ww * 64 + row) * 33 + e4 + j];
                    lg[row * 33 + e4 + j] = sum + KIN(I_BR)[l * 32 + e4 + j]; } }
        }
        __syncthreads();
        if (w == 0) {
            float v[32];
#pragma unroll
            for (int e = 0; e < 32; ++e) v[e] = lg[lane * 33 + e];
            int idx[4]; float val[4];
#pragma unroll
            for (int k = 0; k < 4; ++k) { float best = v[0]; int bi = 0;
#pragma unroll
                for (int e = 1; e < 32; ++e) { const bool g = v[e] > best; best = g ? v[e] : best; bi = g ? e : bi; }
                val[k] = best; idx[k] = bi;
#pragma unroll
                for (int e = 0; e < 32; ++e) v[e] = (e == bi) ? -__builtin_inff() : v[e]; }
            const float p1 = __expf(val[1] - val[0]), p2 = __expf(val[2] - val[0]), p3 = __expf(val[3] - val[0]), inv = 1.0f / (1.0f + p1 + p2 + p3);
            const float gt[4] = {inv, p1 * inv, p2 * inv, p3 * inv};
            const int m = rb * 64 + lane;
#pragma unroll
            for (int k = 0; k < 4; ++k) { const int lr = __hip_atomic_fetch_add(lcnt + idx[k], 1, __ATOMIC_RELAXED, __HIP_MEMORY_SCOPE_WORKGROUP);
                int* eo = dry ? WSP(int, WS_DRY + 96 * MiB) : WSP(int, WS_EIDX); float* go = dry ? WSP(float, WS_DRY + 97 * MiB) : WSP(float, WS_GATE); int* lo_ = dry ? WSP(int, WS_DRY + 98 * MiB) : WSP(int, WS_LRANK);
                eo[m * 4 + k] = idx[k]; go[m * 4 + k] = gt[k]; lo_[m * 4 + k] = lr; }
        }
    }
    __syncthreads();
    if (tid < 32 && !dry) { const int base = (int)__hip_atomic_fetch_add(KCTL + CW_GCNT + l * 64 + tid, (unsigned)lcnt[tid], __ATOMIC_RELAXED, __HIP_MEMORY_SCOPE_AGENT);
        WSP(int, WS_BASE)[blockIdx.x * 32 + tid] = base; }
    __syncthreads();
}
__device__ __forceinline__ void gather_phase(Frame& F, int l) {
    PHASE_BEGIN();
    LAS int* tst = (LAS int*)(F.lds + LDSCTL_OFF);
    LAS int* tmp = (LAS int*)F.lds;
    if (F.tid < 32) tmp[F.tid] = (int)((__hip_atomic_load(KCTL + CW_GCNT + l * 64 + F.tid, __ATOMIC_RELAXED, __HIP_MEMORY_SCOPE_AGENT) + 255u) >> 8);
    __syncthreads();
    if (F.tid == 0) { int a = 0; for (int e = 0; e < 32; ++e) { tst[e] = a; a += tmp[e]; } tst[32] = a; }
    __syncthreads();
    if (F.tid < 320) { int e = 0;
#pragma unroll
        for (int k = 1; k < 32; ++k) e += ((int)F.tid >= tst[k]) ? 1 : 0;
        tst[2048 + F.tid] = e; }
    __syncthreads();
    const int gw = blockIdx.x * NWAVES + F.wave, lane = (F.tid & 63), p0 = gw * 32;
    const unsigned char* XN = WSP(unsigned char, WS_XN8); unsigned char* AS = WSP(unsigned char, WS_AS8);
    int dest = 0;
    if (lane < 32) { const int p = p0 + lane, tok = p >> 2, e = WSP(int, WS_EIDX)[p];
        dest = tst[e] * 256 + WSP(int, WS_BASE)[((tok >> 6) % GRIDN) * 32 + e] + WSP(int, WS_LRANK)[p];
        WSP(int, WS_PPOS)[p] = dest; }
    u32x4 rows[8];
#pragma unroll
    for (int t = 0; t < 8; ++t) rows[t] = *((const u32x4*)(XN + (size_t)(gw * 8 + t) * D) + lane);
#pragma unroll
    for (int i = 0; i < 32; ++i) { const int d = __builtin_amdgcn_readlane(dest, i); *((u32x4*)(AS + (size_t)d * D) + lane) = rows[i >> 2]; }
}
__device__ __forceinline__ void combine_phase(Frame& F, int l, const float* xsrc, bool last, bool dry = false) {
    PHASE_BEGIN();
    const int gw = blockIdx.x * NWAVES + F.wave, lane = (F.tid & 63), c0 = 16 * lane;
    const float* modl = WSP(float, WS_MOD) + (size_t)l * 8 * 6144; const float* modn = WSP(float, WS_MOD) + (size_t)(l + 1) * 8 * 6144;
    const unsigned char* YP = WSP(unsigned char, WS_ASORT); float* X = dry ? WSP(float, WS_DRY) : WSP(float, WS_X); bf16* XN = dry ? WSP(bf16, WS_DRY + 64 * MiB) : WSP(bf16, WS_XN);
    unsigned char* XN8 = dry ? WSP(unsigned char, WS_DRY + 96 * MiB) : WSP(unsigned char, WS_XN1_8_);
    const int m0 = gw * 8, b = m0 >> 11;
    f32x4 g2[4], sh[4], sc[4];
#pragma unroll
    for (int q = 0; q < 4; ++q) { g2[q] = *(const f32x4*)(modl + (size_t)b * 6144 + 5120 + c0 + 4 * q);
        if (last) { sh[q] = *(const f32x4*)(KIN(I_FG) + c0 + 4 * q); sc[q] = sh[q]; }
        else { sh[q] = *(const f32x4*)(modn + (size_t)b * 6144 + c0 + 4 * q); sc[q] = *(const f32x4*)(modn + (size_t)b * 6144 + 1024 + c0 + 4 * q); } }
    typedef int i32x4_t __attribute__((ext_vector_type(4)));
    i32x4_t posn = *(const i32x4_t*)(WSP(int, WS_PPOS) + (size_t)m0 * 4); f32x4 gkn = *(const f32x4*)(WSP(float, WS_GATE) + (size_t)m0 * 4);
    u32x4 yqn[4]; f32x4 vn[4]; f32x4 gk1 = gkn;
#pragma unroll
    for (int k = 0; k < 4; ++k) yqn[k] = *(const u32x4*)(YP + (size_t)posn[k] * D + c0);
#pragma unroll
    for (int q = 0; q < 4; ++q) vn[q] = *(const f32x4*)(xsrc + (size_t)m0 * D + c0 + 4 * q);
    posn = *(const i32x4_t*)(WSP(int, WS_PPOS) + (size_t)(m0 + 1) * 4); gkn = *(const f32x4*)(WSP(float, WS_GATE) + (size_t)(m0 + 1) * 4);
    for (int t = 0; t < 8; ++t) {
        const int m = m0 + t;
        const f32x4 gk = gk1 * 0.0625f;
        u32x4 yq[4]; f32x4 v[4];
#pragma unroll
        for (int k = 0; k < 4; ++k) yq[k] = yqn[k];
#pragma unroll
        for (int q = 0; q < 4; ++q) v[q] = vn[q];
        if (t < 7) {
#pragma unroll
            for (int k = 0; k < 4; ++k) yqn[k] = *(const u32x4*)(YP + (size_t)posn[k] * D + c0);
#pragma unroll
            for (int q = 0; q < 4; ++q) vn[q] = *(const f32x4*)(xsrc + (size_t)(m + 1) * D + c0 + 4 * q);
            gk1 = gkn;
            const int m2 = (t < 6) ? m + 2 : m + 1;
            posn = *(const i32x4_t*)(WSP(int, WS_PPOS) + (size_t)m2 * 4); gkn = *(const f32x4*)(WSP(float, WS_GATE) + (size_t)m2 * 4); }
        float s = 0.f;
#pragma unroll
        for (int q = 0; q < 4; ++q) { f32x4 y = {0.f, 0.f, 0.f, 0.f};
#pragma unroll
            for (int k = 0; k < 4; ++k) { const f32x2 lo = __builtin_amdgcn_cvt_pk_f32_fp8((int)yq[k][q], false), hi = __builtin_amdgcn_cvt_pk_f32_fp8((int)yq[k][q], true);
                y.x += gk[k] * lo[0]; y.y += gk[k] * lo[1]; y.z += gk[k] * hi[0]; y.w += gk[k] * hi[1]; }
            v[q] = v[q] + g2[q] * y; s += (v[q].x * v[q].x + v[q].y * v[q].y) + (v[q].z * v[q].z + v[q].w * v[q].w); }
        const float r = 1.0f / sqrtf(wave_sum(s) * (1.0f / D) + EPS);
        if (last) {
#pragma unroll
            for (int q = 0; q < 4; ++q) *(f32x4*)(KOUT + (size_t)m * D + c0 + 4 * q) = v[q] * r * sh[q];
        } else {
            unsigned w8[4]; unsigned wb[8];
#pragma unroll
            for (int q = 0; q < 4; ++q) { *(f32x4*)(X + (size_t)m * D + c0 + 4 * q) = v[q];
                const f32x4 h = v[q] * r * (1.0f + sc[q]) + sh[q]; wb[2 * q] = pk2(h.x, h.y); wb[2 * q + 1] = pk2(h.z, h.w); w8[q] = pk4_fp8(h.x, h.y, h.z, h.w); }
            *(u32x4*)(XN + (size_t)m * D + c0) = (u32x4){wb[0], wb[1], wb[2], wb[3]}; *(u32x4*)(XN + (size_t)m * D + c0 + 8) = (u32x4){wb[4], wb[5], wb[6], wb[7]};
            *(u32x4*)(XN8 + (size_t)m * D + c0) = (u32x4){w8[0], w8[1], w8[2], w8[3]};
        }
    }
}

template <int NTN> struct MoeSched {
    const LAS int* tst; int total, G, c; int deg = 0;
    __device__ __forceinline__ bool next(int i, pg8::Unit& u) const {
        const int L = i * G + c; if (L >= total) return false;
        const int rt = L / NTN, j = L - rt * NTN; const int e = tst[2048 + rt];
        u.pm = rt; u.pn = e * NTN + j;
        if (DUP_MASK && deg) { u.pm = 0; u.pn = j; }
        return true;
    }
    __device__ __forceinline__ void a_ready(const pg8::Unit&) const {}
    __device__ __forceinline__ void done(const pg8::Unit&) const {}
};
struct EpiMoe1 {
    static constexpr bool PERM = true, AFTER_DRAIN = false;
    bf16* ACT; const float* b1;
    __device__ __forceinline__ void operator()(const f32x4 (&acc)[2][2][4][2], const pg8::Unit& u, int wr, int wc, int fr, int fq) const {
        asm volatile("" : "+v"(fr), "+v"(fq));
        const int e = u.pn >> 3, j = u.pn & 7, row0 = u.pm * 256 + wr * 64 + fr, c0 = j * 128 + 32 * wc + 8 * fq;
        f32x4 bg[2], bl[2];
#pragma unroll
        for (int n = 0; n < 2; ++n) { bg[n] = *(const f32x4*)(b1 + (size_t)e * 2048 + c0 + 4 * n); bl[n] = *(const f32x4*)(b1 + (size_t)e * 2048 + 1024 + c0 + 4 * n); }
#pragma unroll
        for (int ai = 0; ai < 2; ++ai)
#pragma unroll
            for (int m = 0; m < 4; ++m) { unsigned w[4];
#pragma unroll
                for (int n = 0; n < 2; ++n) { const f32x4 g = acc[ai][0][m][n] + bg[n], li = acc[ai][1][m][n] + bl[n]; float o[4];
#pragma unroll
                    for (int q = 0; q < 4; ++q) { const float gl = fminf(g[q], 7.0f), ln = fminf(fmaxf(li[q], -7.0f), 7.0f);
                        o[q] = gl * (ln + 1.0f) * __builtin_amdgcn_rcpf(1.0f + __builtin_amdgcn_exp2f(-2.4554669595930156f * gl)); }
                    w[2 * n] = pg8::cvt_pk_bf16(o[0], o[1]); w[2 * n + 1] = pg8::cvt_pk_bf16(o[2], o[3]); }
                *(u32x4*)(ACT + (size_t)(row0 + ai * 128 + m * 16) * D + c0) = (u32x4){w[0], w[1], w[2], w[3]}; }
    }
};
struct EpiMoe2 {
    static constexpr bool PERM = true, AFTER_DRAIN = false;
    bf16* YP; const float* b2; const float* rowgate;
    __device__ __forceinline__ void operator()(const f32x4 (&acc)[2][2][4][2], const pg8::Unit& u, int wr, int wc, int fr, int fq) const {
        asm volatile("" : "+v"(fr), "+v"(fq));
        const int e = u.pn >> 2, row0 = u.pm * 256 + wr * 64 + fr, c0 = (u.pn & 3) * 256 + 32 * wc + 8 * fq;
        f32x4 bv[2][2];
#pragma unroll
        for (int bj = 0; bj < 2; ++bj)
#pragma unroll
            for (int n = 0; n < 2; ++n) bv[bj][n] = *(const f32x4*)(b2 + (size_t)e * 1024 + c0 + bj * 128 + 4 * n);
#pragma unroll
        for (int ai = 0; ai < 2; ++ai)
#pragma unroll
            for (int m = 0; m < 4; ++m) { const int row = row0 + ai * 128 + m * 16; const float g = rowgate[row];
#pragma unroll
                for (int bj = 0; bj < 2; ++bj) { const f32x4 v0 = (acc[ai][bj][m][0] + bv[bj][0]) * g, v1 = (acc[ai][bj][m][1] + bv[bj][1]) * g;
                    *(u32x4*)(YP + (size_t)row * D + c0 + bj * 128) = (u32x4){pg8::cvt_pk_bf16(v0[0], v0[1]), pg8::cvt_pk_bf16(v0[2], v0[3]), pg8::cvt_pk_bf16(v1[0], v1[1]), pg8::cvt_pk_bf16(v1[2], v1[3])}; } }
    }
};

struct EpiW1 {
    unsigned char* ACT8; const float* b1;
    __device__ __forceinline__ void operator()(const f32x4 (&acc)[4][8], const pg8::Unit& u, int wr, int wc, int fr, int fq) const {
        asm volatile("" : "+v"(fr), "+v"(fq));
        const int e = u.pn >> 3, j = u.pn & 7, row0 = u.pm * 256 + wr * 64 + fr, c0 = j * 128 + wc * 64 + 4 * fq;
#pragma unroll
        for (int n = 0; n < 4; ++n) { const f32x4 bg = *(const f32x4*)(b1 + (size_t)e * 2048 + c0 + 16 * n), bl = *(const f32x4*)(b1 + (size_t)e * 2048 + 1024 + c0 + 16 * n);
#pragma unroll
            for (int m = 0; m < 4; ++m) { const f32x4 g = acc[m][n] + bg, li = acc[m][4 + n] + bl; float o[4];
#pragma unroll
                for (int q = 0; q < 4; ++q) { const float gl = fminf(g[q], 7.0f), ln = fminf(fmaxf(li[q], -7.0f), 7.0f);
                    o[q] = gl * (ln + 1.0f) * __builtin_amdgcn_rcpf(1.0f + __builtin_amdgcn_exp2f(-2.4554669595930156f * gl)); }
                *(unsigned*)(ACT8 + (size_t)(row0 + 16 * m) * D + c0 + 16 * n) = pk4_fp8(o[0], o[1], o[2], o[3]); } }
    }
};
struct EpiW2 {
    bf16* YP; const float* b2; const float* rowgate;
    __device__ __forceinline__ void operator()(const f32x4 (&acc)[4][8], const pg8::Unit& u, int wr, int wc, int fr, int fq) const {
        asm volatile("" : "+v"(fr), "+v"(fq));
        const int e = u.pn >> 2, row0 = u.pm * 256 + wr * 64 + fr, c0 = (u.pn & 3) * 256 + wc * 128 + 4 * fq;
        float gt[4];
#pragma unroll
        for (int m = 0; m < 4; ++m) gt[m] = rowgate[row0 + 16 * m];
#pragma unroll
        for (int n = 0; n < 8; ++n) { const f32x4 bv = *(const f32x4*)(b2 + (size_t)e * 1024 + c0 + 16 * n);
#pragma unroll
            for (int m = 0; m < 4; ++m) { const f32x4 v = (acc[m][n] + bv) * gt[m];
                *(u32x2*)(YP + (size_t)(row0 + 16 * m) * D + c0 + 16 * n) = (u32x2){pg8::cvt_pk_bf16(v[0], v[1]), pg8::cvt_pk_bf16(v[2], v[3])}; } }
    }
};
typedef __bf16 bf16x2_nt __attribute__((ext_vector_type(2)));
__device__ __forceinline__ unsigned cvtpk_c(float lo, float hi) { f32x2 v = {lo, hi}; bf16x2_nt b = __builtin_convertvector(v, bf16x2_nt); return __builtin_bit_cast(unsigned, b); }
struct EpiP1 {
    static constexpr bool PERM = true, AFTER_DRAIN = false, BIAS_INIT = true;
    unsigned char* ACT8; const float* b1;
    static constexpr int NSTORE = 16;
    __device__ __forceinline__ const float* bias_src(const pg8::Unit& u, int q) const { return b1 + (size_t)(u.pn >> 3) * 2048 + (q >> 5) * 1024 + (u.pn & 7) * 128 + 4 * (q & 31); }
    __device__ __forceinline__ void load_bias(f32x4 (&nb)[4], const PG8_LAS float* sl, int wc, int fq) const {
        const PG8_LAS float* bp = sl + 16 * wc + 4 * fq;
        nb[0] = *(const PG8_LAS f32x4*)bp; nb[1] = *(const PG8_LAS f32x4*)(bp + 128); nb[2] = *(const PG8_LAS f32x4*)(bp + 64); nb[3] = *(const PG8_LAS f32x4*)(bp + 128 + 64);
    }
    __device__ __forceinline__ void set_bias(f32x4 (&acc)[2][2][4][2], const f32x4 (&nb)[4]) const {
#pragma unroll
        for (int bj = 0; bj < 2; ++bj)
#pragma unroll
            for (int ai = 0; ai < 2; ++ai)
#pragma unroll
                for (int m = 0; m < 4; ++m) { acc[ai][bj][m][0] = nb[2 * bj]; acc[ai][bj][m][1] = nb[2 * bj + 1]; }
    }
    __device__ __forceinline__ void operator()(const f32x4 (&acc)[2][2][4][2], const pg8::Unit& u, int wr, int wc, int fr, int fq) const {
        asm volatile("" : "+v"(fr), "+v"(fq));
        const int j = u.pn & 7, row0 = u.pm * 256 + wr * 64 + fr, c0 = j * 128 + 16 * wc + 4 * fq;
#pragma unroll
        for (int ai = 0; ai < 2; ++ai)
#pragma unroll
            for (int m = 0; m < 4; ++m) { const int row = row0 + ai * 128 + m * 16;
#pragma unroll
                for (int bj = 0; bj < 2; ++bj) { const f32x4 g = acc[ai][bj][m][0], li = acc[ai][bj][m][1]; float o[4];
#pragma unroll
                    for (int q = 0; q < 4; ++q) { const float gl = fminf(g[q], 7.0f), ln = fminf(fmaxf(li[q], -7.0f), 7.0f);
                        o[q] = gl * (ln + 1.0f) * __builtin_amdgcn_rcpf(1.0f + __builtin_amdgcn_exp2f(-2.4554669595930156f * gl)); }
                    *(unsigned*)(ACT8 + (size_t)row * D + c0 + bj * 64) = pk4_fp8(o[0], o[1], o[2], o[3]); } }
    }
};
struct EpiP2 {
    static constexpr bool PERM = true, AFTER_DRAIN = false, BIAS_INIT = true;
    bf16* YP; const float* b2; int skip = 0;
    static constexpr int NSTORE = 16;
    __device__ __forceinline__ const float* bias_src(const pg8::Unit& u, int q) const { return b2 + (size_t)(u.pn >> 2) * 1024 + (u.pn & 3) * 256 + 4 * q; }
    __device__ __forceinline__ void load_bias(f32x4 (&nb)[4], const PG8_LAS float* sl, int wc, int fq) const {
        const PG8_LAS float* bp = sl + 32 * wc + 8 * fq;
        nb[0] = *(const PG8_LAS f32x4*)bp; nb[1] = *(const PG8_LAS f32x4*)(bp + 4); nb[2] = *(const PG8_LAS f32x4*)(bp + 128); nb[3] = *(const PG8_LAS f32x4*)(bp + 128 + 4);
    }
    __device__ __forceinline__ void set_bias(f32x4 (&acc)[2][2][4][2], const f32x4 (&nb)[4]) const {
#pragma unroll
        for (int bj = 0; bj < 2; ++bj)
#pragma unroll
            for (int ai = 0; ai < 2; ++ai)
#pragma unroll
                for (int m = 0; m < 4; ++m) { acc[ai][bj][m][0] = nb[2 * bj]; acc[ai][bj][m][1] = nb[2 * bj + 1]; }
    }
    __device__ __forceinline__ void operator()(const f32x4 (&acc)[2][2][4][2], const pg8::Unit& u, int wr, int wc, int fr, int fq) const {
        if (DUP_MASK != 0 && skip == 1) return;
        asm volatile("" : "+v"(fr), "+v"(fq));
        const int row0 = u.pm * 256 + wr * 64 + fr, c0 = (u.pn & 3) * 256 + 32 * wc + 8 * fq;
#pragma unroll
        for (int ai = 0; ai < 2; ++ai)
#pragma unroll
            for (int m = 0; m < 4; ++m) { const int row = row0 + ai * 128 + m * 16;
#pragma unroll
                for (int bj = 0; bj < 2; ++bj) { const f32x4 v0 = acc[ai][bj][m][0], v1 = acc[ai][bj][m][1];
                    *(u32x2*)((unsigned char*)YP + (size_t)row * D + c0 + bj * 128) = (u32x2){pk4_fp8(16.f * v0[0], 16.f * v0[1], 16.f * v0[2], 16.f * v0[3]), pk4_fp8(16.f * v1[0], 16.f * v1[1], 16.f * v1[2], 16.f * v1[3])}; } }
    }
};
struct EpiF8Moe1 {
    unsigned char* ACT8; const float* b1;
    __device__ __forceinline__ void operator()(const f32x4 (&acc)[4][4], const pg8::Unit& u, int wr, int wc, int fr, int fq) const {
        asm volatile("" : "+v"(fr), "+v"(fq));
        const int e = u.pn >> 4, j = u.pn & 15, row0 = u.pm * 256 + wr * 64 + fr, c0 = j * 64 + wc * 32 + 4 * fq;
        f32x4 bg[2], bl[2];
#pragma unroll
        for (int n = 0; n < 2; ++n) { bg[n] = *(const f32x4*)(b1 + (size_t)e * 2048 + c0 + 16 * n); bl[n] = *(const f32x4*)(b1 + (size_t)e * 2048 + 1024 + c0 + 16 * n); }
#pragma unroll
        for (int m = 0; m < 4; ++m)
#pragma unroll
            for (int n = 0; n < 2; ++n) { const f32x4 g = acc[m][n] + bg[n], li = acc[m][2 + n] + bl[n]; float o[4];
#pragma unroll
                for (int q = 0; q < 4; ++q) { const float gl = fminf(g[q], 7.0f), ln = fminf(fmaxf(li[q], -7.0f), 7.0f);
                    o[q] = gl * (ln + 1.0f) * __builtin_amdgcn_rcpf(1.0f + __builtin_amdgcn_exp2f(-2.4554669595930156f * gl)); }
                *(unsigned*)(ACT8 + (size_t)(row0 + 16 * m) * D + c0 + 16 * n) = pk4_fp8(o[0], o[1], o[2], o[3]); }
    }
};
struct EpiF8Moe2 {
    bf16* YP; const float* b2; const float* rowgate;
    __device__ __forceinline__ void operator()(const f32x4 (&acc)[4][4], const pg8::Unit& u, int wr, int wc, int fr, int fq) const {
        asm volatile("" : "+v"(fr), "+v"(fq));
        const int e = u.pn >> 3, row0 = u.pm * 256 + wr * 64 + fr, c0 = (u.pn & 7) * 128 + wc * 64 + 4 * fq;
        f32x4 bv[4];
#pragma unroll
        for (int n = 0; n < 4; ++n) bv[n] = *(const f32x4*)(b2 + (size_t)e * 1024 + c0 + 16 * n);
#pragma unroll
        for (int m = 0; m < 4; ++m) { const int row = row0 + 16 * m; const float g = rowgate[row];
#pragma unroll
            for (int n = 0; n < 4; ++n) { const f32x4 v = (acc[m][n] + bv[n]) * g;
                *(u32x2*)(YP + (size_t)row * D + c0 + 16 * n) = (u32x2){pg8::cvt_pk_bf16(v[0], v[1]), pg8::cvt_pk_bf16(v[2], v[3])}; } }
    }
};
namespace att {
typedef short s16x4 __attribute__((ext_vector_type(4)));
typedef float f32x16 __attribute__((ext_vector_type(16)));
constexpr int DH = 128, NW = 8, QBLK = 32, KVBLK = 64, QB = NW * QBLK;
constexpr int SHM_V = KVBLK * DH * 2, SHM_K = KVBLK * DH * 2;
constexpr int BODY_LDS = 2 * SHM_V + 2 * SHM_K + NW * 64 * 4;
constexpr int LDS_KB = BODY_LDS;
constexpr int LDS_BM = LDS_KB + 8192;
constexpr int LDS_SCAN = LDS_BM + 16384;
constexpr int LDS_GN = LDS_SCAN + 256;
constexpr float THR = 8.f;
#define KSWZ(row, colB) ((row) * 256 + ((colB) ^ (((row) & 7) << 4)))
#define SBAR() __builtin_amdgcn_sched_barrier(0)
__device__ __forceinline__ int v_st(int k, int c) { const int kk = (k & ~0xC) | ((k & 4) << 1) | ((k & 8) >> 1); return ((kk >> 3) * 4 + (c >> 5)) * 512 + ((kk & 7) * 32 + (c & 31)) * 2; }
__device__ __forceinline__ int v_rd_base(int lane) { return ((lane & 3) << 3) | (((lane >> 2) & 3) << 6) | (((lane >> 4) & 1) << 5) | (((lane >> 5) & 1) << 8); }
constexpr int v_rd_off(int d0, int ks, int half) { return d0 * 512 + ks * 4096 + half * 2048; }
__device__ __forceinline__ int crow(int r, int hi) { return (r & 3) + 8 * (r >> 2) + 4 * hi; }
__device__ __forceinline__ unsigned cvtpk(float lo, float hi) { unsigned r; asm volatile("v_cvt_pk_bf16_f32 %0, %1, %2" : "=v"(r) : "v"(lo), "v"(hi)); return r; }
__device__ __forceinline__ bf16x8 load8(const bf16* p) { return *reinterpret_cast<const bf16x8*>(p); }
__device__ __forceinline__ void mask_tile(f32x16& p0, f32x16& p1, int dq, unsigned W) {
    const float NEG = -__builtin_inff();
#pragma unroll
    for (int r = 0; r < 16; ++r) { const int c = (r & 3) + 8 * (r >> 2);
        if ((unsigned)(dq - c) >= W) p0[r] = NEG;
        if ((unsigned)(dq - c - 32) >= W) p1[r] = NEG; }
}
template <int MODE> __device__ __forceinline__ void partialSM(f32x16& p0, f32x16& p1, float& m_reg, float& mn, float& alpha) {
    constexpr float SCALE = MODE == 0 ? 0.08838834764831845f : 1.0f;
    float pmax = p0[0]; for (int r = 1; r < 16; ++r) pmax = fmaxf(pmax, p0[r]); for (int r = 0; r < 16; ++r) pmax = fmaxf(pmax, p1[r]);
    { auto rr = __builtin_amdgcn_permlane32_swap(__float_as_uint(pmax), __float_as_uint(pmax), false, false);
      pmax = fmaxf(__uint_as_float(rr[0]), __uint_as_float(rr[1])); }
    constexpr float C2 = 1.4426950408889634f * SCALE;
    if (__builtin_expect(__all((pmax - m_reg) * SCALE <= THR), 1)) { mn = m_reg; alpha = 1.f; }
    else { mn = fmaxf(m_reg, pmax); alpha = __builtin_amdgcn_exp2f((m_reg - mn) * C2); m_reg = mn; }
    const float mnL = -mn * C2;
    for (int r = 0; r < 16; ++r) p0[r] = fmaf(p0[r], C2, mnL); for (int r = 0; r < 16; ++r) p1[r] = fmaf(p1[r], C2, mnL);
    for (int r = 0; r < 16; ++r) p0[r] = __builtin_amdgcn_exp2f(p0[r]);
}
__device__ __forceinline__ void finishSM(f32x16& p0, f32x16& p1, float alpha, float& l_reg, bf16x8& pa0, bf16x8& pa1, bf16x8& pa2, bf16x8& pa3) {
    for (int r = 0; r < 16; ++r) p1[r] = __builtin_amdgcn_exp2f(p1[r]);
    float ps = 0; for (int r = 0; r < 16; ++r) ps += p0[r]; for (int r = 0; r < 16; ++r) ps += p1[r];
    { auto rr = __builtin_amdgcn_permlane32_swap(__float_as_uint(ps), __float_as_uint(ps), false, false);
      ps = __uint_as_float(rr[0]) + __uint_as_float(rr[1]); }
    l_reg = l_reg * alpha + ps;
#define PK4(P, B_, OUT) do { unsigned a0 = cvtpk(P[B_+0], P[B_+1]), a1 = cvtpk(P[B_+2], P[B_+3]);                          \
        unsigned b0 = cvtpk(P[B_+4], P[B_+5]), b1 = cvtpk(P[B_+6], P[B_+7]);                                             \
        auto r0 = __builtin_amdgcn_permlane32_swap(a0, b0, false, false); auto r1 = __builtin_amdgcn_permlane32_swap(a1, b1, false, false); \
        u32x4 w = {r0[0], r1[0], r0[1], r1[1]}; OUT = *reinterpret_cast<bf16x8*>(&w); } while (0)
    PK4(p0, 0, pa0); PK4(p0, 8, pa1); PK4(p1, 0, pa2); PK4(p1, 8, pa3);
}
template <int MODE> __device__ __forceinline__ void cinit(f32x16& p0, f32x16& p1, const char* lds, int kbase, int hi, int tq, int t) {
    if constexpr (MODE == 0) {
        const float* kb = (const float*)(lds + LDS_KB) + kbase + 4 * hi;
#pragma unroll
        for (int g = 0; g < 4; ++g) { const f32x4 a = *(const f32x4*)(kb + 8 * g), b = *(const f32x4*)(kb + 32 + 8 * g);
            p0[4 * g] = a[0]; p0[4 * g + 1] = a[1]; p0[4 * g + 2] = a[2]; p0[4 * g + 3] = a[3]; p1[4 * g] = b[0]; p1[4 * g + 1] = b[1]; p1[4 * g + 2] = b[2]; p1[4 * g + 3] = b[3]; }
    } else {
        const u32x2 w = *(const u32x2*)((const unsigned*)(lds + LDS_BM) + tq * 64 + 2 * t);
        const unsigned lo = w.x >> (4 * hi), hh = w.y >> (4 * hi);
        const float NEG = -__builtin_inff();
#pragma unroll
        for (int r = 0; r < 16; ++r) { const int c = (r & 3) + 8 * (r >> 2); p0[r] = ((lo >> c) & 1u) ? 0.f : NEG; p1[r] = ((hh >> c) & 1u) ? 0.f : NEG; }
    }
}
template <int KB>
__device__ __forceinline__ void qkt(f32x16& p0, f32x16& p1, const char* K_lds, int r32, int hi, const bf16x8* qr) {
    const char* kb[4];
#pragma unroll
    for (int dd = 0; dd < 4; ++dd) kb[dd] = K_lds + KB * SHM_K + KSWZ(r32, (dd * 16 + hi * 8) * 2);
#pragma unroll
    for (int d0 = 0; d0 < 8; ++d0) { const char* a = kb[d0 & 3] + (d0 >> 2) * 128;
        bf16x8 b0 = *reinterpret_cast<const bf16x8*>(a);
        bf16x8 b1 = *reinterpret_cast<const bf16x8*>(a + 32 * 256);
        p0 = __builtin_amdgcn_mfma_f32_32x32x16_bf16(b0, qr[d0], p0, 0, 0, 0);
        p1 = __builtin_amdgcn_mfma_f32_32x32x16_bf16(b1, qr[d0], p1, 0, 0, 0); }
}
template <int VB>
__device__ __forceinline__ void pv_tile(f32x16* o, int vb0, bf16x8 pa0, bf16x8 pa1, bf16x8 pa2, bf16x8 pa3) {
#define TRRD(dst, off) asm volatile("ds_read_b64_tr_b16 %0, %1 offset:%2" : "=&v"(dst) : "v"(vb0), "i"(off) : "memory")
#define PV_D0(d0) do { s16x4 l0, l1, l2, l3, h0, h1, h2, h3; constexpr int b_ = VB * SHM_V + v_rd_off(d0, 0, 0); \
        TRRD(l0, b_); TRRD(h0, b_ + 2048); TRRD(l1, b_ + 4096); TRRD(h1, b_ + 6144); TRRD(l2, b_ + 8192); TRRD(h2, b_ + 10240); TRRD(l3, b_ + 12288); TRRD(h3, b_ + 14336); \
        asm volatile("s_waitcnt lgkmcnt(0)" ::: "memory"); SBAR();   \
        o[d0] = __builtin_amdgcn_mfma_f32_32x32x16_bf16(pa0, (bf16x8){l0[0], l0[1], l0[2], l0[3], h0[0], h0[1], h0[2], h0[3]}, o[d0], 0, 0, 0);   \
        o[d0] = __builtin_amdgcn_mfma_f32_32x32x16_bf16(pa1, (bf16x8){l1[0], l1[1], l1[2], l1[3], h1[0], h1[1], h1[2], h1[3]}, o[d0], 0, 0, 0);   \
        o[d0] = __builtin_amdgcn_mfma_f32_32x32x16_bf16(pa2, (bf16x8){l2[0], l2[1], l2[2], l2[3], h2[0], h2[1], h2[2], h2[3]}, o[d0], 0, 0, 0);   \
        o[d0] = __builtin_amdgcn_mfma_f32_32x32x16_bf16(pa3, (bf16x8){l3[0], l3[1], l3[2], l3[3], h3[0], h3[1], h3[2], h3[3]}, o[d0], 0, 0, 0); } while (0)
    PV_D0(0); PV_D0(1); PV_D0(2); PV_D0(3);
#undef PV_D0
}
struct BlockRef { const bf16* Q; const bf16* K; const bf16* V; bf16* O; int ldo; int P0; int NT; const float* g; };
struct Seam { bf16x8 qr[8]; bf16x8 st_v0, st_v1, st_k0, st_k1; };
__device__ __forceinline__ bf16x8 nrm8(bf16x8 x, const float* gl) {
    const f32x4 g0 = *(const f32x4*)gl, g1 = *(const f32x4*)(gl + 4);
    float f[8]; float ss = 0.f;
#pragma unroll
    for (int i = 0; i < 8; ++i) { f[i] = bf2f((unsigned short)x[i]); ss += f[i] * f[i]; }
    ss += __builtin_bit_cast(float, __builtin_amdgcn_update_dpp(0, __builtin_bit_cast(int, ss), 0x128, 0xf, 0xf, false));
    ss += __builtin_bit_cast(float, __builtin_amdgcn_update_dpp(0, __builtin_bit_cast(int, ss), 0x124, 0xf, 0xf, false));
    ss += __builtin_bit_cast(float, __builtin_amdgcn_update_dpp(0, __builtin_bit_cast(int, ss), 0x122, 0xf, 0xf, false));
    ss += __builtin_bit_cast(float, __builtin_amdgcn_update_dpp(0, __builtin_bit_cast(int, ss), 0x121, 0xf, 0xf, false));
    const float r = __builtin_amdgcn_rsqf(ss * (1.0f / 128.0f) + EPS);
    u32x4 w = {cvtpk(f[0] * r * g0[0], f[1] * r * g0[1]), cvtpk(f[2] * r * g0[2], f[3] * r * g0[3]), cvtpk(f[4] * r * g1[0], f[5] * r * g1[1]), cvtpk(f[6] * r * g1[2], f[7] * r * g1[3])};
    return *reinterpret_cast<bf16x8*>(&w);
}
#define ROW(p, k0, rr) ((p) + (size_t)((k0) + (rr)) * DH + sc)
#define VMW() asm volatile("s_waitcnt vmcnt(0)" ::: "memory")
#define VMWN(n) asm volatile("s_waitcnt vmcnt(%0)" :: "i"(n) : "memory")
#define STG_IDS() int tid_s = tid; asm volatile("" : "+v"(tid_s)); const int sr = tid_s >> 4, sc = (tid_s & 15) * 8
#define SLOAD_H(Kp, Vp, k0) do { STG_IDS(); if constexpr (MODE == 0) { S.st_v0 = load8(ROW(Vp, k0, sr)); S.st_v1 = load8(ROW(Vp, k0, 32 + sr)); }             \
                         S.st_k0 = load8(ROW(Kp, k0, sr)); S.st_k1 = load8(ROW(Kp, k0, 32 + sr)); } while (0)
#define NORMKV() do { if constexpr (MODE == 1) { S.st_v0 = S.st_k0; S.st_v1 = S.st_k1; } } while (0)
#define SWRITE_HK(bf) do { STG_IDS(); const int kws = KSWZ(sr, sc * 2); *(bf16x8*)(K_lds + (bf) * SHM_K + kws) = S.st_k0; *(bf16x8*)(K_lds + (bf) * SHM_K + kws + 32 * 256) = S.st_k1; } while (0)
#define SWRITE_HV(bf) do { STG_IDS(); const int vst0 = v_st(sr, sc), vst1 = v_st(32 + sr, sc); *(bf16x8*)(V_lds + (bf) * SHM_V + vst0) = S.st_v0; *(bf16x8*)(V_lds + (bf) * SHM_V + vst1) = S.st_v1; } while (0)
#define SWRITE_H(bf) do { SWRITE_HV(bf); SWRITE_HK(bf); } while (0)
template <int MODE>
__device__ __forceinline__ void prime(const BlockRef& cur, char* lds, Seam& S, const int tid) {
    const int wid = __builtin_amdgcn_readfirstlane(tid >> 6), lane = tid & 63, r32 = lane & 31, hi = lane >> 5;
    char* K_lds = lds + 2 * SHM_V;
    for (int d0 = 0; d0 < 8; ++d0) S.qr[d0] = load8(cur.Q + (size_t)(wid * QBLK + r32) * DH + d0 * 16 + hi * 8);
    SLOAD_H(cur.K, cur.V, 0); VMW(); NORMKV(); SWRITE_HK(0);
    __syncthreads();
}
template <int MODE>
__device__ __forceinline__ void block(const BlockRef& cur, const BlockRef& nxt, char* lds, Seam& S, const int tid) {
    const int wid = __builtin_amdgcn_readfirstlane(tid >> 6), lane = tid & 63, r32 = lane & 31, hi = lane >> 5;
    const int NT = cur.NT;
    const int qlo = cur.P0 + wid * QBLK, qm = qlo + r32 - 4 * hi;
    const int tq = wid * 8 + (r32 >> 2);
    constexpr unsigned W = 1u << 30;
    char* V_lds = lds; char* K_lds = lds + 2 * SHM_V;
    float* ws = (float*)(lds + 2 * SHM_V + 2 * SHM_K) + wid * 64; float* li_l = ws, * al_l = ws + 32;
    float m_reg = -1e30f, l_reg = 0; f32x16 o[4]; { const f32x16 z16 = ozero16(); o[0] = z16; o[1] = z16; o[2] = z16; o[3] = z16; }
    const int vb0 = (int)(uintptr_t)V_lds + v_rd_base(lane);
    const bf16* Kh = cur.K; const bf16* Vh = cur.V;
#define RESC(a) do { if (__any((a) < 1.f)) { if (hi == 0) al_l[r32] = (a); asm volatile("s_waitcnt lgkmcnt(0)" ::: "memory");              \
                     for (int d_ = 0; d_ < 4; ++d_) for (int r = 0; r < 16; ++r) o[d_][r] *= al_l[crow(r, hi)]; } } while (0)
#define KBASE(t) ((t) * KVBLK)
#define MASKT(P0_, P1_, t) do { if constexpr (MODE == 0) { const int kb_ = KBASE(t); if (kb_ + KVBLK - 1 > qlo) mask_tile(P0_, P1_, qm - kb_, W); } } while (0)
    constexpr int NQL = 8;
#define SEAM_K0() do { VMWN(NQL); NORMKV(); SWRITE_HK(0); SBAR(); } while (0)
    f32x16 pA0, pA1, pB0, pB1; float mnA, mnB, alA, alB; bf16x8 pa0, pa1, pa2, pa3;
    SWRITE_HV(0); SBAR();
    if (NT > 1) { SLOAD_H(Kh, Vh, KBASE(1)); }
    SBAR(); cinit<MODE>(pA0, pA1, lds, KBASE(0), hi, tq, 0); qkt<0>(pA0, pA1, K_lds, r32, hi, S.qr);
    MASKT(pA0, pA1, 0); partialSM<MODE>(pA0, pA1, m_reg, mnA, alA);
    if (NT > 1) { VMW(); NORMKV(); SWRITE_H(1); }
    __syncthreads();
#define HALF_STEP(PX0, PX1, mnX, alX, PY0, PY1, alY, t, KB, VB, SB) do {                                                      \
        SBAR(); cinit<MODE>(PX0, PX1, lds, KBASE(t), hi, tq, (t)); qkt<KB>(PX0, PX1, K_lds, r32, hi, S.qr);                     \
        finishSM(PY0, PY1, alY, l_reg, pa0, pa1, pa2, pa3); SBAR();                                                           \
        if ((t) + 1 < NT) { SLOAD_H(Kh, Vh, KBASE((t) + 1)); SBAR(); }                                                        \
        pv_tile<VB>(o, vb0, pa0, pa1, pa2, pa3); MASKT(PX0, PX1, (t)); partialSM<MODE>(PX0, PX1, m_reg, mnX, alX);             \
        __syncthreads();                                                                                                      \
        if ((t) + 1 < NT) { VMW(); NORMKV(); SWRITE_H(SB); }                                                                  \
        RESC(alX); __syncthreads(); } while (0)
    for (int t = 1; t + 1 < NT; t += 2) {
        HALF_STEP(pB0, pB1, mnB, alB, pA0, pA1, alA, t, 1, 0, 0);
        HALF_STEP(pA0, pA1, mnA, alA, pB0, pB1, alB, t + 1, 0, 1, 1);
    }
    const bool even = (NT & 1) == 0;
    if (even) { SBAR(); cinit<MODE>(pB0, pB1, lds, KBASE(NT - 1), hi, tq, NT - 1); qkt<1>(pB0, pB1, K_lds, r32, hi, S.qr); SBAR(); }
    SBAR();
    finishSM(pA0, pA1, alA, l_reg, pa0, pa1, pa2, pa3); SBAR();
    pv_tile<0>(o, vb0, pa0, pa1, pa2, pa3);
    if (even) { MASKT(pB0, pB1, NT - 1); partialSM<MODE>(pB0, pB1, m_reg, mnB, alB); __syncthreads(); RESC(alB);
        finishSM(pB0, pB1, alB, l_reg, pa0, pa1, pa2, pa3); SBAR(); pv_tile<1>(o, vb0, pa0, pa1, pa2, pa3); }
    SBAR();
    if (hi == 0) li_l[r32] = l_reg; asm volatile("s_waitcnt lgkmcnt(0)" ::: "memory");
    float rli[16];
#pragma unroll
    for (int r = 0; r < 16; ++r) rli[r] = __builtin_amdgcn_rcpf(li_l[crow(r, hi)]);
    constexpr int LDO = MODE == 0 ? 512 : 128;
    bf16* Ow = cur.O + (size_t)(wid * QBLK) * LDO;
#pragma unroll
    for (int r = 0; r < 16; ++r) { const int orow = crow(r, hi);
#pragma unroll
        for (int d0 = 0; d0 < 4; ++d0) { const float v = o[d0][r] * rli[r];
            const float vn = qxor1(v);
            if ((r32 & 1) == 0) *(unsigned*)(Ow + (size_t)orow * LDO + d0 * 32 + r32) = cvtpk(v, vn); } }
    __syncthreads();
#undef RESC
#undef KBASE
#undef MASKT
#undef SEAM_K0
#undef HALF_STEP
}
#undef ROW
#undef VMWN
#undef SLOAD_H
#undef STG_IDS
#undef NORMKV
#undef SWRITE_HK
#undef SWRITE_HV
#undef SWRITE_H
#undef PK4
#undef TRRD
}

constexpr size_t WS_MLQK = 848 * MiB, WS_MLV = 864 * MiB, WS_MLO = 880 * MiB, WS_QABS = 896 * MiB, WS_CKV = 912 * MiB, WS_IK = 916 * MiB, WS_SCAL = 918 * MiB, WS_IQ = 920 * MiB;
constexpr size_t WS_FXQ = 928 * MiB, WS_FXK = 944 * MiB, WS_FXV = 960 * MiB, WS_GATES = 976 * MiB, WS_YCAT = 1072 * MiB, WS_MERGED = 1120 * MiB;
constexpr size_t WS_CLOC = 1152 * MiB, WS_CPREV = 1184 * MiB, WS_MLST = 1200 * MiB, WS_SCORE = 1208 * MiB, WS_XN1_8 = 1352 * MiB  , WS_WIN8 = 1368 * MiB  , WS_MERGED8 = 1384 * MiB  , WS_WOUT8 = 1400 * MiB  , WS_CKVN = 1402 * MiB  , WS_END2 = 1406 * MiB;
constexpr int CW_Q = 512;

struct EpiInProj {
    static constexpr bool PERM = true, AFTER_DRAIN = false;
    const float* bias; unsigned char* ws;
    __device__ __forceinline__ void operator()(const f32x4 (&acc)[2][2][4][2], const pg8::Unit& u, int wr, int wc, int fr, int fq) const {
        asm volatile("" : "+v"(fr), "+v"(fq));
        const int pn = u.pn, row0 = u.pm * 256 + wr * 64 + fr, b = u.pm >> 3;
#pragma unroll
        for (int bj = 0; bj < 2; ++bj) {
            const int c8 = 128 * bj + 32 * wc + 8 * fq;
            bf16* base = nullptr; int pitch = 0; float* fbase = nullptr;
            if (pn < 2) { base = (bf16*)(ws + WS_MLQK) + pn * 256 + c8; pitch = 512; }
            else if (pn < 4) { base = (bf16*)(ws + WS_MLV) + (pn - 2) * 256 + c8; pitch = 512; }
            else if (pn < 6) { base = (bf16*)(ws + WS_MLO) + (pn - 4) * 256 + c8; pitch = 512; }
            else if (pn < 8) { base = (bf16*)(ws + WS_QABS) + (pn - 6) * 256 + c8; pitch = 512; }
            else if (pn == 8) { if (c8 < 128) { base = (bf16*)(ws + WS_CKV) + c8; pitch = 128; } else if (c8 < 192) { base = (bf16*)(ws + WS_IK) + (c8 - 128); pitch = 64; }
                                else if (c8 < 208) { fbase = (float*)(ws + WS_SCAL) + (c8 - 192); } }
            else if (pn == 9) { base = (bf16*)(ws + WS_IQ) + c8; pitch = 256; }
            else if (pn < 16) { const int t = (pn - 10) >> 1, hh = ((pn - 10) & 1) * 2 + bj;
                base = (bf16*)(ws + WS_FXQ + (size_t)t * (WS_FXK - WS_FXQ)) + (size_t)(b * 3 + hh) * 2048 * 128 + 32 * wc + 8 * fq; pitch = 128; }
            else { base = (bf16*)(ws + WS_GATES) + (pn - 16) * 256 + c8; pitch = 3072; }
            const f32x4 bv0 = *(const f32x4*)(bias + pn * 256 + c8), bv1 = *(const f32x4*)(bias + pn * 256 + c8 + 4);
            if (base) {
#pragma unroll
                for (int ai = 0; ai < 2; ++ai)
#pragma unroll
                    for (int m = 0; m < 4; ++m) { const int row = row0 + ai * 128 + m * 16; const f32x4 v0 = acc[ai][bj][m][0] + bv0, v1 = acc[ai][bj][m][1] + bv1;
                        *(u32x4*)(base + (size_t)row * pitch) = (u32x4){pg8::cvt_pk_bf16(v0[0], v0[1]), pg8::cvt_pk_bf16(v0[2], v0[3]), pg8::cvt_pk_bf16(v1[0], v1[1]), pg8::cvt_pk_bf16(v1[2], v1[3])}; }
            } else if (fbase) {
#pragma unroll
                for (int ai = 0; ai < 2; ++ai)
#pragma unroll
                    for (int m = 0; m < 4; ++m) { const int row = row0 + ai * 128 + m * 16; *(f32x4*)(fbase + (size_t)row * 16) = acc[ai][bj][m][0] + bv0; *(f32x4*)(fbase + (size_t)row * 16 + 4) = acc[ai][bj][m][1] + bv1; }
            }
        }
    }
};
struct InProjSched {
    pg8::StaticOrder so; int f8;
    __device__ __forceinline__ bool next(int i, pg8::Unit& u) const { if (!so.next(i, u)) return false; u.pn = f8 ? (u.pn < 6 ? u.pn : u.pn + 4) : u.pn + 6; return true; }
    __device__ __forceinline__ void a_ready(const pg8::Unit&) const {}
    __device__ __forceinline__ void done(const pg8::Unit&) const {}
};
struct EpiInProj8 {
    static constexpr bool PERM = true, AFTER_DRAIN = false;
    const float* bias; unsigned char* ws;
    __device__ __forceinline__ void operator()(const f32x4 (&acc)[2][2][4][2], const pg8::Unit& u, int wr, int wc, int fr, int fq) const {
        asm volatile("" : "+v"(fr), "+v"(fq));
        const int pn = u.pn, row0 = u.pm * 256 + wr * 64 + fr, b = u.pm >> 3;
#pragma unroll
        for (int bj = 0; bj < 2; ++bj) {
            const int c8 = 128 * bj + 32 * wc + 8 * fq;
            bf16* base; int pitch;
            if (pn < 2) { base = (bf16*)(ws + WS_MLQK) + pn * 256 + c8; pitch = 512; }
            else if (pn < 4) { base = (bf16*)(ws + WS_MLV) + (pn - 2) * 256 + c8; pitch = 512; }
            else if (pn < 6) { base = (bf16*)(ws + WS_MLO) + (pn - 4) * 256 + c8; pitch = 512; }
            else if (pn < 16) { const int t = (pn - 10) >> 1, hh = ((pn - 10) & 1) * 2 + bj;
                base = (bf16*)(ws + WS_FXQ + (size_t)t * (WS_FXK - WS_FXQ)) + (size_t)(b * 3 + hh) * 2048 * 128 + 32 * wc + 8 * fq; pitch = 128; }
            else { base = (bf16*)(ws + WS_GATES) + (pn - 16) * 256 + c8; pitch = 3072; }
            const f32x4 bv0 = *(const f32x4*)(bias + pn * 256 + c8), bv1 = *(const f32x4*)(bias + pn * 256 + c8 + 4);
#pragma unroll
            for (int ai = 0; ai < 2; ++ai)
#pragma unroll
                for (int m = 0; m < 4; ++m) { const int row = row0 + ai * 128 + m * 16; const f32x4 v0 = acc[ai][bj][m][0] + bv0, v1 = acc[ai][bj][m][1] + bv1;
                    *(u32x4*)(base + (size_t)row * pitch) = (u32x4){pg8::cvt_pk_bf16(v0[0], v0[1]), pg8::cvt_pk_bf16(v0[2], v0[3]), pg8::cvt_pk_bf16(v1[0], v1[1]), pg8::cvt_pk_bf16(v1[2], v1[3])}; }
        }
    }
};
struct BranchSched {
    int G, c, brpack, nbr;
    __device__ __forceinline__ bool next(int i, pg8::Unit& u) const {
        const int tile = (i / nbr) * G + c, br = (brpack >> (2 * (i % nbr))) & 3; if (tile >= 256) return false;
        u.pm = br * 64 + (tile >> 2); u.pn = br * 4 + (tile & 3); return true;
    }
    __device__ __forceinline__ void a_ready(const pg8::Unit&) const {}
    __device__ __forceinline__ void done(const pg8::Unit&) const {}
};
struct EpiBranch {
    static constexpr bool PERM = true, AFTER_DRAIN = false;
    const bf16* gates; bf16* merged; int br0; unsigned char* merged8;
    __device__ __forceinline__ void operator()(const f32x4 (&acc)[2][2][4][2], const pg8::Unit& u, int wr, int wc, int fr, int fq) const {
        asm volatile("" : "+v"(fr), "+v"(fq));
        const int br = u.pm >> 6, row0 = (u.pm & 63) * 256 + wr * 64 + fr, col0 = (u.pn & 3) * 256 + 32 * wc + 8 * fq;
        u32x4 gqn[2], oldn[2];
#pragma unroll
        for (int bj = 0; bj < 2; ++bj) { gqn[bj] = *(const u32x4*)(gates + (size_t)row0 * 3072 + br * 1024 + col0 + bj * 128);
            oldn[bj] = (br != br0) ? *(const u32x4*)(merged + (size_t)row0 * 1024 + col0 + bj * 128) : (u32x4){0u, 0u, 0u, 0u}; }
#pragma unroll
        for (int gi = 0; gi < 8; ++gi) { const int ai = gi >> 2, m = gi & 3, row = row0 + ai * 128 + m * 16;
            u32x4 gq[2], old[2];
#pragma unroll
            for (int bj = 0; bj < 2; ++bj) { gq[bj] = gqn[bj]; old[bj] = oldn[bj]; }
            if (gi < 7) { const int rown = row0 + ((gi + 1) >> 2) * 128 + ((gi + 1) & 3) * 16;
#pragma unroll
                for (int bj = 0; bj < 2; ++bj) { gqn[bj] = *(const u32x4*)(gates + (size_t)rown * 3072 + br * 1024 + col0 + bj * 128);
                    if (br != br0) oldn[bj] = *(const u32x4*)(merged + (size_t)rown * 1024 + col0 + bj * 128); } }
#pragma unroll
            for (int bj = 0; bj < 2; ++bj) { const int col = col0 + bj * 128;
                float v[8];
#pragma unroll
                for (int q = 0; q < 4; ++q) { const float g0 = bf2f(gq[bj][q] & 0xffffu), g1 = bf2f(gq[bj][q] >> 16);
                    v[2 * q] = acc[ai][bj][m][q >> 1][(2 * q) & 3] * __builtin_amdgcn_rcpf(1.0f + __builtin_amdgcn_exp2f(-1.4426950408889634f * g0));
                    v[2 * q + 1] = acc[ai][bj][m][q >> 1][(2 * q + 1) & 3] * __builtin_amdgcn_rcpf(1.0f + __builtin_amdgcn_exp2f(-1.4426950408889634f * g1)); }
                if (br != br0) {
#pragma unroll
                    for (int q = 0; q < 4; ++q) { v[2 * q] += bf2f(old[bj][q] & 0xffffu); v[2 * q + 1] += bf2f(old[bj][q] >> 16); } }
                if (br == 2) *(u32x2*)(merged8 + (size_t)row * 1024 + col) = (u32x2){pk4_fp8(v[0], v[1], v[2], v[3]), pk4_fp8(v[4], v[5], v[6], v[7])};
                else *(u32x4*)(merged + (size_t)row * 1024 + col) = (u32x4){pg8::cvt_pk_bf16(v[0], v[1]), pg8::cvt_pk_bf16(v[2], v[3]), pg8::cvt_pk_bf16(v[4], v[5]), pg8::cvt_pk_bf16(v[6], v[7])}; }
            asm volatile("" ::: "memory"); }
    }
};
struct EpiOutProj {
    static constexpr bool PERM = false, AFTER_DRAIN = false;
    const float* xsrc; float* X; const float* modl;
    __device__ __forceinline__ void operator()(const f32x4 (&acc)[2][2][4][2], const pg8::Unit& u, int wr, int wc, int fr, int fq) const {
        asm volatile("" : "+v"(fr), "+v"(fq));
        const int row0 = u.pm * 256 + wr * 64 + fr, col0 = u.pn * 256 + wc * 32 + 4 * fq; const float* g1 = modl + (size_t)(u.pm >> 3) * 6144 + 2048;
        f32x4 gv[2][2];
#pragma unroll
        for (int bj = 0; bj < 2; ++bj)
#pragma unroll
            for (int n = 0; n < 2; ++n) gv[bj][n] = *(const f32x4*)(g1 + col0 + bj * 128 + n * 16);
        f32x4 xn[2][2];
#pragma unroll
        for (int bj = 0; bj < 2; ++bj)
#pragma unroll
            for (int n = 0; n < 2; ++n) xn[bj][n] = *(const f32x4*)(xsrc + (size_t)row0 * 1024 + col0 + bj * 128 + n * 16);
#pragma unroll
        for (int gi = 0; gi < 8; ++gi) { const int ai = gi >> 2, m = gi & 3; const size_t off = (size_t)(row0 + ai * 128 + m * 16) * 1024 + col0;
            f32x4 xc[2][2];
#pragma unroll
            for (int bj = 0; bj < 2; ++bj)
#pragma unroll
                for (int n = 0; n < 2; ++n) xc[bj][n] = xn[bj][n];
            if (gi < 7) { const size_t offn = (size_t)(row0 + ((gi + 1) >> 2) * 128 + ((gi + 1) & 3) * 16) * 1024 + col0;
#pragma unroll
                for (int bj = 0; bj < 2; ++bj)
#pragma unroll
                    for (int n = 0; n < 2; ++n) xn[bj][n] = *(const f32x4*)(xsrc + offn + bj * 128 + n * 16); }
#pragma unroll
            for (int bj = 0; bj < 2; ++bj)
#pragma unroll
                for (int n = 0; n < 2; ++n) *(f32x4*)(X + off + bj * 128 + n * 16) = xc[bj][n] + gv[bj][n] * acc[ai][bj][m][n];
            asm volatile("" ::: "memory"); }
    }
};

__device__ __forceinline__ float logsigf(float f) { return fminf(f, 0.f) - __logf(1.0f + __expf(-fabsf(f))); }
__device__ __forceinline__ void fox_unit(Frame& F, int b, int h, int qb) {
    char* lds = (char*)F.lds; const int tid = F.tid, lane = (F.tid & 63), wid = F.wave;
    const int n = (qb + 1) * 256;
    {   const float* fsrc = WSP(float, WS_SCAL) + (size_t)b * 2048 * 16 + 12 + h;
        float ls[4], run = 0.f;
#pragma unroll
        for (int q = 0; q < 4; ++q) { const int s = 4 * tid + q; const float v = (s < n) ? logsigf(fsrc[(size_t)s * 16]) : 0.f; run += v; ls[q] = run; }
        float incl = run;
#pragma unroll
        for (int off = 1; off < 64; off <<= 1) { const float t = lshfl(incl, (lane - off) & 63); if (lane >= off) incl += t; }
        float* scan = (float*)(lds + att::LDS_SCAN);
        if (lane == 63) scan[wid] = incl;
        __syncthreads();
        float base = 0.f;
        for (int w2 = 0; w2 < wid; ++w2) base += scan[w2];
        const float excl = base + incl - run;
        *(f32x4*)((float*)(lds + att::LDS_KB) + 4 * tid) = (f32x4){-(excl + ls[0]) * 11.313708498984761f, -(excl + ls[1]) * 11.313708498984761f, -(excl + ls[2]) * 11.313708498984761f, -(excl + ls[3]) * 11.313708498984761f};
        __syncthreads();
    }
    const size_t hb = (size_t)(b * 4 + h) * 2048 * 128;
    att::BlockRef r{WSP(bf16, WS_FXQ) + hb + (size_t)qb * 256 * 128, WSP(bf16, WS_FXK) + hb, WSP(bf16, WS_FXV) + hb,
                    WSP(bf16, WS_YCAT) + (size_t)2 * M * 512 + (size_t)(b * 2048 + qb * 256) * 512 + h * 128, 512, qb * 256, 4 * (qb + 1), nullptr};
    att::Seam S;
    att::prime<0>(r, lds, S, tid); att::block<0>(r, r, lds, S, tid);
}
constexpr size_t WS_NLOC = WS_MLST, WS_NPREV = WS_MLST + 262144, WS_MLOC = WS_MLST + 524288, WS_BLAST = WS_MLOC + 4096, WS_MPREV = WS_BLAST + 4096;
namespace ml {
using att::f32x16; using att::s16x4;
constexpr int L_Q = 0, L_K = 8192, L_V = 16384, L_HID = 32768, L_G = L_HID + 64 * 132 * 4, L_WS = L_G + 2048;
__device__ __forceinline__ void stage_conv(char* tile, const bf16* X, const float* cw, const float* cb, int row0, int spos0, int ch0, float scale, int tid) {
    const int s = tid >> 3, ch = ch0 + (tid & 7) * 8;
    float a[8];
    { const f32x4 b0 = *(const f32x4*)(cb + ch), b1 = *(const f32x4*)(cb + ch + 4); a[0] = b0[0]; a[1] = b0[1]; a[2] = b0[2]; a[3] = b0[3]; a[4] = b1[0]; a[5] = b1[1]; a[6] = b1[2]; a[7] = b1[3]; }
#pragma unroll
    for (int j = 0; j < 4; ++j) { if (spos0 + s - 3 + j >= 0) {
            const bf16x8 x = *(const bf16x8*)(X + (size_t)(row0 + s - 3 + j) * 512 + ch);
            const f32x4 w0 = *(const f32x4*)(cw + j * 512 + ch), w1 = *(const f32x4*)(cw + j * 512 + ch + 4);
#pragma unroll
            for (int i = 0; i < 4; ++i) { a[i] += w0[i] * bf2f((unsigned short)x[i]); a[4 + i] += w1[i] * bf2f((unsigned short)x[4 + i]); } } }
#pragma unroll
    for (int i = 0; i < 8; ++i) a[i] = a[i] * scale / (1.0f + __expf(-a[i]));
    *(u32x4*)(tile + (s * 64 + (tid & 7) * 8) * 2) = (u32x4){att::cvtpk(a[0], a[1]), att::cvtpk(a[2], a[3]), att::cvtpk(a[4], a[5]), att::cvtpk(a[6], a[7])};
}
__device__ __forceinline__ void stage_conv4(char* tile0, const bf16* X, const float* cw, const float* cb, int row0, int spos0, int ch0, float scale, int tid) {
    const int s = tid >> 3, ch = ch0 + (tid & 7) * 8;
    bf16x8 x[4][4];
#pragma unroll
    for (int c = 0; c < 4; ++c)
#pragma unroll
        for (int j = 0; j < 4; ++j) { const int sp = spos0 + 64 * c + s - 3 + j; x[c][j] = *(const bf16x8*)(X + (size_t)(row0 + 64 * c + s - 3 + j + (sp < 0 ? 3 : 0)) * 512 + ch); }
    f32x4 w0[4], w1[4];
#pragma unroll
    for (int j = 0; j < 4; ++j) { w0[j] = *(const f32x4*)(cw + j * 512 + ch); w1[j] = *(const f32x4*)(cw + j * 512 + ch + 4); }
    const f32x4 b0 = *(const f32x4*)(cb + ch), b1 = *(const f32x4*)(cb + ch + 4);
#pragma unroll
    for (int c = 0; c < 4; ++c) { float a[8] = {b0[0], b0[1], b0[2], b0[3], b1[0], b1[1], b1[2], b1[3]};
#pragma unroll
        for (int j = 0; j < 4; ++j) { const float msk = (spos0 + 64 * c + s - 3 + j >= 0) ? 1.0f : 0.0f;
#pragma unroll
            for (int i = 0; i < 4; ++i) { a[i] += msk * w0[j][i] * bf2f((unsigned short)x[c][j][i]); a[4 + i] += msk * w1[j][i] * bf2f((unsigned short)x[c][j][4 + i]); } }
#pragma unroll
        for (int i = 0; i < 8; ++i) a[i] = a[i] * scale / (1.0f + __expf(-a[i]));
        *(u32x4*)(tile0 + c * 8192 + (s * 64 + (tid & 7) * 8) * 2) = (u32x4){att::cvtpk(a[0], a[1]), att::cvtpk(a[2], a[3]), att::cvtpk(a[4], a[5]), att::cvtpk(a[6], a[7])}; }
}
__device__ __forceinline__ void stage_v(char* V_lds, const bf16* Vg, int row0, int h, int tid) {
    const int sr = tid >> 4, sc = (tid & 15) * 8;
    const bf16x8 v0 = *(const bf16x8*)(Vg + (size_t)(row0 + sr) * 512 + h * 128 + sc), v1 = *(const bf16x8*)(Vg + (size_t)(row0 + 32 + sr) * 512 + h * 128 + sc);
    *(bf16x8*)(V_lds + att::v_st(sr, sc)) = v0; *(bf16x8*)(V_lds + att::v_st(32 + sr, sc)) = v1;
}
__device__ __forceinline__ void stage_gates(float* G, const float* scal, int row0, int h, int lane, float& b_last, float& m_loc) {
    const float ig = scal[(size_t)(row0 + lane) * 16 + h], f = logsigf(scal[(size_t)(row0 + lane) * 16 + 4 + h]);
    float b = f;
#pragma unroll
    for (int off = 1; off < 64; off <<= 1) { const float t = lshfl(b, (lane - off) & 63); if (lane >= off) b += t; }
    b_last = __builtin_bit_cast(float, __builtin_amdgcn_readlane(__builtin_bit_cast(int, b), 63));
    const float wst = b_last - b + ig; float mx = wst;
#pragma unroll
    for (int off = 1; off < 64; off <<= 1) mx = fmaxf(mx, lshfl(mx, lane ^ off));
    m_loc = mx;
    G[lane] = b; G[64 + lane] = ig - b; G[128 + lane] = __expf(wst - mx);
}
#define TRRD(dst, off) asm volatile("ds_read_b64_tr_b16 %0, %1 offset:%2" : "=&v"(dst) : "v"(vb), "i"(off) : "memory")
#define VFRAG(l_, h_) (bf16x8){l_[0], l_[1], l_[2], l_[3], h_[0], h_[1], h_[2], h_[3]}
__device__ __forceinline__ void mma_v(f32x16& acc, int vb, bf16x8 pa0, bf16x8 pa1, bf16x8 pa2, bf16x8 pa3) {
    s16x4 l0, l1, l2, l3, h0, h1, h2, h3;
    TRRD(l0, 0); TRRD(h0, 2048); TRRD(l1, 4096); TRRD(h1, 6144); TRRD(l2, 8192); TRRD(h2, 10240); TRRD(l3, 12288); TRRD(h3, 14336);
    asm volatile("s_waitcnt lgkmcnt(0)" ::: "memory"); __builtin_amdgcn_sched_barrier(0);
    acc = __builtin_amdgcn_mfma_f32_32x32x16_bf16(pa0, VFRAG(l0, h0), acc, 0, 0, 0);
    acc = __builtin_amdgcn_mfma_f32_32x32x16_bf16(pa1, VFRAG(l1, h1), acc, 0, 0, 0);
    acc = __builtin_amdgcn_mfma_f32_32x32x16_bf16(pa2, VFRAG(l2, h2), acc, 0, 0, 0);
    acc = __builtin_amdgcn_mfma_f32_32x32x16_bf16(pa3, VFRAG(l3, h3), acc, 0, 0, 0);
}
#undef TRRD
#undef VFRAG
__device__ __forceinline__ void unit_local(Frame& F, int l, int u) {
    char* lds = (char*)F.lds; const int tid = F.tid, lane = tid & 63, wid = F.wave, r32 = lane & 31, hi = lane >> 5;
    const int bh = u >> 5, c = u & 31, b = bh >> 2, h = bh & 3, row0 = b * 2048 + c * 64;
    float* G = (float*)(lds + L_G);
    stage_conv(lds + L_K, WSP(bf16, WS_MLQK), KIN(I_CONVW) + (size_t)l * 2048, KIN(I_CONVB) + (size_t)l * 512, row0, c * 64, 256 + h * 64, 1.0f, tid);
    stage_v(lds + L_V, WSP(bf16, WS_MLV), row0, h, tid);
    if (wid == 0) { float bl, mlc; stage_gates(G, WSP(float, WS_SCAL), row0, h, lane, bl, mlc); if (lane == 0) { WSP(float, WS_MLOC)[u] = mlc; WSP(float, WS_BLAST)[u] = bl; } }
    __syncthreads();
    const int kblk = wid >> 2, vblk = wid & 3;
    bf16x8 pa[4];
    const unsigned short* Kc = (const unsigned short*)(lds + L_K);
#pragma unroll
    for (int ks = 0; ks < 4; ++ks) { float w[8];
#pragma unroll
        for (int j = 0; j < 8; ++j) { const int s = 16 * ks + 8 * hi + j; w[j] = bf2f(Kc[s * 64 + kblk * 32 + r32]) * G[128 + s]; }
        u32x4 q = {att::cvtpk(w[0], w[1]), att::cvtpk(w[2], w[3]), att::cvtpk(w[4], w[5]), att::cvtpk(w[6], w[7])}; pa[ks] = *reinterpret_cast<bf16x8*>(&q); }
    f32x16 acc = ozero16();
    mma_v(acc, (int)(uintptr_t)(lds + L_V) + att::v_rd_base(lane) + vblk * 512, pa[0], pa[1], pa[2], pa[3]);
    float* cl = WSP(float, WS_CLOC) + (size_t)u * 8192 + (size_t)(vblk * 32 + r32) * 64 + kblk * 32 + 4 * hi;
#pragma unroll
    for (int g = 0; g < 4; ++g) *(f32x4*)(cl + 8 * g) = (f32x4){acc[4 * g], acc[4 * g + 1], acc[4 * g + 2], acc[4 * g + 3]};
    if (tid < 64) { float s_ = 0.f; for (int s = 0; s < 64; ++s) s_ += G[128 + s] * bf2f(Kc[s * 64 + tid]); WSP(float, WS_NLOC)[(size_t)u * 64 + tid] = s_; }
    __syncthreads();
}
__device__ __forceinline__ void scan_item(Frame& F, int it) {
    const int tid = F.tid;
    float* dec_l = (float*)F.lds; float* scl_l = dec_l + 32; float* mpr_l = dec_l + 64;
    {
        const int bh = it / 5, seg = it % 5;
        __syncthreads();
        if (tid < 32) { dec_l[96 + tid] = WSP(float, WS_MLOC)[bh * 32 + tid]; dec_l[128 + tid] = WSP(float, WS_BLAST)[bh * 32 + tid]; }
        __syncthreads();
        if (tid == 0) { float m = -__builtin_inff();
            for (int c = 0; c < 32; ++c) { const float ml_ = dec_l[96 + c], bl = dec_l[128 + c], mn = fmaxf(bl + m, ml_);
                mpr_l[c] = m; dec_l[c] = __expf(bl + m - mn); scl_l[c] = __expf(ml_ - mn); m = mn; } }
        __syncthreads();
        if (seg < 4) { const int e = seg * 2048 + tid * 4; const float* cl = WSP(float, WS_CLOC) + (size_t)bh * 32 * 8192 + e; bf16* cp = WSP(bf16, WS_CPREV) + (size_t)bh * 32 * 8192 + e;
            f32x4 v[32];
#pragma unroll
            for (int c = 0; c < 32; ++c) v[c] = *(const f32x4*)(cl + (size_t)c * 8192);
            f32x4 st = ozero4();
#pragma unroll
            for (int c = 0; c < 32; ++c) { *(u32x2*)(cp + (size_t)c * 8192) = (u32x2){pk2(st[0], st[1]), pk2(st[2], st[3])}; st = dec_l[c] * st + scl_l[c] * v[c]; }
        } else if (tid < 64) { const float* nl = WSP(float, WS_NLOC) + (size_t)bh * 32 * 64 + tid; float* np = WSP(float, WS_NPREV) + (size_t)bh * 32 * 64 + tid;
            float v[32];
#pragma unroll
            for (int c = 0; c < 32; ++c) v[c] = nl[(size_t)c * 64];
            float st = 0.f;
#pragma unroll
            for (int c = 0; c < 32; ++c) { np[(size_t)c * 64] = st; if (tid == 0) WSP(float, WS_MPREV)[bh * 32 + c] = mpr_l[c]; st = dec_l[c] * st + scl_l[c] * v[c]; }
        }
    }
}
__device__ __forceinline__ void unit_out(Frame& F, int l, int u) {
    char* lds = (char*)F.lds; const int tid = F.tid, lane = tid & 63, wid = F.wave, r32 = lane & 31, hi = lane >> 5;
    const int bh = u >> 5, c = u & 31, b = bh >> 2, h = bh & 3, row0 = b * 2048 + c * 64;
    float* G = (float*)(lds + L_G);
    stage_conv(lds + L_Q, WSP(bf16, WS_MLQK), KIN(I_CONVW) + (size_t)l * 2048, KIN(I_CONVB) + (size_t)l * 512, row0, c * 64, h * 64, 0.125f, tid);
    stage_conv(lds + L_K, WSP(bf16, WS_MLQK), KIN(I_CONVW) + (size_t)l * 2048, KIN(I_CONVB) + (size_t)l * 512, row0, c * 64, 256 + h * 64, 1.0f, tid);
    stage_v(lds + L_V, WSP(bf16, WS_MLV), row0, h, tid);
    if (wid == 0) { float bl, mlc; stage_gates(G, WSP(float, WS_SCAL), row0, h, lane, bl, mlc); G[192 + lane] = WSP(float, WS_NPREV)[(size_t)u * 64 + lane]; }
    __syncthreads();
    const int rb = wid >> 2, vblk = wid & 3, t = rb * 32 + r32;
    bf16x8 qf[4];
#pragma unroll
    for (int ks = 0; ks < 4; ++ks) qf[ks] = *(const bf16x8*)(lds + L_Q + t * 128 + (16 * ks + 8 * hi) * 2);
    f32x16 p0 = ozero16(), p1 = p0;
#pragma unroll
    for (int ks = 0; ks < 4; ++ks) { const bf16x8 k0 = *(const bf16x8*)(lds + L_K + r32 * 128 + (16 * ks + 8 * hi) * 2), k1 = *(const bf16x8*)(lds + L_K + (32 + r32) * 128 + (16 * ks + 8 * hi) * 2);
        p0 = __builtin_amdgcn_mfma_f32_32x32x16_bf16(k0, qf[ks], p0, 0, 0, 0); p1 = __builtin_amdgcn_mfma_f32_32x32x16_bf16(k1, qf[ks], p1, 0, 0, 0); }
    const float bt = G[t], inter = bt + WSP(float, WS_MPREV)[u];
    const float NEG = -__builtin_inff();
    f32x16 d0, d1; float mo = inter;
#pragma unroll
    for (int r = 0; r < 16; ++r) { const int s0 = att::crow(r, hi), s1 = 32 + s0; d0[r] = (s0 <= t) ? bt + G[64 + s0] : NEG; d1[r] = (s1 <= t) ? bt + G[64 + s1] : NEG; mo = fmaxf(mo, fmaxf(d0[r], d1[r])); }
    { auto rr = __builtin_amdgcn_permlane32_swap(__float_as_uint(mo), __float_as_uint(mo), false, false); mo = fmaxf(__uint_as_float(rr[0]), __uint_as_float(rr[1])); }
    float den = 0.f;
#pragma unroll
    for (int r = 0; r < 16; ++r) { p0[r] *= __expf(d0[r] - mo); p1[r] *= __expf(d1[r] - mo); den += p0[r] + p1[r]; }
    const float a_int = __expf(inter - mo);
    float nd = 0.f;
#pragma unroll
    for (int ks = 0; ks < 4; ++ks)
#pragma unroll
        for (int j = 0; j < 8; ++j) nd += G[192 + 16 * ks + 8 * hi + j] * bf2f((unsigned short)qf[ks][j]);
    den += a_int * nd;
    { auto rr = __builtin_amdgcn_permlane32_swap(__float_as_uint(den), __float_as_uint(den), false, false); den = __uint_as_float(rr[0]) + __uint_as_float(rr[1]); }
    float* wsl = (float*)(lds + L_WS) + wid * 64;
    if (hi == 0) wsl[r32] = 1.0f / fmaxf(fabsf(den), __expf(-mo));
    bf16x8 pa0, pa1, pa2, pa3;
#define PK4(P, B_, OUT) do { unsigned a0 = att::cvtpk(P[B_+0], P[B_+1]), a1 = att::cvtpk(P[B_+2], P[B_+3]);                          \
        unsigned b0 = att::cvtpk(P[B_+4], P[B_+5]), b1 = att::cvtpk(P[B_+6], P[B_+7]);                                             \
        auto r0 = __builtin_amdgcn_permlane32_swap(a0, b0, false, false); auto r1 = __builtin_amdgcn_permlane32_swap(a1, b1, false, false); \
        u32x4 w = {r0[0], r1[0], r0[1], r1[1]}; OUT = *reinterpret_cast<bf16x8*>(&w); } while (0)
    PK4(p0, 0, pa0); PK4(p0, 8, pa1); PK4(p1, 0, pa2); PK4(p1, 8, pa3);
#undef PK4
    f32x16 o = ozero16();
    mma_v(o, (int)(uintptr_t)(lds + L_V) + att::v_rd_base(lane) + vblk * 512, pa0, pa1, pa2, pa3);
    const bf16* cp = WSP(bf16, WS_CPREV) + (size_t)u * 8192 + (size_t)(vblk * 32 + r32) * 64 + 8 * hi;
#pragma unroll
    for (int ks = 0; ks < 4; ++ks) { float w[8];
#pragma unroll
        for (int j = 0; j < 8; ++j) w[j] = a_int * bf2f((unsigned short)qf[ks][j]);
        u32x4 q = {att::cvtpk(w[0], w[1]), att::cvtpk(w[2], w[3]), att::cvtpk(w[4], w[5]), att::cvtpk(w[6], w[7])};
        o = __builtin_amdgcn_mfma_f32_32x32x16_bf16(*reinterpret_cast<bf16x8*>(&q), *(const bf16x8*)(cp + 16 * ks), o, 0, 0, 0); }
    asm volatile("s_waitcnt lgkmcnt(0)" ::: "memory");
    float* hid = (float*)(lds + L_HID);
#pragma unroll
    for (int r = 0; r < 16; ++r) { const int tr = att::crow(r, hi); hid[(rb * 32 + tr) * 132 + vblk * 32 + r32] = o[r] * wsl[tr]; }
    __syncthreads();
    {   const int row = tid >> 3, seg = (tid & 7) * 16; const float* hr = hid + row * 132 + seg;
        float v[16], ss = 0.f;
#pragma unroll
        for (int i = 0; i < 4; ++i) { const f32x4 q = *(const f32x4*)(hr + 4 * i); v[4 * i] = q[0]; v[4 * i + 1] = q[1]; v[4 * i + 2] = q[2]; v[4 * i + 3] = q[3]; ss += (q[0] * q[0] + q[1] * q[1]) + (q[2] * q[2] + q[3] * q[3]); }
        ss += qxor1(ss); ss += qxor2(ss); ss += hmirror(ss);
        const float rn = 1.0f / sqrtf(ss * (1.0f / 128.0f) + EPS);
        const float* gn = KIN(I_MLG) + (size_t)l * 512 + h * 128 + seg;
        const bf16* og = WSP(bf16, WS_MLO) + (size_t)(row0 + row) * 512 + h * 128 + seg;
        const u32x4 o0 = *(const u32x4*)og, o1 = *(const u32x4*)(og + 8); unsigned w[8];
#pragma unroll
        for (int i = 0; i < 8; ++i) { const unsigned oo = i < 4 ? o0[i] : o1[i - 4]; const float g0 = bf2f(oo & 0xffffu), g1 = bf2f(oo >> 16);
            const float y0 = v[2 * i] * rn * gn[2 * i] / (1.0f + __expf(-g0)), y1 = v[2 * i + 1] * rn * gn[2 * i + 1] / (1.0f + __expf(-g1));
            w[i] = att::cvtpk(y0, y1); }
        bf16* yo = WSP(bf16, WS_YCAT) + (size_t)(row0 + row) * 512 + h * 128 + seg;
        *(u32x4*)yo = (u32x4){w[0], w[1], w[2], w[3]}; *(u32x4*)(yo + 8) = (u32x4){w[4], w[5], w[6], w[7]};
    }
    __syncthreads();
}
__device__ __forceinline__ void unit_out4(Frame& F, int l, int u4) {
    char* lds = (char*)F.lds; const int tid = F.tid, lane = tid & 63, wid = F.wave, r32 = lane & 31, hi = lane >> 5;
    const int bh = u4 >> 3, g4 = u4 & 7, b = bh >> 2, h = bh & 3, row00 = b * 2048 + g4 * 256;
    constexpr int O_Q = 0, O_K = 32768, O_V = 65536, O_G = LDSCTL_OFF + 1024, O_WS = O_G + 4096;
    const float* cw = KIN(I_CONVW) + (size_t)l * 2048; const float* cb = KIN(I_CONVB) + (size_t)l * 512;
    stage_conv4(lds + O_Q, WSP(bf16, WS_MLQK), cw, cb, row00, g4 * 256, h * 64, 0.125f, tid);
    stage_conv4(lds + O_K, WSP(bf16, WS_MLQK), cw, cb, row00, g4 * 256, 256 + h * 64, 1.0f, tid);
#pragma unroll
    for (int c = 0; c < 4; ++c) stage_v(lds + O_V + c * 16384, WSP(bf16, WS_MLV), row00 + 64 * c, h, tid);
    if (wid < 4) { float bl, mlc; float* G = (float*)(lds + O_G) + wid * 256; stage_gates(G, WSP(float, WS_SCAL), row00 + 64 * wid, h, lane, bl, mlc);
        G[192 + lane] = WSP(float, WS_NPREV)[((size_t)bh * 32 + g4 * 4 + wid) * 64 + lane]; }
    const int c = wid >> 1, t = 32 * (wid & 1) + r32; const size_t u = (size_t)bh * 32 + g4 * 4 + c;
    bf16x8 cpf[4][4];
#pragma unroll
    for (int d0 = 0; d0 < 4; ++d0)
#pragma unroll
        for (int ks = 0; ks < 4; ++ks) cpf[d0][ks] = *(const bf16x8*)(WSP(bf16, WS_CPREV) + u * 8192 + (size_t)(d0 * 32 + r32) * 64 + 8 * hi + 16 * ks);
    const float mprev_u = WSP(float, WS_MPREV)[u];
    __syncthreads();
    const float* G = (const float*)(lds + O_G) + c * 256;
    bf16x8 qf[4];
#pragma unroll
    for (int ks = 0; ks < 4; ++ks) qf[ks] = *(const bf16x8*)(lds + O_Q + c * 8192 + t * 128 + (16 * ks + 8 * hi) * 2);
    f32x16 p0 = ozero16(), p1 = p0;
#pragma unroll
    for (int ks = 0; ks < 4; ++ks) { const bf16x8 k0 = *(const bf16x8*)(lds + O_K + c * 8192 + r32 * 128 + (16 * ks + 8 * hi) * 2), k1 = *(const bf16x8*)(lds + O_K + c * 8192 + (32 + r32) * 128 + (16 * ks + 8 * hi) * 2);
        p0 = __builtin_amdgcn_mfma_f32_32x32x16_bf16(k0, qf[ks], p0, 0, 0, 0); p1 = __builtin_amdgcn_mfma_f32_32x32x16_bf16(k1, qf[ks], p1, 0, 0, 0); }
    const float bt = G[t], inter = bt + mprev_u;
    const float NEG = -__builtin_inff();
    float mo = inter;
    {   f32x16 d0, d1;
#pragma unroll
        for (int r = 0; r < 16; ++r) { const int s0 = att::crow(r, hi), s1 = 32 + s0; d0[r] = (s0 <= t) ? bt + G[64 + s0] : NEG; d1[r] = (s1 <= t) ? bt + G[64 + s1] : NEG; mo = fmaxf(mo, fmaxf(d0[r], d1[r])); }
        { auto rr = __builtin_amdgcn_permlane32_swap(__float_as_uint(mo), __float_as_uint(mo), false, false); mo = fmaxf(__uint_as_float(rr[0]), __uint_as_float(rr[1])); }
#pragma unroll
        for (int r = 0; r < 16; ++r) { p0[r] *= __expf(d0[r] - mo); p1[r] *= __expf(d1[r] - mo); }
    }
    float den = 0.f;
#pragma unroll
    for (int r = 0; r < 16; ++r) den += p0[r] + p1[r];
    const float a_int = __expf(inter - mo);
    float nd = 0.f;
#pragma unroll
    for (int ks = 0; ks < 4; ++ks)
#pragma unroll
        for (int j = 0; j < 8; ++j) nd += G[192 + 16 * ks + 8 * hi + j] * bf2f((unsigned short)qf[ks][j]);
    den += a_int * nd;
    { auto rr = __builtin_amdgcn_permlane32_swap(__float_as_uint(den), __float_as_uint(den), false, false); den = __uint_as_float(rr[0]) + __uint_as_float(rr[1]); }
    float* wsl = (float*)(lds + O_WS) + wid * 64;
    if (hi == 0) wsl[r32] = 1.0f / fmaxf(fabsf(den), __expf(-mo));
    bf16x8 pa0, pa1, pa2, pa3;
#define PK4(P, B_, OUT) do { unsigned a0 = att::cvtpk(P[B_+0], P[B_+1]), a1 = att::cvtpk(P[B_+2], P[B_+3]);                          \
        unsigned b0 = att::cvtpk(P[B_+4], P[B_+5]), b1 = att::cvtpk(P[B_+6], P[B_+7]);                                             \
        auto r0 = __builtin_amdgcn_permlane32_swap(a0, b0, false, false); auto r1 = __builtin_amdgcn_permlane32_swap(a1, b1, false, false); \
        u32x4 w = {r0[0], r1[0], r0[1], r1[1]}; OUT = *reinterpret_cast<bf16x8*>(&w); } while (0)
    PK4(p0, 0, pa0); PK4(p0, 8, pa1); PK4(p1, 0, pa2); PK4(p1, 8, pa3);
#undef PK4
    bf16x8 qa[4];
#pragma unroll
    for (int ks = 0; ks < 4; ++ks) { float w[8];
#pragma unroll
        for (int j = 0; j < 8; ++j) w[j] = a_int * bf2f((unsigned short)qf[ks][j]);
        u32x4 q = {att::cvtpk(w[0], w[1]), att::cvtpk(w[2], w[3]), att::cvtpk(w[4], w[5]), att::cvtpk(w[6], w[7])}; qa[ks] = *reinterpret_cast<bf16x8*>(&q); }
    f32x16 o[4];
    const int vbase = (int)(uintptr_t)(lds + O_V + c * 16384) + att::v_rd_base(lane);
#pragma unroll
    for (int d0 = 0; d0 < 4; ++d0) { o[d0] = ozero16();
        mma_v(o[d0], vbase + d0 * 512, pa0, pa1, pa2, pa3);
#pragma unroll
        for (int ks = 0; ks < 4; ++ks) o[d0] = __builtin_amdgcn_mfma_f32_32x32x16_bf16(qa[ks], cpf[d0][ks], o[d0], 0, 0, 0); }
    asm volatile("s_waitcnt lgkmcnt(0)" ::: "memory");
    float rinv[16];
#pragma unroll
    for (int r = 0; r < 16; ++r) rinv[r] = wsl[att::crow(r, hi)];
    __syncthreads();
    unsigned short* ht = (unsigned short*)(lds + wid * 8704);
#pragma unroll
    for (int r = 0; r < 16; ++r) { const int tr = att::crow(r, hi);
#pragma unroll
        for (int d0 = 0; d0 < 4; ++d0) ht[tr * 136 + d0 * 32 + r32] = (unsigned short)f2bf(o[d0][r] * rinv[r]); }
    asm volatile("s_waitcnt lgkmcnt(0)" ::: "memory");
    {   const int row = lane >> 1, seg = (lane & 1) * 64; const unsigned short* hr = ht + row * 136 + seg;
        u32x4 hv[8]; float ss = 0.f;
#pragma unroll
        for (int i = 0; i < 8; ++i) { hv[i] = *(const u32x4*)(hr + 8 * i);
#pragma unroll
            for (int q = 0; q < 4; ++q) { const float a = bf2f(hv[i][q] & 0xffffu), b2 = bf2f(hv[i][q] >> 16); ss += a * a + b2 * b2; } }
        ss += __builtin_bit_cast(float, __builtin_amdgcn_update_dpp(0, __builtin_bit_cast(int, ss), 0xB1, 0xf, 0xf, false));
        const float rn = 1.0f / sqrtf(ss * (1.0f / 128.0f) + EPS);
        const int grow = row00 + 64 * c + 32 * (wid & 1) + row;
        const float* gn = KIN(I_MLG) + (size_t)l * 512 + h * 128 + seg;
        const bf16* og = WSP(bf16, WS_MLO) + (size_t)grow * 512 + h * 128 + seg;
        bf16* yo = WSP(bf16, WS_YCAT) + (size_t)grow * 512 + h * 128 + seg;
#pragma unroll
        for (int i = 0; i < 8; ++i) { const u32x4 oo = *(const u32x4*)(og + 8 * i); const f32x4 g0 = *(const f32x4*)(gn + 8 * i), g1 = *(const f32x4*)(gn + 8 * i + 4); unsigned w[4];
#pragma unroll
            for (int q = 0; q < 4; ++q) { const float a = bf2f(hv[i][q] & 0xffffu), b2 = bf2f(hv[i][q] >> 16), ga = bf2f(oo[q] & 0xffffu), gb = bf2f(oo[q] >> 16);
                const float wa = q < 2 ? g0[2 * q] : g1[2 * q - 4], wb = q < 2 ? g0[2 * q + 1] : g1[2 * q - 3];
                w[q] = att::cvtpk(a * rn * wa / (1.0f + __expf(-ga)), b2 * rn * wb / (1.0f + __expf(-gb))); }
            *(u32x4*)(yo + 8 * i) = (u32x4){w[0], w[1], w[2], w[3]}; }
    }
    __syncthreads();
}
__device__ __forceinline__ void unit_local4(Frame& F, int l, int u4) {
    char* lds = (char*)F.lds; const int tid = F.tid, lane = tid & 63, wid = F.wave, r32 = lane & 31, hi = lane >> 5;
    const int bh = u4 >> 3, g4 = u4 & 7, b = bh >> 2, h = bh & 3, row00 = b * 2048 + g4 * 256;
    constexpr int O_K = 32768, O_V = 65536, O_G = LDSCTL_OFF + 1024;
    stage_conv4(lds + O_K, WSP(bf16, WS_MLQK), KIN(I_CONVW) + (size_t)l * 2048, KIN(I_CONVB) + (size_t)l * 512, row00, g4 * 256, 256 + h * 64, 1.0f, tid);
#pragma unroll
    for (int c = 0; c < 4; ++c) stage_v(lds + O_V + c * 16384, WSP(bf16, WS_MLV), row00 + 64 * c, h, tid);
    if (wid < 4) { float bl, mlc; stage_gates((float*)(lds + O_G) + wid * 256, WSP(float, WS_SCAL), row00 + 64 * wid, h, lane, bl, mlc);
        if (lane == 0) { WSP(float, WS_MLOC)[bh * 32 + g4 * 4 + wid] = mlc; WSP(float, WS_BLAST)[bh * 32 + g4 * 4 + wid] = bl; } }
    __syncthreads();
    const int c = wid >> 1, kblk = wid & 1; const size_t u = (size_t)bh * 32 + g4 * 4 + c;
    const float* G = (const float*)(lds + O_G) + c * 256;
    const unsigned short* Kc = (const unsigned short*)(lds + O_K + c * 8192);
    bf16x8 pa[4];
#pragma unroll
    for (int ks = 0; ks < 4; ++ks) { float w[8];
#pragma unroll
        for (int j = 0; j < 8; ++j) { const int s = 16 * ks + 8 * hi + j; w[j] = bf2f(Kc[s * 64 + kblk * 32 + r32]) * G[128 + s]; }
        u32x4 q = {att::cvtpk(w[0], w[1]), att::cvtpk(w[2], w[3]), att::cvtpk(w[4], w[5]), att::cvtpk(w[6], w[7])}; pa[ks] = *reinterpret_cast<bf16x8*>(&q); }
    const int vbase = (int)(uintptr_t)(lds + O_V + c * 16384) + att::v_rd_base(lane);
#pragma unroll
    for (int vblk = 0; vblk < 4; ++vblk) { f32x16 acc = ozero16();
        mma_v(acc, vbase + vblk * 512, pa[0], pa[1], pa[2], pa[3]);
        float* cl = WSP(float, WS_CLOC) + u * 8192 + (size_t)(vblk * 32 + r32) * 64 + kblk * 32 + 4 * hi;
#pragma unroll
        for (int g = 0; g < 4; ++g) *(f32x4*)(cl + 8 * g) = (f32x4){acc[4 * g], acc[4 * g + 1], acc[4 * g + 2], acc[4 * g + 3]}; }
    if (tid < 256) { const int c2 = tid >> 6, k = tid & 63; const float* G2 = (const float*)(lds + O_G) + c2 * 256; const unsigned short* K2 = (const unsigned short*)(lds + O_K + c2 * 8192);
        float s_ = 0.f; for (int s = 0; s < 64; ++s) s_ += G2[128 + s] * bf2f(K2[s * 64 + k]); WSP(float, WS_NLOC)[((size_t)bh * 32 + g4 * 4 + c2) * 64 + k] = s_; }
    __syncthreads();
}
}
__device__ __forceinline__ int wave_sum_i(int v) {
    v += __builtin_amdgcn_update_dpp(0, v, 0x128, 0xf, 0xf, false);
    v += __builtin_amdgcn_update_dpp(0, v, 0x124, 0xf, 0xf, false);
    v += __builtin_amdgcn_update_dpp(0, v, 0x122, 0xf, 0xf, false);
    v += __builtin_amdgcn_update_dpp(0, v, 0x121, 0xf, 0xf, false);
    return __builtin_amdgcn_readlane(v, 0) + __builtin_amdgcn_readlane(v, 16) + __builtin_amdgcn_readlane(v, 32) + __builtin_amdgcn_readlane(v, 48);
}
__device__ __forceinline__ unsigned sortkey(float f) { unsigned u = __float_as_uint(f); u = (u == 0x80000000u) ? 0u : u; return (u & 0x80000000u) ? ~u : (u | 0x80000000u); }
__device__ __forceinline__ void transpose32(unsigned (&A)[32]) {
    unsigned m = 0x0000FFFFu;
#pragma unroll
    for (int j = 16; j != 0; j >>= 1, m ^= (m << j)) {
#pragma unroll
        for (int k = 0; k < 32; k = (k + j + 1) & ~j) { const unsigned t = (A[k] ^ (A[k + j] >> j)) & m; A[k] ^= t; A[k + j] ^= (t << j); }
    }
}
__device__ __forceinline__ void dsa_select_pair(const float* SC, unsigned* bm, int q0, int nt, int lane) {
    unsigned ka[32], kb[32], A[32], B[32];
#pragma unroll
    for (int j = 0; j < 32; ++j) { if (j < nt) { ka[j] = sortkey(SC[(size_t)q0 * 2048 + 64 * j + lane]); kb[j] = sortkey(SC[(size_t)(q0 + 1) * 2048 + 64 * j + lane]); } else { ka[j] = 0u; kb[j] = 0u; } A[j] = ka[j]; B[j] = kb[j]; }
    transpose32(A); transpose32(B);
    unsigned pa = 0u, pb = 0u; int npa = 1 << 30, npb = 1 << 30;
    for (int rep_ = 0; rep_ < 1 + ((DUP_MASK >> 26) & 1); ++rep_) { pa = 0u; pb = 0u; npa = 1 << 30; npb = 1 << 30; asm volatile("" : "+s"(pa), "+s"(pb));
    unsigned alA = 0xffffffffu, alB = 0xffffffffu; int abA = 0, abB = 0;
#pragma unroll
    for (int bit = 31; bit >= 0; --bit) {
        const unsigned tA = alA & A[31 - bit], tB = alB & B[31 - bit];
        const int cA = __builtin_popcount(tA) + abA, cB = __builtin_popcount(tB) + abB;
        const int nA = wave_sum_i(cA), nB = wave_sum_i(cB);
        if (nA >= 256) { alA = tA; pa |= 1u << bit; npa = nA; } else { alA ^= tA; abA = cA; }
        if (nB >= 256) { alB = tB; pb |= 1u << bit; npb = nB; } else { alB ^= tB; abB = cB; }
        if (npa == 256 && npb == 256) break;
    } }
#pragma unroll
    for (int which = 0; which < 2; ++which) {
        const unsigned prefix = which ? pb : pa; const int np = which ? npb : npa;
        int ngt = 0;
        if (np != 256) {
#pragma unroll
            for (int j = 0; j < 32; ++j) ngt += ((which ? kb[j] : ka[j]) > prefix) ? 1 : 0;
            ngt = wave_sum_i(ngt);
        }
        const int need = 256 - ngt; int running = 0; unsigned keep0 = 0u, keep1 = 0u;
#pragma unroll
        for (int j = 0; j < 32; ++j) { if (j < nt) { const unsigned k_ = which ? kb[j] : ka[j];
                bool sel;
                if (np == 256) sel = k_ >= prefix;
                else { const bool eq = k_ == prefix; const unsigned long long e = __ballot(eq);
                    const int rank = running + (int)__builtin_amdgcn_mbcnt_hi((unsigned)(e >> 32), __builtin_amdgcn_mbcnt_lo((unsigned)e, 0u));
                    sel = (k_ > prefix) || (eq && rank < need); running += __builtin_popcountll(e); }
                const unsigned long long m = __ballot(sel);
                if (lane == j) { keep0 = (unsigned)m; keep1 = (unsigned)(m >> 32); } } }
        if (lane < nt) *(u32x2*)(bm + (q0 + which) * 64 + 2 * lane) = (u32x2){keep0, keep1};
    }
}
constexpr int CW_DEP = 8192;
__device__ __forceinline__ unsigned* dep_word(int l, int kind, int bh) { return (unsigned*)KCTL + CW_DEP + 64 * (l * 64 + kind * 32 + bh); }
__device__ __forceinline__ void dep_signal(Frame& F, unsigned* w) {
    asm volatile("s_waitcnt vmcnt(0)" ::: "memory");
    __syncthreads();
    if (F.wave == 0 && hw_lane() == 0) { __builtin_amdgcn_fence(__ATOMIC_RELEASE, "agent"); asm volatile("s_waitcnt vmcnt(0)" ::: "memory"); (void)xb_add(w, 1u); }
}
__device__ __forceinline__ void dep_wait(Frame& F, unsigned* w, unsigned target) {
    if (F.wave == 0 && hw_lane() == 0) { unsigned sp = 0u; while (xb_ld(w) < target) { __builtin_amdgcn_s_sleep(2); if (++sp > (1u << 24)) break; }
        __builtin_amdgcn_fence(__ATOMIC_ACQUIRE, "agent"); asm volatile("s_waitcnt vmcnt(0)" ::: "memory"); }
    __syncthreads();
}
__device__ __forceinline__ unsigned* dep_nrm(int l, int b) { return (unsigned*)KCTL + CW_DEP + 64 * (128 + l * 8 + b); }
__device__ __forceinline__ void ckv_norm_item(Frame& F, int l, int item) {
    const int lane = F.tid & 63, sc = (lane & 15) * 8;
    const float* g = KIN(I_KVG) + (size_t)l * 128 + sc;
#pragma unroll
    for (int i = 0; i < 8; ++i) { const size_t row = (size_t)item * 256 + F.wave * 32 + i * 4 + (lane >> 4);
        const bf16x8 x = *(const bf16x8*)(WSP(bf16, WS_CKV) + row * 128 + sc);
        *(bf16x8*)(WSP(bf16, WS_CKVN) + row * 128 + sc) = att::nrm8(x, g); }
}
__device__ __forceinline__ void dsa_unit(Frame& F, int l, int b, int cq) {
    char* lds = (char*)F.lds; const int tid = F.tid, lane = tid & 63, wid = F.wave, r32 = lane & 31, hi = lane >> 5;
    const int m0 = b * 2048 + cq * 64, nvis = 64 * (cq + 1);
    float* SC = WSP(float, WS_SCORE) + (size_t)blockIdx.x * 64 * 2048;
    for (int rep_ = 0; rep_ < 1 + ((DUP_MASK >> 25) & 1); ++rep_)
    {
        bf16x8 af[4];
        const bf16* qa = WSP(bf16, WS_IQ) + ((size_t)(m0 + 8 * wid) * 4 + r32) * 64 + 8 * hi;
#pragma unroll
        for (int ks = 0; ks < 4; ++ks) af[ks] = *(const bf16x8*)(qa + 16 * ks);
        float wq[4][4];
#pragma unroll
        for (int g = 0; g < 4; ++g) { const f32x4 w4 = *(const f32x4*)(WSP(float, WS_SCAL) + (size_t)(m0 + 8 * wid + 2 * g + hi) * 16 + 8);
            wq[g][0] = w4[0] * 0.0625f; wq[g][1] = w4[1] * 0.0625f; wq[g][2] = w4[2] * 0.0625f; wq[g][3] = w4[3] * 0.0625f; }
        const bf16* kg = WSP(bf16, WS_IK) + ((size_t)b * 2048 + (tid >> 3)) * 64 + (tid & 7) * 8;
        const int kw = (tid >> 3) * 144 + (tid & 7) * 16;
        bf16x8 stg = *(const bf16x8*)kg;
        *(bf16x8*)(lds + kw) = stg;
        __syncthreads();
        const int ntile = cq + 1;
        for (int t = 0; t < ntile; ++t) {
            const char* kb_ = lds + (t & 1) * 9216;
            if (t + 1 < ntile) stg = *(const bf16x8*)(kg + (size_t)(t + 1) * 64 * 64);
#pragma unroll
            for (int kb = 0; kb < 2; ++kb) {
                att::f32x16 d = ozero16();
#pragma unroll
                for (int ks = 0; ks < 4; ++ks) d = __builtin_amdgcn_mfma_f32_32x32x16_bf16(af[ks], *(const bf16x8*)(kb_ + (32 * kb + r32) * 144 + (16 * ks + 8 * hi) * 2), d, 0, 0, 0);
                float sv[4];
#pragma unroll
                for (int g = 0; g < 4; ++g) sv[g] = wq[g][0] * fmaxf(d[4 * g], 0.f) + wq[g][1] * fmaxf(d[4 * g + 1], 0.f) + wq[g][2] * fmaxf(d[4 * g + 2], 0.f) + wq[g][3] * fmaxf(d[4 * g + 3], 0.f);
                {
                    const bool up = (r32 & 2) != 0, od = (r32 & 1) != 0;
                    const float x1 = up ? sv[0] : sv[2], y1 = up ? sv[1] : sv[3]; const float rx1 = qxor2(x1), ry1 = qxor2(y1);
                    if (up) { sv[0] = rx1; sv[1] = ry1; } else { sv[2] = rx1; sv[3] = ry1; }
                    const float x2 = od ? sv[0] : sv[1], y2 = od ? sv[2] : sv[3]; const float rx2 = qxor1(x2), ry2 = qxor1(y2);
                    if (od) { sv[0] = rx2; sv[2] = ry2; } else { sv[1] = rx2; sv[3] = ry2; }
                    *(f32x4*)(SC + (size_t)(8 * wid + 2 * (r32 & 3) + hi) * 2048 + t * 64 + kb * 32 + (r32 & ~3)) = (f32x4){sv[0], sv[1], sv[2], sv[3]}; }
            }
            if (t + 1 < ntile) *(bf16x8*)(lds + ((t + 1) & 1) * 9216 + kw) = stg;
            asm volatile("s_waitcnt lgkmcnt(0)" ::: "memory"); __builtin_amdgcn_s_barrier(); asm volatile("" ::: "memory");
        }
    }
    asm volatile("s_waitcnt vmcnt(0)" ::: "memory"); __builtin_amdgcn_fence(__ATOMIC_ACQUIRE, "agent"); asm volatile("s_waitcnt vmcnt(0)" ::: "memory");
    {
        unsigned* bm = (unsigned*)(lds + att::LDS_BM);
        const int nt = cq + 1;
        if (nvis <= 256) {
            for (int ql = 0; ql < 8; ++ql) if (32 * lane < nvis) bm[(8 * wid + ql) * 64 + lane] = 0xffffffffu;
        } else {
            for (int qp = 0; qp < 4; ++qp) dsa_select_pair(SC, bm, 8 * wid + 2 * qp, nt, lane);
        }
    }
    __syncthreads();
    dep_wait(F, dep_nrm(l, b), 8u);
    att::BlockRef r{WSP(bf16, WS_QABS) + (size_t)m0 * 512, WSP(bf16, WS_CKVN) + (size_t)b * 2048 * 128, WSP(bf16, WS_CKVN) + (size_t)b * 2048 * 128,
                    WSP(bf16, WS_YCAT) + (size_t)M * 512 + (size_t)m0 * 512, 128, 0, cq + 1, KIN(I_KVG) + (size_t)l * 128};
    if (tid < 128) ((float*)(lds + att::LDS_GN))[tid] = r.g[tid];
    __syncthreads();
    att::Seam S;
    for (int rep_ = 0; rep_ < 1 + ((DUP_MASK >> 27) & 1); ++rep_) { att::prime<1>(r, lds, S, tid); att::block<1>(r, r, lds, S, tid); }
}
__device__ __forceinline__ void mixer_queue(Frame& F, int l, int qidx) {
    PHASE_BEGIN();
    volatile LAS int* qslot = (volatile LAS int*)(F.lds + LDSCTL_OFF + 192);
    unsigned* head = (unsigned*)KCTL + CW_Q + 64 * qidx;
    constexpr int N_DSA = 256, N_FOX = 256, N_ML = 256, N_SCAN = 32 * 5, N_OUT = 256;
    for (;;) {
        __syncthreads();
        if (F.tid == 0) *qslot = (int)__hip_atomic_fetch_add(head, 1u, __ATOMIC_RELAXED, __HIP_MEMORY_SCOPE_AGENT);
        __syncthreads();
        int item = *qslot;
        const int dup = (l == 0) ? 1 : 0;
        const int R_DSA = N_DSA << (dup & (DUP_MASK >> 8)), R_FOX = N_FOX << (dup & (DUP_MASK >> 9)), R_ML = N_ML << (dup & (DUP_MASK >> 10)), R_SCAN = N_SCAN << (dup & (DUP_MASK >> 11)), R_OUT = N_OUT << (dup & (DUP_MASK >> 12));
        if (item >= 64 + R_DSA + R_FOX + R_ML + R_SCAN + R_OUT) break;
        PHASE_BEGIN();
        if (item < 64) { ckv_norm_item(F, l, item); dep_signal(F, dep_nrm(l, item >> 3)); continue; }
        item -= 64;
        if (item < R_DSA) { item %= N_DSA; dsa_unit(F, l, item & 7, 31 - (item >> 3)); continue; }
        item -= R_DSA;
        if (item < R_FOX) { item %= N_FOX; fox_unit(F, (item & 31) >> 2, item & 3, 7 - (item >> 5)); continue; }
        item -= R_FOX;
        if (item < R_ML) { item %= N_ML; ml::unit_local4(F, l, item); dep_signal(F, dep_word(l, 0, item >> 3)); continue; }
        item -= R_ML;
        if (item < R_SCAN) { item %= N_SCAN; dep_wait(F, dep_word(l, 0, item / 5), 8u); ml::scan_item(F, item); dep_signal(F, dep_word(l, 1, item / 5)); continue; }
        item -= R_SCAN;
        item %= N_OUT; dep_wait(F, dep_word(l, 1, item >> 3), 5u);
        ml::unit_out4(F, l, item);
    }
}


__global__ void __launch_bounds__(NTHREADS, 2) fwd_kernel(Args args) {
    extern __shared__ __attribute__((aligned(16))) unsigned char lds[];
    cg::grid_group grid = cg::this_grid();
    Frame F;
    F.lds = (LAS unsigned char*)lds;
    F.wave = __builtin_amdgcn_readfirstlane((int)threadIdx.x >> 6); F.tid = F.wave * 64 + hw_lane();
    volatile LAS unsigned* MISC = (volatile LAS unsigned*)(F.lds + MISC_OFF);
    for (int u = F.tid; u < (LDS_BYTES - LDSCTL_OFF) / 4; u += NTHREADS) ((LAS unsigned*)(F.lds + LDSCTL_OFF))[u] = 0u;
    __syncthreads();
    (void)xcd_barrier_post((unsigned*)KCTL + CW_BAR, MISC + 8, F.tid == 0);
    grid.sync();
#define GRID_BAR() do { XcdBarrier bar_; bar_.bar = (unsigned*)KCTL + CW_BAR; bar_.x = xb_xcc_id(); bar_.st = (volatile LAS unsigned*)(F.lds + MISC_OFF) + 8; bar_.t0 = (F.wave == 0) && (hw_lane() == 0); xcd_barrier(bar_); } while (0)
#define REPS(k) (((DUP_MASK >> (k)) & 1) && l == 0 ? 2 : 1)
    for (int rep = 0; rep < ((DUP_MASK & 1) ? 2 : 1); ++rep) { p0_prologue(F); p0_moe_weights(F); GRID_BAR(); }
    norm_rows(F, KIN(I_X), 0, 0, 1024); GRID_BAR();
    for (int l = 0; l < DEPTH; ++l) {
        const float* xsrc = (l == 0) ? KIN(I_X) : WSP(float, WS_X);
        for (int rep = 0; rep < REPS(1); ++rep) {
            {   PHASE_BEGIN(); pg8::Gemm g{WSP(bf16, WS_XN), WSP(bf16, WS_WIN_T) + (size_t)l * NV * 1024, M, NV, 1024};
                InProjSched Sc; Sc.so.init(M, 4 * 256, GRIDN, (int)blockIdx.x); Sc.f8 = 0; EpiInProj E{WSP(float, WS_BINP) + (size_t)l * NV, (unsigned char*)KWS};
                pg8::gemm_phase<EpiInProj, InProjSched, true, true>(F.lds, g, Sc, E, F.tid); }
            {   PHASE_BEGIN(); pg8::Gemm g{(const bf16*)WSP(unsigned char, WS_XN1_8), (const bf16*)(WSP(unsigned char, WS_WIN8) + (size_t)l * NV * 1024), M, NV, 512};
                InProjSched Sc; Sc.so.init(M, 24 * 256, GRIDN, (int)blockIdx.x); Sc.f8 = 1; EpiInProj8 E{WSP(float, WS_BINP) + (size_t)l * NV, (unsigned char*)KWS};
                pg8::gemm_phase<EpiInProj8, InProjSched, false, true, true>(F.lds, g, Sc, E, F.tid); }
            GRID_BAR(); }
        mixer_queue(F, l, l); GRID_BAR();
        for (int rep = 0; rep < REPS(4); ++rep) {
            {   PHASE_BEGIN(); pg8::Gemm g{WSP(bf16, WS_YCAT), WSP(bf16, WS_WBR_T) + (size_t)l * 3072 * 512, 3 * M, 3072, 512};
                BranchSched Sc{GRIDN, vcu_id(), 0 | (1 << 2) | (2 << 4), 3}; EpiBranch E{WSP(bf16, WS_GATES), WSP(bf16, WS_MERGED), 0, WSP(unsigned char, WS_MERGED8)};
                pg8::gemm_phase<EpiBranch, BranchSched, true, true>(F.lds, g, Sc, E, F.tid); }
            GRID_BAR();
            {   PHASE_BEGIN(); pg8::Gemm g{(const bf16*)WSP(unsigned char, WS_MERGED8), (const bf16*)(WSP(unsigned char, WS_WOUT8) + (size_t)l * 1024 * 1024), M, 1024, 512};
                pg8::StaticOrder Sc; Sc.init(M, 1024, GRIDN, (int)blockIdx.x); EpiOutProj E{xsrc, WSP(float, WS_X), WSP(float, WS_MOD) + (size_t)l * 8 * 6144};
                pg8::gemm_phase<EpiOutProj, pg8::StaticOrder, false, true, true>(F.lds, g, Sc, E, F.tid); }
            GRID_BAR(); }
        xsrc = WSP(float, WS_X);
        if (((DUP_MASK >> 16) & 1) && l == 0) { route_phase(F, l, xsrc, true); GRID_BAR(); }
        route_phase(F, l, xsrc); GRID_BAR();
        for (int rep = 0; rep < REPS(5); ++rep) { gather_phase(F, l); GRID_BAR(); }
        const LAS int* tst = (const LAS int*)(F.lds + LDSCTL_OFF);
        for (int rep = 0; rep < REPS(6); ++rep) {
            {   PHASE_BEGIN(); pg8::Gemm gp{(const bf16*)WSP(unsigned char, WS_AS8), (const bf16*)(WSP(unsigned char, WS_W1T) + (size_t)l * 32 * 2048 * 1024), MP, 32 * 2048, 512};
                MoeSched<8> Sc{tst, tst[32] * 8, GRIDN, vcu_id()}; EpiP1 E{WSP(unsigned char, WS_ACT8), KIN(I_B1) + (size_t)l * 32 * 2048};
                pg8::gemm_phase<EpiP1, MoeSched<8>, false, true, true>(F.lds, gp, Sc, E, F.tid); }
            GRID_BAR(); }
        for (int rep = 0; rep < REPS(18); ++rep) {
        {   PHASE_BEGIN(); f8::Gemm g{WSP(unsigned char, WS_ACT8), WSP(unsigned char, WS_W2T) + (size_t)l * 32 * 1024 * 1024, 1024};
            MoeSched<4> Sc{tst, tst[32] * 4, GRIDN, vcu_id(), (DUP_MASK >> 24) & 1 & ((rep == 0 && l == 0) ? 1 : 0)}; EpiP2 E{WSP(bf16, WS_ASORT), KIN(I_B2) + (size_t)l * 32 * 1024, (((DUP_MASK >> 22) & 3) && rep == 0 && l == 0) ? ((DUP_MASK >> 22) & 3) : 0};
            pg8::Gemm gp{(const bf16*)g.A, (const bf16*)g.Bt, MP, 32 * 1024, 512, (((DUP_MASK >> 21) & 1) && rep == 0 && l == 0) ? 2 : 0};
            {
                const int nmax = (Sc.total + GRIDN - 1) / GRIDN, nmine = (Sc.total - Sc.c + GRIDN - 1) / GRIDN;
                if (nmine < nmax) { __builtin_amdgcn_s_sleep(100); __builtin_amdgcn_s_sleep(100); } }
            pg8::gemm_phase<EpiP2, MoeSched<4>, false, true, true>(F.lds, gp, Sc, E, F.tid); }
        GRID_BAR(); }
        if (((DUP_MASK >> 17) & 1) && l == 0) { combine_phase(F, l, xsrc, false, true); GRID_BAR(); }
        combine_phase(F, l, xsrc, l == DEPTH - 1); GRID_BAR();
    }
}

extern "C" void kernel_launch(void* const* d_in, const int* in_sizes, int n_in, void* d_out, int out_size, void* d_ws, size_t ws_size, hipStream_t stream) {
    static int grid = 0;
    if (grid == 0) {
        if (n_in != 23 || out_size != M * D || ws_size < WS_END2) { fprintf(stderr, "kernel_launch: unexpected shapes (n_in %d out %d ws %zu)\n", n_in, out_size, ws_size); grid = -1; return; }
        int dev = 0, cus = 0, per_cu = 0;
        (void)hipGetDevice(&dev);
        (void)hipDeviceGetAttribute(&cus, hipDeviceAttributeMultiprocessorCount, dev);
        (void)hipFuncSetAttribute((const void*)fwd_kernel, hipFuncAttributeMaxDynamicSharedMemorySize, LDS_BYTES);
        (void)hipOccupancyMaxActiveBlocksPerMultiprocessor(&per_cu, (const void*)fwd_kernel, NTHREADS, LDS_BYTES);
        if (per_cu < 1) { fprintf(stderr, "kernel_launch: occupancy query says %d blocks/CU\n", per_cu); per_cu = 1; }
        grid = cus;
    }
    if (grid < 0) return;
    (void)hipMemsetAsync((char*)d_ws + WS_CTL, 0, CTL_ZERO_BYTES, stream);
    Args a{};
    for (int i = 0; i < 23; ++i) a.in[i] = (const float*)d_in[i];
    a.out = (float*)d_out; a.ws = (unsigned char*)d_ws;
    void* kargs[] = {&a};
    hipError_t e = hipLaunchCooperativeKernel((const void*)fwd_kernel, dim3(grid), dim3(NTHREADS), kargs, LDS_BYTES, stream);
    if (e != hipSuccess) fprintf(stderr, "cooperative launch failed: %s (grid %d)\n", hipGetErrorString(e), grid);
}
```

```cpp
#include <hip/hip_runtime.h>
#include <hip/hip_cooperative_groups.h>
#include <cstdio>
#include <cstdint>
namespace cg = cooperative_groups;
#define DUP_MASK 0
__device__ __forceinline__ int hw_lane() { int x; asm volatile("v_mbcnt_lo_u32_b32 %0, -1, 0\n\tv_mbcnt_hi_u32_b32 %0, -1, %0" : "=v"(x)); return x; }
typedef float ozf4_t __attribute__((ext_vector_type(4)));
typedef float ozf16_t __attribute__((ext_vector_type(16)));
__device__ __forceinline__ float ozero() { float z; asm volatile("v_mov_b32 %0, 0" : "=v"(z)); return z; }
__device__ __forceinline__ ozf4_t ozero4() { const float z = ozero(); return (ozf4_t){z, z, z, z}; }
__device__ __forceinline__ ozf16_t ozero16() { const float z = ozero(); return (ozf16_t){z, z, z, z, z, z, z, z, z, z, z, z, z, z, z, z}; }
__device__ __forceinline__ float lshfl(float x, int srclane) { return __builtin_bit_cast(float, __builtin_amdgcn_ds_bpermute(srclane << 2, __builtin_bit_cast(int, x))); }
__device__ __forceinline__ float qxor1(float x) { return __builtin_bit_cast(float, __builtin_amdgcn_mov_dpp(__builtin_bit_cast(int, x), 0xB1, 0xf, 0xf, true)); }
__device__ __forceinline__ float qxor2(float x) { return __builtin_bit_cast(float, __builtin_amdgcn_mov_dpp(__builtin_bit_cast(int, x), 0x4E, 0xf, 0xf, true)); }
__device__ __forceinline__ float hmirror(float x) { return __builtin_bit_cast(float, __builtin_amdgcn_mov_dpp(__builtin_bit_cast(int, x), 0x141, 0xf, 0xf, true)); }
namespace pg8 {
#define PG8_LAS __attribute__((address_space(3)))
typedef unsigned short bf16_t;
typedef short bf16x8 __attribute__((ext_vector_type(8)));
typedef float f32x4 __attribute__((ext_vector_type(4)));
typedef unsigned u32x4 __attribute__((ext_vector_type(4)));
constexpr int BM = 256, BK = 64, HALF = 128, HTB = HALF * BK * 2  , STAGE_BYTES = 8 * HTB, NXCD = 8, WGM = 8;

__host__ __device__ __forceinline__ int lds_byte(int r, int c) { const int st = (r >> 4) * 2 + (c >> 5), rr = r & 15, cc = c & 31, ob = rr * 64 + cc * 2; return st * 1024 + (ob ^ (((ob >> 9) & 1) << 5)); }
__host__ __device__ __forceinline__ void stage_rc(int b, int& R, int& C) { const int st = b / 1024, sb = b % 1024, swz = sb ^ (((sb >> 9) & 1) << 5); R = (st >> 1) * 16 + swz / 64; C = (st & 1) * 32 + (swz % 64) / 2; }
__host__ __device__ __forceinline__ int perm32(int rho) { const int n = rho >> 4, i = rho & 15; return 8 * (i >> 2) + 4 * n + (i & 3); }

struct Unit { int pm, pn; };
struct Gemm { const bf16_t* A; const bf16_t* Bt; int M, N, K; int nt_probe = 0; };

struct StaticOrder {
    int nM, nN, nwg, G, c;
    __host__ __device__ void init(int M, int N, int G_, int c_) { nM = M / BM; nN = N / BM; nwg = nM * nN; G = G_; c = c_; }
    __host__ __device__ bool next(int i, Unit& u) const {
        const long L = (long)i * G + c; if (L >= nwg) return false;
        int wgid = (int)L; { const int q = nwg / NXCD, r = nwg % NXCD, xcd = wgid % NXCD, off = wgid / NXCD; wgid = (xcd < r ? xcd * (q + 1) : r * (q + 1) + (xcd - r) * q) + off; }
        const int nig = WGM * nN, gid = wgid / nig, fm = gid * WGM, gsz = (nM - fm) < WGM ? (nM - fm) : WGM;
        u.pm = fm + ((wgid % nig) % gsz); u.pn = (wgid % nig) / gsz; return true;
    }
    __device__ __forceinline__ void a_ready(const Unit&) const {}
    __device__ __forceinline__ void done(const Unit&) const {}
};

__device__ __forceinline__ unsigned cvt_pk_bf16(float lo, float hi) { unsigned r; asm volatile("v_cvt_pk_bf16_f32 %0, %1, %2" : "=v"(r) : "v"(lo), "v"(hi)); return r; }
__device__ __forceinline__ void glds16s(const void* sbase, unsigned voff, unsigned lds_dst) { unsigned keep;
    asm volatile("s_mov_b32 %0, m0\n\ts_mov_b32 m0, %3\n\ts_nop 0\n\tglobal_load_lds_dwordx4 %1, %2\n\ts_mov_b32 m0, %0" : "=&s"(keep) : "v"(voff), "s"(sbase), "s"(lds_dst) : "memory"); }
typedef int v8i_t __attribute__((ext_vector_type(8)));
typedef int v4i_t __attribute__((ext_vector_type(4)));
template <class T, class = void> struct epi_bias_init { static constexpr bool value = false; };
template <class T> struct epi_bias_init<T, decltype((void)T::BIAS_INIT)> { static constexpr bool value = T::BIAS_INIT; };
template <class T, class = void> struct epi_nstore { static constexpr int value = 0; };
template <class T> struct epi_nstore<T, decltype((void)T::NSTORE)> { static constexpr int value = T::NSTORE; };
template <class Epi, class Sched, bool ALIGN_EPI = false, bool SP2 = false, bool FP8 = false>
__device__ __forceinline__ void gemm_phase(PG8_LAS unsigned char* lds, const Gemm g, const Sched& S, const Epi& E, const int tid) {
    const int wid = __builtin_amdgcn_readfirstlane(tid >> 6), lane = tid & 63, wr = wid >> 2, wc = wid & 3, fr = lane & 15, fq = lane >> 4;
    const int K = g.K, nt = (DUP_MASK != 0 && g.nt_probe) ? g.nt_probe : K / BK;
    unsigned voffA[2], voffB[2];
#pragma unroll
    for (int i = 0; i < 2; ++i) { int R, C; stage_rc(tid * 16 + i * 8192, R, C); const int Rb = Epi::PERM ? ((R & ~31) + perm32(R & 31)) : R;
        voffA[i] = (unsigned)(R * K + C) * 2u; voffB[i] = (unsigned)(Rb * K + C) * 2u; }
    const size_t kstep = (size_t)(BK * 2);
    const size_t hstep = (size_t)HALF * K * 2;
    const size_t tstep = 2 * hstep;
    const unsigned ldsw = (unsigned)wid * 1024u, ldsbase = (unsigned)(uintptr_t)lds;
    const int aoff0 = lds_byte(wr * 64 + fr, fq * 8), aoff1 = aoff0 + 1024;
    const int boff0 = lds_byte(wc * 32 + fr, fq * 8), boff1 = boff0 + 1024;
#define PG8_SA(b, h) (((b) * 2 + (h)) * HTB)
#define PG8_SB(b, h) ((4 + (b) * 2 + (h)) * HTB)
#define PG8_STAGE(bufoff, gbase, voff) do { _Pragma("unroll") for (int _i = 0; _i < 2; ++_i) \
        glds16s((const void*)(gbase), (voff)[_i], (unsigned)__builtin_amdgcn_readfirstlane((int)(ldsbase + (bufoff) + ldsw + _i * 8192))); } while (0)
#define PG8_LDA(dst, b, h) do { _Pragma("unroll") for (int m = 0; m < 4; ++m) { if constexpr (FP8) { \
        const v4i_t lo_ = *(const PG8_LAS v4i_t*)(lds + PG8_SA(b, h) + aoff0 + m * 2048), hi_ = *(const PG8_LAS v4i_t*)(lds + PG8_SA(b, h) + aoff1 + m * 2048); dst##8[m] = __builtin_shufflevector(lo_, hi_, 0, 1, 2, 3, 4, 5, 6, 7); } \
        else { dst[m][0] = *(const PG8_LAS bf16x8*)(lds + PG8_SA(b, h) + aoff0 + m * 2048); dst[m][1] = *(const PG8_LAS bf16x8*)(lds + PG8_SA(b, h) + aoff1 + m * 2048); } } } while (0)
#define PG8_LDB(dst, b, h) do { _Pragma("unroll") for (int n = 0; n < 2; ++n) { if constexpr (FP8) { \
        const v4i_t lo_ = *(const PG8_LAS v4i_t*)(lds + PG8_SB(b, h) + boff0 + n * 2048), hi_ = *(const PG8_LAS v4i_t*)(lds + PG8_SB(b, h) + boff1 + n * 2048); dst##8[n] = __builtin_shufflevector(lo_, hi_, 0, 1, 2, 3, 4, 5, 6, 7); } \
        else { dst[n][0] = *(const PG8_LAS bf16x8*)(lds + PG8_SB(b, h) + boff0 + n * 2048); dst[n][1] = *(const PG8_LAS bf16x8*)(lds + PG8_SB(b, h) + boff1 + n * 2048); } } } while (0)
#define PG8_MMA(ai, bj, At, Bt) do { __builtin_amdgcn_s_setprio(1); _Pragma("unroll") for (int m = 0; m < 4; ++m) _Pragma("unroll") for (int n = 0; n < 2; ++n) { \
        if constexpr (FP8) { asm volatile("v_mfma_scale_f32_16x16x128_f8f6f4 %0, %1, %2, %0, %3, %4 op_sel_hi:[0,0,0]" : "+v"(acc[ai][bj][m][n]) : "v"(Bt##8[n]), "v"(At##8[m]), "v"(sclW), "v"(sclX)); } \
        else { _Pragma("unroll") for (int k = 0; k < 2; ++k) acc[ai][bj][m][n] = __builtin_amdgcn_mfma_f32_16x16x32_bf16(Bt[n][k], At[m][k], acc[ai][bj][m][n], 0, 0, 0); } } __builtin_amdgcn_s_setprio(0); } while (0)
#define PG8_WAIT_V(n) asm volatile("s_waitcnt vmcnt(" #n ")" ::: "memory")
#define PG8_WAIT_VN(n) asm volatile("s_waitcnt vmcnt(%0)" :: "n"(n) : "memory")
#define PG8_WAIT_L(n) asm volatile("s_waitcnt lgkmcnt(" #n ")" ::: "memory")
#define PG8_BAR __builtin_amdgcn_s_barrier()
#define PG8_SCHED __builtin_amdgcn_sched_barrier(0)
    Unit cur, nxt; int ui = 0;
    if (!S.next(0, cur)) return;
    const int sclW = 0x7a7a7a7a, sclX = 0x7f7f7f7f;
    cur.pm = __builtin_amdgcn_readfirstlane(cur.pm); cur.pn = __builtin_amdgcn_readfirstlane(cur.pn);
    f32x4 acc[2][2][4][2];
    constexpr int NST = epi_nstore<Epi>::value;
    f32x4 nb[4];
    if constexpr (epi_bias_init<Epi>::value) {
#pragma unroll
        for (int p = 0; p < 2; ++p) { Unit bu; const int bi = p * 8 + wid;
            if (S.next(bi, bu)) *(PG8_LAS f32x4*)(lds + STAGE_BYTES + bi * 1024 + lane * 16) = *(const f32x4*)E.bias_src(bu, lane); }
        __syncthreads();
        E.load_bias(nb, (const PG8_LAS float*)(lds + STAGE_BYTES), wc, fq); E.set_bias(acc, nb); }
    else {
#pragma unroll
    for (int a = 0; a < 2; ++a)
#pragma unroll
        for (int b = 0; b < 2; ++b)
#pragma unroll
            for (int m = 0; m < 4; ++m)
#pragma unroll
                for (int n = 0; n < 2; ++n) acc[a][b][m][n] = ozero4();
    }
    bf16x8 At[4][2], B0[2][2], B1[2][2]; v8i_t At8[4], B08[2], B18[2];
    const char* cA = (const char*)g.A + (size_t)cur.pm * tstep; const char* cB = (const char*)g.Bt + (size_t)cur.pn * tstep;
    S.a_ready(cur);
    if constexpr (SP2) {
        PG8_STAGE(PG8_SB(0, 0), cB, voffB); PG8_STAGE(PG8_SB(0, 1), cB + hstep, voffB); PG8_STAGE(PG8_SA(0, 0), cA, voffA); PG8_STAGE(PG8_SA(0, 1), cA + hstep, voffA);
        if (wr == 1) PG8_BAR;
        PG8_WAIT_V(2); PG8_BAR;
        PG8_STAGE(PG8_SB(1, 0), cB + kstep, voffB); PG8_STAGE(PG8_SA(1, 0), cA + kstep, voffA); PG8_STAGE(PG8_SB(1, 1), cB + hstep + kstep, voffB);
        PG8_WAIT_V(6); PG8_BAR;
    } else {
        PG8_STAGE(PG8_SB(0, 0), cB, voffB); PG8_STAGE(PG8_SA(0, 0), cA, voffA); PG8_STAGE(PG8_SB(0, 1), cB + hstep, voffB); PG8_STAGE(PG8_SA(0, 1), cA + hstep, voffA);
        if (wr == 1) PG8_BAR;
        PG8_WAIT_V(4); PG8_BAR;
        PG8_STAGE(PG8_SB(1, 0), cB + kstep, voffB); PG8_STAGE(PG8_SA(1, 0), cA + kstep, voffA); PG8_STAGE(PG8_SB(1, 1), cB + hstep + kstep, voffB);
        PG8_WAIT_V(6); PG8_BAR;
    }
    for (;;) {
        const bool has_next = S.next(ui + 1, nxt);
        nxt.pm = __builtin_amdgcn_readfirstlane(nxt.pm); nxt.pn = __builtin_amdgcn_readfirstlane(nxt.pn);
        const char* nA = has_next ? (const char*)g.A + (size_t)nxt.pm * tstep : cA; const char* nB = has_next ? (const char*)g.Bt + (size_t)nxt.pn * tstep : cB;
        for (int t = 0; t < nt; t += 2) {
            const bool last = (t == nt - 2);
            const bool rl = NST > 0 && t == 0 && ui > 0;
            const char* a1 = cA + (size_t)(t + 1) * kstep;
            const char* a2 = last ? nA : cA + (size_t)(t + 2) * kstep; const char* b2 = last ? nB : cB + (size_t)(t + 2) * kstep;
            const char* a3 = a2 + kstep; const char* b3 = b2 + kstep;
            if (last && has_next) S.a_ready(nxt);
            if constexpr (SP2) {
            PG8_LDB(B0, 0, 0); PG8_LDB(B1, 0, 1); PG8_SCHED; PG8_LDA(At, 0, 0); PG8_STAGE(PG8_SA(1, 1), a1 + hstep, voffA);
            if (rl) PG8_WAIT_VN(NST + 2); else PG8_WAIT_V(8);
            PG8_WAIT_L(0); PG8_BAR; PG8_MMA(0, 0, At, B0); PG8_MMA(0, 1, At, B1); PG8_BAR; PG8_SCHED;
            PG8_LDA(At, 0, 1); PG8_STAGE(PG8_SB(0, 0), b2, voffB); PG8_STAGE(PG8_SB(0, 1), b2 + hstep, voffB); PG8_STAGE(PG8_SA(0, 0), a2, voffA);
            if (rl) PG8_WAIT_VN(NST + 8); else PG8_WAIT_V(8);
            PG8_WAIT_L(0); PG8_BAR; PG8_MMA(1, 0, At, B0); PG8_MMA(1, 1, At, B1); PG8_BAR; PG8_SCHED;
            PG8_LDB(B0, 1, 0); PG8_LDB(B1, 1, 1); PG8_SCHED; PG8_LDA(At, 1, 0); PG8_STAGE(PG8_SA(0, 1), a2 + hstep, voffA);
            if (rl) PG8_WAIT_VN(NST + 10); else PG8_WAIT_V(8);
            PG8_WAIT_L(0); PG8_BAR; PG8_MMA(0, 0, At, B0); PG8_MMA(0, 1, At, B1); PG8_BAR; PG8_SCHED;
            PG8_LDA(At, 1, 1); PG8_STAGE(PG8_SB(1, 0), b3, voffB); PG8_STAGE(PG8_SB(1, 1), b3 + hstep, voffB); PG8_STAGE(PG8_SA(1, 0), a3, voffA);
            PG8_WAIT_V(8); PG8_WAIT_L(0); PG8_BAR; PG8_MMA(1, 0, At, B0); PG8_MMA(1, 1, At, B1); PG8_BAR; PG8_SCHED;
            } else {
            PG8_LDB(B0, 0, 0); PG8_SCHED; PG8_LDA(At, 0, 0); PG8_STAGE(PG8_SA(1, 1), a1 + hstep, voffA);
            PG8_WAIT_L(8); PG8_BAR; PG8_WAIT_L(0); PG8_MMA(0, 0, At, B0); PG8_BAR; PG8_SCHED;
            PG8_LDB(B1, 0, 1); PG8_STAGE(PG8_SB(0, 0), b2, voffB);
            PG8_BAR; PG8_WAIT_L(0); PG8_MMA(0, 1, At, B1); PG8_BAR;
            PG8_LDA(At, 0, 1); PG8_STAGE(PG8_SA(0, 0), a2, voffA);
            PG8_BAR; PG8_WAIT_L(0); PG8_MMA(1, 0, At, B0); PG8_BAR; PG8_SCHED;
            PG8_STAGE(PG8_SB(0, 1), b2 + hstep, voffB);
            PG8_WAIT_V(6); PG8_BAR; PG8_MMA(1, 1, At, B1); PG8_BAR;
            PG8_LDB(B0, 1, 0); PG8_SCHED; PG8_LDA(At, 1, 0); PG8_STAGE(PG8_SA(0, 1), a2 + hstep, voffA);
            PG8_WAIT_L(8); PG8_BAR; PG8_WAIT_L(0); PG8_MMA(0, 0, At, B0); PG8_BAR; PG8_SCHED;
            PG8_LDB(B1, 1, 1); PG8_STAGE(PG8_SB(1, 0), b3, voffB);
            PG8_BAR; PG8_WAIT_L(0); PG8_MMA(0, 1, At, B1); PG8_BAR;
            PG8_LDA(At, 1, 1); PG8_STAGE(PG8_SA(1, 0), a3, voffA);
            PG8_BAR; PG8_WAIT_L(0); PG8_MMA(1, 0, At, B0); PG8_BAR; PG8_SCHED;
            PG8_STAGE(PG8_SB(1, 1), b3 + hstep, voffB);
            PG8_WAIT_V(6); PG8_BAR; PG8_MMA(1, 1, At, B1); PG8_BAR;
            }
        }
        if constexpr (FP8) asm volatile("s_nop 15\n\ts_nop 15" ::: "memory");
        if constexpr (ALIGN_EPI) { if (wr == 0) PG8_BAR; }
        if constexpr (epi_bias_init<Epi>::value) { if (has_next) E.load_bias(nb, (const PG8_LAS float*)(lds + STAGE_BYTES + (ui + 1) * 1024), wc, hw_lane() >> 4); }
        if constexpr (!Epi::AFTER_DRAIN) { const int el = hw_lane(); E(acc, cur, wr, wc, el & 15, el >> 4); S.done(cur); }
        if (!has_next) break;
        if constexpr (epi_bias_init<Epi>::value) E.set_bias(acc, nb);
        else {
#pragma unroll
        for (int a = 0; a < 2; ++a)
#pragma unroll
            for (int b = 0; b < 2; ++b)
#pragma unroll
                for (int m = 0; m < 4; ++m)
#pragma unroll
                    for (int n = 0; n < 2; ++n) acc[a][b][m][n] = ozero4();
        }
        cur = nxt; cA = nA; cB = nB; ++ui;
        if constexpr (ALIGN_EPI) { if (wr == 1) PG8_BAR; }
    }
    PG8_WAIT_V(0);
    if constexpr (!ALIGN_EPI) { if (wr == 0) PG8_BAR; }
    PG8_BAR;
    if constexpr (Epi::AFTER_DRAIN) { E.fused(acc, cur, wr, wc, fr, fq, lds, wid, lane); S.done(cur); }
#undef PG8_SA
#undef PG8_SB
#undef PG8_STAGE
#undef PG8_LDA
#undef PG8_LDB
#undef PG8_MMA
#undef PG8_WAIT_V
#undef PG8_WAIT_L
#undef PG8_BAR
#undef PG8_SCHED
}
}
typedef float f32x4 __attribute__((ext_vector_type(4)));
#define LAS __attribute__((address_space(3)))

namespace f8 {
typedef int v8i_t __attribute__((ext_vector_type(8)));
typedef int v4i_t __attribute__((ext_vector_type(4)));
constexpr int STG = 49152;
struct Gemm { const unsigned char* A; const unsigned char* Bt; int K; };
template <class Epi, class Sched>
__device__ __forceinline__ void gemm_phase(LAS unsigned char* lds, const Gemm g, const Sched& S, const Epi& E, const int tid) {
    const int wid = __builtin_amdgcn_readfirstlane(tid >> 6), lane = tid & 63, wr = wid >> 1, wc = wid & 1, fr = lane & 15, fq = lane >> 4;
    const int K = g.K, nt = K >> 7;
    unsigned voff[2];
#pragma unroll
    for (int i = 0; i < 2; ++i) { int R, C; pg8::stage_rc(tid * 16 + i * 8192, R, C); voff[i] = (unsigned)(R * K + C * 2); }
    const unsigned ldsbase = (unsigned)(uintptr_t)lds, ldsw = (unsigned)wid * 1024u;
    const int aoff0 = (wr >> 1) * 16384 + pg8::lds_byte((wr & 1) * 64 + fr, fq * 16), aoff1 = (wr >> 1) * 16384 + pg8::lds_byte((wr & 1) * 64 + fr, fq * 16 + 8);
    const int boff0 = 32768 + pg8::lds_byte(wc * 64 + fr, fq * 16), boff1 = 32768 + pg8::lds_byte(wc * 64 + fr, fq * 16 + 8);
#define F8_STAGE(s, pa, pb, kt) do { const size_t ko_ = (size_t)(kt) * 128; _Pragma("unroll") for (int _i = 0; _i < 2; ++_i) { \
        pg8::glds16s((const void*)((pa) + ko_), voff[_i], (unsigned)__builtin_amdgcn_readfirstlane((int)(ldsbase + (s) * STG + ldsw + _i * 8192))); \
        pg8::glds16s((const void*)((pa) + (size_t)128 * K + ko_), voff[_i], (unsigned)__builtin_amdgcn_readfirstlane((int)(ldsbase + (s) * STG + 16384 + ldsw + _i * 8192))); \
        pg8::glds16s((const void*)((pb) + ko_), voff[_i], (unsigned)__builtin_amdgcn_readfirstlane((int)(ldsbase + (s) * STG + 32768 + ldsw + _i * 8192))); } } while (0)
    pg8::Unit cur, nxt; int ui = 0;
    if (!S.next(0, cur)) return;
    cur.pm = __builtin_amdgcn_readfirstlane(cur.pm); cur.pn = __builtin_amdgcn_readfirstlane(cur.pn);
    const unsigned char* cA = g.A + (size_t)cur.pm * 256 * K; const unsigned char* cB = g.Bt + (size_t)cur.pn * 128 * K;
    bool has_next = S.next(1, nxt);
    nxt.pm = __builtin_amdgcn_readfirstlane(nxt.pm); nxt.pn = __builtin_amdgcn_readfirstlane(nxt.pn);
    const unsigned char* nA = has_next ? g.A + (size_t)nxt.pm * 256 * K : cA; const unsigned char* nB = has_next ? g.Bt + (size_t)nxt.pn * 128 * K : cB;
    F8_STAGE(0, cA, cB, 0);
    if (nt > 1) F8_STAGE(1, cA, cB, 1); else F8_STAGE(1, nA, nB, 0);
    asm volatile("s_waitcnt vmcnt(6)" ::: "memory"); __builtin_amdgcn_s_barrier(); asm volatile("" ::: "memory");
    int st = 0;
    for (;;) {
        f32x4 acc[4][4];
#pragma unroll
        for (int m = 0; m < 4; ++m)
#pragma unroll
            for (int n = 0; n < 4; ++n) acc[m][n] = ozero4();
        for (int t = 0; t < nt; ++t) {
            const int s2 = st >= 1 ? st - 1 : 2;
            if (t + 2 < nt) F8_STAGE(s2, cA, cB, t + 2); else F8_STAGE(s2, nA, nB, t + 2 - nt);
            v8i_t af[4], bfr[4];
            const LAS unsigned char* sb = lds + st * STG;
#pragma unroll
            for (int m = 0; m < 4; ++m) { const v4i_t lo_ = *(const LAS v4i_t*)(sb + aoff0 + m * 2048), hi_ = *(const LAS v4i_t*)(sb + aoff1 + m * 2048); af[m] = __builtin_shufflevector(lo_, hi_, 0, 1, 2, 3, 4, 5, 6, 7); }
#pragma unroll
            for (int n = 0; n < 4; ++n) { const v4i_t lo_ = *(const LAS v4i_t*)(sb + boff0 + n * 2048), hi_ = *(const LAS v4i_t*)(sb + boff1 + n * 2048); bfr[n] = __builtin_shufflevector(lo_, hi_, 0, 1, 2, 3, 4, 5, 6, 7); }
            asm volatile("s_waitcnt lgkmcnt(0)" ::: "memory"); __builtin_amdgcn_sched_barrier(0);
            __builtin_amdgcn_s_setprio(1);
#pragma unroll
            for (int m = 0; m < 4; ++m)
#pragma unroll
                for (int n = 0; n < 4; ++n) acc[m][n] = __builtin_amdgcn_mfma_scale_f32_16x16x128_f8f6f4(bfr[n], af[m], acc[m][n], 0, 0, 0, 0x7a7a7a7a, 0, 0x7f7f7f7f);
            __builtin_amdgcn_s_setprio(0);
            __builtin_amdgcn_sched_barrier(0);
            asm volatile("s_waitcnt vmcnt(6)" ::: "memory"); __builtin_amdgcn_s_barrier(); asm volatile("" ::: "memory");
            st = st == 2 ? 0 : st + 1;
        }
        E(acc, cur, wr, wc, fr, fq);
        if (!has_next) break;
        cur = nxt; cA = nA; cB = nB; ++ui;
        has_next = S.next(ui + 1, nxt);
        nxt.pm = __builtin_amdgcn_readfirstlane(nxt.pm); nxt.pn = __builtin_amdgcn_readfirstlane(nxt.pn);
        nA = has_next ? g.A + (size_t)nxt.pm * 256 * K : cA; nB = has_next ? g.Bt + (size_t)nxt.pn * 128 * K : cB;
    }
    asm volatile("s_waitcnt vmcnt(0)" ::: "memory"); __builtin_amdgcn_s_barrier(); asm volatile("" ::: "memory");
#undef F8_STAGE
}
constexpr int STGW = 65536;
template <class Epi, class Sched>
__device__ __forceinline__ void gemm_phase_w(LAS unsigned char* lds, const Gemm g, const Sched& S, const Epi& E, const int tid) {
    const int wid = __builtin_amdgcn_readfirstlane(tid >> 6), lane = tid & 63, wr = wid >> 1, wc = wid & 1, fr = lane & 15, fq = lane >> 4;
    const int K = g.K, nt = K >> 7;
    unsigned voff[2];
#pragma unroll
    for (int i = 0; i < 2; ++i) { int R, C; pg8::stage_rc(tid * 16 + i * 8192, R, C); voff[i] = (unsigned)(R * K + C * 2); }
    const unsigned ldsbase = (unsigned)(uintptr_t)lds, ldsw = (unsigned)wid * 1024u;
    const int aoff0 = (wr >> 1) * 16384 + pg8::lds_byte((wr & 1) * 64 + fr, fq * 16), aoff1 = (wr >> 1) * 16384 + pg8::lds_byte((wr & 1) * 64 + fr, fq * 16 + 8);
    const int boff0 = 32768 + wc * 16384 + pg8::lds_byte(fr, fq * 16), boff1 = 32768 + wc * 16384 + pg8::lds_byte(fr, fq * 16 + 8);
#define F8W_STAGE(s, pa, pb, kt) do { const size_t ko_ = (size_t)(kt) * 128; _Pragma("unroll") for (int _i = 0; _i < 2; ++_i) { \
        pg8::glds16s((const void*)((pa) + ko_), voff[_i], (unsigned)__builtin_amdgcn_readfirstlane((int)(ldsbase + (s) * STGW + ldsw + _i * 8192))); \
        pg8::glds16s((const void*)((pa) + (size_t)128 * K + ko_), voff[_i], (unsigned)__builtin_amdgcn_readfirstlane((int)(ldsbase + (s) * STGW + 16384 + ldsw + _i * 8192))); \
        pg8::glds16s((const void*)((pb) + ko_), voff[_i], (unsigned)__builtin_amdgcn_readfirstlane((int)(ldsbase + (s) * STGW + 32768 + ldsw + _i * 8192))); \
        pg8::glds16s((const void*)((pb) + (size_t)128 * K + ko_), voff[_i], (unsigned)__builtin_amdgcn_readfirstlane((int)(ldsbase + (s) * STGW + 49152 + ldsw + _i * 8192))); } } while (0)
    pg8::Unit cur, nxt; int ui = 0;
    if (!S.next(0, cur)) return;
    cur.pm = __builtin_amdgcn_readfirstlane(cur.pm); cur.pn = __builtin_amdgcn_readfirstlane(cur.pn);
    const unsigned char* cA = g.A + (size_t)cur.pm * 256 * K; const unsigned char* cB = g.Bt + (size_t)cur.pn * 256 * K;
    bool has_next = S.next(1, nxt);
    nxt.pm = __builtin_amdgcn_readfirstlane(nxt.pm); nxt.pn = __builtin_amdgcn_readfirstlane(nxt.pn);
    const unsigned char* nA = has_next ? g.A + (size_t)nxt.pm * 256 * K : cA; const unsigned char* nB = has_next ? g.Bt + (size_t)nxt.pn * 256 * K : cB;
    F8W_STAGE(0, cA, cB, 0);
    asm volatile("s_waitcnt vmcnt(0)" ::: "memory"); __builtin_amdgcn_s_barrier(); asm volatile("" ::: "memory");
    int st = 0;
    for (;;) {
        f32x4 acc[4][8];
#pragma unroll
        for (int m = 0; m < 4; ++m)
#pragma unroll
            for (int n = 0; n < 8; ++n) acc[m][n] = ozero4();
        for (int t = 0; t < nt; ++t) {
            if (t + 1 < nt) F8W_STAGE(st ^ 1, cA, cB, t + 1); else F8W_STAGE(st ^ 1, nA, nB, 0);
            v8i_t af[4];
            const LAS unsigned char* sb = lds + st * STGW;
#pragma unroll
            for (int m = 0; m < 4; ++m) { const v4i_t lo_ = *(const LAS v4i_t*)(sb + aoff0 + m * 2048), hi_ = *(const LAS v4i_t*)(sb + aoff1 + m * 2048); af[m] = __builtin_shufflevector(lo_, hi_, 0, 1, 2, 3, 4, 5, 6, 7); }
#pragma unroll
            for (int h2 = 0; h2 < 4; ++h2) {
                v8i_t bfr[2];
#pragma unroll
                for (int n = 0; n < 2; ++n) { const v4i_t lo_ = *(const LAS v4i_t*)(sb + boff0 + (2 * h2 + n) * 2048), hi_ = *(const LAS v4i_t*)(sb + boff1 + (2 * h2 + n) * 2048); bfr[n] = __builtin_shufflevector(lo_, hi_, 0, 1, 2, 3, 4, 5, 6, 7); }
                asm volatile("s_waitcnt lgkmcnt(0)" ::: "memory"); __builtin_amdgcn_sched_barrier(0);
                __builtin_amdgcn_s_setprio(1);
#pragma unroll
                for (int m = 0; m < 4; ++m)
#pragma unroll
                    for (int n = 0; n < 2; ++n) acc[m][2 * h2 + n] = __builtin_amdgcn_mfma_scale_f32_16x16x128_f8f6f4(bfr[n], af[m], acc[m][2 * h2 + n], 0, 0, 0, 0x7a7a7a7a, 0, 0x7f7f7f7f);
                __builtin_amdgcn_s_setprio(0);
                __builtin_amdgcn_sched_barrier(0);
            }
            asm volatile("s_waitcnt vmcnt(0)" ::: "memory"); __builtin_amdgcn_s_barrier(); asm volatile("" ::: "memory");
            st ^= 1;
        }
        E(acc, cur, wr, wc, fr, fq);
        if (!has_next) break;
        cur = nxt; cA = nA; cB = nB; ++ui;
        has_next = S.next(ui + 1, nxt);
        nxt.pm = __builtin_amdgcn_readfirstlane(nxt.pm); nxt.pn = __builtin_amdgcn_readfirstlane(nxt.pn);
        nA = has_next ? g.A + (size_t)nxt.pm * 256 * K : cA; nB = has_next ? g.Bt + (size_t)nxt.pn * 256 * K : cB;
    }
    asm volatile("s_waitcnt vmcnt(0)" ::: "memory"); __builtin_amdgcn_s_barrier(); asm volatile("" ::: "memory");
#undef F8W_STAGE
}
}

#define GAS __attribute__((address_space(1)))
#define LAS __attribute__((address_space(3)))
typedef unsigned short bf16;
typedef float f32x4 __attribute__((ext_vector_type(4)));
typedef float f32x2 __attribute__((ext_vector_type(2)));
typedef unsigned u32x4 __attribute__((ext_vector_type(4)));
typedef unsigned u32x2 __attribute__((ext_vector_type(2)));
typedef short bf16x8 __attribute__((ext_vector_type(8)));
typedef GAS unsigned gu32;

constexpr int NTHREADS = 512, NWAVES = 8;
constexpr int D = 1024, NB = 8, S = 2048, M = NB * S, DEPTH = 2;
constexpr int D_IN = 7120, NV = 7168;
constexpr int NE = 32, TOPK = 4, NPAIR = M * TOPK, MP = NPAIR + NE * 256;
constexpr float EPS = 1e-6f;
enum { I_X = 0, I_C, I_WADA, I_BADA, I_WIN, I_BIN, I_CONVW, I_CONVB, I_MLG, I_KVG, I_WUK, I_WUV, I_WBRML, I_WBRDSA, I_WBRFOX, I_WOUT, I_WR, I_BR, I_W1, I_B1, I_W2, I_B2, I_FG };

constexpr size_t MiB = 1u << 20;
constexpr size_t WS_CTL = 0, CTL_ZERO_BYTES = 1 * MiB;
constexpr size_t WS_MOD = 1 * MiB;
constexpr size_t WS_BINP = 2 * MiB;
constexpr size_t WS_WRT = 3 * MiB;
constexpr size_t WS_EIDX = 4 * MiB, WS_GATE = WS_EIDX + 256 * 1024, WS_LRANK = WS_GATE + 256 * 1024, WS_PPOS = WS_LRANK + 256 * 1024, WS_BASE = WS_PPOS + 256 * 1024;
constexpr size_t WS_ROWGATE = 6 * MiB;
constexpr size_t WS_WOUT_T = 8 * MiB;
constexpr size_t WS_WBR_T = 12 * MiB;
constexpr size_t WS_WIN_T = 18 * MiB;
constexpr size_t WS_W1T = 48 * MiB;
constexpr size_t WS_W2T = 304 * MiB;
constexpr size_t WS_X = 432 * MiB;
constexpr size_t WS_XN = 496 * MiB;
constexpr size_t WS_XNL = 528 * MiB;
constexpr size_t WS_ASORT = 560 * MiB;
constexpr size_t WS_ACT = 704 * MiB;
constexpr size_t WS_END = 848 * MiB;
constexpr size_t WS_XN1_8_ = 1352 * MiB, WS_WIN8_ = 1368 * MiB, WS_WOUT8_ = 1400 * MiB;
constexpr size_t WS_XN8 = 1336 * MiB;
constexpr size_t WS_AS8 = WS_ACT, WS_ACT8 = WS_ACT + 72 * MiB;
constexpr size_t WS_DRY = 1208 * MiB;
constexpr int CW_GCNT = 64;
constexpr int CW_BAR = 4096;

constexpr int RING_BYTES = 147456;
constexpr int LDSCTL_OFF = RING_BYTES, MISC_OFF = LDSCTL_OFF + 320;
constexpr int LDS_BYTES = 163840;

__device__ __forceinline__ unsigned f2bf(float f) { unsigned u = __builtin_bit_cast(unsigned, f); return (u + 0x7fffu + ((u >> 16) & 1u)) >> 16; }
__device__ __forceinline__ float bf2f(unsigned b) { return __builtin_bit_cast(float, b << 16); }
__device__ __forceinline__ unsigned pk2(float lo, float hi) { return f2bf(lo) | (f2bf(hi) << 16); }
__device__ __forceinline__ unsigned pk4_fp8(float a, float b, float c, float d) { int w = 0; w = __builtin_amdgcn_cvt_pk_fp8_f32(a, b, w, false); w = __builtin_amdgcn_cvt_pk_fp8_f32(c, d, w, true); return (unsigned)w; }
#define LDS_WAIT() asm volatile("s_waitcnt lgkmcnt(0)" ::: "memory")
#define VM_WAIT() asm volatile("s_waitcnt vmcnt(0)" ::: "memory")

#define XB_TMO      128
#define XB_XCNT(j)  (256  + 64 * (j))
#define XB_XSUB(j)  (1280 + 64 * (j))
#define XB_XGEN(j)  (2304 + 64 * (j))
#define XB_TOP      3328
#define XB_TOPGEN   3392
#define XCD_BAR_WORDS 3456
#define XB_SPIN_CAP (1u << 22)
__device__ __forceinline__ unsigned xb_ld(unsigned* p)              { return __hip_atomic_load(p, __ATOMIC_RELAXED, __HIP_MEMORY_SCOPE_AGENT); }
__device__ __forceinline__ unsigned xb_add(unsigned* p, unsigned v) { return __hip_atomic_fetch_add(p, v, __ATOMIC_RELAXED, __HIP_MEMORY_SCOPE_AGENT); }
__device__ __forceinline__ unsigned xb_xcc_id() { return (unsigned)__builtin_amdgcn_s_getreg((3 << 11) | 20) & 0xFu; }
#define XB_SPIN(cond, bar) do { unsigned _sp = 0; while (cond) { __builtin_amdgcn_s_sleep(1); \
    if ((++_sp & 255u) == 0u) { if (xb_ld(&(bar)[XB_TMO])) break; if (_sp > XB_SPIN_CAP) { atomicAdd(&(bar)[XB_TMO], 1u); break; } } } } while (0)
struct XcdBarrier { unsigned* bar; unsigned x; volatile LAS unsigned* st; bool t0; };
__device__ __forceinline__ XcdBarrier xcd_barrier_post(unsigned* bar, volatile LAS unsigned* st, bool t0) {
    XcdBarrier b; b.bar = bar; b.x = xb_xcc_id(); b.st = st; b.t0 = t0;
    if (t0) (void)xb_add(&bar[XB_XCNT(b.x)], 1u);
    return b;
}
__device__ __forceinline__ void xcd_barrier_complete(unsigned* bar, unsigned x, unsigned& nloc, unsigned& nx) {
    const unsigned G = gridDim.x * gridDim.y * gridDim.z;
    unsigned sum, cnt, mine, sp = 0u;
    for (;;) {
        sum = 0u; cnt = 0u; mine = 0u;
#pragma unroll
        for (unsigned j = 0; j < 16; ++j) { const unsigned c = xb_ld(&bar[XB_XCNT(j)]); sum += c; cnt += (c > 0u) ? 1u : 0u; mine = (j == x) ? c : mine; }
        if (sum == G) break;
        __builtin_amdgcn_s_sleep(1);
        if ((++sp & 255u) == 0u) { if (xb_ld(&bar[XB_TMO])) break; if (sp > XB_SPIN_CAP) { atomicAdd(&bar[XB_TMO], 1u); break; } }
    }
    nloc = mine > 0u ? mine : 1u; nx = cnt > 0u ? cnt : 1u;
}
__device__ __forceinline__ void xcd_barrier(const XcdBarrier& b) {
    asm volatile("s_waitcnt vmcnt(0)" ::: "memory");
    __syncthreads();
    if (b.t0) {
        unsigned* bar = b.bar;
        __builtin_amdgcn_s_waitcnt(0);
        unsigned nloc = b.st[0], nx = b.st[1];
        if (nloc == 0u) { xcd_barrier_complete(bar, b.x, nloc, nx); b.st[0] = nloc; b.st[1] = nx; }
        const unsigned old = xb_add(&bar[XB_XSUB(b.x)], 1u);
        const unsigned gen = old / nloc;
        if (old + 1u == (gen + 1u) * nloc) {
            __builtin_amdgcn_fence(__ATOMIC_RELEASE, "agent");
            asm volatile("s_waitcnt vmcnt(0)" ::: "memory");
            const unsigned og = xb_add(&bar[XB_TOP], 1u);
            const unsigned tg = og / nx;
            if (og + 1u == (tg + 1u) * nx) xb_add(&bar[XB_TOPGEN], 1u);
            else XB_SPIN(xb_ld(&bar[XB_TOPGEN]) == tg, bar);
            __builtin_amdgcn_fence(__ATOMIC_ACQUIRE, "agent");
            xb_add(&bar[XB_XGEN(b.x)], 1u);
            asm volatile("s_waitcnt vmcnt(0)" ::: "memory");
        } else {
            XB_SPIN(xb_ld(&bar[XB_XGEN(b.x)]) == gen, bar);
            __builtin_amdgcn_fence(__ATOMIC_ACQUIRE, "agent");
            asm volatile("s_waitcnt vmcnt(0)" ::: "memory");
        }
    }
    __syncthreads();
}

__device__ __forceinline__ float wave_sum(float v) {
    v += __builtin_bit_cast(float, __builtin_amdgcn_update_dpp(0, __builtin_bit_cast(int, v), 0x128, 0xf, 0xf, false));
    v += __builtin_bit_cast(float, __builtin_amdgcn_update_dpp(0, __builtin_bit_cast(int, v), 0x124, 0xf, 0xf, false));
    v += __builtin_bit_cast(float, __builtin_amdgcn_update_dpp(0, __builtin_bit_cast(int, v), 0x122, 0xf, 0xf, false));
    v += __builtin_bit_cast(float, __builtin_amdgcn_update_dpp(0, __builtin_bit_cast(int, v), 0x121, 0xf, 0xf, false));
    const int b = __builtin_bit_cast(int, v);
    return (__builtin_bit_cast(float, __builtin_amdgcn_readlane(b, 0)) + __builtin_bit_cast(float, __builtin_amdgcn_readlane(b, 16))) + (__builtin_bit_cast(float, __builtin_amdgcn_readlane(b, 32)) + __builtin_bit_cast(float, __builtin_amdgcn_readlane(b, 48)));
}

struct Args { const float* in[23]; float* out; unsigned char* ws; };
struct Frame { LAS unsigned char* lds; int tid, wave; };
#define KARGS ((const __attribute__((address_space(4))) Args*)__builtin_amdgcn_kernarg_segment_ptr())
#define KWS ((GAS unsigned char*)KARGS->ws)
#define KOUT ((GAS float*)KARGS->out)
#define KCTL ((GAS unsigned*)(KWS + WS_CTL))
#define GRIDN ((int)gridDim.x)
__device__ __forceinline__ int vcu_id() { const int G = gridDim.x, bx = blockIdx.x; return (G % 8 == 0) ? (bx % 8) * (G / 8) + bx / 8 : bx; }
#define WSP(T, off) ((T*)(KWS + (off)))
#define KIN(i) ((const float*)(((const __attribute__((address_space(4))) Args*)__builtin_amdgcn_kernarg_segment_ptr())->in[i]))
#define PHASE_BEGIN() do { asm volatile("" : "+s"(F.wave)); F.tid = F.wave * 64 + hw_lane(); } while (0)

__device__ __forceinline__ int vcol_real(int v) {
    if (v < 1536) return v;
    if (v < 2048) return -1;
    if (v < 2176) return 2056 + (v - 2048);
    if (v < 2240) return 2440 + (v - 2176);
    if (v < 2244) return 1536 + (v - 2240);
    if (v < 2248) return 1540 + (v - 2244);
    if (v < 2252) return 2504 + (v - 2248);
    if (v < 2256) return 4044 + (v - 2252);
    if (v < 2304) return -1;
    if (v < 2560) return 2184 + (v - 2304);
    if (v < 4096) return 2508 + (v - 2560);
    return 4048 + (v - 4096);
}
struct P0Item { const float* W; bf16* WT; int ldw, K, destrow0, k0, srccol4; bool valid, fp8; };
__device__ __forceinline__ void p0_load(const P0Item& d, f32x4 (&v)[8], int lane) {
    const int kr = lane >> 3;
#pragma unroll
    for (int i = 0; i < 8; ++i) v[i] = (d.valid && d.srccol4 >= 0) ? *(const f32x4*)(d.W + (size_t)(d.k0 + 8 * i + kr) * d.ldw + d.srccol4) : (f32x4){0.f, 0.f, 0.f, 0.f};
}
__device__ __forceinline__ void p0_finish(const P0Item& d, const f32x4 (&v)[8], LAS float* scr, int lane) {
    if (!d.valid) return;
    const int kr = lane >> 3, n4 = 4 * (lane & 7);
#pragma unroll
    for (int i = 0; i < 8; ++i) *(LAS f32x4*)(scr + (8 * i + kr) * 36 + n4) = v[i];
    LDS_WAIT(); asm volatile("" ::: "memory");
    const int c = lane & 7;
#pragma unroll
    for (int j = 0; j < 4; ++j) { const int n = (lane >> 3) + 8 * j; const LAS float* s = scr + (8 * c) * 36 + n;
        if (d.fp8) { u32x2 o; o.x = pk4_fp8(32.f * s[0 * 36], 32.f * s[1 * 36], 32.f * s[2 * 36], 32.f * s[3 * 36]); o.y = pk4_fp8(32.f * s[4 * 36], 32.f * s[5 * 36], 32.f * s[6 * 36], 32.f * s[7 * 36]);
            *(u32x2*)((unsigned char*)d.WT + (size_t)(d.destrow0 + n) * d.K + d.k0 + 8 * c) = o; }
        else { u32x4 o; o.x = pk2(s[0 * 36], s[1 * 36]); o.y = pk2(s[2 * 36], s[3 * 36]); o.z = pk2(s[4 * 36], s[5 * 36]); o.w = pk2(s[6 * 36], s[7 * 36]);
            *(u32x4*)(d.WT + (size_t)(d.destrow0 + n) * d.K + d.k0 + 8 * c) = o; } }
    LDS_WAIT(); asm volatile("" ::: "memory");
}
__device__ __forceinline__ void p0_moe_weights(Frame& F) {
    PHASE_BEGIN();
    const int tid = F.tid, lane = tid & 63, w = F.wave;
    constexpr int NI1 = 64 * 8 * 8, NI2 = 64 * 8 * 4;
    __syncthreads();
    int buf = 0;
#define P0M_DECODE(it_, is1_, le_, kt_, nb_, Wp_) const bool is1_ = (it_) < NI1; const int r_##it_ = is1_ ? (it_) : (it_) - NI1; \
        const int le_ = is1_ ? r_##it_ >> 6 : r_##it_ >> 5, kt_ = is1_ ? (r_##it_ >> 3) & 7 : (r_##it_ >> 2) & 7, nb_ = is1_ ? r_##it_ & 7 : r_##it_ & 3, ldw_##it_ = is1_ ? 2048 : 1024; \
        const float* Wp_ = (is1_ ? KIN(I_W1) + (size_t)le_ * 1024 * 2048 : KIN(I_W2) + (size_t)le_ * 1024 * 1024) + (size_t)(kt_ * 128 + 16 * w) * ldw_##it_ + nb_ * 256 + 4 * lane;
    f32x4 v[16], vn[16];
    { const int it0 = blockIdx.x; if (it0 < NI1 + NI2) { P0M_DECODE(it0, a_, b_, c_, d_, Wq)
#pragma unroll
        for (int i = 0; i < 16; ++i) v[i] = __builtin_nontemporal_load((const f32x4*)(Wq + (size_t)i * ldw_it0)); } }
    for (int it = blockIdx.x; it < NI1 + NI2; it += GRIDN) {
        P0M_DECODE(it, is1, le, kt, nb, W)
        (void)W;
        { const int itn = it + GRIDN; if (itn < NI1 + NI2) { P0M_DECODE(itn, a_, b_, c_, d_, Wq)
#pragma unroll
            for (int i = 0; i < 16; ++i) vn[i] = __builtin_nontemporal_load((const f32x4*)(Wq + (size_t)i * ldw_itn)); } }
        LAS unsigned* T = (LAS unsigned*)(F.lds + buf * 32768);
#pragma unroll
        for (int g = 0; g < 4; ++g) {
            unsigned d[4];
#pragma unroll
            for (int q = 0; q < 4; ++q) d[q] = pk4_fp8(32.f * v[4 * g + q].x, 32.f * v[4 * g + q].y, 32.f * v[4 * g + q].z, 32.f * v[4 * g + q].w);
            const unsigned x0 = __builtin_amdgcn_perm(d[1], d[0], 0x05010400u), x1 = __builtin_amdgcn_perm(d[1], d[0], 0x07030602u), y0 = __builtin_amdgcn_perm(d[3], d[2], 0x05010400u), y1 = __builtin_amdgcn_perm(d[3], d[2], 0x07030602u);
            const unsigned t[4] = {__builtin_amdgcn_perm(y0, x0, 0x05040100u), __builtin_amdgcn_perm(y0, x0, 0x07060302u), __builtin_amdgcn_perm(y1, x1, 0x05040100u), __builtin_amdgcn_perm(y1, x1, 0x07060302u)};
#pragma unroll
            for (int c = 0; c < 4; ++c) T[(4 * lane + c) * 32 + ((4 * w + g) ^ (lane & 31))] = t[c];
        }
        __syncthreads();
        unsigned char* WT = is1 ? WSP(unsigned char, WS_W1T) + (size_t)le * 2048 * 1024 : WSP(unsigned char, WS_W2T) + (size_t)le * 1024 * 1024;
#pragma unroll
        for (int j = 0; j < 4; ++j) { const int n = (tid >> 3) + 64 * j, c8 = tid & 7, sw = (n >> 2) & 31;
            u32x4 o; o.x = T[n * 32 + ((4 * c8 + 0) ^ sw)]; o.y = T[n * 32 + ((4 * c8 + 1) ^ sw)]; o.z = T[n * 32 + ((4 * c8 + 2) ^ sw)]; o.w = T[n * 32 + ((4 * c8 + 3) ^ sw)];
            const int rc = nb * 256 + n; int vrow = rc;
            if (is1) { const int half = rc >> 10, c = rc & 1023; vrow = (c >> 7) * 256 + ((c >> 6) & 1) * 128 + ((c >> 2) & 15) * 8 + 4 * half + (c & 3); }
            __builtin_nontemporal_store(o, (u32x4*)(WT + (size_t)vrow * 1024 + kt * 128 + 16 * c8)); }
        buf ^= 1;
#pragma unroll
        for (int i = 0; i < 16; ++i) v[i] = vn[i];
    }
#undef P0M_DECODE
    __syncthreads();
}
__device__ __forceinline__ void p0_prologue(Frame& F) {
    PHASE_BEGIN();
    const int tid = F.tid, lane = (F.tid & 63);
    {
        LAS float* cond = (LAS float*)F.lds;
        LAS float* part = (LAS float*)(F.lds + 32768);
        bool staged = false;
        for (int it = blockIdx.x; it < 2 * 96; it += GRIDN) {
            if (!staged) { for (int i = tid; i < 8 * 1024; i += NTHREADS) { const float v = KIN(I_C)[i]; cond[i] = v / (1.f + __expf(-v)); } staged = true; }
            __syncthreads();
            const int l = it / 96, cb = it % 96, ks = tid >> 6, col = tid & 63, n = cb * 64 + col;
            const float* w = KIN(I_WADA) + (size_t)l * 1024 * 6144 + n;
            float a[8];
#pragma unroll
            for (int b = 0; b < 8; ++b) a[b] = 0.f;
            for (int k = ks * 128; k < ks * 128 + 128; ++k) { const float wv = w[(size_t)k * 6144];
#pragma unroll
                for (int b = 0; b < 8; ++b) a[b] += cond[b * 1024 + k] * wv; }
#pragma unroll
            for (int b = 0; b < 8; ++b) part[(ks * 8 + b) * 64 + col] = a[b];
            __syncthreads();
            { const int b = tid >> 6; float s = 0.f;
#pragma unroll
              for (int q = 0; q < 8; ++q) s += part[(q * 8 + b) * 64 + col];
              WSP(float, WS_MOD)[((size_t)l * 8 + b) * 6144 + n] = s + KIN(I_BADA)[l * 6144 + n]; }
        }
        __syncthreads();
    }
    {
        LAS float* As = (LAS float*)F.lds;
        LAS float* Us = (LAS float*)(F.lds + 64 * 129 * 4);
        for (int it = blockIdx.x; it < 128; it += GRIDN) {
            const int l = it >> 6, h = (it >> 4) & 3, kb = it & 15, k0 = kb * 64;
            __syncthreads();
            for (int i = tid; i < 64 * 128; i += NTHREADS) { const int k = i >> 7, d = i & 127; As[k * 129 + d] = KIN(I_WIN)[((size_t)l * 1024 + k0 + k) * D_IN + 1544 + h * 128 + d]; }
            for (int i = tid; i < 128 * 128; i += NTHREADS) { const int c = i >> 7, d = i & 127; Us[c * 129 + d] = KIN(I_WUK)[(((size_t)l * 4 + h) * 128 + c) * 128 + d]; }
            __syncthreads();
            const int c = tid & 127, kq = tid >> 7; float a[16];
#pragma unroll
            for (int i = 0; i < 16; ++i) a[i] = 0.f;
            for (int d = 0; d < 128; ++d) { const float u = Us[c * 129 + d];
#pragma unroll
                for (int i = 0; i < 16; ++i) a[i] += u * As[(kq * 16 + i) * 129 + d]; }
            const float sc = 0.08838834764831845f;
            bf16* dst = WSP(bf16, WS_WIN_T) + ((size_t)l * NV + 1536 + h * 128 + c) * 1024 + k0 + kq * 16;
            u32x4 o0, o1; o0.x = pk2(a[0] * sc, a[1] * sc); o0.y = pk2(a[2] * sc, a[3] * sc); o0.z = pk2(a[4] * sc, a[5] * sc); o0.w = pk2(a[6] * sc, a[7] * sc);
            o1.x = pk2(a[8] * sc, a[9] * sc); o1.y = pk2(a[10] * sc, a[11] * sc); o1.z = pk2(a[12] * sc, a[13] * sc); o1.w = pk2(a[14] * sc, a[15] * sc);
            *(u32x4*)dst = o0; *(u32x4*)(dst + 8) = o1;
            if (kb == 0 && kq == 0) { float s = 0.f; for (int d = 0; d < 128; ++d) s += Us[c * 129 + d] * KIN(I_BIN)[l * D_IN + 1544 + h * 128 + d];
                WSP(float, WS_BINP)[l * NV + 1536 + h * 128 + c] = s * sc; }
        }
        __syncthreads();
    }
    {
        LAS float* Us = (LAS float*)F.lds;
        LAS float* Bs = (LAS float*)(F.lds + 128 * 129 * 4);
        for (int it = blockIdx.x; it < 128; it += GRIDN) {
            const int l = it >> 6, h = (it >> 4) & 3, nb = it & 15, n0 = nb * 64;
            __syncthreads();
            for (int i = tid; i < 128 * 128; i += NTHREADS) { const int c = i >> 7, d = i & 127; Us[c * 129 + d] = KIN(I_WUV)[(((size_t)l * 4 + h) * 128 + c) * 128 + d]; }
            for (int i = tid; i < 128 * 64; i += NTHREADS) { const int d = i >> 6, n = i & 63; Bs[d * 65 + n] = KIN(I_WBRDSA)[((size_t)l * 512 + h * 128 + d) * 1024 + n0 + n]; }
            __syncthreads();
            const int c = tid & 127, nq = tid >> 7; float a[16];
#pragma unroll
            for (int i = 0; i < 16; ++i) a[i] = 0.f;
            for (int d = 0; d < 128; ++d) { const float u = Us[c * 129 + d];
#pragma unroll
                for (int i = 0; i < 16; ++i) a[i] += u * Bs[d * 65 + nq * 16 + i]; }
#pragma unroll
            for (int i = 0; i < 16; ++i) WSP(bf16, WS_WBR_T)[((size_t)l * 3072 + 1024 + n0 + nq * 16 + i) * 512 + h * 128 + c] = (bf16)f2bf(a[i]);
        }
        __syncthreads();
    }
    for (int i = blockIdx.x * NTHREADS + tid; i < 2 * 32 * 1024; i += GRIDN * NTHREADS) { const int l = i >> 15, e = (i >> 10) & 31, k = i & 1023;
        const float w = KIN(I_WR)[((size_t)l * 1024 + k) * 32 + e]; const unsigned hi = f2bf(w), lo = f2bf(w - bf2f(hi));
        WSP(bf16, WS_WRT)[((size_t)l * 2 + 0) * 32768 + e * 1024 + k] = (bf16)hi; WSP(bf16, WS_WRT)[((size_t)l * 2 + 1) * 32768 + e * 1024 + k] = (bf16)lo; }
    for (int i = blockIdx.x * NTHREADS + tid; i < 2 * NV; i += GRIDN * NTHREADS) { const int l = i / NV, v = i % NV; const int r = vcol_real(v);
        if (!(v >= 1536 && v < 2048)) WSP(float, WS_BINP)[i] = r >= 0 ? KIN(I_BIN)[l * D_IN + r] : 0.f; }
    LAS float* scr = (LAS float*)(F.lds + F.wave * 16384);
    const int gw = vcu_id() * NWAVES + F.wave, NGW = GRIDN * NWAVES;
    constexpr int IT_IN = 16 * (NV / 32), IT_BR = 8 * 32, IT_OUT = 16 * 32;
    constexpr int N_IN = 2 * IT_IN, N_BR = 2 * 2 * IT_BR, N_OUT = 2 * IT_OUT;
    constexpr int IT_IN8 = 16 * (24 * 8), N_IN8 = 2 * IT_IN8;
    constexpr int N_ALL = N_IN + N_BR + N_OUT + N_IN8;
    auto decode = [&](int it) -> P0Item {
        P0Item d; d.fp8 = false; d.valid = it < N_ALL; d.W = nullptr; d.WT = nullptr; d.ldw = 0; d.K = 0; d.destrow0 = 0; d.k0 = 0; d.srccol4 = -1;
        if (!d.valid) return d;
        int r = it;
        if (r < N_IN) { const int l = r / IT_IN, q = r % IT_IN, kb = q / (NV / 32), nb = q % (NV / 32), v = nb * 32 + 4 * (lane & 7);
            if (nb < 48 || nb >= 80) { d.valid = false; return d; }
            if (nb * 32 >= 1536 && nb * 32 < 2048) { d.valid = false; return d; }
            d.W = KIN(I_WIN) + (size_t)l * 1024 * D_IN; d.ldw = D_IN; d.K = 1024; d.WT = WSP(bf16, WS_WIN_T) + (size_t)l * NV * 1024; d.destrow0 = nb * 32; d.k0 = kb * 64; d.srccol4 = vcol_real(v); return d; }
        r -= N_IN;
        if (r < N_BR) { const int l = r / (2 * IT_BR), q = r % (2 * IT_BR), which = q / IT_BR, q2 = q % IT_BR, kb = q2 / 32, nb = q2 % 32;
            d.W = (which ? KIN(I_WBRFOX) : KIN(I_WBRML)) + (size_t)l * 512 * 1024; d.ldw = 1024; d.K = 512; d.WT = WSP(bf16, WS_WBR_T) + (size_t)l * 3072 * 512; d.destrow0 = (which ? 2048 : 0) + nb * 32; d.k0 = kb * 64; d.srccol4 = nb * 32 + 4 * (lane & 7); return d; }
        r -= N_BR;
        if (r < N_OUT) { const int l = r / IT_OUT, q = r % IT_OUT, kb = q / 32, nb = q % 32;
            d.fp8 = true; d.W = KIN(I_WOUT) + (size_t)l * 1024 * 1024; d.ldw = 1024; d.K = 1024; d.WT = (bf16*)(WSP(unsigned char, WS_WOUT8_) + (size_t)l * 1024 * 1024); d.destrow0 = nb * 32; d.k0 = kb * 64; d.srccol4 = nb * 32 + 4 * (lane & 7); return d; }
        r -= N_OUT;
        if (r < N_IN8) { const int l = r / IT_IN8, q = r % IT_IN8, kb = q / 192, nv = q % 192, tv = nv >> 3, nb = (tv < 6 ? tv : tv + 4) * 8 + (nv & 7), v = nb * 32 + 4 * (lane & 7);
            d.fp8 = true; d.W = KIN(I_WIN) + (size_t)l * 1024 * D_IN; d.ldw = D_IN; d.K = 1024; d.WT = (bf16*)(WSP(unsigned char, WS_WIN8_) + (size_t)l * NV * 1024); d.destrow0 = nb * 32; d.k0 = kb * 64; d.srccol4 = vcol_real(v); return d; }
        d.valid = false; return d;
    };
    P0Item cur = decode(gw); f32x4 vc[8], vn[8]; p0_load(cur, vc, lane);
    for (int it = gw; it < N_ALL; it += NGW) {
        const P0Item nxt = decode(it + NGW); p0_load(nxt, vn, lane);
        p0_finish(cur, vc, scr, lane);
        cur = nxt;
#pragma unroll
        for (int i = 0; i < 8; ++i) vc[i] = vn[i];
    }
}

__device__ __forceinline__ void norm_rows(Frame& F, const float* xsrc, int l, int shoff, int scoff) {
    PHASE_BEGIN();
    const int gw = blockIdx.x * NWAVES + F.wave, lane = (F.tid & 63), c0 = 16 * lane, m0 = gw * 8;
    const float* mo = WSP(float, WS_MOD) + (size_t)l * 8 * 6144 + (size_t)(m0 >> 11) * 6144; bf16* XN = WSP(bf16, WS_XN);
    f32x4 sh[4], sc[4];
#pragma unroll
    for (int q = 0; q < 4; ++q) { sh[q] = *(const f32x4*)(mo + shoff + c0 + 4 * q); sc[q] = *(const f32x4*)(mo + scoff + c0 + 4 * q); }
    for (int t = 0; t < 8; ++t) {
        const int m = m0 + t;
        f32x4 v[4]; float s = 0.f;
#pragma unroll
        for (int q = 0; q < 4; ++q) { v[q] = *(const f32x4*)(xsrc + (size_t)m * D + c0 + 4 * q); s += (v[q].x * v[q].x + v[q].y * v[q].y) + (v[q].z * v[q].z + v[q].w * v[q].w); }
        const float r = 1.0f / sqrtf(wave_sum(s) * (1.0f / D) + EPS);
        unsigned wb[8], w8[4];
#pragma unroll
        for (int q = 0; q < 4; ++q) { const f32x4 h = v[q] * r * (1.0f + sc[q]) + sh[q]; wb[2 * q] = pk2(h.x, h.y); wb[2 * q + 1] = pk2(h.z, h.w); w8[q] = pk4_fp8(h.x, h.y, h.z, h.w); }
        *(u32x4*)(XN + (size_t)m * D + c0) = (u32x4){wb[0], wb[1], wb[2], wb[3]}; *(u32x4*)(XN + (size_t)m * D + c0 + 8) = (u32x4){wb[4], wb[5], wb[6], wb[7]};
        *(u32x4*)(WSP(unsigned char, WS_XN1_8_) + (size_t)m * D + c0) = (u32x4){w8[0], w8[1], w8[2], w8[3]};
    }
}
__device__ __forceinline__ void route_phase(Frame& F, int l, const float* xsrc, bool dry = false) {
    PHASE_BEGIN();
    LAS int* lcnt = (LAS int*)F.lds;
    LAS float* lg = (LAS float*)(F.lds + 1024);
    const int tid = F.tid, lane = (F.tid & 63), w = F.wave;
    if (tid < 32) lcnt[tid] = 0;
    const float* modl = WSP(float, WS_MOD) + (size_t)l * 8 * 6144;
    bf16* XN = dry ? WSP(bf16, WS_DRY) : WSP(bf16, WS_XN); bf16* XNL = dry ? WSP(bf16, WS_DRY + 32 * MiB) : WSP(bf16, WS_XNL);
    const bf16* WH = WSP(bf16, WS_WRT) + (size_t)l * 2 * 32768; const bf16* WL = WH + 32768;
    for (int rb = blockIdx.x; rb < M / 64; rb += GRIDN) {
        __syncthreads();
        {
            const int c0 = 16 * lane; const float* mo = modl + (size_t)((rb * 64) >> 11) * 6144;
            f32x4 sh[4], sc[4];
#pragma unroll
            for (int q = 0; q < 4; ++q) { sh[q] = *(const f32x4*)(mo + 3072 + c0 + 4 * q); sc[q] = *(const f32x4*)(mo + 4096 + c0 + 4 * q); }
            unsigned char* XN8 = dry ? WSP(unsigned char, WS_DRY + 100 * MiB) : WSP(unsigned char, WS_XN8);
            for (int i0 = 0; i0 < 8; i0 += 4) {
              f32x4 vv[4][4];
#pragma unroll
              for (int i = 0; i < 4; ++i)
#pragma unroll
                for (int q = 0; q < 4; ++q) vv[i][q] = *(const f32x4*)(xsrc + (size_t)(rb * 64 + w * 8 + i0 + i) * D + c0 + 4 * q);
#pragma unroll
              for (int i = 0; i < 4; ++i) {
                const int m = rb * 64 + w * 8 + i0 + i;
                f32x4 v[4]; float s = 0.f;
#pragma unroll
                for (int q = 0; q < 4; ++q) { v[q] = vv[i][q]; s += (v[q].x * v[q].x + v[q].y * v[q].y) + (v[q].z * v[q].z + v[q].w * v[q].w); }
                const float r = 1.0f / sqrtf(wave_sum(s) * (1.0f / D) + EPS);
                unsigned wh[8], wl[8], w8[4];
#pragma unroll
                for (int q = 0; q < 4; ++q) { const f32x4 h = v[q] * r * (1.0f + sc[q]) + sh[q];
                    const unsigned h0 = f2bf(h.x), h1 = f2bf(h.y), h2 = f2bf(h.z), h3 = f2bf(h.w);
                    wh[2 * q] = h0 | (h1 << 16); wh[2 * q + 1] = h2 | (h3 << 16);
                    wl[2 * q] = pk2(h.x - bf2f(h0), h.y - bf2f(h1)); wl[2 * q + 1] = pk2(h.z - bf2f(h2), h.w - bf2f(h3)); w8[q] = pk4_fp8(h.x, h.y, h.z, h.w); }
                *(u32x4*)(XN + (size_t)m * D + c0) = (u32x4){wh[0], wh[1], wh[2], wh[3]}; *(u32x4*)(XN + (size_t)m * D + c0 + 8) = (u32x4){wh[4], wh[5], wh[6], wh[7]};
                *(u32x4*)(XNL + (size_t)m * D + c0) = (u32x4){wl[0], wl[1], wl[2], wl[3]}; *(u32x4*)(XNL + (size_t)m * D + c0 + 8) = (u32x4){wl[4], wl[5], wl[6], wl[7]};
                *(u32x4*)(XN8 + (size_t)m * D + c0) = (u32x4){w8[0], w8[1], w8[2], w8[3]};
              }
            }
        }
        const int fr = lane & 15, kq = lane >> 4, kb = 128 * w + 8 * kq;
        const bf16* pbh = WH + (size_t)fr * 1024 + kb; const bf16* pbl = WL + (size_t)fr * 1024 + kb;
        bf16x8 bhn[2], bln[2];
#pragma unroll
        for (int et = 0; et < 2; ++et) { bhn[et] = *(const bf16x8*)(pbh + et * 16 * 1024); bln[et] = *(const bf16x8*)(pbl + et * 16 * 1024); }
        VM_WAIT(); __builtin_amdgcn_fence(__ATOMIC_ACQUIRE, "agent"); VM_WAIT(); __syncthreads();
        {
            f32x4 acc[4][2];
#pragma unroll
            for (int rt = 0; rt < 4; ++rt) { acc[rt][0] = ozero4(); acc[rt][1] = acc[rt][0]; }
            const bf16* pa = XN + (size_t)(rb * 64 + fr) * D + kb; const bf16* pal = XNL + (size_t)(rb * 64 + fr) * D + kb;
            bf16x8 ahn[4], aln[4];
#pragma unroll
            for (int rt = 0; rt < 4; ++rt) { ahn[rt] = *(const bf16x8*)(pa + (size_t)rt * 16 * D); aln[rt] = *(const bf16x8*)(pal + (size_t)rt * 16 * D); }
#pragma unroll
            for (int ks = 0; ks < 4; ++ks) {
                bf16x8 ah[4], al[4], bh[2], bl[2];
#pragma unroll
                for (int rt = 0; rt < 4; ++rt) { ah[rt] = ahn[rt]; al[rt] = aln[rt]; }
#pragma unroll
                for (int et = 0; et < 2; ++et) { bh[et] = bhn[et]; bl[et] = bln[et]; }
                if (ks < 3) {
#pragma unroll
                    for (int rt = 0; rt < 4; ++rt) { ahn[rt] = *(const bf16x8*)(pa + (size_t)rt * 16 * D + (ks + 1) * 32); aln[rt] = *(const bf16x8*)(pal + (size_t)rt * 16 * D + (ks + 1) * 32); }
#pragma unroll
                    for (int et = 0; et < 2; ++et) { bhn[et] = *(const bf16x8*)(pbh + et * 16 * 1024 + (ks + 1) * 32); bln[et] = *(const bf16x8*)(pbl + et * 16 * 1024 + (ks + 1) * 32); } }
#pragma unroll
                for (int rt = 0; rt < 4; ++rt)
#pragma unroll
                    for (int et = 0; et < 2; ++et) {
                        acc[rt][et] = __builtin_amdgcn_mfma_f32_16x16x32_bf16(ah[rt], bh[et], acc[rt][et], 0, 0, 0);
                        acc[rt][et] = __builtin_amdgcn_mfma_f32_16x16x32_bf16(ah[rt], bl[et], acc[rt][et], 0, 0, 0);
                        acc[rt][et] = __builtin_amdgcn_mfma_f32_16x16x32_bf16(al[rt], bh[et], acc[rt][et], 0, 0, 0); }
            }
            LAS float* part = (LAS float*)(F.lds + 16384);
#pragma unroll
            for (int rt = 0; rt < 4; ++rt)
#pragma unroll
                for (int et = 0; et < 2; ++et)
#pragma unroll
                    for (int rg = 0; rg < 4; ++rg) part[(w * 64 + rt * 16 + 4 * kq + rg) * 33 + et * 16 + fr] = acc[rt][et][rg];
            __syncthreads();
            {   const int row = tid >> 3, e4 = (tid & 7) * 4;
#pragma unroll
                for (int j = 0; j < 4; ++j) { float sum = 0.f;
#pragma unroll
                    for (int ww = 0; ww < 8; ++ww) sum += part[(ww * 64 + row) * 33 + e4 + j];
                    lg[row * 33 + e4 + j] = sum + KIN(I_BR)[l * 32 + e4 + j]; } }
        }
        __syncthreads();
        if (w == 0) {
            float v[32];
#pragma unroll
            for (int e = 0; e < 32; ++e) v[e] = lg[lane * 33 + e];
            int idx[4]; float val[4];
#pragma unroll
            for (int k = 0; k < 4; ++k) { float best = v[0]; int bi = 0;
#pragma unroll
                for (int e = 1; e < 32; ++e) { const bool g = v[e] > best; best = g ? v[e] : best; bi = g ? e : bi; }
                val[k] = best; idx[k] = bi;
#pragma unroll
                for (int e = 0; e < 32; ++e) v[e] = (e == bi) ? -__builtin_inff() : v[e]; }
            const float p1 = __expf(val[1] - val[0]), p2 = __expf(val[2] - val[0]), p3 = __expf(val[3] - val[0]), inv = 1.0f / (1.0f + p1 + p2 + p3);
            const float gt[4] = {inv, p1 * inv, p2 * inv, p3 * inv};
            const int m = rb * 64 + lane;
#pragma unroll
            for (int k = 0; k < 4; ++k) { const int lr = __hip_atomic_fetch_add(lcnt + idx[k], 1, __ATOMIC_RELAXED, __HIP_MEMORY_SCOPE_WORKGROUP);
                int* eo = dry ? WSP(int, WS_DRY + 96 * MiB) : WSP(int, WS_EIDX); float* go = dry ? WSP(float, WS_DRY + 97 * MiB) : WSP(float, WS_GATE); int* lo_ = dry ? WSP(int, WS_DRY + 98 * MiB) : WSP(int, WS_LRANK);
                eo[m * 4 + k] = idx[k]; go[m * 4 + k] = gt[k]; lo_[m * 4 + k] = lr; }
        }
    }
    __syncthreads();
    if (tid < 32 && !dry) { const int base = (int)__hip_atomic_fetch_add(KCTL + CW_GCNT + l * 64 + tid, (unsigned)lcnt[tid], __ATOMIC_RELAXED, __HIP_MEMORY_SCOPE_AGENT);
        WSP(int, WS_BASE)[blockIdx.x * 32 + tid] = base; }
    __syncthreads();
}
__device__ __forceinline__ void gather_phase(Frame& F, int l) {
    PHASE_BEGIN();
    LAS int* tst = (LAS int*)(F.lds + LDSCTL_OFF);
    LAS int* tmp = (LAS int*)F.lds;
    if (F.tid < 32) tmp[F.tid] = (int)((__hip_atomic_load(KCTL + CW_GCNT + l * 64 + F.tid, __ATOMIC_RELAXED, __HIP_MEMORY_SCOPE_AGENT) + 255u) >> 8);
    __syncthreads();
    if (F.tid == 0) { int a = 0; for (int e = 0; e < 32; ++e) { tst[e] = a; a += tmp[e]; } tst[32] = a; }
    __syncthreads();
    if (F.tid < 320) { int e = 0;
#pragma unroll
        for (int k = 1; k < 32; ++k) e += ((int)F.tid >= tst[k]) ? 1 : 0;
        tst[2048 + F.tid] = e; }
    __syncthreads();
    const int gw = blockIdx.x * NWAVES + F.wave, lane = (F.tid & 63), p0 = gw * 32;
    const unsigned char* XN = WSP(unsigned char, WS_XN8); unsigned char* AS = WSP(unsigned char, WS_AS8);
    int dest = 0;
    if (lane < 32) { const int p = p0 + lane, tok = p >> 2, e = WSP(int, WS_EIDX)[p];
        dest = tst[e] * 256 + WSP(int, WS_BASE)[((tok >> 6) % GRIDN) * 32 + e] + WSP(int, WS_LRANK)[p];
        WSP(int, WS_PPOS)[p] = dest; }
    u32x4 rows[8];
#pragma unroll
    for (int t = 0; t < 8; ++t) rows[t] = *((const u32x4*)(XN + (size_t)(gw * 8 + t) * D) + lane);
#pragma unroll
    for (int i = 0; i < 32; ++i) { const int d = __builtin_amdgcn_readlane(dest, i); *((u32x4*)(AS + (size_t)d * D) + lane) = rows[i >> 2]; }
}
__device__ __forceinline__ void combine_phase(Frame& F, int l, const float* xsrc, bool last, bool dry = false) {
    PHASE_BEGIN();
    const int gw = blockIdx.x * NWAVES + F.wave, lane = (F.tid & 63), c0 = 16 * lane;
    const float* modl = WSP(float, WS_MOD) + (size_t)l * 8 * 6144; const float* modn = WSP(float, WS_MOD) + (size_t)(l + 1) * 8 * 6144;
    const unsigned char* YP = WSP(unsigned char, WS_ASORT); float* X = dry ? WSP(float, WS_DRY) : WSP(float, WS_X); bf16* XN = dry ? WSP(bf16, WS_DRY + 64 * MiB) : WSP(bf16, WS_XN);
    unsigned char* XN8 = dry ? WSP(unsigned char, WS_DRY + 96 * MiB) : WSP(unsigned char, WS_XN1_8_);
    const int m0 = gw * 8, b = m0 >> 11;
    f32x4 g2[4], sh[4], sc[4];
#pragma unroll
    for (int q = 0; q < 4; ++q) { g2[q] = *(const f32x4*)(modl + (size_t)b * 6144 + 5120 + c0 + 4 * q);
        if (last) { sh[q] = *(const f32x4*)(KIN(I_FG) + c0 + 4 * q); sc[q] = sh[q]; }
        else { sh[q] = *(const f32x4*)(modn + (size_t)b * 6144 + c0 + 4 * q); sc[q] = *(const f32x4*)(modn + (size_t)b * 6144 + 1024 + c0 + 4 * q); } }
    typedef int i32x4_t __attribute__((ext_vector_type(4)));
    i32x4_t posn = *(const i32x4_t*)(WSP(int, WS_PPOS) + (size_t)m0 * 4); f32x4 gkn = *(const f32x4*)(WSP(float, WS_GATE) + (size_t)m0 * 4);
    u32x4 yqn[4]; f32x4 vn[4]; f32x4 gk1 = gkn;
#pragma unroll
    for (int k = 0; k < 4; ++k) yqn[k] = *(const u32x4*)(YP + (size_t)posn[k] * D + c0);
#pragma unroll
    for (int q = 0; q < 4; ++q) vn[q] = *(const f32x4*)(xsrc + (size_t)m0 * D + c0 + 4 * q);
    posn = *(const i32x4_t*)(WSP(int, WS_PPOS) + (size_t)(m0 + 1) * 4); gkn = *(const f32x4*)(WSP(float, WS_GATE) + (size_t)(m0 + 1) * 4);
    for (int t = 0; t < 8; ++t) {
        const int m = m0 + t;
        const f32x4 gk = gk1 * 0.0625f;
        u32x4 yq[4]; f32x4 v[4];
#pragma unroll
        for (int k = 0; k < 4; ++k) yq[k] = yqn[k];
#pragma unroll
        for (int q = 0; q < 4; ++q) v[q] = vn[q];
        if (t < 7) {
#pragma unroll
            for (int k = 0; k < 4; ++k) yqn[k] = *(const u32x4*)(YP + (size_t)posn[k] * D + c0);
#pragma unroll
            for (int q = 0; q < 4; ++q) vn[q] = *(const f32x4*)(xsrc + (size_t)(m + 1) * D + c0 + 4 * q);
            gk1 = gkn;
            const int m2 = (t < 6) ? m + 2 : m + 1;
            posn = *(const i32x4_t*)(WSP(int, WS_PPOS) + (size_t)m2 * 4); gkn = *(const f32x4*)(WSP(float, WS_GATE) + (size_t)m2 * 4); }
        float s = 0.f;
#pragma unroll
        for (int q = 0; q < 4; ++q) { f32x4 y = {0.f, 0.f, 0.f, 0.f};
#pragma unroll
            for (int k = 0; k < 4; ++k) { const f32x2 lo = __builtin_amdgcn_cvt_pk_f32_fp8((int)yq[k][q], false), hi = __builtin_amdgcn_cvt_pk_f32_fp8((int)yq[k][q], true);
                y.x += gk[k] * lo[0]; y.y += gk[k] * lo[1]; y.z += gk[k] * hi[0]; y.w += gk[k] * hi[1]; }
            v[q] = v[q] + g2[q] * y; s += (v[q].x * v[q].x + v[q].y * v[q].y) + (v[q].z * v[q].z + v[q].w * v[q].w); }
        const float r = 1.0f / sqrtf(wave_sum(s) * (1.0f / D) + EPS);
        if (last) {
#pragma unroll
            for (int q = 0; q < 4; ++q) *(f32x4*)(KOUT + (size_t)m * D + c0 + 4 * q) = v[q] * r * sh[q];
        } else {
            unsigned w8[4]; unsigned wb[8];
#pragma unroll
            for (int q = 0; q < 4; ++q) { *(f32x4*)(X + (size_t)m * D + c0 + 4 * q) = v[q];
                const f32x4 h = v[q] * r * (1.0f + sc[q]) + sh[q]; wb[2 * q] = pk2(h.x, h.y); wb[2 * q + 1] = pk2(h.z, h.w); w8[q] = pk4_fp8(h.x, h.y, h.z, h.w); }
            *(u32x4*)(XN + (size_t)m * D + c0) = (u32x4){wb[0], wb[1], wb[2], wb[3]}; *(u32x4*)(XN + (size_t)m * D + c0 + 8) = (u32x4){wb[4], wb[5], wb[6], wb[7]};
            *(u32x4*)(XN8 + (size_t)m * D + c0) = (u32x4){w8[0], w8[1], w8[2], w8[3]};
        }
    }
}

template <int NTN> struct MoeSched {
    const LAS int* tst; int total, G, c; int deg = 0;
    __device__ __forceinline__ bool next(int i, pg8::Unit& u) const {
        const int L = i * G + c; if (L >= total) return false;
        const int rt = L / NTN, j = L - rt * NTN; const int e = tst[2048 + rt];
        u.pm = rt; u.pn = e * NTN + j;
        if (DUP_MASK && deg) { u.pm = 0; u.pn = j; }
        return true;
    }
    __device__ __forceinline__ void a_ready(const pg8::Unit&) const {}
    __device__ __forceinline__ void done(const pg8::Unit&) const {}
};
struct EpiMoe1 {
    static constexpr bool PERM = true, AFTER_DRAIN = false;
    bf16* ACT; const float* b1;
    __device__ __forceinline__ void operator()(const f32x4 (&acc)[2][2][4][2], const pg8::Unit& u, int wr, int wc, int fr, int fq) const {
        asm volatile("" : "+v"(fr), "+v"(fq));
        const int e = u.pn >> 3, j = u.pn & 7, row0 = u.pm * 256 + wr * 64 + fr, c0 = j * 128 + 32 * wc + 8 * fq;
        f32x4 bg[2], bl[2];
#pragma unroll
        for (int n = 0; n < 2; ++n) { bg[n] = *(const f32x4*)(b1 + (size_t)e * 2048 + c0 + 4 * n); bl[n] = *(const f32x4*)(b1 + (size_t)e * 2048 + 1024 + c0 + 4 * n); }
#pragma unroll
        for (int ai = 0; ai < 2; ++ai)
#pragma unroll
            for (int m = 0; m < 4; ++m) { unsigned w[4];
#pragma unroll
                for (int n = 0; n < 2; ++n) { const f32x4 g = acc[ai][0][m][n] + bg[n], li = acc[ai][1][m][n] + bl[n]; float o[4];
#pragma unroll
                    for (int q = 0; q < 4; ++q) { const float gl = fminf(g[q], 7.0f), ln = fminf(fmaxf(li[q], -7.0f), 7.0f);
                        o[q] = gl * (ln + 1.0f) * __builtin_amdgcn_rcpf(1.0f + __builtin_amdgcn_exp2f(-2.4554669595930156f * gl)); }
                    w[2 * n] = pg8::cvt_pk_bf16(o[0], o[1]); w[2 * n + 1] = pg8::cvt_pk_bf16(o[2], o[3]); }
                *(u32x4*)(ACT + (size_t)(row0 + ai * 128 + m * 16) * D + c0) = (u32x4){w[0], w[1], w[2], w[3]}; }
    }
};
struct EpiMoe2 {
    static constexpr bool PERM = true, AFTER_DRAIN = false;
    bf16* YP; const float* b2; const float* rowgate;
    __device__ __forceinline__ void operator()(const f32x4 (&acc)[2][2][4][2], const pg8::Unit& u, int wr, int wc, int fr, int fq) const {
        asm volatile("" : "+v"(fr), "+v"(fq));
        const int e = u.pn >> 2, row0 = u.pm * 256 + wr * 64 + fr, c0 = (u.pn & 3) * 256 + 32 * wc + 8 * fq;
        f32x4 bv[2][2];
#pragma unroll
        for (int bj = 0; bj < 2; ++bj)
#pragma unroll
            for (int n = 0; n < 2; ++n) bv[bj][n] = *(const f32x4*)(b2 + (size_t)e * 1024 + c0 + bj * 128 + 4 * n);
#pragma unroll
        for (int ai = 0; ai < 2; ++ai)
#pragma unroll
            for (int m = 0; m < 4; ++m) { const int row = row0 + ai * 128 + m * 16; const float g = rowgate[row];
#pragma unroll
                for (int bj = 0; bj < 2; ++bj) { const f32x4 v0 = (acc[ai][bj][m][0] + bv[bj][0]) * g, v1 = (acc[ai][bj][m][1] + bv[bj][1]) * g;
                    *(u32x4*)(YP + (size_t)row * D + c0 + bj * 128) = (u32x4){pg8::cvt_pk_bf16(v0[0], v0[1]), pg8::cvt_pk_bf16(v0[2], v0[3]), pg8::cvt_pk_bf16(v1[0], v1[1]), pg8::cvt_pk_bf16(v1[2], v1[3])}; } }
    }
};

struct EpiW1 {
    unsigned char* ACT8; const float* b1;
    __device__ __forceinline__ void operator()(const f32x4 (&acc)[4][8], const pg8::Unit& u, int wr, int wc, int fr, int fq) const {
        asm volatile("" : "+v"(fr), "+v"(fq));
        const int e = u.pn >> 3, j = u.pn & 7, row0 = u.pm * 256 + wr * 64 + fr, c0 = j * 128 + wc * 64 + 4 * fq;
#pragma unroll
        for (int n = 0; n < 4; ++n) { const f32x4 bg = *(const f32x4*)(b1 + (size_t)e * 2048 + c0 + 16 * n), bl = *(const f32x4*)(b1 + (size_t)e * 2048 + 1024 + c0 + 16 * n);
#pragma unroll
            for (int m = 0; m < 4; ++m) { const f32x4 g = acc[m][n] + bg, li = acc[m][4 + n] + bl; float o[4];
#pragma unroll
                for (int q = 0; q < 4; ++q) { const float gl = fminf(g[q], 7.0f), ln = fminf(fmaxf(li[q], -7.0f), 7.0f);
                    o[q] = gl * (ln + 1.0f) * __builtin_amdgcn_rcpf(1.0f + __builtin_amdgcn_exp2f(-2.4554669595930156f * gl)); }
                *(unsigned*)(ACT8 + (size_t)(row0 + 16 * m) * D + c0 + 16 * n) = pk4_fp8(o[0], o[1], o[2], o[3]); } }
    }
};
struct EpiW2 {
    bf16* YP; const float* b2; const float* rowgate;
    __device__ __forceinline__ void operator()(const f32x4 (&acc)[4][8], const pg8::Unit& u, int wr, int wc, int fr, int fq) const {
        asm volatile("" : "+v"(fr), "+v"(fq));
        const int e = u.pn >> 2, row0 = u.pm * 256 + wr * 64 + fr, c0 = (u.pn & 3) * 256 + wc * 128 + 4 * fq;
        float gt[4];
#pragma unroll
        for (int m = 0; m < 4; ++m) gt[m] = rowgate[row0 + 16 * m];
#pragma unroll
        for (int n = 0; n < 8; ++n) { const f32x4 bv = *(const f32x4*)(b2 + (size_t)e * 1024 + c0 + 16 * n);
#pragma unroll
            for (int m = 0; m < 4; ++m) { const f32x4 v = (acc[m][n] + bv) * gt[m];
                *(u32x2*)(YP + (size_t)(row0 + 16 * m) * D + c0 + 16 * n) = (u32x2){pg8::cvt_pk_bf16(v[0], v[1]), pg8::cvt_pk_bf16(v[2], v[3])}; } }
    }
};
typedef __bf16 bf16x2_nt __attribute__((ext_vector_type(2)));
__device__ __forceinline__ unsigned cvtpk_c(float lo, float hi) { f32x2 v = {lo, hi}; bf16x2_nt b = __builtin_convertvector(v, bf16x2_nt); return __builtin_bit_cast(unsigned, b); }
struct EpiP1 {
    static constexpr bool PERM = true, AFTER_DRAIN = false, BIAS_INIT = true;
    unsigned char* ACT8; const float* b1;
    static constexpr int NSTORE = 16;
    __device__ __forceinline__ const float* bias_src(const pg8::Unit& u, int q) const { return b1 + (size_t)(u.pn >> 3) * 2048 + (q >> 5) * 1024 + (u.pn & 7) * 128 + 4 * (q & 31); }
    __device__ __forceinline__ void load_bias(f32x4 (&nb)[4], const PG8_LAS float* sl, int wc, int fq) const {
        const PG8_LAS float* bp = sl + 16 * wc + 4 * fq;
        nb[0] = *(const PG8_LAS f32x4*)bp; nb[1] = *(const PG8_LAS f32x4*)(bp + 128); nb[2] = *(const PG8_LAS f32x4*)(bp + 64); nb[3] = *(const PG8_LAS f32x4*)(bp + 128 + 64);
    }
    __device__ __forceinline__ void set_bias(f32x4 (&acc)[2][2][4][2], const f32x4 (&nb)[4]) const {
#pragma unroll
        for (int bj = 0; bj < 2; ++bj)
#pragma unroll
            for (int ai = 0; ai < 2; ++ai)
#pragma unroll
                for (int m = 0; m < 4; ++m) { acc[ai][bj][m][0] = nb[2 * bj]; acc[ai][bj][m][1] = nb[2 * bj + 1]; }
    }
    __device__ __forceinline__ void operator()(const f32x4 (&acc)[2][2][4][2], const pg8::Unit& u, int wr, int wc, int fr, int fq) const {
        asm volatile("" : "+v"(fr), "+v"(fq));
        const int j = u.pn & 7, row0 = u.pm * 256 + wr * 64 + fr, c0 = j * 128 + 16 * wc + 4 * fq;
#pragma unroll
        for (int ai = 0; ai < 2; ++ai)
#pragma unroll
            for (int m = 0; m < 4; ++m) { const int row = row0 + ai * 128 + m * 16;
#pragma unroll
                for (int bj = 0; bj < 2; ++bj) { const f32x4 g = acc[ai][bj][m][0], li = acc[ai][bj][m][1]; float o[4];
#pragma unroll
                    for (int q = 0; q < 4; ++q) { const float gl = fminf(g[q], 7.0f), ln = fminf(fmaxf(li[q], -7.0f), 7.0f);
                        o[q] = gl * (ln + 1.0f) * __builtin_amdgcn_rcpf(1.0f + __builtin_amdgcn_exp2f(-2.4554669595930156f * gl)); }
                    *(unsigned*)(ACT8 + (size_t)row * D + c0 + bj * 64) = pk4_fp8(o[0], o[1], o[2], o[3]); } }
    }
};
struct EpiP2 {
    static constexpr bool PERM = true, AFTER_DRAIN = false, BIAS_INIT = true;
    bf16* YP; const float* b2; int skip = 0;
    static constexpr int NSTORE = 16;
    __device__ __forceinline__ const float* bias_src(const pg8::Unit& u, int q) const { return b2 + (size_t)(u.pn >> 2) * 1024 + (u.pn & 3) * 256 + 4 * q; }
    __device__ __forceinline__ void load_bias(f32x4 (&nb)[4], const PG8_LAS float* sl, int wc, int fq) const {
        const PG8_LAS float* bp = sl + 32 * wc + 8 * fq;
        nb[0] = *(const PG8_LAS f32x4*)bp; nb[1] = *(const PG8_LAS f32x4*)(bp + 4); nb[2] = *(const PG8_LAS f32x4*)(bp + 128); nb[3] = *(const PG8_LAS f32x4*)(bp + 128 + 4);
    }
    __device__ __forceinline__ void set_bias(f32x4 (&acc)[2][2][4][2], const f32x4 (&nb)[4]) const {
#pragma unroll
        for (int bj = 0; bj < 2; ++bj)
#pragma unroll
            for (int ai = 0; ai < 2; ++ai)
#pragma unroll
                for (int m = 0; m < 4; ++m) { acc[ai][bj][m][0] = nb[2 * bj]; acc[ai][bj][m][1] = nb[2 * bj + 1]; }
    }
    __device__ __forceinline__ void operator()(const f32x4 (&acc)[2][2][4][2], const pg8::Unit& u, int wr, int wc, int fr, int fq) const {
        if (DUP_MASK != 0 && skip == 1) return;
        asm volatile("" : "+v"(fr), "+v"(fq));
        const int row0 = u.pm * 256 + wr * 64 + fr, c0 = (u.pn & 3) * 256 + 32 * wc + 8 * fq;
#pragma unroll
        for (int ai = 0; ai < 2; ++ai)
#pragma unroll
            for (int m = 0; m < 4; ++m) { const int row = row0 + ai * 128 + m * 16;
#pragma unroll
                for (int bj = 0; bj < 2; ++bj) { const f32x4 v0 = acc[ai][bj][m][0], v1 = acc[ai][bj][m][1];
                    *(u32x2*)((unsigned char*)YP + (size_t)row * D + c0 + bj * 128) = (u32x2){pk4_fp8(16.f * v0[0], 16.f * v0[1], 16.f * v0[2], 16.f * v0[3]), pk4_fp8(16.f * v1[0], 16.f * v1[1], 16.f * v1[2], 16.f * v1[3])}; } }
    }
};
struct EpiF8Moe1 {
    unsigned char* ACT8; const float* b1;
    __device__ __forceinline__ void operator()(const f32x4 (&acc)[4][4], const pg8::Unit& u, int wr, int wc, int fr, int fq) const {
        asm volatile("" : "+v"(fr), "+v"(fq));
        const int e = u.pn >> 4, j = u.pn & 15, row0 = u.pm * 256 + wr * 64 + fr, c0 = j * 64 + wc * 32 + 4 * fq;
        f32x4 bg[2], bl[2];
#pragma unroll
        for (int n = 0; n < 2; ++n) { bg[n] = *(const f32x4*)(b1 + (size_t)e * 2048 + c0 + 16 * n); bl[n] = *(const f32x4*)(b1 + (size_t)e * 2048 + 1024 + c0 + 16 * n); }
#pragma unroll
        for (int m = 0; m < 4; ++m)
#pragma unroll
            for (int n = 0; n < 2; ++n) { const f32x4 g = acc[m][n] + bg[n], li = acc[m][2 + n] + bl[n]; float o[4];
#pragma unroll
                for (int q = 0; q < 4; ++q) { const float gl = fminf(g[q], 7.0f), ln = fminf(fmaxf(li[q], -7.0f), 7.0f);
                    o[q] = gl * (ln + 1.0f) * __builtin_amdgcn_rcpf(1.0f + __builtin_amdgcn_exp2f(-2.4554669595930156f * gl)); }
                *(unsigned*)(ACT8 + (size_t)(row0 + 16 * m) * D + c0 + 16 * n) = pk4_fp8(o[0], o[1], o[2], o[3]); }
    }
};
struct EpiF8Moe2 {
    bf16* YP; const float* b2; const float* rowgate;
    __device__ __forceinline__ void operator()(const f32x4 (&acc)[4][4], const pg8::Unit& u, int wr, int wc, int fr, int fq) const {
        asm volatile("" : "+v"(fr), "+v"(fq));
        const int e = u.pn >> 3, row0 = u.pm * 256 + wr * 64 + fr, c0 = (u.pn & 7) * 128 + wc * 64 + 4 * fq;
        f32x4 bv[4];
#pragma unroll
        for (int n = 0; n < 4; ++n) bv[n] = *(const f32x4*)(b2 + (size_t)e * 1024 + c0 + 16 * n);
#pragma unroll
        for (int m = 0; m < 4; ++m) { const int row = row0 + 16 * m; const float g = rowgate[row];
#pragma unroll
            for (int n = 0; n < 4; ++n) { const f32x4 v = (acc[m][n] + bv[n]) * g;
                *(u32x2*)(YP + (size_t)row * D + c0 + 16 * n) = (u32x2){pg8::cvt_pk_bf16(v[0], v[1]), pg8::cvt_pk_bf16(v[2], v[3])}; } }
    }
};
namespace att {
typedef short s16x4 __attribute__((ext_vector_type(4)));
typedef float f32x16 __attribute__((ext_vector_type(16)));
constexpr int DH = 128, NW = 8, QBLK = 32, KVBLK = 64, QB = NW * QBLK;
constexpr int SHM_V = KVBLK * DH * 2, SHM_K = KVBLK * DH * 2;
constexpr int BODY_LDS = 2 * SHM_V + 2 * SHM_K + NW * 64 * 4;
constexpr int LDS_KB = BODY_LDS;
constexpr int LDS_BM = LDS_KB + 8192;
constexpr int LDS_SCAN = LDS_BM + 16384;
constexpr int LDS_GN = LDS_SCAN + 256;
constexpr float THR = 8.f;
#define KSWZ(row, colB) ((row) * 256 + ((colB) ^ (((row) & 7) << 4)))
#define SBAR() __builtin_amdgcn_sched_barrier(0)
__device__ __forceinline__ int v_st(int k, int c) { const int kk = (k & ~0xC) | ((k & 4) << 1) | ((k & 8) >> 1); return ((kk >> 3) * 4 + (c >> 5)) * 512 + ((kk & 7) * 32 + (c & 31)) * 2; }
__device__ __forceinline__ int v_rd_base(int lane) { return ((lane & 3) << 3) | (((lane >> 2) & 3) << 6) | (((lane >> 4) & 1) << 5) | (((lane >> 5) & 1) << 8); }
constexpr int v_rd_off(int d0, int ks, int half) { return d0 * 512 + ks * 4096 + half * 2048; }
__device__ __forceinline__ int crow(int r, int hi) { return (r & 3) + 8 * (r >> 2) + 4 * hi; }
__device__ __forceinline__ unsigned cvtpk(float lo, float hi) { unsigned r; asm volatile("v_cvt_pk_bf16_f32 %0, %1, %2" : "=v"(r) : "v"(lo), "v"(hi)); return r; }
__device__ __forceinline__ bf16x8 load8(const bf16* p) { return *reinterpret_cast<const bf16x8*>(p); }
__device__ __forceinline__ void mask_tile(f32x16& p0, f32x16& p1, int dq, unsigned W) {
    const float NEG = -__builtin_inff();
#pragma unroll
    for (int r = 0; r < 16; ++r) { const int c = (r & 3) + 8 * (r >> 2);
        if ((unsigned)(dq - c) >= W) p0[r] = NEG;
        if ((unsigned)(dq - c - 32) >= W) p1[r] = NEG; }
}
template <int MODE> __device__ __forceinline__ void partialSM(f32x16& p0, f32x16& p1, float& m_reg, float& mn, float& alpha) {
    constexpr float SCALE = MODE == 0 ? 0.08838834764831845f : 1.0f;
    float pmax = p0[0]; for (int r = 1; r < 16; ++r) pmax = fmaxf(pmax, p0[r]); for (int r = 0; r < 16; ++r) pmax = fmaxf(pmax, p1[r]);
    { auto rr = __builtin_amdgcn_permlane32_swap(__float_as_uint(pmax), __float_as_uint(pmax), false, false);
      pmax = fmaxf(__uint_as_float(rr[0]), __uint_as_float(rr[1])); }
    constexpr float C2 = 1.4426950408889634f * SCALE;
    if (__builtin_expect(__all((pmax - m_reg) * SCALE <= THR), 1)) { mn = m_reg; alpha = 1.f; }
    else { mn = fmaxf(m_reg, pmax); alpha = __builtin_amdgcn_exp2f((m_reg - mn) * C2); m_reg = mn; }
    const float mnL = -mn * C2;
    for (int r = 0; r < 16; ++r) p0[r] = fmaf(p0[r], C2, mnL); for (int r = 0; r < 16; ++r) p1[r] = fmaf(p1[r], C2, mnL);
    for (int r = 0; r < 16; ++r) p0[r] = __builtin_amdgcn_exp2f(p0[r]);
}
__device__ __forceinline__ void finishSM(f32x16& p0, f32x16& p1, float alpha, float& l_reg, bf16x8& pa0, bf16x8& pa1, bf16x8& pa2, bf16x8& pa3) {
    for (int r = 0; r < 16; ++r) p1[r] = __builtin_amdgcn_exp2f(p1[r]);
    float ps = 0; for (int r = 0; r < 16; ++r) ps += p0[r]; for (int r = 0; r < 16; ++r) ps += p1[r];
    { auto rr = __builtin_amdgcn_permlane32_swap(__float_as_uint(ps), __float_as_uint(ps), false, false);
      ps = __uint_as_float(rr[0]) + __uint_as_float(rr[1]); }
    l_reg = l_reg * alpha + ps;
#define PK4(P, B_, OUT) do { unsigned a0 = cvtpk(P[B_+0], P[B_+1]), a1 = cvtpk(P[B_+2], P[B_+3]);                          \
        unsigned b0 = cvtpk(P[B_+4], P[B_+5]), b1 = cvtpk(P[B_+6], P[B_+7]);                                             \
        auto r0 = __builtin_amdgcn_permlane32_swap(a0, b0, false, false); auto r1 = __builtin_amdgcn_permlane32_swap(a1, b1, false, false); \
        u32x4 w = {r0[0], r1[0], r0[1], r1[1]}; OUT = *reinterpret_cast<bf16x8*>(&w); } while (0)
    PK4(p0, 0, pa0); PK4(p0, 8, pa1); PK4(p1, 0, pa2); PK4(p1, 8, pa3);
}
template <int MODE> __device__ __forceinline__ void cinit(f32x16& p0, f32x16& p1, const char* lds, int kbase, int hi, int tq, int t) {
    if constexpr (MODE == 0) {
        const float* kb = (const float*)(lds + LDS_KB) + kbase + 4 * hi;
#pragma unroll
        for (int g = 0; g < 4; ++g) { const f32x4 a = *(const f32x4*)(kb + 8 * g), b = *(const f32x4*)(kb + 32 + 8 * g);
            p0[4 * g] = a[0]; p0[4 * g + 1] = a[1]; p0[4 * g + 2] = a[2]; p0[4 * g + 3] = a[3]; p1[4 * g] = b[0]; p1[4 * g + 1] = b[1]; p1[4 * g + 2] = b[2]; p1[4 * g + 3] = b[3]; }
    } else {
        const u32x2 w = *(const u32x2*)((const unsigned*)(lds + LDS_BM) + tq * 64 + 2 * t);
        const unsigned lo = w.x >> (4 * hi), hh = w.y >> (4 * hi);
        const float NEG = -__builtin_inff();
#pragma unroll
        for (int r = 0; r < 16; ++r) { const int c = (r & 3) + 8 * (r >> 2); p0[r] = ((lo >> c) & 1u) ? 0.f : NEG; p1[r] = ((hh >> c) & 1u) ? 0.f : NEG; }
    }
}
template <int KB>
__device__ __forceinline__ void qkt(f32x16& p0, f32x16& p1, const char* K_lds, int r32, int hi, const bf16x8* qr) {
    const char* kb[4];
#pragma unroll
    for (int dd = 0; dd < 4; ++dd) kb[dd] = K_lds + KB * SHM_K + KSWZ(r32, (dd * 16 + hi * 8) * 2);
#pragma unroll
    for (int d0 = 0; d0 < 8; ++d0) { const char* a = kb[d0 & 3] + (d0 >> 2) * 128;
        bf16x8 b0 = *reinterpret_cast<const bf16x8*>(a);
        bf16x8 b1 = *reinterpret_cast<const bf16x8*>(a + 32 * 256);
        p0 = __builtin_amdgcn_mfma_f32_32x32x16_bf16(b0, qr[d0], p0, 0, 0, 0);
        p1 = __builtin_amdgcn_mfma_f32_32x32x16_bf16(b1, qr[d0], p1, 0, 0, 0); }
}
template <int VB>
__device__ __forceinline__ void pv_tile(f32x16* o, int vb0, bf16x8 pa0, bf16x8 pa1, bf16x8 pa2, bf16x8 pa3) {
#define TRRD(dst, off) asm volatile("ds_read_b64_tr_b16 %0, %1 offset:%2" : "=&v"(dst) : "v"(vb0), "i"(off) : "memory")
#define PV_D0(d0) do { s16x4 l0, l1, l2, l3, h0, h1, h2, h3; constexpr int b_ = VB * SHM_V + v_rd_off(d0, 0, 0); \
        TRRD(l0, b_); TRRD(h0, b_ + 2048); TRRD(l1, b_ + 4096); TRRD(h1, b_ + 6144); TRRD(l2, b_ + 8192); TRRD(h2, b_ + 10240); TRRD(l3, b_ + 12288); TRRD(h3, b_ + 14336); \
        asm volatile("s_waitcnt lgkmcnt(0)" ::: "memory"); SBAR();   \
        o[d0] = __builtin_amdgcn_mfma_f32_32x32x16_bf16(pa0, (bf16x8){l0[0], l0[1], l0[2], l0[3], h0[0], h0[1], h0[2], h0[3]}, o[d0], 0, 0, 0);   \
        o[d0] = __builtin_amdgcn_mfma_f32_32x32x16_bf16(pa1, (bf16x8){l1[0], l1[1], l1[2], l1[3], h1[0], h1[1], h1[2], h1[3]}, o[d0], 0, 0, 0);   \
        o[d0] = __builtin_amdgcn_mfma_f32_32x32x16_bf16(pa2, (bf16x8){l2[0], l2[1], l2[2], l2[3], h2[0], h2[1], h2[2], h2[3]}, o[d0], 0, 0, 0);   \
        o[d0] = __builtin_amdgcn_mfma_f32_32x32x16_bf16(pa3, (bf16x8){l3[0], l3[1], l3[2], l3[3], h3[0], h3[1], h3[2], h3[3]}, o[d0], 0, 0, 0); } while (0)
    PV_D0(0); PV_D0(1); PV_D0(2); PV_D0(3);
#undef PV_D0
}
struct BlockRef { const bf16* Q; const bf16* K; const bf16* V; bf16* O; int ldo; int P0; int NT; const float* g; };
struct Seam { bf16x8 qr[8]; bf16x8 st_v0, st_v1, st_k0, st_k1; };
__device__ __forceinline__ bf16x8 nrm8(bf16x8 x, const float* gl) {
    const f32x4 g0 = *(const f32x4*)gl, g1 = *(const f32x4*)(gl + 4);
    float f[8]; float ss = 0.f;
#pragma unroll
    for (int i = 0; i < 8; ++i) { f[i] = bf2f((unsigned short)x[i]); ss += f[i] * f[i]; }
    ss += __builtin_bit_cast(float, __builtin_amdgcn_update_dpp(0, __builtin_bit_cast(int, ss), 0x128, 0xf, 0xf, false));
    ss += __builtin_bit_cast(float, __builtin_amdgcn_update_dpp(0, __builtin_bit_cast(int, ss), 0x124, 0xf, 0xf, false));
    ss += __builtin_bit_cast(float, __builtin_amdgcn_update_dpp(0, __builtin_bit_cast(int, ss), 0x122, 0xf, 0xf, false));
    ss += __builtin_bit_cast(float, __builtin_amdgcn_update_dpp(0, __builtin_bit_cast(int, ss), 0x121, 0xf, 0xf, false));
    const float r = __builtin_amdgcn_rsqf(ss * (1.0f / 128.0f) + EPS);
    u32x4 w = {cvtpk(f[0] * r * g0[0], f[1] * r * g0[1]), cvtpk(f[2] * r * g0[2], f[3] * r * g0[3]), cvtpk(f[4] * r * g1[0], f[5] * r * g1[1]), cvtpk(f[6] * r * g1[2], f[7] * r * g1[3])};
    return *reinterpret_cast<bf16x8*>(&w);
}
#define ROW(p, k0, rr) ((p) + (size_t)((k0) + (rr)) * DH + sc)
#define VMW() asm volatile("s_waitcnt vmcnt(0)" ::: "memory")
#define VMWN(n) asm volatile("s_waitcnt vmcnt(%0)" :: "i"(n) : "memory")
#define STG_IDS() int tid_s = tid; asm volatile("" : "+v"(tid_s)); const int sr = tid_s >> 4, sc = (tid_s & 15) * 8
#define SLOAD_H(Kp, Vp, k0) do { STG_IDS(); if constexpr (MODE == 0) { S.st_v0 = load8(ROW(Vp, k0, sr)); S.st_v1 = load8(ROW(Vp, k0, 32 + sr)); }             \
                         S.st_k0 = load8(ROW(Kp, k0, sr)); S.st_k1 = load8(ROW(Kp, k0, 32 + sr)); } while (0)
#define NORMKV() do { if constexpr (MODE == 1) { S.st_v0 = S.st_k0; S.st_v1 = S.st_k1; } } while (0)
#define SWRITE_HK(bf) do { STG_IDS(); const int kws = KSWZ(sr, sc * 2); *(bf16x8*)(K_lds + (bf) * SHM_K + kws) = S.st_k0; *(bf16x8*)(K_lds + (bf) * SHM_K + kws + 32 * 256) = S.st_k1; } while (0)
#define SWRITE_HV(bf) do { STG_IDS(); const int vst0 = v_st(sr, sc), vst1 = v_st(32 + sr, sc); *(bf16x8*)(V_lds + (bf) * SHM_V + vst0) = S.st_v0; *(bf16x8*)(V_lds + (bf) * SHM_V + vst1) = S.st_v1; } while (0)
#define SWRITE_H(bf) do { SWRITE_HV(bf); SWRITE_HK(bf); } while (0)
template <int MODE>
__device__ __forceinline__ void prime(const BlockRef& cur, char* lds, Seam& S, const int tid) {
    const int wid = __builtin_amdgcn_readfirstlane(tid >> 6), lane = tid & 63, r32 = lane & 31, hi = lane >> 5;
    char* K_lds = lds + 2 * SHM_V;
    for (int d0 = 0; d0 < 8; ++d0) S.qr[d0] = load8(cur.Q + (size_t)(wid * QBLK + r32) * DH + d0 * 16 + hi * 8);
    SLOAD_H(cur.K, cur.V, 0); VMW(); NORMKV(); SWRITE_HK(0);
    __syncthreads();
}
template <int MODE>
__device__ __forceinline__ void block(const BlockRef& cur, const BlockRef& nxt, char* lds, Seam& S, const int tid) {
    const int wid = __builtin_amdgcn_readfirstlane(tid >> 6), lane = tid & 63, r32 = lane & 31, hi = lane >> 5;
    const int NT = cur.NT;
    const int qlo = cur.P0 + wid * QBLK, qm = qlo + r32 - 4 * hi;
    const int tq = wid * 8 + (r32 >> 2);
    constexpr unsigned W = 1u << 30;
    char* V_lds = lds; char* K_lds = lds + 2 * SHM_V;
    float* ws = (float*)(lds + 2 * SHM_V + 2 * SHM_K) + wid * 64; float* li_l = ws, * al_l = ws + 32;
    float m_reg = -1e30f, l_reg = 0; f32x16 o[4]; { const f32x16 z16 = ozero16(); o[0] = z16; o[1] = z16; o[2] = z16; o[3] = z16; }
    const int vb0 = (int)(uintptr_t)V_lds + v_rd_base(lane);
    const bf16* Kh = cur.K; const bf16* Vh = cur.V;
#define RESC(a) do { if (__any((a) < 1.f)) { if (hi == 0) al_l[r32] = (a); asm volatile("s_waitcnt lgkmcnt(0)" ::: "memory");              \
                     for (int d_ = 0; d_ < 4; ++d_) for (int r = 0; r < 16; ++r) o[d_][r] *= al_l[crow(r, hi)]; } } while (0)
#define KBASE(t) ((t) * KVBLK)
#define MASKT(P0_, P1_, t) do { if constexpr (MODE == 0) { const int kb_ = KBASE(t); if (kb_ + KVBLK - 1 > qlo) mask_tile(P0_, P1_, qm - kb_, W); } } while (0)
    constexpr int NQL = 8;
#define SEAM_K0() do { VMWN(NQL); NORMKV(); SWRITE_HK(0); SBAR(); } while (0)
    f32x16 pA0, pA1, pB0, pB1; float mnA, mnB, alA, alB; bf16x8 pa0, pa1, pa2, pa3;
    SWRITE_HV(0); SBAR();
    if (NT > 1) { SLOAD_H(Kh, Vh, KBASE(1)); }
    SBAR(); cinit<MODE>(pA0, pA1, lds, KBASE(0), hi, tq, 0); qkt<0>(pA0, pA1, K_lds, r32, hi, S.qr);
    MASKT(pA0, pA1, 0); partialSM<MODE>(pA0, pA1, m_reg, mnA, alA);
    if (NT > 1) { VMW(); NORMKV(); SWRITE_H(1); }
    __syncthreads();
#define HALF_STEP(PX0, PX1, mnX, alX, PY0, PY1, alY, t, KB, VB, SB) do {                                                      \
        SBAR(); cinit<MODE>(PX0, PX1, lds, KBASE(t), hi, tq, (t)); qkt<KB>(PX0, PX1, K_lds, r32, hi, S.qr);                     \
        finishSM(PY0, PY1, alY, l_reg, pa0, pa1, pa2, pa3); SBAR();                                                           \
        if ((t) + 1 < NT) { SLOAD_H(Kh, Vh, KBASE((t) + 1)); SBAR(); }                                                        \
        pv_tile<VB>(o, vb0, pa0, pa1, pa2, pa3); MASKT(PX0, PX1, (t)); partialSM<MODE>(PX0, PX1, m_reg, mnX, alX);             \
        __syncthreads();                                                                                                      \
        if ((t) + 1 < NT) { VMW(); NORMKV(); SWRITE_H(SB); }                                                                  \
        RESC(alX); __syncthreads(); } while (0)
    for (int t = 1; t + 1 < NT; t += 2) {
        HALF_STEP(pB0, pB1, mnB, alB, pA0, pA1, alA, t, 1, 0, 0);
        HALF_STEP(pA0, pA1, mnA, alA, pB0, pB1, alB, t + 1, 0, 1, 1);
    }
    const bool even = (NT & 1) == 0;
    if (even) { SBAR(); cinit<MODE>(pB0, pB1, lds, KBASE(NT - 1), hi, tq, NT - 1); qkt<1>(pB0, pB1, K_lds, r32, hi, S.qr); SBAR(); }
    SBAR();
    finishSM(pA0, pA1, alA, l_reg, pa0, pa1, pa2, pa3); SBAR();
    pv_tile<0>(o, vb0, pa0, pa1, pa2, pa3);
    if (even) { MASKT(pB0, pB1, NT - 1); partialSM<MODE>(pB0, pB1, m_reg, mnB, alB); __syncthreads(); RESC(alB);
        finishSM(pB0, pB1, alB, l_reg, pa0, pa1, pa2, pa3); SBAR(); pv_tile<1>(o, vb0, pa0, pa1, pa2, pa3); }
    SBAR();
    if (hi == 0) li_l[r32] = l_reg; asm volatile("s_waitcnt lgkmcnt(0)" ::: "memory");
    float rli[16];
#pragma unroll
    for (int r = 0; r < 16; ++r) rli[r] = __builtin_amdgcn_rcpf(li_l[crow(r, hi)]);
    constexpr int LDO = MODE == 0 ? 512 : 128;
    bf16* Ow = cur.O + (size_t)(wid * QBLK) * LDO;
#pragma unroll
    for (int r = 0; r < 16; ++r) { const int orow = crow(r, hi);
#pragma unroll
        for (int d0 = 0; d0 < 4; ++d0) { const float v = o[d0][r] * rli[r];
            const float vn = qxor1(v);
            if ((r32 & 1) == 0) *(unsigned*)(Ow + (size_t)orow * LDO + d0 * 32 + r32) = cvtpk(v, vn); } }
    __syncthreads();
#undef RESC
#undef KBASE
#undef MASKT
#undef SEAM_K0
#undef HALF_STEP
}
#undef ROW
#undef VMWN
#undef SLOAD_H
#undef STG_IDS
#undef NORMKV
#undef SWRITE_HK
#undef SWRITE_HV
#undef SWRITE_H
#undef PK4
#undef TRRD
}

constexpr size_t WS_MLQK = 848 * MiB, WS_MLV = 864 * MiB, WS_MLO = 880 * MiB, WS_QABS = 896 * MiB, WS_CKV = 912 * MiB, WS_IK = 916 * MiB, WS_SCAL = 918 * MiB, WS_IQ = 920 * MiB;
constexpr size_t WS_FXQ = 928 * MiB, WS_FXK = 944 * MiB, WS_FXV = 960 * MiB, WS_GATES = 976 * MiB, WS_YCAT = 1072 * MiB, WS_MERGED = 1120 * MiB;
constexpr size_t WS_CLOC = 1152 * MiB, WS_CPREV = 1184 * MiB, WS_MLST = 1200 * MiB, WS_SCORE = 1208 * MiB, WS_XN1_8 = 1352 * MiB  , WS_WIN8 = 1368 * MiB  , WS_MERGED8 = 1384 * MiB  , WS_WOUT8 = 1400 * MiB  , WS_CKVN = 1402 * MiB  , WS_END2 = 1406 * MiB;
constexpr int CW_Q = 512;

struct EpiInProj {
    static constexpr bool PERM = true, AFTER_DRAIN = false;
    const float* bias; unsigned char* ws;
    __device__ __forceinline__ void operator()(const f32x4 (&acc)[2][2][4][2], const pg8::Unit& u, int wr, int wc, int fr, int fq) const {
        asm volatile("" : "+v"(fr), "+v"(fq));
        const int pn = u.pn, row0 = u.pm * 256 + wr * 64 + fr, b = u.pm >> 3;
#pragma unroll
        for (int bj = 0; bj < 2; ++bj) {
            const int c8 = 128 * bj + 32 * wc + 8 * fq;
            bf16* base = nullptr; int pitch = 0; float* fbase = nullptr;
            if (pn < 2) { base = (bf16*)(ws + WS_MLQK) + pn * 256 + c8; pitch = 512; }
            else if (pn < 4) { base = (bf16*)(ws + WS_MLV) + (pn - 2) * 256 + c8; pitch = 512; }
            else if (pn < 6) { base = (bf16*)(ws + WS_MLO) + (pn - 4) * 256 + c8; pitch = 512; }
            else if (pn < 8) { base = (bf16*)(ws + WS_QABS) + (pn - 6) * 256 + c8; pitch = 512; }
            else if (pn == 8) { if (c8 < 128) { base = (bf16*)(ws + WS_CKV) + c8; pitch = 128; } else if (c8 < 192) { base = (bf16*)(ws + WS_IK) + (c8 - 128); pitch = 64; }
                                else if (c8 < 208) { fbase = (float*)(ws + WS_SCAL) + (c8 - 192); } }
            else if (pn == 9) { base = (bf16*)(ws + WS_IQ) + c8; pitch = 256; }
            else if (pn < 16) { const int t = (pn - 10) >> 1, hh = ((pn - 10) & 1) * 2 + bj;
                base = (bf16*)(ws + WS_FXQ + (size_t)t * (WS_FXK - WS_FXQ)) + (size_t)(b * 3 + hh) * 2048 * 128 + 32 * wc + 8 * fq; pitch = 128; }
            else { base = (bf16*)(ws + WS_GATES) + (pn - 16) * 256 + c8; pitch = 3072; }
            const f32x4 bv0 = *(const f32x4*)(bias + pn * 256 + c8), bv1 = *(const f32x4*)(bias + pn * 256 + c8 + 4);
            if (base) {
#pragma unroll
                for (int ai = 0; ai < 2; ++ai)
#pragma unroll
                    for (int m = 0; m < 4; ++m) { const int row = row0 + ai * 128 + m * 16; const f32x4 v0 = acc[ai][bj][m][0] + bv0, v1 = acc[ai][bj][m][1] + bv1;
                        *(u32x4*)(base + (size_t)row * pitch) = (u32x4){pg8::cvt_pk_bf16(v0[0], v0[1]), pg8::cvt_pk_bf16(v0[2], v0[3]), pg8::cvt_pk_bf16(v1[0], v1[1]), pg8::cvt_pk_bf16(v1[2], v1[3])}; }
            } else if (fbase) {
#pragma unroll
                for (int ai = 0; ai < 2; ++ai)
#pragma unroll
                    for (int m = 0; m < 4; ++m) { const int row = row0 + ai * 128 + m * 16; *(f32x4*)(fbase + (size_t)row * 16) = acc[ai][bj][m][0] + bv0; *(f32x4*)(fbase + (size_t)row * 16 + 4) = acc[ai][bj][m][1] + bv1; }
            }
        }
    }
};
struct InProjSched {
    pg8::StaticOrder so; int f8;
    __device__ __forceinline__ bool next(int i, pg8::Unit& u) const { if (!so.next(i, u)) return false; u.pn = f8 ? (u.pn < 6 ? u.pn : u.pn + 4) : u.pn + 6; return true; }
    __device__ __forceinline__ void a_ready(const pg8::Unit&) const {}
    __device__ __forceinline__ void done(const pg8::Unit&) const {}
};
struct EpiInProj8 {
    static constexpr bool PERM = true, AFTER_DRAIN = false, BIAS_INIT = true;
    static constexpr int NSTORE = 16;
    const float* bias; unsigned char* ws;
    __device__ __forceinline__ const float* bias_src(const pg8::Unit& u, int q) const { return bias + u.pn * 256 + 4 * q; }
    __device__ __forceinline__ void load_bias(f32x4 (&nb)[4], const PG8_LAS float* sl, int wc, int fq) const {
        const PG8_LAS float* bp = sl + 32 * wc + 8 * fq;
        nb[0] = *(const PG8_LAS f32x4*)bp; nb[1] = *(const PG8_LAS f32x4*)(bp + 4); nb[2] = *(const PG8_LAS f32x4*)(bp + 128); nb[3] = *(const PG8_LAS f32x4*)(bp + 128 + 4);
    }
    __device__ __forceinline__ void set_bias(f32x4 (&acc)[2][2][4][2], const f32x4 (&nb)[4]) const {
#pragma unroll
        for (int bj = 0; bj < 2; ++bj)
#pragma unroll
            for (int ai = 0; ai < 2; ++ai)
#pragma unroll
                for (int m = 0; m < 4; ++m) { acc[ai][bj][m][0] = nb[2 * bj]; acc[ai][bj][m][1] = nb[2 * bj + 1]; }
    }
    __device__ __forceinline__ void operator()(const f32x4 (&acc)[2][2][4][2], const pg8::Unit& u, int wr, int wc, int fr, int fq) const {
        asm volatile("" : "+v"(fr), "+v"(fq));
        const int pn = u.pn, row0 = u.pm * 256 + wr * 64 + fr, b = u.pm >> 3;
#pragma unroll
        for (int bj = 0; bj < 2; ++bj) {
            const int c8 = 128 * bj + 32 * wc + 8 * fq;
            bf16* base; int pitch;
            if (pn < 2) { base = (bf16*)(ws + WS_MLQK) + pn * 256 + c8; pitch = 512; }
            else if (pn < 4) { base = (bf16*)(ws + WS_MLV) + (pn - 2) * 256 + c8; pitch = 512; }
            else if (pn < 6) { base = (bf16*)(ws + WS_MLO) + (pn - 4) * 256 + c8; pitch = 512; }
            else if (pn < 16) { const int t = (pn - 10) >> 1, hh = ((pn - 10) & 1) * 2 + bj;
                base = (bf16*)(ws + WS_FXQ + (size_t)t * (WS_FXK - WS_FXQ)) + (size_t)(b * 3 + hh) * 2048 * 128 + 32 * wc + 8 * fq; pitch = 128; }
            else { base = (bf16*)(ws + WS_GATES) + (pn - 16) * 256 + c8; pitch = 3072; }
#pragma unroll
            for (int ai = 0; ai < 2; ++ai)
#pragma unroll
                for (int m = 0; m < 4; ++m) { const int row = row0 + ai * 128 + m * 16; const f32x4 v0 = acc[ai][bj][m][0], v1 = acc[ai][bj][m][1];
                    *(u32x4*)(base + (size_t)row * pitch) = (u32x4){pg8::cvt_pk_bf16(v0[0], v0[1]), pg8::cvt_pk_bf16(v0[2], v0[3]), pg8::cvt_pk_bf16(v1[0], v1[1]), pg8::cvt_pk_bf16(v1[2], v1[3])}; }
        }
    }
};
struct BranchSched {
    int G, c, brpack, nbr;
    __device__ __forceinline__ bool next(int i, pg8::Unit& u) const {
        const int tile = (i / nbr) * G + c, br = (brpack >> (2 * (i % nbr))) & 3; if (tile >= 256) return false;
        u.pm = br * 64 + (tile >> 2); u.pn = br * 4 + (tile & 3); return true;
    }
    __device__ __forceinline__ void a_ready(const pg8::Unit&) const {}
    __device__ __forceinline__ void done(const pg8::Unit&) const {}
};
struct EpiBranch {
    static constexpr bool PERM = true, AFTER_DRAIN = false;
    const bf16* gates; bf16* merged; int br0; unsigned char* merged8;
    __device__ __forceinline__ void operator()(const f32x4 (&acc)[2][2][4][2], const pg8::Unit& u, int wr, int wc, int fr, int fq) const {
        asm volatile("" : "+v"(fr), "+v"(fq));
        const int br = u.pm >> 6, row0 = (u.pm & 63) * 256 + wr * 64 + fr, col0 = (u.pn & 3) * 256 + 32 * wc + 8 * fq;
        u32x4 gqn[2], oldn[2];
#pragma unroll
        for (int bj = 0; bj < 2; ++bj) { gqn[bj] = *(const u32x4*)(gates + (size_t)row0 * 3072 + br * 1024 + col0 + bj * 128);
            oldn[bj] = (br != br0) ? *(const u32x4*)(merged + (size_t)row0 * 1024 + col0 + bj * 128) : (u32x4){0u, 0u, 0u, 0u}; }
#pragma unroll
        for (int gi = 0; gi < 8; ++gi) { const int ai = gi >> 2, m = gi & 3, row = row0 + ai * 128 + m * 16;
            u32x4 gq[2], old[2];
#pragma unroll
            for (int bj = 0; bj < 2; ++bj) { gq[bj] = gqn[bj]; old[bj] = oldn[bj]; }
            if (gi < 7) { const int rown = row0 + ((gi + 1) >> 2) * 128 + ((gi + 1) & 3) * 16;
#pragma unroll
                for (int bj = 0; bj < 2; ++bj) { gqn[bj] = *(const u32x4*)(gates + (size_t)rown * 3072 + br * 1024 + col0 + bj * 128);
                    if (br != br0) oldn[bj] = *(const u32x4*)(merged + (size_t)rown * 1024 + col0 + bj * 128); } }
#pragma unroll
            for (int bj = 0; bj < 2; ++bj) { const int col = col0 + bj * 128;
                float v[8];
#pragma unroll
                for (int q = 0; q < 4; ++q) { const float g0 = bf2f(gq[bj][q] & 0xffffu), g1 = bf2f(gq[bj][q] >> 16);
                    v[2 * q] = acc[ai][bj][m][q >> 1][(2 * q) & 3] * __builtin_amdgcn_rcpf(1.0f + __builtin_amdgcn_exp2f(-1.4426950408889634f * g0));
                    v[2 * q + 1] = acc[ai][bj][m][q >> 1][(2 * q + 1) & 3] * __builtin_amdgcn_rcpf(1.0f + __builtin_amdgcn_exp2f(-1.4426950408889634f * g1)); }
                if (br != br0) {
#pragma unroll
                    for (int q = 0; q < 4; ++q) { v[2 * q] += bf2f(old[bj][q] & 0xffffu); v[2 * q + 1] += bf2f(old[bj][q] >> 16); } }
                if (br == 2) *(u32x2*)(merged8 + (size_t)row * 1024 + col) = (u32x2){pk4_fp8(v[0], v[1], v[2], v[3]), pk4_fp8(v[4], v[5], v[6], v[7])};
                else *(u32x4*)(merged + (size_t)row * 1024 + col) = (u32x4){pg8::cvt_pk_bf16(v[0], v[1]), pg8::cvt_pk_bf16(v[2], v[3]), pg8::cvt_pk_bf16(v[4], v[5]), pg8::cvt_pk_bf16(v[6], v[7])}; }
            asm volatile("" ::: "memory"); }
    }
};
struct EpiOutProj {
    static constexpr bool PERM = false, AFTER_DRAIN = false;
    const float* xsrc; float* X; const float* modl;
    __device__ __forceinline__ void operator()(const f32x4 (&acc)[2][2][4][2], const pg8::Unit& u, int wr, int wc, int fr, int fq) const {
        asm volatile("" : "+v"(fr), "+v"(fq));
        const int row0 = u.pm * 256 + wr * 64 + fr, col0 = u.pn * 256 + wc * 32 + 4 * fq; const float* g1 = modl + (size_t)(u.pm >> 3) * 6144 + 2048;
        f32x4 gv[2][2];
#pragma unroll
        for (int bj = 0; bj < 2; ++bj)
#pragma unroll
            for (int n = 0; n < 2; ++n) gv[bj][n] = *(const f32x4*)(g1 + col0 + bj * 128 + n * 16);
        f32x4 xn[2][2];
#pragma unroll
        for (int bj = 0; bj < 2; ++bj)
#pragma unroll
            for (int n = 0; n < 2; ++n) xn[bj][n] = *(const f32x4*)(xsrc + (size_t)row0 * 1024 + col0 + bj * 128 + n * 16);
#pragma unroll
        for (int gi = 0; gi < 8; ++gi) { const int ai = gi >> 2, m = gi & 3; const size_t off = (size_t)(row0 + ai * 128 + m * 16) * 1024 + col0;
            f32x4 xc[2][2];
#pragma unroll
            for (int bj = 0; bj < 2; ++bj)
#pragma unroll
                for (int n = 0; n < 2; ++n) xc[bj][n] = xn[bj][n];
            if (gi < 7) { const size_t offn = (size_t)(row0 + ((gi + 1) >> 2) * 128 + ((gi + 1) & 3) * 16) * 1024 + col0;
#pragma unroll
                for (int bj = 0; bj < 2; ++bj)
#pragma unroll
                    for (int n = 0; n < 2; ++n) xn[bj][n] = *(const f32x4*)(xsrc + offn + bj * 128 + n * 16); }
#pragma unroll
            for (int bj = 0; bj < 2; ++bj)
#pragma unroll
                for (int n = 0; n < 2; ++n) *(f32x4*)(X + off + bj * 128 + n * 16) = xc[bj][n] + gv[bj][n] * acc[ai][bj][m][n];
            asm volatile("" ::: "memory"); }
    }
};

__device__ __forceinline__ float logsigf(float f) { return fminf(f, 0.f) - __logf(1.0f + __expf(-fabsf(f))); }
__device__ __forceinline__ void fox_unit(Frame& F, int b, int h, int qb) {
    char* lds = (char*)F.lds; const int tid = F.tid, lane = (F.tid & 63), wid = F.wave;
    const int n = (qb + 1) * 256;
    {   const float* fsrc = WSP(float, WS_SCAL) + (size_t)b * 2048 * 16 + 12 + h;
        float ls[4], run = 0.f;
#pragma unroll
        for (int q = 0; q < 4; ++q) { const int s = 4 * tid + q; const float v = (s < n) ? logsigf(fsrc[(size_t)s * 16]) : 0.f; run += v; ls[q] = run; }
        float incl = run;
#pragma unroll
        for (int off = 1; off < 64; off <<= 1) { const float t = lshfl(incl, (lane - off) & 63); if (lane >= off) incl += t; }
        float* scan = (float*)(lds + att::LDS_SCAN);
        if (lane == 63) scan[wid] = incl;
        __syncthreads();
        float base = 0.f;
        for (int w2 = 0; w2 < wid; ++w2) base += scan[w2];
        const float excl = base + incl - run;
        *(f32x4*)((float*)(lds + att::LDS_KB) + 4 * tid) = (f32x4){-(excl + ls[0]) * 11.313708498984761f, -(excl + ls[1]) * 11.313708498984761f, -(excl + ls[2]) * 11.313708498984761f, -(excl + ls[3]) * 11.313708498984761f};
        __syncthreads();
    }
    const size_t hb = (size_t)(b * 4 + h) * 2048 * 128;
    att::BlockRef r{WSP(bf16, WS_FXQ) + hb + (size_t)qb * 256 * 128, WSP(bf16, WS_FXK) + hb, WSP(bf16, WS_FXV) + hb,
                    WSP(bf16, WS_YCAT) + (size_t)2 * M * 512 + (size_t)(b * 2048 + qb * 256) * 512 + h * 128, 512, qb * 256, 4 * (qb + 1), nullptr};
    att::Seam S;
    att::prime<0>(r, lds, S, tid); att::block<0>(r, r, lds, S, tid);
}
constexpr size_t WS_NLOC = WS_MLST, WS_NPREV = WS_MLST + 262144, WS_MLOC = WS_MLST + 524288, WS_BLAST = WS_MLOC + 4096, WS_MPREV = WS_BLAST + 4096;
namespace ml {
using att::f32x16; using att::s16x4;
constexpr int L_Q = 0, L_K = 8192, L_V = 16384, L_HID = 32768, L_G = L_HID + 64 * 132 * 4, L_WS = L_G + 2048;
__device__ __forceinline__ void stage_conv(char* tile, const bf16* X, const float* cw, const float* cb, int row0, int spos0, int ch0, float scale, int tid) {
    const int s = tid >> 3, ch = ch0 + (tid & 7) * 8;
    float a[8];
    { const f32x4 b0 = *(const f32x4*)(cb + ch), b1 = *(const f32x4*)(cb + ch + 4); a[0] = b0[0]; a[1] = b0[1]; a[2] = b0[2]; a[3] = b0[3]; a[4] = b1[0]; a[5] = b1[1]; a[6] = b1[2]; a[7] = b1[3]; }
#pragma unroll
    for (int j = 0; j < 4; ++j) { if (spos0 + s - 3 + j >= 0) {
            const bf16x8 x = *(const bf16x8*)(X + (size_t)(row0 + s - 3 + j) * 512 + ch);
            const f32x4 w0 = *(const f32x4*)(cw + j * 512 + ch), w1 = *(const f32x4*)(cw + j * 512 + ch + 4);
#pragma unroll
            for (int i = 0; i < 4; ++i) { a[i] += w0[i] * bf2f((unsigned short)x[i]); a[4 + i] += w1[i] * bf2f((unsigned short)x[4 + i]); } } }
#pragma unroll
    for (int i = 0; i < 8; ++i) a[i] = a[i] * scale / (1.0f + __expf(-a[i]));
    *(u32x4*)(tile + (s * 64 + (tid & 7) * 8) * 2) = (u32x4){att::cvtpk(a[0], a[1]), att::cvtpk(a[2], a[3]), att::cvtpk(a[4], a[5]), att::cvtpk(a[6], a[7])};
}
__device__ __forceinline__ void stage_conv4(char* tile0, const bf16* X, const float* cw, const float* cb, int row0, int spos0, int ch0, float scale, int tid) {
    const int s = tid >> 3, ch = ch0 + (tid & 7) * 8;
    bf16x8 x[4][4];
#pragma unroll
    for (int c = 0; c < 4; ++c)
#pragma unroll
        for (int j = 0; j < 4; ++j) { const int sp = spos0 + 64 * c + s - 3 + j; x[c][j] = *(const bf16x8*)(X + (size_t)(row0 + 64 * c + s - 3 + j + (sp < 0 ? 3 : 0)) * 512 + ch); }
    f32x4 w0[4], w1[4];
#pragma unroll
    for (int j = 0; j < 4; ++j) { w0[j] = *(const f32x4*)(cw + j * 512 + ch); w1[j] = *(const f32x4*)(cw + j * 512 + ch + 4); }
    const f32x4 b0 = *(const f32x4*)(cb + ch), b1 = *(const f32x4*)(cb + ch + 4);
#pragma unroll
    for (int c = 0; c < 4; ++c) { float a[8] = {b0[0], b0[1], b0[2], b0[3], b1[0], b1[1], b1[2], b1[3]};
#pragma unroll
        for (int j = 0; j < 4; ++j) { const float msk = (spos0 + 64 * c + s - 3 + j >= 0) ? 1.0f : 0.0f;
#pragma unroll
            for (int i = 0; i < 4; ++i) { a[i] += msk * w0[j][i] * bf2f((unsigned short)x[c][j][i]); a[4 + i] += msk * w1[j][i] * bf2f((unsigned short)x[c][j][4 + i]); } }
#pragma unroll
        for (int i = 0; i < 8; ++i) a[i] = a[i] * scale / (1.0f + __expf(-a[i]));
        *(u32x4*)(tile0 + c * 8192 + (s * 64 + (tid & 7) * 8) * 2) = (u32x4){att::cvtpk(a[0], a[1]), att::cvtpk(a[2], a[3]), att::cvtpk(a[4], a[5]), att::cvtpk(a[6], a[7])}; }
}
__device__ __forceinline__ void stage_v(char* V_lds, const bf16* Vg, int row0, int h, int tid) {
    const int sr = tid >> 4, sc = (tid & 15) * 8;
    const bf16x8 v0 = *(const bf16x8*)(Vg + (size_t)(row0 + sr) * 512 + h * 128 + sc), v1 = *(const bf16x8*)(Vg + (size_t)(row0 + 32 + sr) * 512 + h * 128 + sc);
    *(bf16x8*)(V_lds + att::v_st(sr, sc)) = v0; *(bf16x8*)(V_lds + att::v_st(32 + sr, sc)) = v1;
}
__device__ __forceinline__ void stage_gates(float* G, const float* scal, int row0, int h, int lane, float& b_last, float& m_loc) {
    const float ig = scal[(size_t)(row0 + lane) * 16 + h], f = logsigf(scal[(size_t)(row0 + lane) * 16 + 4 + h]);
    float b = f;
#pragma unroll
    for (int off = 1; off < 64; off <<= 1) { const float t = lshfl(b, (lane - off) & 63); if (lane >= off) b += t; }
    b_last = __builtin_bit_cast(float, __builtin_amdgcn_readlane(__builtin_bit_cast(int, b), 63));
    const float wst = b_last - b + ig; float mx = wst;
#pragma unroll
    for (int off = 1; off < 64; off <<= 1) mx = fmaxf(mx, lshfl(mx, lane ^ off));
    m_loc = mx;
    G[lane] = b; G[64 + lane] = ig - b; G[128 + lane] = __expf(wst - mx);
}
#define TRRD(dst, off) asm volatile("ds_read_b64_tr_b16 %0, %1 offset:%2" : "=&v"(dst) : "v"(vb), "i"(off) : "memory")
#define VFRAG(l_, h_) (bf16x8){l_[0], l_[1], l_[2], l_[3], h_[0], h_[1], h_[2], h_[3]}
__device__ __forceinline__ void mma_v(f32x16& acc, int vb, bf16x8 pa0, bf16x8 pa1, bf16x8 pa2, bf16x8 pa3) {
    s16x4 l0, l1, l2, l3, h0, h1, h2, h3;
    TRRD(l0, 0); TRRD(h0, 2048); TRRD(l1, 4096); TRRD(h1, 6144); TRRD(l2, 8192); TRRD(h2, 10240); TRRD(l3, 12288); TRRD(h3, 14336);
    asm volatile("s_waitcnt lgkmcnt(0)" ::: "memory"); __builtin_amdgcn_sched_barrier(0);
    acc = __builtin_amdgcn_mfma_f32_32x32x16_bf16(pa0, VFRAG(l0, h0), acc, 0, 0, 0);
    acc = __builtin_amdgcn_mfma_f32_32x32x16_bf16(pa1, VFRAG(l1, h1), acc, 0, 0, 0);
    acc = __builtin_amdgcn_mfma_f32_32x32x16_bf16(pa2, VFRAG(l2, h2), acc, 0, 0, 0);
    acc = __builtin_amdgcn_mfma_f32_32x32x16_bf16(pa3, VFRAG(l3, h3), acc, 0, 0, 0);
}
#undef TRRD
#undef VFRAG
__device__ __forceinline__ void unit_local(Frame& F, int l, int u) {
    char* lds = (char*)F.lds; const int tid = F.tid, lane = tid & 63, wid = F.wave, r32 = lane & 31, hi = lane >> 5;
    const int bh = u >> 5, c = u & 31, b = bh >> 2, h = bh & 3, row0 = b * 2048 + c * 64;
    float* G = (float*)(lds + L_G);
    stage_conv(lds + L_K, WSP(bf16, WS_MLQK), KIN(I_CONVW) + (size_t)l * 2048, KIN(I_CONVB) + (size_t)l * 512, row0, c * 64, 256 + h * 64, 1.0f, tid);
    stage_v(lds + L_V, WSP(bf16, WS_MLV), row0, h, tid);
    if (wid == 0) { float bl, mlc; stage_gates(G, WSP(float, WS_SCAL), row0, h, lane, bl, mlc); if (lane == 0) { WSP(float, WS_MLOC)[u] = mlc; WSP(float, WS_BLAST)[u] = bl; } }
    __syncthreads();
    const int kblk = wid >> 2, vblk = wid & 3;
    bf16x8 pa[4];
    const unsigned short* Kc = (const unsigned short*)(lds + L_K);
#pragma unroll
    for (int ks = 0; ks < 4; ++ks) { float w[8];
#pragma unroll
        for (int j = 0; j < 8; ++j) { const int s = 16 * ks + 8 * hi + j; w[j] = bf2f(Kc[s * 64 + kblk * 32 + r32]) * G[128 + s]; }
        u32x4 q = {att::cvtpk(w[0], w[1]), att::cvtpk(w[2], w[3]), att::cvtpk(w[4], w[5]), att::cvtpk(w[6], w[7])}; pa[ks] = *reinterpret_cast<bf16x8*>(&q); }
    f32x16 acc = ozero16();
    mma_v(acc, (int)(uintptr_t)(lds + L_V) + att::v_rd_base(lane) + vblk * 512, pa[0], pa[1], pa[2], pa[3]);
    float* cl = WSP(float, WS_CLOC) + (size_t)u * 8192 + (size_t)(vblk * 32 + r32) * 64 + kblk * 32 + 4 * hi;
#pragma unroll
    for (int g = 0; g < 4; ++g) *(f32x4*)(cl + 8 * g) = (f32x4){acc[4 * g], acc[4 * g + 1], acc[4 * g + 2], acc[4 * g + 3]};
    if (tid < 64) { float s_ = 0.f; for (int s = 0; s < 64; ++s) s_ += G[128 + s] * bf2f(Kc[s * 64 + tid]); WSP(float, WS_NLOC)[(size_t)u * 64 + tid] = s_; }
    __syncthreads();
}
__device__ __forceinline__ void scan_item(Frame& F, int it) {
    const int tid = F.tid;
    float* dec_l = (float*)F.lds; float* scl_l = dec_l + 32; float* mpr_l = dec_l + 64;
    {
        const int bh = it / 5, seg = it % 5;
        __syncthreads();
        if (tid < 32) { dec_l[96 + tid] = WSP(float, WS_MLOC)[bh * 32 + tid]; dec_l[128 + tid] = WSP(float, WS_BLAST)[bh * 32 + tid]; }
        __syncthreads();
        if (tid == 0) { float m = -__builtin_inff();
            for (int c = 0; c < 32; ++c) { const float ml_ = dec_l[96 + c], bl = dec_l[128 + c], mn = fmaxf(bl + m, ml_);
                mpr_l[c] = m; dec_l[c] = __expf(bl + m - mn); scl_l[c] = __expf(ml_ - mn); m = mn; } }
        __syncthreads();
        if (seg < 4) { const int e = seg * 2048 + tid * 4; const float* cl = WSP(float, WS_CLOC) + (size_t)bh * 32 * 8192 + e; bf16* cp = WSP(bf16, WS_CPREV) + (size_t)bh * 32 * 8192 + e;
            f32x4 v[32];
#pragma unroll
            for (int c = 0; c < 32; ++c) v[c] = *(const f32x4*)(cl + (size_t)c * 8192);
            f32x4 st = ozero4();
#pragma unroll
            for (int c = 0; c < 32; ++c) { *(u32x2*)(cp + (size_t)c * 8192) = (u32x2){pk2(st[0], st[1]), pk2(st[2], st[3])}; st = dec_l[c] * st + scl_l[c] * v[c]; }
        } else if (tid < 64) { const float* nl = WSP(float, WS_NLOC) + (size_t)bh * 32 * 64 + tid; float* np = WSP(float, WS_NPREV) + (size_t)bh * 32 * 64 + tid;
            float v[32];
#pragma unroll
            for (int c = 0; c < 32; ++c) v[c] = nl[(size_t)c * 64];
            float st = 0.f;
#pragma unroll
            for (int c = 0; c < 32; ++c) { np[(size_t)c * 64] = st; if (tid == 0) WSP(float, WS_MPREV)[bh * 32 + c] = mpr_l[c]; st = dec_l[c] * st + scl_l[c] * v[c]; }
        }
    }
}
__device__ __forceinline__ void unit_out(Frame& F, int l, int u) {
    char* lds = (char*)F.lds; const int tid = F.tid, lane = tid & 63, wid = F.wave, r32 = lane & 31, hi = lane >> 5;
    const int bh = u >> 5, c = u & 31, b = bh >> 2, h = bh & 3, row0 = b * 2048 + c * 64;
    float* G = (float*)(lds + L_G);
    stage_conv(lds + L_Q, WSP(bf16, WS_MLQK), KIN(I_CONVW) + (size_t)l * 2048, KIN(I_CONVB) + (size_t)l * 512, row0, c * 64, h * 64, 0.125f, tid);
    stage_conv(lds + L_K, WSP(bf16, WS_MLQK), KIN(I_CONVW) + (size_t)l * 2048, KIN(I_CONVB) + (size_t)l * 512, row0, c * 64, 256 + h * 64, 1.0f, tid);
    stage_v(lds + L_V, WSP(bf16, WS_MLV), row0, h, tid);
    if (wid == 0) { float bl, mlc; stage_gates(G, WSP(float, WS_SCAL), row0, h, lane, bl, mlc); G[192 + lane] = WSP(float, WS_NPREV)[(size_t)u * 64 + lane]; }
    __syncthreads();
    const int rb = wid >> 2, vblk = wid & 3, t = rb * 32 + r32;
    bf16x8 qf[4];
#pragma unroll
    for (int ks = 0; ks < 4; ++ks) qf[ks] = *(const bf16x8*)(lds + L_Q + t * 128 + (16 * ks + 8 * hi) * 2);
    f32x16 p0 = ozero16(), p1 = p0;
#pragma unroll
    for (int ks = 0; ks < 4; ++ks) { const bf16x8 k0 = *(const bf16x8*)(lds + L_K + r32 * 128 + (16 * ks + 8 * hi) * 2), k1 = *(const bf16x8*)(lds + L_K + (32 + r32) * 128 + (16 * ks + 8 * hi) * 2);
        p0 = __builtin_amdgcn_mfma_f32_32x32x16_bf16(k0, qf[ks], p0, 0, 0, 0); p1 = __builtin_amdgcn_mfma_f32_32x32x16_bf16(k1, qf[ks], p1, 0, 0, 0); }
    const float bt = G[t], inter = bt + WSP(float, WS_MPREV)[u];
    const float NEG = -__builtin_inff();
    f32x16 d0, d1; float mo = inter;
#pragma unroll
    for (int r = 0; r < 16; ++r) { const int s0 = att::crow(r, hi), s1 = 32 + s0; d0[r] = (s0 <= t) ? bt + G[64 + s0] : NEG; d1[r] = (s1 <= t) ? bt + G[64 + s1] : NEG; mo = fmaxf(mo, fmaxf(d0[r], d1[r])); }
    { auto rr = __builtin_amdgcn_permlane32_swap(__float_as_uint(mo), __float_as_uint(mo), false, false); mo = fmaxf(__uint_as_float(rr[0]), __uint_as_float(rr[1])); }
    float den = 0.f;
#pragma unroll
    for (int r = 0; r < 16; ++r) { p0[r] *= __expf(d0[r] - mo); p1[r] *= __expf(d1[r] - mo); den += p0[r] + p1[r]; }
    const float a_int = __expf(inter - mo);
    float nd = 0.f;
#pragma unroll
    for (int ks = 0; ks < 4; ++ks)
#pragma unroll
        for (int j = 0; j < 8; ++j) nd += G[192 + 16 * ks + 8 * hi + j] * bf2f((unsigned short)qf[ks][j]);
    den += a_int * nd;
    { auto rr = __builtin_amdgcn_permlane32_swap(__float_as_uint(den), __float_as_uint(den), false, false); den = __uint_as_float(rr[0]) + __uint_as_float(rr[1]); }
    float* wsl = (float*)(lds + L_WS) + wid * 64;
    if (hi == 0) wsl[r32] = 1.0f / fmaxf(fabsf(den), __expf(-mo));
    bf16x8 pa0, pa1, pa2, pa3;
#define PK4(P, B_, OUT) do { unsigned a0 = att::cvtpk(P[B_+0], P[B_+1]), a1 = att::cvtpk(P[B_+2], P[B_+3]);                          \
        unsigned b0 = att::cvtpk(P[B_+4], P[B_+5]), b1 = att::cvtpk(P[B_+6], P[B_+7]);                                             \
        auto r0 = __builtin_amdgcn_permlane32_swap(a0, b0, false, false); auto r1 = __builtin_amdgcn_permlane32_swap(a1, b1, false, false); \
        u32x4 w = {r0[0], r1[0], r0[1], r1[1]}; OUT = *reinterpret_cast<bf16x8*>(&w); } while (0)
    PK4(p0, 0, pa0); PK4(p0, 8, pa1); PK4(p1, 0, pa2); PK4(p1, 8, pa3);
#undef PK4
    f32x16 o = ozero16();
    mma_v(o, (int)(uintptr_t)(lds + L_V) + att::v_rd_base(lane) + vblk * 512, pa0, pa1, pa2, pa3);
    const bf16* cp = WSP(bf16, WS_CPREV) + (size_t)u * 8192 + (size_t)(vblk * 32 + r32) * 64 + 8 * hi;
#pragma unroll
    for (int ks = 0; ks < 4; ++ks) { float w[8];
#pragma unroll
        for (int j = 0; j < 8; ++j) w[j] = a_int * bf2f((unsigned short)qf[ks][j]);
        u32x4 q = {att::cvtpk(w[0], w[1]), att::cvtpk(w[2], w[3]), att::cvtpk(w[4], w[5]), att::cvtpk(w[6], w[7])};
        o = __builtin_amdgcn_mfma_f32_32x32x16_bf16(*reinterpret_cast<bf16x8*>(&q), *(const bf16x8*)(cp + 16 * ks), o, 0, 0, 0); }
    asm volatile("s_waitcnt lgkmcnt(0)" ::: "memory");
    float* hid = (float*)(lds + L_HID);
#pragma unroll
    for (int r = 0; r < 16; ++r) { const int tr = att::crow(r, hi); hid[(rb * 32 + tr) * 132 + vblk * 32 + r32] = o[r] * wsl[tr]; }
    __syncthreads();
    {   const int row = tid >> 3, seg = (tid & 7) * 16; const float* hr = hid + row * 132 + seg;
        float v[16], ss = 0.f;
#pragma unroll
        for (int i = 0; i < 4; ++i) { const f32x4 q = *(const f32x4*)(hr + 4 * i); v[4 * i] = q[0]; v[4 * i + 1] = q[1]; v[4 * i + 2] = q[2]; v[4 * i + 3] = q[3]; ss += (q[0] * q[0] + q[1] * q[1]) + (q[2] * q[2] + q[3] * q[3]); }
        ss += qxor1(ss); ss += qxor2(ss); ss += hmirror(ss);
        const float rn = 1.0f / sqrtf(ss * (1.0f / 128.0f) + EPS);
        const float* gn = KIN(I_MLG) + (size_t)l * 512 + h * 128 + seg;
        const bf16* og = WSP(bf16, WS_MLO) + (size_t)(row0 + row) * 512 + h * 128 + seg;
        const u32x4 o0 = *(const u32x4*)og, o1 = *(const u32x4*)(og + 8); unsigned w[8];
#pragma unroll
        for (int i = 0; i < 8; ++i) { const unsigned oo = i < 4 ? o0[i] : o1[i - 4]; const float g0 = bf2f(oo & 0xffffu), g1 = bf2f(oo >> 16);
            const float y0 = v[2 * i] * rn * gn[2 * i] / (1.0f + __expf(-g0)), y1 = v[2 * i + 1] * rn * gn[2 * i + 1] / (1.0f + __expf(-g1));
            w[i] = att::cvtpk(y0, y1); }
        bf16* yo = WSP(bf16, WS_YCAT) + (size_t)(row0 + row) * 512 + h * 128 + seg;
        *(u32x4*)yo = (u32x4){w[0], w[1], w[2], w[3]}; *(u32x4*)(yo + 8) = (u32x4){w[4], w[5], w[6], w[7]};
    }
    __syncthreads();
}
__device__ __forceinline__ void unit_out4(Frame& F, int l, int u4) {
    char* lds = (char*)F.lds; const int tid = F.tid, lane = tid & 63, wid = F.wave, r32 = lane & 31, hi = lane >> 5;
    const int bh = u4 >> 3, g4 = u4 & 7, b = bh >> 2, h = bh & 3, row00 = b * 2048 + g4 * 256;
    constexpr int O_Q = 0, O_K = 32768, O_V = 65536, O_G = LDSCTL_OFF + 1024, O_WS = O_G + 4096;
    const float* cw = KIN(I_CONVW) + (size_t)l * 2048; const float* cb = KIN(I_CONVB) + (size_t)l * 512;
    stage_conv4(lds + O_Q, WSP(bf16, WS_MLQK), cw, cb, row00, g4 * 256, h * 64, 0.125f, tid);
    stage_conv4(lds + O_K, WSP(bf16, WS_MLQK), cw, cb, row00, g4 * 256, 256 + h * 64, 1.0f, tid);
#pragma unroll
    for (int c = 0; c < 4; ++c) stage_v(lds + O_V + c * 16384, WSP(bf16, WS_MLV), row00 + 64 * c, h, tid);
    if (wid < 4) { float bl, mlc; float* G = (float*)(lds + O_G) + wid * 256; stage_gates(G, WSP(float, WS_SCAL), row00 + 64 * wid, h, lane, bl, mlc);
        G[192 + lane] = WSP(float, WS_NPREV)[((size_t)bh * 32 + g4 * 4 + wid) * 64 + lane]; }
    const int c = wid >> 1, t = 32 * (wid & 1) + r32; const size_t u = (size_t)bh * 32 + g4 * 4 + c;
    bf16x8 cpf[4][4];
#pragma unroll
    for (int d0 = 0; d0 < 4; ++d0)
#pragma unroll
        for (int ks = 0; ks < 4; ++ks) cpf[d0][ks] = *(const bf16x8*)(WSP(bf16, WS_CPREV) + u * 8192 + (size_t)(d0 * 32 + r32) * 64 + 8 * hi + 16 * ks);
    const float mprev_u = WSP(float, WS_MPREV)[u];
    __syncthreads();
    const float* G = (const float*)(lds + O_G) + c * 256;
    bf16x8 qf[4];
#pragma unroll
    for (int ks = 0; ks < 4; ++ks) qf[ks] = *(const bf16x8*)(lds + O_Q + c * 8192 + t * 128 + (16 * ks + 8 * hi) * 2);
    f32x16 p0 = ozero16(), p1 = p0;
#pragma unroll
    for (int ks = 0; ks < 4; ++ks) { const bf16x8 k0 = *(const bf16x8*)(lds + O_K + c * 8192 + r32 * 128 + (16 * ks + 8 * hi) * 2), k1 = *(const bf16x8*)(lds + O_K + c * 8192 + (32 + r32) * 128 + (16 * ks + 8 * hi) * 2);
        p0 = __builtin_amdgcn_mfma_f32_32x32x16_bf16(k0, qf[ks], p0, 0, 0, 0); p1 = __builtin_amdgcn_mfma_f32_32x32x16_bf16(k1, qf[ks], p1, 0, 0, 0); }
    const float bt = G[t], inter = bt + mprev_u;
    const float NEG = -__builtin_inff();
    float mo = inter;
    {   f32x16 d0, d1;
#pragma unroll
        for (int r = 0; r < 16; ++r) { const int s0 = att::crow(r, hi), s1 = 32 + s0; d0[r] = (s0 <= t) ? bt + G[64 + s0] : NEG; d1[r] = (s1 <= t) ? bt + G[64 + s1] : NEG; mo = fmaxf(mo, fmaxf(d0[r], d1[r])); }
        { auto rr = __builtin_amdgcn_permlane32_swap(__float_as_uint(mo), __float_as_uint(mo), false, false); mo = fmaxf(__uint_as_float(rr[0]), __uint_as_float(rr[1])); }
#pragma unroll
        for (int r = 0; r < 16; ++r) { p0[r] *= __expf(d0[r] - mo); p1[r] *= __expf(d1[r] - mo); }
    }
    float den = 0.f;
#pragma unroll
    for (int r = 0; r < 16; ++r) den += p0[r] + p1[r];
    const float a_int = __expf(inter - mo);
    float nd = 0.f;
#pragma unroll
    for (int ks = 0; ks < 4; ++ks)
#pragma unroll
        for (int j = 0; j < 8; ++j) nd += G[192 + 16 * ks + 8 * hi + j] * bf2f((unsigned short)qf[ks][j]);
    den += a_int * nd;
    { auto rr = __builtin_amdgcn_permlane32_swap(__float_as_uint(den), __float_as_uint(den), false, false); den = __uint_as_float(rr[0]) + __uint_as_float(rr[1]); }
    float* wsl = (float*)(lds + O_WS) + wid * 64;
    if (hi == 0) wsl[r32] = 1.0f / fmaxf(fabsf(den), __expf(-mo));
    bf16x8 pa0, pa1, pa2, pa3;
#define PK4(P, B_, OUT) do { unsigned a0 = att::cvtpk(P[B_+0], P[B_+1]), a1 = att::cvtpk(P[B_+2], P[B_+3]);                          \
        unsigned b0 = att::cvtpk(P[B_+4], P[B_+5]), b1 = att::cvtpk(P[B_+6], P[B_+7]);                                             \
        auto r0 = __builtin_amdgcn_permlane32_swap(a0, b0, false, false); auto r1 = __builtin_amdgcn_permlane32_swap(a1, b1, false, false); \
        u32x4 w = {r0[0], r1[0], r0[1], r1[1]}; OUT = *reinterpret_cast<bf16x8*>(&w); } while (0)
    PK4(p0, 0, pa0); PK4(p0, 8, pa1); PK4(p1, 0, pa2); PK4(p1, 8, pa3);
#undef PK4
    bf16x8 qa[4];
#pragma unroll
    for (int ks = 0; ks < 4; ++ks) { float w[8];
#pragma unroll
        for (int j = 0; j < 8; ++j) w[j] = a_int * bf2f((unsigned short)qf[ks][j]);
        u32x4 q = {att::cvtpk(w[0], w[1]), att::cvtpk(w[2], w[3]), att::cvtpk(w[4], w[5]), att::cvtpk(w[6], w[7])}; qa[ks] = *reinterpret_cast<bf16x8*>(&q); }
    f32x16 o[4];
    const int vbase = (int)(uintptr_t)(lds + O_V + c * 16384) + att::v_rd_base(lane);
#pragma unroll
    for (int d0 = 0; d0 < 4; ++d0) { o[d0] = ozero16();
        mma_v(o[d0], vbase + d0 * 512, pa0, pa1, pa2, pa3);
#pragma unroll
        for (int ks = 0; ks < 4; ++ks) o[d0] = __builtin_amdgcn_mfma_f32_32x32x16_bf16(qa[ks], cpf[d0][ks], o[d0], 0, 0, 0); }
    asm volatile("s_waitcnt lgkmcnt(0)" ::: "memory");
    float rinv[16];
#pragma unroll
    for (int r = 0; r < 16; ++r) rinv[r] = wsl[att::crow(r, hi)];
    __syncthreads();
    unsigned short* ht = (unsigned short*)(lds + wid * 8704);
#pragma unroll
    for (int r = 0; r < 16; ++r) { const int tr = att::crow(r, hi);
#pragma unroll
        for (int d0 = 0; d0 < 4; ++d0) ht[tr * 136 + d0 * 32 + r32] = (unsigned short)f2bf(o[d0][r] * rinv[r]); }
    asm volatile("s_waitcnt lgkmcnt(0)" ::: "memory");
    {   const int row = lane >> 1, seg = (lane & 1) * 64; const unsigned short* hr = ht + row * 136 + seg;
        u32x4 hv[8]; float ss = 0.f;
#pragma unroll
        for (int i = 0; i < 8; ++i) { hv[i] = *(const u32x4*)(hr + 8 * i);
#pragma unroll
            for (int q = 0; q < 4; ++q) { const float a = bf2f(hv[i][q] & 0xffffu), b2 = bf2f(hv[i][q] >> 16); ss += a * a + b2 * b2; } }
        ss += __builtin_bit_cast(float, __builtin_amdgcn_update_dpp(0, __builtin_bit_cast(int, ss), 0xB1, 0xf, 0xf, false));
        const float rn = 1.0f / sqrtf(ss * (1.0f / 128.0f) + EPS);
        const int grow = row00 + 64 * c + 32 * (wid & 1) + row;
        const float* gn = KIN(I_MLG) + (size_t)l * 512 + h * 128 + seg;
        const bf16* og = WSP(bf16, WS_MLO) + (size_t)grow * 512 + h * 128 + seg;
        bf16* yo = WSP(bf16, WS_YCAT) + (size_t)grow * 512 + h * 128 + seg;
#pragma unroll
        for (int i = 0; i < 8; ++i) { const u32x4 oo = *(const u32x4*)(og + 8 * i); const f32x4 g0 = *(const f32x4*)(gn + 8 * i), g1 = *(const f32x4*)(gn + 8 * i + 4); unsigned w[4];
#pragma unroll
            for (int q = 0; q < 4; ++q) { const float a = bf2f(hv[i][q] & 0xffffu), b2 = bf2f(hv[i][q] >> 16), ga = bf2f(oo[q] & 0xffffu), gb = bf2f(oo[q] >> 16);
                const float wa = q < 2 ? g0[2 * q] : g1[2 * q - 4], wb = q < 2 ? g0[2 * q + 1] : g1[2 * q - 3];
                w[q] = att::cvtpk(a * rn * wa / (1.0f + __expf(-ga)), b2 * rn * wb / (1.0f + __expf(-gb))); }
            *(u32x4*)(yo + 8 * i) = (u32x4){w[0], w[1], w[2], w[3]}; }
    }
    __syncthreads();
}
__device__ __forceinline__ void unit_local4(Frame& F, int l, int u4) {
    char* lds = (char*)F.lds; const int tid = F.tid, lane = tid & 63, wid = F.wave, r32 = lane & 31, hi = lane >> 5;
    const int bh = u4 >> 3, g4 = u4 & 7, b = bh >> 2, h = bh & 3, row00 = b * 2048 + g4 * 256;
    constexpr int O_K = 32768, O_V = 65536, O_G = LDSCTL_OFF + 1024;
    stage_conv4(lds + O_K, WSP(bf16, WS_MLQK), KIN(I_CONVW) + (size_t)l * 2048, KIN(I_CONVB) + (size_t)l * 512, row00, g4 * 256, 256 + h * 64, 1.0f, tid);
#pragma unroll
    for (int c = 0; c < 4; ++c) stage_v(lds + O_V + c * 16384, WSP(bf16, WS_MLV), row00 + 64 * c, h, tid);
    if (wid < 4) { float bl, mlc; stage_gates((float*)(lds + O_G) + wid * 256, WSP(float, WS_SCAL), row00 + 64 * wid, h, lane, bl, mlc);
        if (lane == 0) { WSP(float, WS_MLOC)[bh * 32 + g4 * 4 + wid] = mlc; WSP(float, WS_BLAST)[bh * 32 + g4 * 4 + wid] = bl; } }
    __syncthreads();
    const int c = wid >> 1, kblk = wid & 1; const size_t u = (size_t)bh * 32 + g4 * 4 + c;
    const float* G = (const float*)(lds + O_G) + c * 256;
    const unsigned short* Kc = (const unsigned short*)(lds + O_K + c * 8192);
    bf16x8 pa[4];
#pragma unroll
    for (int ks = 0; ks < 4; ++ks) { float w[8];
#pragma unroll
        for (int j = 0; j < 8; ++j) { const int s = 16 * ks + 8 * hi + j; w[j] = bf2f(Kc[s * 64 + kblk * 32 + r32]) * G[128 + s]; }
        u32x4 q = {att::cvtpk(w[0], w[1]), att::cvtpk(w[2], w[3]), att::cvtpk(w[4], w[5]), att::cvtpk(w[6], w[7])}; pa[ks] = *reinterpret_cast<bf16x8*>(&q); }
    const int vbase = (int)(uintptr_t)(lds + O_V + c * 16384) + att::v_rd_base(lane);
#pragma unroll
    for (int vblk = 0; vblk < 4; ++vblk) { f32x16 acc = ozero16();
        mma_v(acc, vbase + vblk * 512, pa[0], pa[1], pa[2], pa[3]);
        float* cl = WSP(float, WS_CLOC) + u * 8192 + (size_t)(vblk * 32 + r32) * 64 + kblk * 32 + 4 * hi;
#pragma unroll
        for (int g = 0; g < 4; ++g) *(f32x4*)(cl + 8 * g) = (f32x4){acc[4 * g], acc[4 * g + 1], acc[4 * g + 2], acc[4 * g + 3]}; }
    if (tid < 256) { const int c2 = tid >> 6, k = tid & 63; const float* G2 = (const float*)(lds + O_G) + c2 * 256; const unsigned short* K2 = (const unsigned short*)(lds + O_K + c2 * 8192);
        float s_ = 0.f; for (int s = 0; s < 64; ++s) s_ += G2[128 + s] * bf2f(K2[s * 64 + k]); WSP(float, WS_NLOC)[((size_t)bh * 32 + g4 * 4 + c2) * 64 + k] = s_; }
    __syncthreads();
}
}
__device__ __forceinline__ int wave_sum_i(int v) {
    v += __builtin_amdgcn_update_dpp(0, v, 0x128, 0xf, 0xf, false);
    v += __builtin_amdgcn_update_dpp(0, v, 0x124, 0xf, 0xf, false);
    v += __builtin_amdgcn_update_dpp(0, v, 0x122, 0xf, 0xf, false);
    v += __builtin_amdgcn_update_dpp(0, v, 0x121, 0xf, 0xf, false);
    return __builtin_amdgcn_readlane(v, 0) + __builtin_amdgcn_readlane(v, 16) + __builtin_amdgcn_readlane(v, 32) + __builtin_amdgcn_readlane(v, 48);
}
__device__ __forceinline__ unsigned sortkey(float f) { unsigned u = __float_as_uint(f); u = (u == 0x80000000u) ? 0u : u; return (u & 0x80000000u) ? ~u : (u | 0x80000000u); }
__device__ __forceinline__ void transpose32(unsigned (&A)[32]) {
    unsigned m = 0x0000FFFFu;
#pragma unroll
    for (int j = 16; j != 0; j >>= 1, m ^= (m << j)) {
#pragma unroll
        for (int k = 0; k < 32; k = (k + j + 1) & ~j) { const unsigned t = (A[k] ^ (A[k + j] >> j)) & m; A[k] ^= t; A[k + j] ^= (t << j); }
    }
}
__device__ __forceinline__ void dsa_select_pair(const float* SC, unsigned* bm, int q0, int nt, int lane) {
    unsigned ka[32], kb[32], A[32], B[32];
#pragma unroll
    for (int j = 0; j < 32; ++j) { if (j < nt) { ka[j] = sortkey(SC[(size_t)q0 * 2048 + 64 * j + lane]); kb[j] = sortkey(SC[(size_t)(q0 + 1) * 2048 + 64 * j + lane]); } else { ka[j] = 0u; kb[j] = 0u; } A[j] = ka[j]; B[j] = kb[j]; }
    transpose32(A); transpose32(B);
    unsigned pa = 0u, pb = 0u; int npa = 1 << 30, npb = 1 << 30;
    for (int rep_ = 0; rep_ < 1 + ((DUP_MASK >> 26) & 1); ++rep_) { pa = 0u; pb = 0u; npa = 1 << 30; npb = 1 << 30; asm volatile("" : "+s"(pa), "+s"(pb));
    unsigned alA = 0xffffffffu, alB = 0xffffffffu; int abA = 0, abB = 0;
#pragma unroll
    for (int bit = 31; bit >= 0; --bit) {
        const unsigned tA = alA & A[31 - bit], tB = alB & B[31 - bit];
        const int cA = __builtin_popcount(tA) + abA, cB = __builtin_popcount(tB) + abB;
        const int nA = wave_sum_i(cA), nB = wave_sum_i(cB);
        if (nA >= 256) { alA = tA; pa |= 1u << bit; npa = nA; } else { alA ^= tA; abA = cA; }
        if (nB >= 256) { alB = tB; pb |= 1u << bit; npb = nB; } else { alB ^= tB; abB = cB; }
        if (npa == 256 && npb == 256) break;
    } }
#pragma unroll
    for (int which = 0; which < 2; ++which) {
        const unsigned prefix = which ? pb : pa; const int np = which ? npb : npa;
        int ngt = 0;
        if (np != 256) {
#pragma unroll
            for (int j = 0; j < 32; ++j) ngt += ((which ? kb[j] : ka[j]) > prefix) ? 1 : 0;
            ngt = wave_sum_i(ngt);
        }
        const int need = 256 - ngt; int running = 0; unsigned keep0 = 0u, keep1 = 0u;
#pragma unroll
        for (int j = 0; j < 32; ++j) { if (j < nt) { const unsigned k_ = which ? kb[j] : ka[j];
                bool sel;
                if (np == 256) sel = k_ >= prefix;
                else { const bool eq = k_ == prefix; const unsigned long long e = __ballot(eq);
                    const int rank = running + (int)__builtin_amdgcn_mbcnt_hi((unsigned)(e >> 32), __builtin_amdgcn_mbcnt_lo((unsigned)e, 0u));
                    sel = (k_ > prefix) || (eq && rank < need); running += __builtin_popcountll(e); }
                const unsigned long long m = __ballot(sel);
                if (lane == j) { keep0 = (unsigned)m; keep1 = (unsigned)(m >> 32); } } }
        if (lane < nt) *(u32x2*)(bm + (q0 + which) * 64 + 2 * lane) = (u32x2){keep0, keep1};
    }
}
constexpr int CW_DEP = 8192;
__device__ __forceinline__ unsigned* dep_word(int l, int kind, int bh) { return (unsigned*)KCTL + CW_DEP + 64 * (l * 64 + kind * 32 + bh); }
__device__ __forceinline__ void dep_signal(Frame& F, unsigned* w) {
    asm volatile("s_waitcnt vmcnt(0)" ::: "memory");
    __syncthreads();
    if (F.wave == 0 && hw_lane() == 0) { __builtin_amdgcn_fence(__ATOMIC_RELEASE, "agent"); asm volatile("s_waitcnt vmcnt(0)" ::: "memory"); (void)xb_add(w, 1u); }
}
__device__ __forceinline__ void dep_wait(Frame& F, unsigned* w, unsigned target) {
    if (F.wave == 0 && hw_lane() == 0) { unsigned sp = 0u; while (xb_ld(w) < target) { __builtin_amdgcn_s_sleep(2); if (++sp > (1u << 24)) break; }
        __builtin_amdgcn_fence(__ATOMIC_ACQUIRE, "agent"); asm volatile("s_waitcnt vmcnt(0)" ::: "memory"); }
    __syncthreads();
}
__device__ __forceinline__ unsigned* dep_nrm(int l, int b) { return (unsigned*)KCTL + CW_DEP + 64 * (128 + l * 8 + b); }
__device__ __forceinline__ void ckv_norm_item(Frame& F, int l, int item) {
    const int lane = F.tid & 63, sc = (lane & 15) * 8;
    const float* g = KIN(I_KVG) + (size_t)l * 128 + sc;
#pragma unroll
    for (int i = 0; i < 8; ++i) { const size_t row = (size_t)item * 256 + F.wave * 32 + i * 4 + (lane >> 4);
        const bf16x8 x = *(const bf16x8*)(WSP(bf16, WS_CKV) + row * 128 + sc);
        *(bf16x8*)(WSP(bf16, WS_CKVN) + row * 128 + sc) = att::nrm8(x, g); }
}
__device__ __forceinline__ void dsa_unit(Frame& F, int l, int b, int cq) {
    char* lds = (char*)F.lds; const int tid = F.tid, lane = tid & 63, wid = F.wave, r32 = lane & 31, hi = lane >> 5;
    const int m0 = b * 2048 + cq * 64, nvis = 64 * (cq + 1);
    float* SC = WSP(float, WS_SCORE) + (size_t)blockIdx.x * 64 * 2048;
    for (int rep_ = 0; rep_ < 1 + ((DUP_MASK >> 25) & 1); ++rep_)
    {
        bf16x8 af[4];
        const bf16* qa = WSP(bf16, WS_IQ) + ((size_t)(m0 + 8 * wid) * 4 + r32) * 64 + 8 * hi;
#pragma unroll
        for (int ks = 0; ks < 4; ++ks) af[ks] = *(const bf16x8*)(qa + 16 * ks);
        float wq[4][4];
#pragma unroll
        for (int g = 0; g < 4; ++g) { const f32x4 w4 = *(const f32x4*)(WSP(float, WS_SCAL) + (size_t)(m0 + 8 * wid + 2 * g + hi) * 16 + 8);
            wq[g][0] = w4[0] * 0.0625f; wq[g][1] = w4[1] * 0.0625f; wq[g][2] = w4[2] * 0.0625f; wq[g][3] = w4[3] * 0.0625f; }
        const bf16* kg = WSP(bf16, WS_IK) + ((size_t)b * 2048 + (tid >> 3)) * 64 + (tid & 7) * 8;
        const int kw = (tid >> 3) * 144 + (tid & 7) * 16;
        bf16x8 stg = *(const bf16x8*)kg;
        *(bf16x8*)(lds + kw) = stg;
        __syncthreads();
        const int ntile = cq + 1;
        for (int t = 0; t < ntile; ++t) {
            const char* kb_ = lds + (t & 1) * 9216;
            if (t + 1 < ntile) stg = *(const bf16x8*)(kg + (size_t)(t + 1) * 64 * 64);
#pragma unroll
            for (int kb = 0; kb < 2; ++kb) {
                att::f32x16 d = ozero16();
#pragma unroll
                for (int ks = 0; ks < 4; ++ks) d = __builtin_amdgcn_mfma_f32_32x32x16_bf16(af[ks], *(const bf16x8*)(kb_ + (32 * kb + r32) * 144 + (16 * ks + 8 * hi) * 2), d, 0, 0, 0);
                float sv[4];
#pragma unroll
                for (int g = 0; g < 4; ++g) sv[g] = wq[g][0] * fmaxf(d[4 * g], 0.f) + wq[g][1] * fmaxf(d[4 * g + 1], 0.f) + wq[g][2] * fmaxf(d[4 * g + 2], 0.f) + wq[g][3] * fmaxf(d[4 * g + 3], 0.f);
                {
                    const bool up = (r32 & 2) != 0, od = (r32 & 1) != 0;
                    const float x1 = up ? sv[0] : sv[2], y1 = up ? sv[1] : sv[3]; const float rx1 = qxor2(x1), ry1 = qxor2(y1);
                    if (up) { sv[0] = rx1; sv[1] = ry1; } else { sv[2] = rx1; sv[3] = ry1; }
                    const float x2 = od ? sv[0] : sv[1], y2 = od ? sv[2] : sv[3]; const float rx2 = qxor1(x2), ry2 = qxor1(y2);
                    if (od) { sv[0] = rx2; sv[2] = ry2; } else { sv[1] = rx2; sv[3] = ry2; }
                    *(f32x4*)(SC + (size_t)(8 * wid + 2 * (r32 & 3) + hi) * 2048 + t * 64 + kb * 32 + (r32 & ~3)) = (f32x4){sv[0], sv[1], sv[2], sv[3]}; }
            }
            if (t + 1 < ntile) *(bf16x8*)(lds + ((t + 1) & 1) * 9216 + kw) = stg;
            asm volatile("s_waitcnt lgkmcnt(0)" ::: "memory"); __builtin_amdgcn_s_barrier(); asm volatile("" ::: "memory");
        }
    }
    asm volatile("s_waitcnt vmcnt(0)" ::: "memory"); __builtin_amdgcn_fence(__ATOMIC_ACQUIRE, "agent"); asm volatile("s_waitcnt vmcnt(0)" ::: "memory");
    {
        unsigned* bm = (unsigned*)(lds + att::LDS_BM);
        const int nt = cq + 1;
        if (nvis <= 256) {
            for (int ql = 0; ql < 8; ++ql) if (32 * lane < nvis) bm[(8 * wid + ql) * 64 + lane] = 0xffffffffu;
        } else {
            for (int qp = 0; qp < 4; ++qp) dsa_select_pair(SC, bm, 8 * wid + 2 * qp, nt, lane);
        }
    }
    __syncthreads();
    dep_wait(F, dep_nrm(l, b), 8u);
    att::BlockRef r{WSP(bf16, WS_QABS) + (size_t)m0 * 512, WSP(bf16, WS_CKVN) + (size_t)b * 2048 * 128, WSP(bf16, WS_CKVN) + (size_t)b * 2048 * 128,
                    WSP(bf16, WS_YCAT) + (size_t)M * 512 + (size_t)m0 * 512, 128, 0, cq + 1, KIN(I_KVG) + (size_t)l * 128};
    if (tid < 128) ((float*)(lds + att::LDS_GN))[tid] = r.g[tid];
    __syncthreads();
    att::Seam S;
    for (int rep_ = 0; rep_ < 1 + ((DUP_MASK >> 27) & 1); ++rep_) { att::prime<1>(r, lds, S, tid); att::block<1>(r, r, lds, S, tid); }
}
__device__ __forceinline__ void mixer_queue(Frame& F, int l, int qidx) {
    PHASE_BEGIN();
    volatile LAS int* qslot = (volatile LAS int*)(F.lds + LDSCTL_OFF + 192);
    unsigned* head = (unsigned*)KCTL + CW_Q + 64 * qidx;
    constexpr int N_DSA = 256, N_FOX = 256, N_ML = 256, N_SCAN = 32 * 5, N_OUT = 256;
    for (;;) {
        __syncthreads();
        if (F.tid == 0) *qslot = (int)__hip_atomic_fetch_add(head, 1u, __ATOMIC_RELAXED, __HIP_MEMORY_SCOPE_AGENT);
        __syncthreads();
        int item = *qslot;
        const int dup = (l == 0) ? 1 : 0;
        const int R_DSA = N_DSA << (dup & (DUP_MASK >> 8)), R_FOX = N_FOX << (dup & (DUP_MASK >> 9)), R_ML = N_ML << (dup & (DUP_MASK >> 10)), R_SCAN = N_SCAN << (dup & (DUP_MASK >> 11)), R_OUT = N_OUT << (dup & (DUP_MASK >> 12));
        if (item >= 64 + R_DSA + R_FOX + R_ML + R_SCAN + R_OUT) break;
        PHASE_BEGIN();
        if (item < 64) { ckv_norm_item(F, l, item); dep_signal(F, dep_nrm(l, item >> 3)); continue; }
        item -= 64;
        if (item < R_DSA) { item %= N_DSA; dsa_unit(F, l, item & 7, 31 - (item >> 3)); continue; }
        item -= R_DSA;
        if (item < R_FOX) { item %= N_FOX; fox_unit(F, (item & 31) >> 2, item & 3, 7 - (item >> 5)); continue; }
        item -= R_FOX;
        if (item < R_ML) { item %= N_ML; ml::unit_local4(F, l, item); dep_signal(F, dep_word(l, 0, item >> 3)); continue; }
        item -= R_ML;
        if (item < R_SCAN) { item %= N_SCAN; dep_wait(F, dep_word(l, 0, item / 5), 8u); ml::scan_item(F, item); dep_signal(F, dep_word(l, 1, item / 5)); continue; }
        item -= R_SCAN;
        item %= N_OUT; dep_wait(F, dep_word(l, 1, item >> 3), 5u);
        ml::unit_out4(F, l, item);
    }
}


__global__ void __launch_bounds__(NTHREADS, 2) fwd_kernel(Args args) {
    extern __shared__ __attribute__((aligned(16))) unsigned char lds[];
    cg::grid_group grid = cg::this_grid();
    Frame F;
    F.lds = (LAS unsigned char*)lds;
    F.wave = __builtin_amdgcn_readfirstlane((int)threadIdx.x >> 6); F.tid = F.wave * 64 + hw_lane();
    volatile LAS unsigned* MISC = (volatile LAS unsigned*)(F.lds + MISC_OFF);
    for (int u = F.tid; u < (LDS_BYTES - LDSCTL_OFF) / 4; u += NTHREADS) ((LAS unsigned*)(F.lds + LDSCTL_OFF))[u] = 0u;
    __syncthreads();
    (void)xcd_barrier_post((unsigned*)KCTL + CW_BAR, MISC + 8, F.tid == 0);
    grid.sync();
#define GRID_BAR() do { XcdBarrier bar_; bar_.bar = (unsigned*)KCTL + CW_BAR; bar_.x = xb_xcc_id(); bar_.st = (volatile LAS unsigned*)(F.lds + MISC_OFF) + 8; bar_.t0 = (F.wave == 0) && (hw_lane() == 0); xcd_barrier(bar_); } while (0)
#define REPS(k) (((DUP_MASK >> (k)) & 1) && l == 0 ? 2 : 1)
    for (int rep = 0; rep < ((DUP_MASK & 1) ? 2 : 1); ++rep) { p0_prologue(F); p0_moe_weights(F); GRID_BAR(); }
    norm_rows(F, KIN(I_X), 0, 0, 1024); GRID_BAR();
    for (int l = 0; l < DEPTH; ++l) {
        const float* xsrc = (l == 0) ? KIN(I_X) : WSP(float, WS_X);
        for (int rep = 0; rep < REPS(1); ++rep) {
            {   PHASE_BEGIN(); pg8::Gemm g{WSP(bf16, WS_XN), WSP(bf16, WS_WIN_T) + (size_t)l * NV * 1024, M, NV, 1024};
                InProjSched Sc; Sc.so.init(M, 4 * 256, GRIDN, (int)blockIdx.x); Sc.f8 = 0; EpiInProj E{WSP(float, WS_BINP) + (size_t)l * NV, (unsigned char*)KWS};
                pg8::gemm_phase<EpiInProj, InProjSched, true, true>(F.lds, g, Sc, E, F.tid); }
            {   PHASE_BEGIN(); pg8::Gemm g{(const bf16*)WSP(unsigned char, WS_XN1_8), (const bf16*)(WSP(unsigned char, WS_WIN8) + (size_t)l * NV * 1024), M, NV, 512};
                InProjSched Sc; Sc.so.init(M, 24 * 256, GRIDN, (int)blockIdx.x); Sc.f8 = 1; EpiInProj8 E{WSP(float, WS_BINP) + (size_t)l * NV, (unsigned char*)KWS};
                pg8::gemm_phase<EpiInProj8, InProjSched, false, true, true>(F.lds, g, Sc, E, F.tid); }
            GRID_BAR(); }
        mixer_queue(F, l, l); GRID_BAR();
        for (int rep = 0; rep < REPS(4); ++rep) {
            {   PHASE_BEGIN(); pg8::Gemm g{WSP(bf16, WS_YCAT), WSP(bf16, WS_WBR_T) + (size_t)l * 3072 * 512, 3 * M, 3072, 512};
                BranchSched Sc{GRIDN, vcu_id(), 0 | (1 << 2) | (2 << 4), 3}; EpiBranch E{WSP(bf16, WS_GATES), WSP(bf16, WS_MERGED), 0, WSP(unsigned char, WS_MERGED8)};
                pg8::gemm_phase<EpiBranch, BranchSched, true, true>(F.lds, g, Sc, E, F.tid); }
            GRID_BAR();
            {   PHASE_BEGIN(); pg8::Gemm g{(const bf16*)WSP(unsigned char, WS_MERGED8), (const bf16*)(WSP(unsigned char, WS_WOUT8) + (size_t)l * 1024 * 1024), M, 1024, 512};
                pg8::StaticOrder Sc; Sc.init(M, 1024, GRIDN, (int)blockIdx.x); EpiOutProj E{xsrc, WSP(float, WS_X), WSP(float, WS_MOD) + (size_t)l * 8 * 6144};
                pg8::gemm_phase<EpiOutProj, pg8::StaticOrder, false, true, true>(F.lds, g, Sc, E, F.tid); }
            GRID_BAR(); }
        xsrc = WSP(float, WS_X);
        if (((DUP_MASK >> 16) & 1) && l == 0) { route_phase(F, l, xsrc, true); GRID_BAR(); }
        route_phase(F, l, xsrc); GRID_BAR();
        for (int rep = 0; rep < REPS(5); ++rep) { gather_phase(F, l); GRID_BAR(); }
        const LAS int* tst = (const LAS int*)(F.lds + LDSCTL_OFF);
        for (int rep = 0; rep < REPS(6); ++rep) {
            {   PHASE_BEGIN(); pg8::Gemm gp{(const bf16*)WSP(unsigned char, WS_AS8), (const bf16*)(WSP(unsigned char, WS_W1T) + (size_t)l * 32 * 2048 * 1024), MP, 32 * 2048, 512};
                MoeSched<8> Sc{tst, tst[32] * 8, GRIDN, vcu_id()}; EpiP1 E{WSP(unsigned char, WS_ACT8), KIN(I_B1) + (size_t)l * 32 * 2048};
                pg8::gemm_phase<EpiP1, MoeSched<8>, false, true, true>(F.lds, gp, Sc, E, F.tid); }
            GRID_BAR(); }
        for (int rep = 0; rep < REPS(18); ++rep) {
        {   PHASE_BEGIN(); f8::Gemm g{WSP(unsigned char, WS_ACT8), WSP(unsigned char, WS_W2T) + (size_t)l * 32 * 1024 * 1024, 1024};
            MoeSched<4> Sc{tst, tst[32] * 4, GRIDN, vcu_id(), (DUP_MASK >> 24) & 1 & ((rep == 0 && l == 0) ? 1 : 0)}; EpiP2 E{WSP(bf16, WS_ASORT), KIN(I_B2) + (size_t)l * 32 * 1024, (((DUP_MASK >> 22) & 3) && rep == 0 && l == 0) ? ((DUP_MASK >> 22) & 3) : 0};
            pg8::Gemm gp{(const bf16*)g.A, (const bf16*)g.Bt, MP, 32 * 1024, 512, (((DUP_MASK >> 21) & 1) && rep == 0 && l == 0) ? 2 : 0};
            {
                const int nmax = (Sc.total + GRIDN - 1) / GRIDN, nmine = (Sc.total - Sc.c + GRIDN - 1) / GRIDN;
                if (nmine < nmax) { __builtin_amdgcn_s_sleep(100); __builtin_amdgcn_s_sleep(100); } }
            pg8::gemm_phase<EpiP2, MoeSched<4>, false, true, true>(F.lds, gp, Sc, E, F.tid); }
        GRID_BAR(); }
        if (((DUP_MASK >> 17) & 1) && l == 0) { combine_phase(F, l, xsrc, false, true); GRID_BAR(); }
        combine_phase(F, l, xsrc, l == DEPTH - 1); GRID_BAR();
    }
}

extern "C" void kernel_launch(void* const* d_in, const int* in_sizes, int n_in, void* d_out, int out_size, void* d_ws, size_t ws_size, hipStream_t stream) {
    static int grid = 0;
    if (grid == 0) {
        if (n_in != 23 || out_size != M * D || ws_size < WS_END2) { fprintf(stderr, "kernel_launch: unexpected shapes (n_in %d out %d ws %zu)\n", n_in, out_size, ws_size); grid = -1; return; }
        int dev = 0, cus = 0, per_cu = 0;
        (void)hipGetDevice(&dev);
        (void)hipDeviceGetAttribute(&cus, hipDeviceAttributeMultiprocessorCount, dev);
        (void)hipFuncSetAttribute((const void*)fwd_kernel, hipFuncAttributeMaxDynamicSharedMemorySize, LDS_BYTES);
        (void)hipOccupancyMaxActiveBlocksPerMultiprocessor(&per_cu, (const void*)fwd_kernel, NTHREADS, LDS_BYTES);
        if (per_cu < 1) { fprintf(stderr, "kernel_launch: occupancy query says %d blocks/CU\n", per_cu); per_cu = 1; }
        grid = cus;
    }
    if (grid < 0) return;
    (void)hipMemsetAsync((char*)d_ws + WS_CTL, 0, CTL_ZERO_BYTES, stream);
    Args a{};
    for (int i = 0; i < 23; ++i) a.in[i] = (const float*)d_in[i];
    a.out = (float*)d_out; a.ws = (unsigned char*)d_ws;
    void* kargs[] = {&a};
    hipError_t e = hipLaunchCooperativeKernel((const void*)fwd_kernel, dim3(grid), dim3(NTHREADS), kargs, LDS_BYTES, stream);
    if (e != hipSuccess) fprintf(stderr, "cooperative launch failed: %s (grid %d)\n", hipGetErrorString(e), grid);
}
```

```cpp
#include <hip/hip_runtime.h>
#include <hip/hip_cooperative_groups.h>
#include <cstdio>
#include <cstdint>
namespace cg = cooperative_groups;
#define DUP_MASK 0
__device__ __forceinline__ int hw_lane() { int x; asm volatile("v_mbcnt_lo_u32_b32 %0, -1, 0\n\tv_mbcnt_hi_u32_b32 %0, -1, %0" : "=v"(x)); return x; }
typedef float ozf4_t __attribute__((ext_vector_type(4)));
typedef float ozf16_t __attribute__((ext_vector_type(16)));
__device__ __forceinline__ float ozero() { float z; asm volatile("v_mov_b32 %0, 0" : "=v"(z)); return z; }
__device__ __forceinline__ ozf4_t ozero4() { const float z = ozero(); return (ozf4_t){z, z, z, z}; }
__device__ __forceinline__ ozf16_t ozero16() { const float z = ozero(); return (ozf16_t){z, z, z, z, z, z, z, z, z, z, z, z, z, z, z, z}; }
__device__ __forceinline__ float lshfl(float x, int srclane) { return __builtin_bit_cast(float, __builtin_amdgcn_ds_bpermute(srclane << 2, __builtin_bit_cast(int, x))); }
__device__ __forceinline__ float qxor1(float x) { return __builtin_bit_cast(float, __builtin_amdgcn_mov_dpp(__builtin_bit_cast(int, x), 0xB1, 0xf, 0xf, true)); }
__device__ __forceinline__ float qxor2(float x) { return __builtin_bit_cast(float, __builtin_amdgcn_mov_dpp(__builtin_bit_cast(int, x), 0x4E, 0xf, 0xf, true)); }
__device__ __forceinline__ float hmirror(float x) { return __builtin_bit_cast(float, __builtin_amdgcn_mov_dpp(__builtin_bit_cast(int, x), 0x141, 0xf, 0xf, true)); }
namespace pg8 {
#define PG8_LAS __attribute__((address_space(3)))
typedef unsigned short bf16_t;
typedef short bf16x8 __attribute__((ext_vector_type(8)));
typedef float f32x4 __attribute__((ext_vector_type(4)));
typedef unsigned u32x4 __attribute__((ext_vector_type(4)));
constexpr int BM = 256, BK = 64, HALF = 128, HTB = HALF * BK * 2  , STAGE_BYTES = 8 * HTB, NXCD = 8, WGM = 8;

__host__ __device__ __forceinline__ int lds_byte(int r, int c) { const int st = (r >> 4) * 2 + (c >> 5), rr = r & 15, cc = c & 31, ob = rr * 64 + cc * 2; return st * 1024 + (ob ^ (((ob >> 9) & 1) << 5)); }
__host__ __device__ __forceinline__ void stage_rc(int b, int& R, int& C) { const int st = b / 1024, sb = b % 1024, swz = sb ^ (((sb >> 9) & 1) << 5); R = (st >> 1) * 16 + swz / 64; C = (st & 1) * 32 + (swz % 64) / 2; }
__host__ __device__ __forceinline__ int perm32(int rho) { const int n = rho >> 4, i = rho & 15; return 8 * (i >> 2) + 4 * n + (i & 3); }

struct Unit { int pm, pn; };
struct Gemm { const bf16_t* A; const bf16_t* Bt; int M, N, K; int nt_probe = 0; };

struct StaticOrder {
    int nM, nN, nwg, G, c;
    __host__ __device__ void init(int M, int N, int G_, int c_) { nM = M / BM; nN = N / BM; nwg = nM * nN; G = G_; c = c_; }
    __host__ __device__ bool next(int i, Unit& u) const {
        const long L = (long)i * G + c; if (L >= nwg) return false;
        int wgid = (int)L; { const int q = nwg / NXCD, r = nwg % NXCD, xcd = wgid % NXCD, off = wgid / NXCD; wgid = (xcd < r ? xcd * (q + 1) : r * (q + 1) + (xcd - r) * q) + off; }
        const int nig = WGM * nN, gid = wgid / nig, fm = gid * WGM, gsz = (nM - fm) < WGM ? (nM - fm) : WGM;
        u.pm = fm + ((wgid % nig) % gsz); u.pn = (wgid % nig) / gsz; return true;
    }
    __device__ __forceinline__ void a_ready(const Unit&) const {}
    __device__ __forceinline__ void done(const Unit&) const {}
};

__device__ __forceinline__ unsigned cvt_pk_bf16(float lo, float hi) { unsigned r; asm volatile("v_cvt_pk_bf16_f32 %0, %1, %2" : "=v"(r) : "v"(lo), "v"(hi)); return r; }
__device__ __forceinline__ void glds16s(const void* sbase, unsigned voff, unsigned lds_dst) { unsigned keep;
    asm volatile("s_mov_b32 %0, m0\n\ts_mov_b32 m0, %3\n\ts_nop 0\n\tglobal_load_lds_dwordx4 %1, %2\n\ts_mov_b32 m0, %0" : "=&s"(keep) : "v"(voff), "s"(sbase), "s"(lds_dst) : "memory"); }
typedef int v8i_t __attribute__((ext_vector_type(8)));
typedef int v4i_t __attribute__((ext_vector_type(4)));
template <class T, class = void> struct epi_bias_init { static constexpr bool value = false; };
template <class T> struct epi_bias_init<T, decltype((void)T::BIAS_INIT)> { static constexpr bool value = T::BIAS_INIT; };
template <class T, class = void> struct epi_nstore { static constexpr int value = 0; };
template <class T> struct epi_nstore<T, decltype((void)T::NSTORE)> { static constexpr int value = T::NSTORE; };
template <class T, class = void> struct epi_gather { static constexpr bool value = false; };
template <class T> struct epi_gather<T, decltype((void)T::GATHER_A)> { static constexpr bool value = T::GATHER_A; };
template <class Epi, class Sched, bool ALIGN_EPI = false, bool SP2 = false, bool FP8 = false>
__device__ __forceinline__ void gemm_phase(PG8_LAS unsigned char* lds, const Gemm g, const Sched& S, const Epi& E, const int tid) {
    const int wid = __builtin_amdgcn_readfirstlane(tid >> 6), lane = tid & 63, wr = wid >> 2, wc = wid & 3, fr = lane & 15, fq = lane >> 4;
    const int K = g.K, nt = (DUP_MASK != 0 && g.nt_probe) ? g.nt_probe : K / BK;
    unsigned voffA[2], voffB[2];
#pragma unroll
    for (int i = 0; i < 2; ++i) { int R, C; stage_rc(tid * 16 + i * 8192, R, C); const int Rb = Epi::PERM ? ((R & ~31) + perm32(R & 31)) : R;
        voffA[i] = (unsigned)(R * K + C) * 2u; voffB[i] = (unsigned)(Rb * K + C) * 2u; }
    const size_t kstep = (size_t)(BK * 2);
    const size_t hstep = (size_t)HALF * K * 2;
    const size_t tstep = 2 * hstep;
    const unsigned ldsw = (unsigned)wid * 1024u, ldsbase = (unsigned)(uintptr_t)lds;
    const int aoff0 = lds_byte(wr * 64 + fr, fq * 8), aoff1 = aoff0 + 1024;
    const int boff0 = lds_byte(wc * 32 + fr, fq * 8), boff1 = boff0 + 1024;
#define PG8_SA(b, h) (((b) * 2 + (h)) * HTB)
#define PG8_SB(b, h) ((4 + (b) * 2 + (h)) * HTB)
#define PG8_STAGE(bufoff, gbase, voff) do { _Pragma("unroll") for (int _i = 0; _i < 2; ++_i) \
        glds16s((const void*)(gbase), (voff)[_i], (unsigned)__builtin_amdgcn_readfirstlane((int)(ldsbase + (bufoff) + ldsw + _i * 8192))); } while (0)
#define PG8_LDA(dst, b, h) do { _Pragma("unroll") for (int m = 0; m < 4; ++m) { if constexpr (FP8) { \
        const v4i_t lo_ = *(const PG8_LAS v4i_t*)(lds + PG8_SA(b, h) + aoff0 + m * 2048), hi_ = *(const PG8_LAS v4i_t*)(lds + PG8_SA(b, h) + aoff1 + m * 2048); dst##8[m] = __builtin_shufflevector(lo_, hi_, 0, 1, 2, 3, 4, 5, 6, 7); } \
        else { dst[m][0] = *(const PG8_LAS bf16x8*)(lds + PG8_SA(b, h) + aoff0 + m * 2048); dst[m][1] = *(const PG8_LAS bf16x8*)(lds + PG8_SA(b, h) + aoff1 + m * 2048); } } } while (0)
#define PG8_LDB(dst, b, h) do { _Pragma("unroll") for (int n = 0; n < 2; ++n) { if constexpr (FP8) { \
        const v4i_t lo_ = *(const PG8_LAS v4i_t*)(lds + PG8_SB(b, h) + boff0 + n * 2048), hi_ = *(const PG8_LAS v4i_t*)(lds + PG8_SB(b, h) + boff1 + n * 2048); dst##8[n] = __builtin_shufflevector(lo_, hi_, 0, 1, 2, 3, 4, 5, 6, 7); } \
        else { dst[n][0] = *(const PG8_LAS bf16x8*)(lds + PG8_SB(b, h) + boff0 + n * 2048); dst[n][1] = *(const PG8_LAS bf16x8*)(lds + PG8_SB(b, h) + boff1 + n * 2048); } } } while (0)
#define PG8_MMA(ai, bj, At, Bt) do { __builtin_amdgcn_s_setprio(1); _Pragma("unroll") for (int m = 0; m < 4; ++m) _Pragma("unroll") for (int n = 0; n < 2; ++n) { \
        if constexpr (FP8) { asm volatile("v_mfma_scale_f32_16x16x128_f8f6f4 %0, %1, %2, %0, %3, %4 op_sel_hi:[0,0,0]" : "+v"(acc[ai][bj][m][n]) : "v"(Bt##8[n]), "v"(At##8[m]), "v"(sclW), "v"(sclX)); } \
        else { _Pragma("unroll") for (int k = 0; k < 2; ++k) acc[ai][bj][m][n] = __builtin_amdgcn_mfma_f32_16x16x32_bf16(Bt[n][k], At[m][k], acc[ai][bj][m][n], 0, 0, 0); } } __builtin_amdgcn_s_setprio(0); } while (0)
#define PG8_WAIT_V(n) asm volatile("s_waitcnt vmcnt(" #n ")" ::: "memory")
#define PG8_WAIT_VN(n) asm volatile("s_waitcnt vmcnt(%0)" :: "n"(n) : "memory")
#define PG8_WAIT_L(n) asm volatile("s_waitcnt lgkmcnt(" #n ")" ::: "memory")
#define PG8_BAR __builtin_amdgcn_s_barrier()
#define PG8_SCHED __builtin_amdgcn_sched_barrier(0)
    Unit cur, nxt; int ui = 0;
    if (!S.next(0, cur)) return;
    const int sclW = 0x7a7a7a7a, sclX = 0x7f7f7f7f;
    cur.pm = __builtin_amdgcn_readfirstlane(cur.pm); cur.pn = __builtin_amdgcn_readfirstlane(cur.pn);
    f32x4 acc[2][2][4][2];
    constexpr int NST = epi_nstore<Epi>::value;
    f32x4 nb[4];
    if constexpr (epi_bias_init<Epi>::value) {
#pragma unroll
        for (int p = 0; p < 2; ++p) { Unit bu; const int bi = p * 8 + wid;
            if (S.next(bi, bu)) { *(PG8_LAS f32x4*)(lds + STAGE_BYTES + bi * 1024 + lane * 16) = *(const f32x4*)E.bias_src(bu, lane);
                if constexpr (epi_gather<Epi>::value) { if (bi < 14) *(PG8_LAS unsigned long long*)(lds + STAGE_BYTES + 9216 + bi * 512 + lane * 8) = *(const unsigned long long*)(E.rowsrc(bu) + lane * 4); } } }
        __syncthreads();
        E.load_bias(nb, (const PG8_LAS float*)(lds + STAGE_BYTES), wc, fq); E.set_bias(acc, nb); }
    else {
#pragma unroll
    for (int a = 0; a < 2; ++a)
#pragma unroll
        for (int b = 0; b < 2; ++b)
#pragma unroll
            for (int m = 0; m < 4; ++m)
#pragma unroll
                for (int n = 0; n < 2; ++n) acc[a][b][m][n] = ozero4();
    }
    bf16x8 At[4][2], B0[2][2], B1[2][2]; v8i_t At8[4], B08[2], B18[2];
    constexpr bool GA = epi_gather<Epi>::value;
    static_assert(!GA || (SP2 && epi_bias_init<Epi>::value), "gathered A rows: SP2 body with the LDS slot staging only");
    const char* cA = (const char*)g.A + (GA ? (size_t)0 : (size_t)cur.pm * tstep); const char* cB = (const char*)g.Bt + (size_t)cur.pn * tstep;
    unsigned vC[2][2], vN[2][2];
    auto ga_offsets = [&](int slot, unsigned (&v)[2][2]) {
        const PG8_LAS unsigned short* rm = (const PG8_LAS unsigned short*)(lds + STAGE_BYTES + 9216 + slot * 512);
#pragma unroll
        for (int i = 0; i < 2; ++i) { int R, C; stage_rc(tid * 16 + i * 8192, R, C);
#pragma unroll
            for (int h = 0; h < 2; ++h) v[h][i] = ((unsigned)rm[h * 128 + R] & 16383u) * (unsigned)(K * 2) + (unsigned)C * 2u; } };
    if constexpr (GA) { ga_offsets(0, vC); vN[0][0] = vC[0][0]; vN[0][1] = vC[0][1]; vN[1][0] = vC[1][0]; vN[1][1] = vC[1][1]; }
#define PG8_STAGE_A(bufoff, gbase, h, nx) do { if constexpr (GA) { unsigned vv_[2] = {(nx) ? vN[h][0] : vC[h][0], (nx) ? vN[h][1] : vC[h][1]}; PG8_STAGE(bufoff, gbase, vv_); } \
        else PG8_STAGE(bufoff, (gbase) + ((h) ? hstep : (size_t)0), voffA); } while (0)
    S.a_ready(cur);
    if constexpr (SP2) {
        PG8_STAGE(PG8_SB(0, 0), cB, voffB); PG8_STAGE(PG8_SB(0, 1), cB + hstep, voffB); PG8_STAGE_A(PG8_SA(0, 0), cA, 0, false); PG8_STAGE_A(PG8_SA(0, 1), cA, 1, false);
        if (wr == 1) PG8_BAR;
        PG8_WAIT_V(2); PG8_BAR;
        PG8_STAGE(PG8_SB(1, 0), cB + kstep, voffB); PG8_STAGE_A(PG8_SA(1, 0), cA + kstep, 0, false); PG8_STAGE(PG8_SB(1, 1), cB + hstep + kstep, voffB);
        PG8_WAIT_V(6); PG8_BAR;
    } else {
        PG8_STAGE(PG8_SB(0, 0), cB, voffB); PG8_STAGE(PG8_SA(0, 0), cA, voffA); PG8_STAGE(PG8_SB(0, 1), cB + hstep, voffB); PG8_STAGE(PG8_SA(0, 1), cA + hstep, voffA);
        if (wr == 1) PG8_BAR;
        PG8_WAIT_V(4); PG8_BAR;
        PG8_STAGE(PG8_SB(1, 0), cB + kstep, voffB); PG8_STAGE(PG8_SA(1, 0), cA + kstep, voffA); PG8_STAGE(PG8_SB(1, 1), cB + hstep + kstep, voffB);
        PG8_WAIT_V(6); PG8_BAR;
    }
    for (;;) {
        const bool has_next = S.next(ui + 1, nxt);
        nxt.pm = __builtin_amdgcn_readfirstlane(nxt.pm); nxt.pn = __builtin_amdgcn_readfirstlane(nxt.pn);
        const char* nA = (has_next && !GA) ? (const char*)g.A + (size_t)nxt.pm * tstep : cA; const char* nB = has_next ? (const char*)g.Bt + (size_t)nxt.pn * tstep : cB;
        if constexpr (GA) { if (has_next) ga_offsets(ui + 1, vN); }
        for (int t = 0; t < nt; t += 2) {
            const bool last = (t == nt - 2);
            const bool rl = NST > 0 && t == 0 && ui > 0;
            const char* a1 = cA + (size_t)(t + 1) * kstep;
            const char* a2 = last ? nA : cA + (size_t)(t + 2) * kstep; const char* b2 = last ? nB : cB + (size_t)(t + 2) * kstep;
            const char* a3 = a2 + kstep; const char* b3 = b2 + kstep;
            if (last && has_next) S.a_ready(nxt);
            if constexpr (SP2) {
            PG8_LDB(B0, 0, 0); PG8_LDB(B1, 0, 1); PG8_SCHED; PG8_LDA(At, 0, 0); PG8_STAGE_A(PG8_SA(1, 1), a1, 1, false);
            if (rl) PG8_WAIT_VN(NST + 2); else PG8_WAIT_V(8);
            PG8_WAIT_L(0); PG8_BAR; PG8_MMA(0, 0, At, B0); PG8_MMA(0, 1, At, B1); PG8_BAR; PG8_SCHED;
            PG8_LDA(At, 0, 1); PG8_STAGE(PG8_SB(0, 0), b2, voffB); PG8_STAGE(PG8_SB(0, 1), b2 + hstep, voffB); PG8_STAGE_A(PG8_SA(0, 0), a2, 0, last);
            if (rl) PG8_WAIT_VN(NST + 8); else PG8_WAIT_V(8);
            PG8_WAIT_L(0); PG8_BAR; PG8_MMA(1, 0, At, B0); PG8_MMA(1, 1, At, B1); PG8_BAR; PG8_SCHED;
            PG8_LDB(B0, 1, 0); PG8_LDB(B1, 1, 1); PG8_SCHED; PG8_LDA(At, 1, 0); PG8_STAGE_A(PG8_SA(0, 1), a2, 1, last);
            if (rl) PG8_WAIT_VN(NST + 10); else PG8_WAIT_V(8);
            PG8_WAIT_L(0); PG8_BAR; PG8_MMA(0, 0, At, B0); PG8_MMA(0, 1, At, B1); PG8_BAR; PG8_SCHED;
            PG8_LDA(At, 1, 1); PG8_STAGE(PG8_SB(1, 0), b3, voffB); PG8_STAGE(PG8_SB(1, 1), b3 + hstep, voffB); PG8_STAGE_A(PG8_SA(1, 0), a3, 0, last);
            PG8_WAIT_V(8); PG8_WAIT_L(0); PG8_BAR; PG8_MMA(1, 0, At, B0); PG8_MMA(1, 1, At, B1); PG8_BAR; PG8_SCHED;
            } else {
            PG8_LDB(B0, 0, 0); PG8_SCHED; PG8_LDA(At, 0, 0); PG8_STAGE(PG8_SA(1, 1), a1 + hstep, voffA);
            PG8_WAIT_L(8); PG8_BAR; PG8_WAIT_L(0); PG8_MMA(0, 0, At, B0); PG8_BAR; PG8_SCHED;
            PG8_LDB(B1, 0, 1); PG8_STAGE(PG8_SB(0, 0), b2, voffB);
            PG8_BAR; PG8_WAIT_L(0); PG8_MMA(0, 1, At, B1); PG8_BAR;
            PG8_LDA(At, 0, 1); PG8_STAGE(PG8_SA(0, 0), a2, voffA);
            PG8_BAR; PG8_WAIT_L(0); PG8_MMA(1, 0, At, B0); PG8_BAR; PG8_SCHED;
            PG8_STAGE(PG8_SB(0, 1), b2 + hstep, voffB);
            PG8_WAIT_V(6); PG8_BAR; PG8_MMA(1, 1, At, B1); PG8_BAR;
            PG8_LDB(B0, 1, 0); PG8_SCHED; PG8_LDA(At, 1, 0); PG8_STAGE(PG8_SA(0, 1), a2 + hstep, voffA);
            PG8_WAIT_L(8); PG8_BAR; PG8_WAIT_L(0); PG8_MMA(0, 0, At, B0); PG8_BAR; PG8_SCHED;
            PG8_LDB(B1, 1, 1); PG8_STAGE(PG8_SB(1, 0), b3, voffB);
            PG8_BAR; PG8_WAIT_L(0); PG8_MMA(0, 1, At, B1); PG8_BAR;
            PG8_LDA(At, 1, 1); PG8_STAGE(PG8_SA(1, 0), a3, voffA);
            PG8_BAR; PG8_WAIT_L(0); PG8_MMA(1, 0, At, B0); PG8_BAR; PG8_SCHED;
            PG8_STAGE(PG8_SB(1, 1), b3 + hstep, voffB);
            PG8_WAIT_V(6); PG8_BAR; PG8_MMA(1, 1, At, B1); PG8_BAR;
            }
        }
        if constexpr (FP8) asm volatile("s_nop 15\n\ts_nop 15" ::: "memory");
        if constexpr (ALIGN_EPI) { if (wr == 0) PG8_BAR; }
        if constexpr (epi_bias_init<Epi>::value) { if (has_next) E.load_bias(nb, (const PG8_LAS float*)(lds + STAGE_BYTES + (ui + 1) * 1024), wc, hw_lane() >> 4); }
        if constexpr (!Epi::AFTER_DRAIN) { const int el = hw_lane(); E(acc, cur, wr, wc, el & 15, el >> 4); S.done(cur); }
        if (!has_next) break;
        if constexpr (epi_bias_init<Epi>::value) E.set_bias(acc, nb);
        else {
#pragma unroll
        for (int a = 0; a < 2; ++a)
#pragma unroll
            for (int b = 0; b < 2; ++b)
#pragma unroll
                for (int m = 0; m < 4; ++m)
#pragma unroll
                    for (int n = 0; n < 2; ++n) acc[a][b][m][n] = ozero4();
        }
        cur = nxt; cA = nA; cB = nB; ++ui;
        if constexpr (GA) { vC[0][0] = vN[0][0]; vC[0][1] = vN[0][1]; vC[1][0] = vN[1][0]; vC[1][1] = vN[1][1]; }
        if constexpr (ALIGN_EPI) { if (wr == 1) PG8_BAR; }
    }
    PG8_WAIT_V(0);
    if constexpr (!ALIGN_EPI) { if (wr == 0) PG8_BAR; }
    PG8_BAR;
    if constexpr (Epi::AFTER_DRAIN) { E.fused(acc, cur, wr, wc, fr, fq, lds, wid, lane); S.done(cur); }
#undef PG8_SA
#undef PG8_SB
#undef PG8_STAGE
#undef PG8_STAGE_A
#undef PG8_LDA
#undef PG8_LDB
#undef PG8_MMA
#undef PG8_WAIT_V
#undef PG8_WAIT_L
#undef PG8_BAR
#undef PG8_SCHED
}
}
typedef float f32x4 __attribute__((ext_vector_type(4)));
#define LAS __attribute__((address_space(3)))

namespace f8 {
typedef int v8i_t __attribute__((ext_vector_type(8)));
typedef int v4i_t __attribute__((ext_vector_type(4)));
constexpr int STG = 49152;
struct Gemm { const unsigned char* A; const unsigned char* Bt; int K; };
template <class Epi, class Sched>
__device__ __forceinline__ void gemm_phase(LAS unsigned char* lds, const Gemm g, const Sched& S, const Epi& E, const int tid) {
    const int wid = __builtin_amdgcn_readfirstlane(tid >> 6), lane = tid & 63, wr = wid >> 1, wc = wid & 1, fr = lane & 15, fq = lane >> 4;
    const int K = g.K, nt = K >> 7;
    unsigned voff[2];
#pragma unroll
    for (int i = 0; i < 2; ++i) { int R, C; pg8::stage_rc(tid * 16 + i * 8192, R, C); voff[i] = (unsigned)(R * K + C * 2); }
    const unsigned ldsbase = (unsigned)(uintptr_t)lds, ldsw = (unsigned)wid * 1024u;
    const int aoff0 = (wr >> 1) * 16384 + pg8::lds_byte((wr & 1) * 64 + fr, fq * 16), aoff1 = (wr >> 1) * 16384 + pg8::lds_byte((wr & 1) * 64 + fr, fq * 16 + 8);
    const int boff0 = 32768 + pg8::lds_byte(wc * 64 + fr, fq * 16), boff1 = 32768 + pg8::lds_byte(wc * 64 + fr, fq * 16 + 8);
#define F8_STAGE(s, pa, pb, kt) do { const size_t ko_ = (size_t)(kt) * 128; _Pragma("unroll") for (int _i = 0; _i < 2; ++_i) { \
        pg8::glds16s((const void*)((pa) + ko_), voff[_i], (unsigned)__builtin_amdgcn_readfirstlane((int)(ldsbase + (s) * STG + ldsw + _i * 8192))); \
        pg8::glds16s((const void*)((pa) + (size_t)128 * K + ko_), voff[_i], (unsigned)__builtin_amdgcn_readfirstlane((int)(ldsbase + (s) * STG + 16384 + ldsw + _i * 8192))); \
        pg8::glds16s((const void*)((pb) + ko_), voff[_i], (unsigned)__builtin_amdgcn_readfirstlane((int)(ldsbase + (s) * STG + 32768 + ldsw + _i * 8192))); } } while (0)
    pg8::Unit cur, nxt; int ui = 0;
    if (!S.next(0, cur)) return;
    cur.pm = __builtin_amdgcn_readfirstlane(cur.pm); cur.pn = __builtin_amdgcn_readfirstlane(cur.pn);
    const unsigned char* cA = g.A + (size_t)cur.pm * 256 * K; const unsigned char* cB = g.Bt + (size_t)cur.pn * 128 * K;
    bool has_next = S.next(1, nxt);
    nxt.pm = __builtin_amdgcn_readfirstlane(nxt.pm); nxt.pn = __builtin_amdgcn_readfirstlane(nxt.pn);
    const unsigned char* nA = has_next ? g.A + (size_t)nxt.pm * 256 * K : cA; const unsigned char* nB = has_next ? g.Bt + (size_t)nxt.pn * 128 * K : cB;
    F8_STAGE(0, cA, cB, 0);
    if (nt > 1) F8_STAGE(1, cA, cB, 1); else F8_STAGE(1, nA, nB, 0);
    asm volatile("s_waitcnt vmcnt(6)" ::: "memory"); __builtin_amdgcn_s_barrier(); asm volatile("" ::: "memory");
    int st = 0;
    for (;;) {
        f32x4 acc[4][4];
#pragma unroll
        for (int m = 0; m < 4; ++m)
#pragma unroll
            for (int n = 0; n < 4; ++n) acc[m][n] = ozero4();
        for (int t = 0; t < nt; ++t) {
            const int s2 = st >= 1 ? st - 1 : 2;
            if (t + 2 < nt) F8_STAGE(s2, cA, cB, t + 2); else F8_STAGE(s2, nA, nB, t + 2 - nt);
            v8i_t af[4], bfr[4];
            const LAS unsigned char* sb = lds + st * STG;
#pragma unroll
            for (int m = 0; m < 4; ++m) { const v4i_t lo_ = *(const LAS v4i_t*)(sb + aoff0 + m * 2048), hi_ = *(const LAS v4i_t*)(sb + aoff1 + m * 2048); af[m] = __builtin_shufflevector(lo_, hi_, 0, 1, 2, 3, 4, 5, 6, 7); }
#pragma unroll
            for (int n = 0; n < 4; ++n) { const v4i_t lo_ = *(const LAS v4i_t*)(sb + boff0 + n * 2048), hi_ = *(const LAS v4i_t*)(sb + boff1 + n * 2048); bfr[n] = __builtin_shufflevector(lo_, hi_, 0, 1, 2, 3, 4, 5, 6, 7); }
            asm volatile("s_waitcnt lgkmcnt(0)" ::: "memory"); __builtin_amdgcn_sched_barrier(0);
            __builtin_amdgcn_s_setprio(1);
#pragma unroll
            for (int m = 0; m < 4; ++m)
#pragma unroll
                for (int n = 0; n < 4; ++n) acc[m][n] = __builtin_amdgcn_mfma_scale_f32_16x16x128_f8f6f4(bfr[n], af[m], acc[m][n], 0, 0, 0, 0x7a7a7a7a, 0, 0x7f7f7f7f);
            __builtin_amdgcn_s_setprio(0);
            __builtin_amdgcn_sched_barrier(0);
            asm volatile("s_waitcnt vmcnt(6)" ::: "memory"); __builtin_amdgcn_s_barrier(); asm volatile("" ::: "memory");
            st = st == 2 ? 0 : st + 1;
        }
        E(acc, cur, wr, wc, fr, fq);
        if (!has_next) break;
        cur = nxt; cA = nA; cB = nB; ++ui;
        has_next = S.next(ui + 1, nxt);
        nxt.pm = __builtin_amdgcn_readfirstlane(nxt.pm); nxt.pn = __builtin_amdgcn_readfirstlane(nxt.pn);
        nA = has_next ? g.A + (size_t)nxt.pm * 256 * K : cA; nB = has_next ? g.Bt + (size_t)nxt.pn * 128 * K : cB;
    }
    asm volatile("s_waitcnt vmcnt(0)" ::: "memory"); __builtin_amdgcn_s_barrier(); asm volatile("" ::: "memory");
#undef F8_STAGE
}
constexpr int STGW = 65536;
template <class Epi, class Sched>
__device__ __forceinline__ void gemm_phase_w(LAS unsigned char* lds, const Gemm g, const Sched& S, const Epi& E, const int tid) {
    const int wid = __builtin_amdgcn_readfirstlane(tid >> 6), lane = tid & 63, wr = wid >> 1, wc = wid & 1, fr = lane & 15, fq = lane >> 4;
    const int K = g.K, nt = K >> 7;
    unsigned voff[2];
#pragma unroll
    for (int i = 0; i < 2; ++i) { int R, C; pg8::stage_rc(tid * 16 + i * 8192, R, C); voff[i] = (unsigned)(R * K + C * 2); }
    const unsigned ldsbase = (unsigned)(uintptr_t)lds, ldsw = (unsigned)wid * 1024u;
    const int aoff0 = (wr >> 1) * 16384 + pg8::lds_byte((wr & 1) * 64 + fr, fq * 16), aoff1 = (wr >> 1) * 16384 + pg8::lds_byte((wr & 1) * 64 + fr, fq * 16 + 8);
    const int boff0 = 32768 + wc * 16384 + pg8::lds_byte(fr, fq * 16), boff1 = 32768 + wc * 16384 + pg8::lds_byte(fr, fq * 16 + 8);
#define F8W_STAGE(s, pa, pb, kt) do { const size_t ko_ = (size_t)(kt) * 128; _Pragma("unroll") for (int _i = 0; _i < 2; ++_i) { \
        pg8::glds16s((const void*)((pa) + ko_), voff[_i], (unsigned)__builtin_amdgcn_readfirstlane((int)(ldsbase + (s) * STGW + ldsw + _i * 8192))); \
        pg8::glds16s((const void*)((pa) + (size_t)128 * K + ko_), voff[_i], (unsigned)__builtin_amdgcn_readfirstlane((int)(ldsbase + (s) * STGW + 16384 + ldsw + _i * 8192))); \
        pg8::glds16s((const void*)((pb) + ko_), voff[_i], (unsigned)__builtin_amdgcn_readfirstlane((int)(ldsbase + (s) * STGW + 32768 + ldsw + _i * 8192))); \
        pg8::glds16s((const void*)((pb) + (size_t)128 * K + ko_), voff[_i], (unsigned)__builtin_amdgcn_readfirstlane((int)(ldsbase + (s) * STGW + 49152 + ldsw + _i * 8192))); } } while (0)
    pg8::Unit cur, nxt; int ui = 0;
    if (!S.next(0, cur)) return;
    cur.pm = __builtin_amdgcn_readfirstlane(cur.pm); cur.pn = __builtin_amdgcn_readfirstlane(cur.pn);
    const unsigned char* cA = g.A + (size_t)cur.pm * 256 * K; const unsigned char* cB = g.Bt + (size_t)cur.pn * 256 * K;
    bool has_next = S.next(1, nxt);
    nxt.pm = __builtin_amdgcn_readfirstlane(nxt.pm); nxt.pn = __builtin_amdgcn_readfirstlane(nxt.pn);
    const unsigned char* nA = has_next ? g.A + (size_t)nxt.pm * 256 * K : cA; const unsigned char* nB = has_next ? g.Bt + (size_t)nxt.pn * 256 * K : cB;
    F8W_STAGE(0, cA, cB, 0);
    asm volatile("s_waitcnt vmcnt(0)" ::: "memory"); __builtin_amdgcn_s_barrier(); asm volatile("" ::: "memory");
    int st = 0;
    for (;;) {
        f32x4 acc[4][8];
#pragma unroll
        for (int m = 0; m < 4; ++m)
#pragma unroll
            for (int n = 0; n < 8; ++n) acc[m][n] = ozero4();
        for (int t = 0; t < nt; ++t) {
            if (t + 1 < nt) F8W_STAGE(st ^ 1, cA, cB, t + 1); else F8W_STAGE(st ^ 1, nA, nB, 0);
            v8i_t af[4];
            const LAS unsigned char* sb = lds + st * STGW;
#pragma unroll
            for (int m = 0; m < 4; ++m) { const v4i_t lo_ = *(const LAS v4i_t*)(sb + aoff0 + m * 2048), hi_ = *(const LAS v4i_t*)(sb + aoff1 + m * 2048); af[m] = __builtin_shufflevector(lo_, hi_, 0, 1, 2, 3, 4, 5, 6, 7); }
#pragma unroll
            for (int h2 = 0; h2 < 4; ++h2) {
                v8i_t bfr[2];
#pragma unroll
                for (int n = 0; n < 2; ++n) { const v4i_t lo_ = *(const LAS v4i_t*)(sb + boff0 + (2 * h2 + n) * 2048), hi_ = *(const LAS v4i_t*)(sb + boff1 + (2 * h2 + n) * 2048); bfr[n] = __builtin_shufflevector(lo_, hi_, 0, 1, 2, 3, 4, 5, 6, 7); }
                asm volatile("s_waitcnt lgkmcnt(0)" ::: "memory"); __builtin_amdgcn_sched_barrier(0);
                __builtin_amdgcn_s_setprio(1);
#pragma unroll
                for (int m = 0; m < 4; ++m)
#pragma unroll
                    for (int n = 0; n < 2; ++n) acc[m][2 * h2 + n] = __builtin_amdgcn_mfma_scale_f32_16x16x128_f8f6f4(bfr[n], af[m], acc[m][2 * h2 + n], 0, 0, 0, 0x7a7a7a7a, 0, 0x7f7f7f7f);
                __builtin_amdgcn_s_setprio(0);
                __builtin_amdgcn_sched_barrier(0);
            }
            asm volatile("s_waitcnt vmcnt(0)" ::: "memory"); __builtin_amdgcn_s_barrier(); asm volatile("" ::: "memory");
            st ^= 1;
        }
        E(acc, cur, wr, wc, fr, fq);
        if (!has_next) break;
        cur = nxt; cA = nA; cB = nB; ++ui;
        has_next = S.next(ui + 1, nxt);
        nxt.pm = __builtin_amdgcn_readfirstlane(nxt.pm); nxt.pn = __builtin_amdgcn_readfirstlane(nxt.pn);
        nA = has_next ? g.A + (size_t)nxt.pm * 256 * K : cA; nB = has_next ? g.Bt + (size_t)nxt.pn * 256 * K : cB;
    }
    asm volatile("s_waitcnt vmcnt(0)" ::: "memory"); __builtin_amdgcn_s_barrier(); asm volatile("" ::: "memory");
#undef F8W_STAGE
}
}

#define GAS __attribute__((address_space(1)))
#define LAS __attribute__((address_space(3)))
typedef unsigned short bf16;
typedef float f32x4 __attribute__((ext_vector_type(4)));
typedef float f32x2 __attribute__((ext_vector_type(2)));
typedef unsigned u32x4 __attribute__((ext_vector_type(4)));
typedef unsigned u32x2 __attribute__((ext_vector_type(2)));
typedef int i32x4r __attribute__((ext_vector_type(4)));
typedef short bf16x8 __attribute__((ext_vector_type(8)));
typedef GAS unsigned gu32;

constexpr int NTHREADS = 512, NWAVES = 8;
constexpr int D = 1024, NB = 8, S = 2048, M = NB * S, DEPTH = 2;
constexpr int D_IN = 7120, NV = 7168;
constexpr int NE = 32, TOPK = 4, NPAIR = M * TOPK, MP = NPAIR + NE * 256;
constexpr float EPS = 1e-6f;
enum { I_X = 0, I_C, I_WADA, I_BADA, I_WIN, I_BIN, I_CONVW, I_CONVB, I_MLG, I_KVG, I_WUK, I_WUV, I_WBRML, I_WBRDSA, I_WBRFOX, I_WOUT, I_WR, I_BR, I_W1, I_B1, I_W2, I_B2, I_FG };

constexpr size_t MiB = 1u << 20;
constexpr size_t WS_CTL = 0, CTL_ZERO_BYTES = 1 * MiB;
constexpr size_t WS_MOD = 1 * MiB;
constexpr size_t WS_BINP = 2 * MiB;
constexpr size_t WS_WRT = 3 * MiB;
constexpr size_t WS_EIDX = 4 * MiB, WS_GATE = WS_EIDX + 256 * 1024, WS_LRANK = WS_GATE + 256 * 1024, WS_PPOS = WS_LRANK + 256 * 1024, WS_BASE = WS_PPOS + 256 * 1024;
constexpr size_t WS_ROWGATE = 6 * MiB;
constexpr size_t WS_WOUT_T = 8 * MiB;
constexpr size_t WS_WBR_T = 12 * MiB;
constexpr size_t WS_WIN_T = 18 * MiB;
constexpr size_t WS_W1T = 48 * MiB;
constexpr size_t WS_W2T = 304 * MiB;
constexpr size_t WS_X = 432 * MiB;
constexpr size_t WS_XN = 496 * MiB;
constexpr size_t WS_XNL = 528 * MiB;
constexpr size_t WS_ASORT = 560 * MiB;
constexpr size_t WS_ACT = 704 * MiB;
constexpr size_t WS_END = 848 * MiB;
constexpr size_t WS_XN1_8_ = 1352 * MiB, WS_WIN8_ = 1368 * MiB, WS_WOUT8_ = 1400 * MiB;
constexpr size_t WS_XN8 = 1336 * MiB;
constexpr size_t WS_AS8 = WS_ACT, WS_ACT8 = WS_ACT + 72 * MiB;
constexpr size_t WS_DRY = 1208 * MiB;
constexpr int CW_GCNT = 64;
constexpr int CW_BAR = 4096;

constexpr int RING_BYTES = 147456;
constexpr int LDSCTL_OFF = RING_BYTES, MISC_OFF = LDSCTL_OFF + 320;
constexpr int LDS_BYTES = 163840;

__device__ __forceinline__ unsigned f2bf(float f) { unsigned u = __builtin_bit_cast(unsigned, f); return (u + 0x7fffu + ((u >> 16) & 1u)) >> 16; }
__device__ __forceinline__ float bf2f(unsigned b) { return __builtin_bit_cast(float, b << 16); }
__device__ __forceinline__ unsigned pk2(float lo, float hi) { return f2bf(lo) | (f2bf(hi) << 16); }
typedef _Float16 h2v_t __attribute__((ext_vector_type(2)));
__device__ __forceinline__ unsigned pkh2(float a, float b) { const h2v_t p = {(_Float16)a, (_Float16)b}; return __builtin_bit_cast(unsigned, p); }
__device__ __forceinline__ f32x4 unpkh4(unsigned w0, unsigned w1) { const h2v_t p = __builtin_bit_cast(h2v_t, w0), q = __builtin_bit_cast(h2v_t, w1); return (f32x4){(float)p[0], (float)p[1], (float)q[0], (float)q[1]}; }
__device__ __forceinline__ unsigned pk4_fp8(float a, float b, float c, float d) { int w = 0; w = __builtin_amdgcn_cvt_pk_fp8_f32(a, b, w, false); w = __builtin_amdgcn_cvt_pk_fp8_f32(c, d, w, true); return (unsigned)w; }
#define LDS_WAIT() asm volatile("s_waitcnt lgkmcnt(0)" ::: "memory")
#define VM_WAIT() asm volatile("s_waitcnt vmcnt(0)" ::: "memory")

#define XB_TMO      128
#define XB_XCNT(j)  (256  + 64 * (j))
#define XB_XSUB(j)  (1280 + 64 * (j))
#define XB_XGEN(j)  (2304 + 64 * (j))
#define XB_TOP      3328
#define XB_TOPGEN   3392
#define XCD_BAR_WORDS 3456
#define XB_SPIN_CAP (1u << 22)
__device__ __forceinline__ unsigned xb_ld(unsigned* p)              { return __hip_atomic_load(p, __ATOMIC_RELAXED, __HIP_MEMORY_SCOPE_AGENT); }
__device__ __forceinline__ unsigned xb_add(unsigned* p, unsigned v) { return __hip_atomic_fetch_add(p, v, __ATOMIC_RELAXED, __HIP_MEMORY_SCOPE_AGENT); }
__device__ __forceinline__ unsigned xb_xcc_id() { return (unsigned)__builtin_amdgcn_s_getreg((3 << 11) | 20) & 0xFu; }
#define XB_SPIN(cond, bar) do { unsigned _sp = 0; while (cond) { __builtin_amdgcn_s_sleep(1); \
    if ((++_sp & 255u) == 0u) { if (xb_ld(&(bar)[XB_TMO])) break; if (_sp > XB_SPIN_CAP) { atomicAdd(&(bar)[XB_TMO], 1u); break; } } } } while (0)
struct XcdBarrier { unsigned* bar; unsigned x; volatile LAS unsigned* st; bool t0; };
__device__ __forceinline__ XcdBarrier xcd_barrier_post(unsigned* bar, volatile LAS unsigned* st, bool t0) {
    XcdBarrier b; b.bar = bar; b.x = xb_xcc_id(); b.st = st; b.t0 = t0;
    if (t0) (void)xb_add(&bar[XB_XCNT(b.x)], 1u);
    return b;
}
__device__ __forceinline__ void xcd_barrier_complete(unsigned* bar, unsigned x, unsigned& nloc, unsigned& nx) {
    const unsigned G = gridDim.x * gridDim.y * gridDim.z;
    unsigned sum, cnt, mine, sp = 0u;
    for (;;) {
        sum = 0u; cnt = 0u; mine = 0u;
#pragma unroll
        for (unsigned j = 0; j < 16; ++j) { const unsigned c = xb_ld(&bar[XB_XCNT(j)]); sum += c; cnt += (c > 0u) ? 1u : 0u; mine = (j == x) ? c : mine; }
        if (sum == G) break;
        __builtin_amdgcn_s_sleep(1);
        if ((++sp & 255u) == 0u) { if (xb_ld(&bar[XB_TMO])) break; if (sp > XB_SPIN_CAP) { atomicAdd(&bar[XB_TMO], 1u); break; } }
    }
    nloc = mine > 0u ? mine : 1u; nx = cnt > 0u ? cnt : 1u;
}
__device__ __forceinline__ void xcd_barrier(const XcdBarrier& b) {
    asm volatile("s_waitcnt vmcnt(0)" ::: "memory");
    __syncthreads();
    if (b.t0) {
        unsigned* bar = b.bar;
        __builtin_amdgcn_s_waitcnt(0);
        unsigned nloc = b.st[0], nx = b.st[1];
        if (nloc == 0u) { xcd_barrier_complete(bar, b.x, nloc, nx); b.st[0] = nloc; b.st[1] = nx; }
        const unsigned old = xb_add(&bar[XB_XSUB(b.x)], 1u);
        const unsigned gen = old / nloc;
        if (old + 1u == (gen + 1u) * nloc) {
            __builtin_amdgcn_fence(__ATOMIC_RELEASE, "agent");
            asm volatile("s_waitcnt vmcnt(0)" ::: "memory");
            const unsigned og = xb_add(&bar[XB_TOP], 1u);
            const unsigned tg = og / nx;
            if (og + 1u == (tg + 1u) * nx) xb_add(&bar[XB_TOPGEN], 1u);
            else XB_SPIN(xb_ld(&bar[XB_TOPGEN]) == tg, bar);
            __builtin_amdgcn_fence(__ATOMIC_ACQUIRE, "agent");
            xb_add(&bar[XB_XGEN(b.x)], 1u);
            asm volatile("s_waitcnt vmcnt(0)" ::: "memory");
        } else {
            XB_SPIN(xb_ld(&bar[XB_XGEN(b.x)]) == gen, bar);
            __builtin_amdgcn_fence(__ATOMIC_ACQUIRE, "agent");
            asm volatile("s_waitcnt vmcnt(0)" ::: "memory");
        }
    }
    __syncthreads();
}

__device__ __forceinline__ float wave_sum(float v) {
    v += __builtin_bit_cast(float, __builtin_amdgcn_update_dpp(0, __builtin_bit_cast(int, v), 0x128, 0xf, 0xf, false));
    v += __builtin_bit_cast(float, __builtin_amdgcn_update_dpp(0, __builtin_bit_cast(int, v), 0x124, 0xf, 0xf, false));
    v += __builtin_bit_cast(float, __builtin_amdgcn_update_dpp(0, __builtin_bit_cast(int, v), 0x122, 0xf, 0xf, false));
    v += __builtin_bit_cast(float, __builtin_amdgcn_update_dpp(0, __builtin_bit_cast(int, v), 0x121, 0xf, 0xf, false));
    const int b = __builtin_bit_cast(int, v);
    return (__builtin_bit_cast(float, __builtin_amdgcn_readlane(b, 0)) + __builtin_bit_cast(float, __builtin_amdgcn_readlane(b, 16))) + (__builtin_bit_cast(float, __builtin_amdgcn_readlane(b, 32)) + __builtin_bit_cast(float, __builtin_amdgcn_readlane(b, 48)));
}

struct Args { const float* in[23]; float* out; unsigned char* ws; };
struct Frame { LAS unsigned char* lds; int tid, wave; };
#define KARGS ((const __attribute__((address_space(4))) Args*)__builtin_amdgcn_kernarg_segment_ptr())
#define KWS ((GAS unsigned char*)KARGS->ws)
#define KOUT ((GAS float*)KARGS->out)
#define KCTL ((GAS unsigned*)(KWS + WS_CTL))
#define GRIDN ((int)gridDim.x)
__device__ __forceinline__ int vcu_id() { const int G = gridDim.x, bx = blockIdx.x; return (G % 8 == 0) ? (bx % 8) * (G / 8) + bx / 8 : bx; }
#define WSP(T, off) ((T*)(KWS + (off)))
#define KIN(i) ((const float*)(((const __attribute__((address_space(4))) Args*)__builtin_amdgcn_kernarg_segment_ptr())->in[i]))
#define PHASE_BEGIN() do { asm volatile("" : "+s"(F.wave)); F.tid = F.wave * 64 + hw_lane(); } while (0)

__device__ __forceinline__ int vcol_real(int v) {
    if (v < 1536) return v;
    if (v < 2048) return -1;
    if (v < 2176) return 2056 + (v - 2048);
    if (v < 2240) return 2440 + (v - 2176);
    if (v < 2244) return 1536 + (v - 2240);
    if (v < 2248) return 1540 + (v - 2244);
    if (v < 2252) return 2504 + (v - 2248);
    if (v < 2256) return 4044 + (v - 2252);
    if (v < 2304) return -1;
    if (v < 2560) return 2184 + (v - 2304);
    if (v < 4096) return 2508 + (v - 2560);
    return 4048 + (v - 4096);
}
struct P0Item { const float* W; bf16* WT; int ldw, K, destrow0, k0, srccol4; bool valid, fp8; };
__device__ __forceinline__ void p0_load(const P0Item& d, f32x4 (&v)[8], int lane) {
    const int kr = lane >> 3;
#pragma unroll
    for (int i = 0; i < 8; ++i) v[i] = (d.valid && d.srccol4 >= 0) ? *(const f32x4*)(d.W + (size_t)(d.k0 + 8 * i + kr) * d.ldw + d.srccol4) : (f32x4){0.f, 0.f, 0.f, 0.f};
}
__device__ __forceinline__ void p0_finish(const P0Item& d, const f32x4 (&v)[8], LAS float* scr, int lane) {
    if (!d.valid) return;
    const int kr = lane >> 3, n4 = 4 * (lane & 7);
#pragma unroll
    for (int i = 0; i < 8; ++i) *(LAS f32x4*)(scr + (8 * i + kr) * 36 + n4) = v[i];
    LDS_WAIT(); asm volatile("" ::: "memory");
    const int c = lane & 7;
#pragma unroll
    for (int j = 0; j < 4; ++j) { const int n = (lane >> 3) + 8 * j; const LAS float* s = scr + (8 * c) * 36 + n;
        if (d.fp8) { u32x2 o; o.x = pk4_fp8(32.f * s[0 * 36], 32.f * s[1 * 36], 32.f * s[2 * 36], 32.f * s[3 * 36]); o.y = pk4_fp8(32.f * s[4 * 36], 32.f * s[5 * 36], 32.f * s[6 * 36], 32.f * s[7 * 36]);
            *(u32x2*)((unsigned char*)d.WT + (size_t)(d.destrow0 + n) * d.K + d.k0 + 8 * c) = o; }
        else { u32x4 o; o.x = pk2(s[0 * 36], s[1 * 36]); o.y = pk2(s[2 * 36], s[3 * 36]); o.z = pk2(s[4 * 36], s[5 * 36]); o.w = pk2(s[6 * 36], s[7 * 36]);
            *(u32x4*)(d.WT + (size_t)(d.destrow0 + n) * d.K + d.k0 + 8 * c) = o; } }
    LDS_WAIT(); asm volatile("" ::: "memory");
}
__device__ __forceinline__ void p0_moe_weights(Frame& F) {
    PHASE_BEGIN();
    const int tid = F.tid, lane = tid & 63, w = F.wave;
    constexpr int NI1 = 64 * 8 * 8, NI2 = 64 * 8 * 4;
    __syncthreads();
    int buf = 0;
#define P0M_DECODE(it_, is1_, le_, kt_, nb_, Wp_) const bool is1_ = (it_) < NI1; const int r_##it_ = is1_ ? (it_) : (it_) - NI1; \
        const int le_ = is1_ ? r_##it_ >> 6 : r_##it_ >> 5, kt_ = is1_ ? (r_##it_ >> 3) & 7 : (r_##it_ >> 2) & 7, nb_ = is1_ ? r_##it_ & 7 : r_##it_ & 3, ldw_##it_ = is1_ ? 2048 : 1024; \
        const float* Wp_ = (is1_ ? KIN(I_W1) + (size_t)le_ * 1024 * 2048 : KIN(I_W2) + (size_t)le_ * 1024 * 1024) + (size_t)(kt_ * 128 + 16 * w) * ldw_##it_ + nb_ * 256 + 4 * lane;
    f32x4 v[16], vn[16];
    volatile LAS int* pq = (volatile LAS int*)(F.lds + LDSCTL_OFF + 200);
    unsigned* phead = (unsigned*)KCTL + 1536;
    if (tid == 0) { pq[0] = (int)__hip_atomic_fetch_add(phead, 1u, __ATOMIC_RELAXED, __HIP_MEMORY_SCOPE_AGENT); pq[1] = (int)__hip_atomic_fetch_add(phead, 1u, __ATOMIC_RELAXED, __HIP_MEMORY_SCOPE_AGENT); }
    __syncthreads();
    int it = pq[0], itn = pq[1];
    { const int it0 = it; if (it0 < NI1 + NI2) { P0M_DECODE(it0, a_, b_, c_, d_, Wq)
#pragma unroll
        for (int i = 0; i < 16; ++i) v[i] = __builtin_nontemporal_load((const f32x4*)(Wq + (size_t)i * ldw_it0)); } }
    for (; it < NI1 + NI2; ) {
        P0M_DECODE(it, is1, le, kt, nb, W)
        (void)W;
        int popped = 0;
        if (tid == 0) popped = (int)__hip_atomic_fetch_add(phead, 1u, __ATOMIC_RELAXED, __HIP_MEMORY_SCOPE_AGENT);
        { if (itn < NI1 + NI2) { P0M_DECODE(itn, a_, b_, c_, d_, Wq)
#pragma unroll
            for (int i = 0; i < 16; ++i) vn[i] = __builtin_nontemporal_load((const f32x4*)(Wq + (size_t)i * ldw_itn)); } }
        LAS unsigned* T = (LAS unsigned*)(F.lds + buf * 32768);
#pragma unroll
        for (int g = 0; g < 4; ++g) {
            unsigned d[4];
#pragma unroll
            for (int q = 0; q < 4; ++q) d[q] = pk4_fp8(32.f * v[4 * g + q].x, 32.f * v[4 * g + q].y, 32.f * v[4 * g + q].z, 32.f * v[4 * g + q].w);
            const unsigned x0 = __builtin_amdgcn_perm(d[1], d[0], 0x05010400u), x1 = __builtin_amdgcn_perm(d[1], d[0], 0x07030602u), y0 = __builtin_amdgcn_perm(d[3], d[2], 0x05010400u), y1 = __builtin_amdgcn_perm(d[3], d[2], 0x07030602u);
            const unsigned t[4] = {__builtin_amdgcn_perm(y0, x0, 0x05040100u), __builtin_amdgcn_perm(y0, x0, 0x07060302u), __builtin_amdgcn_perm(y1, x1, 0x05040100u), __builtin_amdgcn_perm(y1, x1, 0x07060302u)};
#pragma unroll
            for (int c = 0; c < 4; ++c) T[(4 * lane + c) * 32 + ((4 * w + g) ^ (lane & 31))] = t[c];
        }
        if (tid == 0) pq[2 + (buf & 1)] = popped;
        __syncthreads();
        const int itnn = pq[2 + (buf & 1)];
        unsigned char* WT = is1 ? WSP(unsigned char, WS_W1T) + (size_t)le * 2048 * 1024 : WSP(unsigned char, WS_W2T) + (size_t)le * 1024 * 1024;
#pragma unroll
        for (int j = 0; j < 4; ++j) { const int n = (tid >> 3) + 64 * j, c8 = tid & 7, sw = (n >> 2) & 31;
            u32x4 o; o.x = T[n * 32 + ((4 * c8 + 0) ^ sw)]; o.y = T[n * 32 + ((4 * c8 + 1) ^ sw)]; o.z = T[n * 32 + ((4 * c8 + 2) ^ sw)]; o.w = T[n * 32 + ((4 * c8 + 3) ^ sw)];
            const int rc = nb * 256 + n; int vrow = rc;
            if (is1) { const int half = rc >> 10, c = rc & 1023; vrow = (c >> 7) * 256 + ((c >> 6) & 1) * 128 + ((c >> 2) & 15) * 8 + 4 * half + (c & 3); }
            __builtin_nontemporal_store(o, (u32x4*)(WT + (size_t)vrow * 1024 + kt * 128 + 16 * c8)); }
        buf ^= 1;
        it = itn; itn = itnn;
#pragma unroll
        for (int i = 0; i < 16; ++i) v[i] = vn[i];
    }
#undef P0M_DECODE
    __syncthreads();
}
__device__ __forceinline__ void p0_prologue(Frame& F) {
    PHASE_BEGIN();
    const int tid = F.tid, lane = (F.tid & 63);
    {
        LAS float* cond = (LAS float*)F.lds;
        LAS float* part = (LAS float*)(F.lds + 32768);
        bool staged = false;
        for (int it = blockIdx.x; it < 2 * 96; it += GRIDN) {
            if (!staged) { for (int i = tid; i < 8 * 1024; i += NTHREADS) { const float v = KIN(I_C)[i]; cond[i] = v / (1.f + __expf(-v)); } staged = true; }
            __syncthreads();
            const int l = it / 96, cb = it % 96, ks = tid >> 4, c4 = (tid & 15) * 4, col = tid & 63, n = cb * 64 + col;
            const float* w = KIN(I_WADA) + (size_t)l * 1024 * 6144 + cb * 64 + c4;
            f32x4 a[8];
#pragma unroll
            for (int b = 0; b < 8; ++b) a[b] = (f32x4){0.f, 0.f, 0.f, 0.f};
#pragma unroll 8
            for (int k = ks * 32; k < ks * 32 + 32; ++k) { const f32x4 wv = *(const f32x4*)(w + (size_t)k * 6144);
#pragma unroll
                for (int b = 0; b < 8; ++b) a[b] += cond[b * 1024 + k] * wv; }
#pragma unroll
            for (int b = 0; b < 8; ++b) *(LAS f32x4*)(part + (ks * 8 + b) * 64 + c4) = a[b];
            __syncthreads();
            { const int b = tid >> 6; float s = 0.f;
#pragma unroll
              for (int q = 0; q < 32; ++q) s += part[(q * 8 + b) * 64 + col];
              WSP(float, WS_MOD)[((size_t)l * 8 + b) * 6144 + n] = s + KIN(I_BADA)[l * 6144 + n]; }
        }
        __syncthreads();
    }
    {
        LAS float* As = (LAS float*)F.lds;
        LAS float* Us = (LAS float*)(F.lds + 64 * 129 * 4);
        for (int it = blockIdx.x; it < 128; it += GRIDN) {
            const int l = it >> 6, h = (it >> 4) & 3, kb = it & 15, k0 = kb * 64;
            __syncthreads();
            for (int i = tid; i < 64 * 128; i += NTHREADS) { const int k = i >> 7, d = i & 127; As[k * 129 + d] = KIN(I_WIN)[((size_t)l * 1024 + k0 + k) * D_IN + 1544 + h * 128 + d]; }
            for (int i = tid; i < 128 * 128; i += NTHREADS) { const int c = i >> 7, d = i & 127; Us[c * 129 + d] = KIN(I_WUK)[(((size_t)l * 4 + h) * 128 + c) * 128 + d]; }
            __syncthreads();
            const int c = tid & 127, kq = tid >> 7; float a[16];
#pragma unroll
            for (int i = 0; i < 16; ++i) a[i] = 0.f;
            for (int d = 0; d < 128; ++d) { const float u = Us[c * 129 + d];
#pragma unroll
                for (int i = 0; i < 16; ++i) a[i] += u * As[(kq * 16 + i) * 129 + d]; }
            const float sc = 0.08838834764831845f;
            bf16* dst = WSP(bf16, WS_WIN_T) + ((size_t)l * NV + 1536 + h * 128 + c) * 1024 + k0 + kq * 16;
            u32x4 o0, o1; o0.x = pk2(a[0] * sc, a[1] * sc); o0.y = pk2(a[2] * sc, a[3] * sc); o0.z = pk2(a[4] * sc, a[5] * sc); o0.w = pk2(a[6] * sc, a[7] * sc);
            o1.x = pk2(a[8] * sc, a[9] * sc); o1.y = pk2(a[10] * sc, a[11] * sc); o1.z = pk2(a[12] * sc, a[13] * sc); o1.w = pk2(a[14] * sc, a[15] * sc);
            *(u32x4*)dst = o0; *(u32x4*)(dst + 8) = o1;
            if (kb == 0 && kq == 0) { float s = 0.f; for (int d = 0; d < 128; ++d) s += Us[c * 129 + d] * KIN(I_BIN)[l * D_IN + 1544 + h * 128 + d];
                WSP(float, WS_BINP)[l * NV + 1536 + h * 128 + c] = s * sc; }
        }
        __syncthreads();
    }
    {
        LAS float* Us = (LAS float*)F.lds;
        LAS float* Bs = (LAS float*)(F.lds + 128 * 129 * 4);
        for (int it = blockIdx.x; it < 128; it += GRIDN) {
            const int l = it >> 6, h = (it >> 4) & 3, nb = it & 15, n0 = nb * 64;
            __syncthreads();
            for (int i = tid; i < 128 * 128; i += NTHREADS) { const int c = i >> 7, d = i & 127; Us[c * 129 + d] = KIN(I_WUV)[(((size_t)l * 4 + h) * 128 + c) * 128 + d]; }
            for (int i = tid; i < 128 * 64; i += NTHREADS) { const int d = i >> 6, n = i & 63; Bs[d * 65 + n] = KIN(I_WBRDSA)[((size_t)l * 512 + h * 128 + d) * 1024 + n0 + n]; }
            __syncthreads();
            const int c = tid & 127, nq = tid >> 7; float a[16];
#pragma unroll
            for (int i = 0; i < 16; ++i) a[i] = 0.f;
            for (int d = 0; d < 128; ++d) { const float u = Us[c * 129 + d];
#pragma unroll
                for (int i = 0; i < 16; ++i) a[i] += u * Bs[d * 65 + nq * 16 + i]; }
#pragma unroll
            for (int i = 0; i < 16; ++i) WSP(bf16, WS_WBR_T)[((size_t)l * 3072 + 1024 + n0 + nq * 16 + i) * 512 + h * 128 + c] = (bf16)f2bf(a[i]);
        }
        __syncthreads();
    }
    for (int i = blockIdx.x * NTHREADS + tid; i < 2 * 32 * 1024; i += GRIDN * NTHREADS) { const int l = i >> 15, e = (i >> 10) & 31, k = i & 1023;
        const float w = KIN(I_WR)[((size_t)l * 1024 + k) * 32 + e];
        WSP(bf16, WS_WRT)[((size_t)l * 2 + 0) * 32768 + e * 1024 + k] = (bf16)__builtin_bit_cast(unsigned short, (_Float16)w); }
    for (int i = blockIdx.x * NTHREADS + tid; i < 2 * NV; i += GRIDN * NTHREADS) { const int l = i / NV, v = i % NV; const int r = vcol_real(v);
        if (!(v >= 1536 && v < 2048)) WSP(float, WS_BINP)[i] = r >= 0 ? KIN(I_BIN)[l * D_IN + r] : 0.f; }
    LAS float* scr = (LAS float*)(F.lds + F.wave * 16384);
    const int gw = vcu_id() * NWAVES + F.wave, NGW = GRIDN * NWAVES;
    constexpr int IT_IN = 16 * (NV / 32), IT_BR = 8 * 32, IT_OUT = 16 * 32;
    constexpr int N_IN = 2 * IT_IN, N_BR = 2 * 2 * IT_BR, N_OUT = 2 * IT_OUT;
    constexpr int IT_IN8 = 16 * (24 * 8), N_IN8 = 2 * IT_IN8;
    constexpr int N_ALL = N_IN + N_BR + N_OUT + N_IN8;
    auto decode = [&](int it) -> P0Item {
        P0Item d; d.fp8 = false; d.valid = it < N_ALL; d.W = nullptr; d.WT = nullptr; d.ldw = 0; d.K = 0; d.destrow0 = 0; d.k0 = 0; d.srccol4 = -1;
        if (!d.valid) return d;
        int r = it;
        if (r < N_IN) { const int l = r / IT_IN, q = r % IT_IN, kb = q / (NV / 32), nb = q % (NV / 32), v = nb * 32 + 4 * (lane & 7);
            if (nb < 48 || nb >= 80) { d.valid = false; return d; }
            if (nb * 32 >= 1536 && nb * 32 < 2048) { d.valid = false; return d; }
            d.W = KIN(I_WIN) + (size_t)l * 1024 * D_IN; d.ldw = D_IN; d.K = 1024; d.WT = WSP(bf16, WS_WIN_T) + (size_t)l * NV * 1024; d.destrow0 = nb * 32; d.k0 = kb * 64; d.srccol4 = vcol_real(v); return d; }
        r -= N_IN;
        if (r < N_BR) { const int l = r / (2 * IT_BR), q = r % (2 * IT_BR), which = q / IT_BR, q2 = q % IT_BR, kb = q2 / 32, nb = q2 % 32;
            d.W = (which ? KIN(I_WBRFOX) : KIN(I_WBRML)) + (size_t)l * 512 * 1024; d.ldw = 1024; d.K = 512; d.WT = WSP(bf16, WS_WBR_T) + (size_t)l * 3072 * 512; d.destrow0 = (which ? 2048 : 0) + nb * 32; d.k0 = kb * 64; d.srccol4 = nb * 32 + 4 * (lane & 7); return d; }
        r -= N_BR;
        if (r < N_OUT) { const int l = r / IT_OUT, q = r % IT_OUT, kb = q / 32, nb = q % 32;
            d.fp8 = true; d.W = KIN(I_WOUT) + (size_t)l * 1024 * 1024; d.ldw = 1024; d.K = 1024; d.WT = (bf16*)(WSP(unsigned char, WS_WOUT8_) + (size_t)l * 1024 * 1024); d.destrow0 = nb * 32; d.k0 = kb * 64; d.srccol4 = nb * 32 + 4 * (lane & 7); return d; }
        r -= N_OUT;
        if (r < N_IN8) { const int l = r / IT_IN8, q = r % IT_IN8, kb = q / 192, nv = q % 192, tv = nv >> 3, nb = (tv < 6 ? tv : tv + 4) * 8 + (nv & 7), v = nb * 32 + 4 * (lane & 7);
            d.fp8 = true; d.W = KIN(I_WIN) + (size_t)l * 1024 * D_IN; d.ldw = D_IN; d.K = 1024; d.WT = (bf16*)(WSP(unsigned char, WS_WIN8_) + (size_t)l * NV * 1024); d.destrow0 = nb * 32; d.k0 = kb * 64; d.srccol4 = vcol_real(v); return d; }
        d.valid = false; return d;
    };
    P0Item cur = decode(gw); f32x4 vc[8], vn[8]; p0_load(cur, vc, lane);
    for (int it = gw; it < N_ALL; it += NGW) {
        const P0Item nxt = decode(it + NGW); p0_load(nxt, vn, lane);
        p0_finish(cur, vc, scr, lane);
        cur = nxt;
#pragma unroll
        for (int i = 0; i < 8; ++i) vc[i] = vn[i];
    }
}

__device__ __forceinline__ void norm_rows(Frame& F, const float* xsrc, int l, int shoff, int scoff) {
    PHASE_BEGIN();
    const int gw = blockIdx.x * NWAVES + F.wave, lane = (F.tid & 63), c0 = 16 * lane, m0 = gw * 8;
    const float* mo = WSP(float, WS_MOD) + (size_t)l * 8 * 6144 + (size_t)(m0 >> 11) * 6144; bf16* XN = WSP(bf16, WS_XN);
    f32x4 sh[4], sc[4];
#pragma unroll
    for (int q = 0; q < 4; ++q) { sh[q] = *(const f32x4*)(mo + shoff + c0 + 4 * q); sc[q] = *(const f32x4*)(mo + scoff + c0 + 4 * q); }
    for (int t = 0; t < 8; ++t) {
        const int m = m0 + t;
        f32x4 v[4]; float s = 0.f;
#pragma unroll
        for (int q = 0; q < 4; ++q) { v[q] = *(const f32x4*)(xsrc + (size_t)m * D + c0 + 4 * q); s += (v[q].x * v[q].x + v[q].y * v[q].y) + (v[q].z * v[q].z + v[q].w * v[q].w); }
        const float r = 1.0f / sqrtf(wave_sum(s) * (1.0f / D) + EPS);
        unsigned wb[8], w8[4];
#pragma unroll
        for (int q = 0; q < 4; ++q) { const f32x4 h = v[q] * r * (1.0f + sc[q]) + sh[q]; wb[2 * q] = pk2(h.x, h.y); wb[2 * q + 1] = pk2(h.z, h.w); w8[q] = pk4_fp8(h.x, h.y, h.z, h.w); }
        *(u32x4*)(XN + (size_t)m * D + c0) = (u32x4){wb[0], wb[1], wb[2], wb[3]}; *(u32x4*)(XN + (size_t)m * D + c0 + 8) = (u32x4){wb[4], wb[5], wb[6], wb[7]};
        *(u32x4*)(WSP(unsigned char, WS_XN1_8_) + (size_t)m * D + c0) = (u32x4){w8[0], w8[1], w8[2], w8[3]};
    }
}
__device__ __forceinline__ void route_phase(Frame& F, int l, const float* xsrc, bool dry = false) {
    PHASE_BEGIN();
    LAS int* lcnt = (LAS int*)F.lds;
    LAS float* lg = (LAS float*)(F.lds + 1024);
    const int tid = F.tid, lane = (F.tid & 63), w = F.wave;
    if (tid < 32) lcnt[tid] = 0;
    const float* modl = WSP(float, WS_MOD) + (size_t)l * 8 * 6144;
    bf16* XN = dry ? WSP(bf16, WS_DRY) : WSP(bf16, WS_XN); bf16* XNL = dry ? WSP(bf16, WS_DRY + 32 * MiB) : WSP(bf16, WS_XNL);
    const bf16* WH = WSP(bf16, WS_WRT) + (size_t)l * 2 * 32768; const bf16* WL = WH + 32768;
    for (int rb = blockIdx.x; rb < M / 64; rb += GRIDN) {
        __syncthreads();
        {
            const int c0 = 16 * lane; const float* mo = modl + (size_t)((rb * 64) >> 11) * 6144;
            f32x4 sh[4], sc[4];
#pragma unroll
            for (int q = 0; q < 4; ++q) { sh[q] = *(const f32x4*)(mo + 3072 + c0 + 4 * q); sc[q] = *(const f32x4*)(mo + 4096 + c0 + 4 * q); }
            unsigned char* XN8 = dry ? WSP(unsigned char, WS_DRY + 100 * MiB) : WSP(unsigned char, WS_XN8);
            for (int i0 = 0; i0 < 8; i0 += 4) {
              u32x4 xr[4][2];
#pragma unroll
              for (int i = 0; i < 4; ++i)
#pragma unroll
                for (int q = 0; q < 2; ++q) xr[i][q] = *(const u32x4*)((const unsigned short*)xsrc + (size_t)(rb * 64 + w * 8 + i0 + i) * D + c0 + 8 * q);
#pragma unroll
              for (int i = 0; i < 4; ++i) {
                const int m = rb * 64 + w * 8 + i0 + i;
                f32x4 v[4]; float s = 0.f;
#pragma unroll
                for (int q = 0; q < 4; ++q) { v[q] = unpkh4(xr[i][q >> 1][2 * (q & 1)], xr[i][q >> 1][2 * (q & 1) + 1]); s += (v[q].x * v[q].x + v[q].y * v[q].y) + (v[q].z * v[q].z + v[q].w * v[q].w); }
                const float r = 1.0f / sqrtf(wave_sum(s) * (1.0f / D) + EPS);
                unsigned wh[8], w8[4];
#pragma unroll
                for (int q = 0; q < 4; ++q) { const f32x4 h = v[q] * r * (1.0f + sc[q]) + sh[q];
                    typedef _Float16 h2_t __attribute__((ext_vector_type(2)));
                    const h2_t p0 = {(_Float16)h.x, (_Float16)h.y}, p1 = {(_Float16)h.z, (_Float16)h.w};
                    wh[2 * q] = __builtin_bit_cast(unsigned, p0); wh[2 * q + 1] = __builtin_bit_cast(unsigned, p1); w8[q] = pk4_fp8(h.x, h.y, h.z, h.w); }
                *(u32x4*)(XN + (size_t)m * D + c0) = (u32x4){wh[0], wh[1], wh[2], wh[3]}; *(u32x4*)(XN + (size_t)m * D + c0 + 8) = (u32x4){wh[4], wh[5], wh[6], wh[7]};
                *(u32x4*)(XN8 + (size_t)m * D + c0) = (u32x4){w8[0], w8[1], w8[2], w8[3]};
              }
            }
        }
        const int fr = lane & 15, kq = lane >> 4, kb = 128 * w + 8 * kq;
        typedef _Float16 f16x8_t __attribute__((ext_vector_type(8)));
        const bf16* pbh = WH + (size_t)fr * 1024 + kb;
        f16x8_t bhn[2];
#pragma unroll
        for (int et = 0; et < 2; ++et) bhn[et] = *(const f16x8_t*)(pbh + et * 16 * 1024);
        VM_WAIT(); __syncthreads();
        {
            f32x4 acc[4][2];
#pragma unroll
            for (int rt = 0; rt < 4; ++rt) { acc[rt][0] = ozero4(); acc[rt][1] = acc[rt][0]; }
            const bf16* pa = XN + (size_t)(rb * 64 + fr) * D + kb;
            f16x8_t ahn[4];
#pragma unroll
            for (int rt = 0; rt < 4; ++rt) ahn[rt] = *(const f16x8_t*)(pa + (size_t)rt * 16 * D);
#pragma unroll
            for (int ks = 0; ks < 4; ++ks) {
                f16x8_t ah[4], bh[2];
#pragma unroll
                for (int rt = 0; rt < 4; ++rt) ah[rt] = ahn[rt];
#pragma unroll
                for (int et = 0; et < 2; ++et) bh[et] = bhn[et];
                if (ks < 3) {
#pragma unroll
                    for (int rt = 0; rt < 4; ++rt) ahn[rt] = *(const f16x8_t*)(pa + (size_t)rt * 16 * D + (ks + 1) * 32);
#pragma unroll
                    for (int et = 0; et < 2; ++et) bhn[et] = *(const f16x8_t*)(pbh + et * 16 * 1024 + (ks + 1) * 32); }
#pragma unroll
                for (int rt = 0; rt < 4; ++rt)
#pragma unroll
                    for (int et = 0; et < 2; ++et) acc[rt][et] = __builtin_amdgcn_mfma_f32_16x16x32_f16(ah[rt], bh[et], acc[rt][et], 0, 0, 0);
            }
            LAS float* part = (LAS float*)(F.lds + 16384);
#pragma unroll
            for (int rt = 0; rt < 4; ++rt)
#pragma unroll
                for (int et = 0; et < 2; ++et)
#pragma unroll
                    for (int rg = 0; rg < 4; ++rg) part[(w * 64 + rt * 16 + 4 * kq + rg) * 33 + et * 16 + fr] = acc[rt][et][rg];
            __syncthreads();
            {   const int row = tid >> 3, e4 = (tid & 7) * 4;
#pragma unroll
                for (int j = 0; j < 4; ++j) { float sum = 0.f;
#pragma unroll
                    for (int ww = 0; ww < 8; ++ww) sum += part[(ww * 64 + row) * 33 + e4 + j];
                    lg[row * 33 + e4 + j] = sum + KIN(I_BR)[l * 32 + e4 + j]; } }
        }
        __syncthreads();
        if (w == 0) {
            float v[32];
#pragma unroll
            for (int e = 0; e < 32; ++e) v[e] = lg[lane * 33 + e];
            int idx[4]; float val[4];
#pragma unroll
            for (int k = 0; k < 4; ++k) { float best = v[0]; int bi = 0;
#pragma unroll
                for (int e = 1; e < 32; ++e) { const bool g = v[e] > best; best = g ? v[e] : best; bi = g ? e : bi; }
                val[k] = best; idx[k] = bi;
#pragma unroll
                for (int e = 0; e < 32; ++e) v[e] = (e == bi) ? -__builtin_inff() : v[e]; }
            const float p1 = __expf(val[1] - val[0]), p2 = __expf(val[2] - val[0]), p3 = __expf(val[3] - val[0]), inv = 1.0f / (1.0f + p1 + p2 + p3);
            const float gt[4] = {inv, p1 * inv, p2 * inv, p3 * inv};
            const int m = rb * 64 + lane;
            int lr[4];
#pragma unroll
            for (int k = 0; k < 4; ++k) lr[k] = __hip_atomic_fetch_add(lcnt + idx[k], 1, __ATOMIC_RELAXED, __HIP_MEMORY_SCOPE_WORKGROUP);
            asm volatile("s_waitcnt lgkmcnt(0)" ::: "memory");
            LAS int* lbase = lcnt + 32;
            if (lane < 32) lbase[lane] = dry ? 0 : (int)__hip_atomic_fetch_add(KCTL + CW_GCNT + l * 64 + lane, (unsigned)lcnt[lane], __ATOMIC_RELAXED, __HIP_MEMORY_SCOPE_AGENT);
            asm volatile("s_waitcnt vmcnt(0) lgkmcnt(0)" ::: "memory");
            int* po = dry ? WSP(int, WS_DRY + 96 * MiB) : WSP(int, WS_PPOS); float* go = dry ? WSP(float, WS_DRY + 97 * MiB) : WSP(float, WS_GATE);
            unsigned short* rel = dry ? WSP(unsigned short, WS_DRY + 98 * MiB) : WSP(unsigned short, WS_AS8);
            i32x4r pk; f32x4 gg = {gt[0], gt[1], gt[2], gt[3]};
#pragma unroll
            for (int k = 0; k < 4; ++k) { const int slot = lbase[idx[k]] + lr[k]; pk[k] = (idx[k] << 16) | slot; rel[(size_t)idx[k] * 16384 + slot] = (unsigned short)m; }
            *(i32x4r*)(po + m * 4) = pk; *(f32x4*)(go + m * 4) = gg;
        }
    }
    __syncthreads();
}
__device__ __forceinline__ void gather_phase(Frame& F, int l) {
    PHASE_BEGIN();
    LAS int* tst = (LAS int*)(F.lds + LDSCTL_OFF);
    LAS int* tmp = (LAS int*)F.lds;
    if (F.tid < 32) tmp[F.tid] = (int)((__hip_atomic_load(KCTL + CW_GCNT + l * 64 + F.tid, __ATOMIC_RELAXED, __HIP_MEMORY_SCOPE_AGENT) + 255u) >> 8);
    __syncthreads();
    if (F.tid == 0) { int a = 0; for (int e = 0; e < 32; ++e) { tst[e] = a; a += tmp[e]; } tst[32] = a; }
    __syncthreads();
    if (F.tid < 320) { int e = 0;
#pragma unroll
        for (int k = 1; k < 32; ++k) e += ((int)F.tid >= tst[k]) ? 1 : 0;
        tst[2048 + F.tid] = e; }
    __syncthreads();
}
__device__ __forceinline__ void combine_phase(Frame& F, int l, const float* xsrc, bool last, bool dry = false) {
    PHASE_BEGIN();
    const int gw = blockIdx.x * NWAVES + F.wave, lane = (F.tid & 63), c0 = 16 * lane;
    const float* modl = WSP(float, WS_MOD) + (size_t)l * 8 * 6144; const float* modn = WSP(float, WS_MOD) + (size_t)(l + 1) * 8 * 6144;
    const unsigned char* YP = WSP(unsigned char, WS_ASORT); unsigned short* X = dry ? WSP(unsigned short, WS_DRY) : WSP(unsigned short, WS_X); bf16* XN = dry ? WSP(bf16, WS_DRY + 64 * MiB) : WSP(bf16, WS_XN);
    unsigned char* XN8 = dry ? WSP(unsigned char, WS_DRY + 96 * MiB) : WSP(unsigned char, WS_XN1_8_); const unsigned short* xs16 = (const unsigned short*)xsrc;
    const int m0 = gw * 8, b = m0 >> 11;
    f32x4 g2[4], sh[4], sc[4];
#pragma unroll
    for (int q = 0; q < 4; ++q) { g2[q] = *(const f32x4*)(modl + (size_t)b * 6144 + 5120 + c0 + 4 * q);
        if (last) { sh[q] = *(const f32x4*)(KIN(I_FG) + c0 + 4 * q); sc[q] = sh[q]; }
        else { sh[q] = *(const f32x4*)(modn + (size_t)b * 6144 + c0 + 4 * q); sc[q] = *(const f32x4*)(modn + (size_t)b * 6144 + 1024 + c0 + 4 * q); } }
    typedef int i32x4_t __attribute__((ext_vector_type(4)));
    const LAS int* ctst = (const LAS int*)(F.lds + LDSCTL_OFF);
    i32x4_t pq[8]; f32x4 gq[8];
#pragma unroll
    for (int t = 0; t < 8; ++t) { pq[t] = *(const i32x4_t*)(WSP(int, WS_PPOS) + (size_t)(m0 + t) * 4); gq[t] = *(const f32x4*)(WSP(float, WS_GATE) + (size_t)(m0 + t) * 4); }
    u32x4 yb[3][4]; u32x4 xb[3][2];
#define CMB_ISSUE(t_, b_) do { _Pragma("unroll") for (int k = 0; k < 4; ++k) yb[b_][k] = *(const u32x4*)(YP + (size_t)(ctst[pq[t_][k] >> 16] * 256 + (pq[t_][k] & 0xffff)) * D + c0); \
        _Pragma("unroll") for (int q = 0; q < 2; ++q) xb[b_][q] = *(const u32x4*)(xs16 + (size_t)(m0 + (t_)) * D + c0 + 8 * q); } while (0)
    CMB_ISSUE(0, 0); CMB_ISSUE(1, 1);
#pragma unroll
    for (int t = 0; t < 8; ++t) {
        const int m = m0 + t;
        const f32x4 gk = gq[t] * 0.0625f;
        if (t + 2 < 8) CMB_ISSUE(t + 2, (t + 2) % 3);
        u32x4 yq[4]; f32x4 v[4];
#pragma unroll
        for (int k = 0; k < 4; ++k) yq[k] = yb[t % 3][k];
#pragma unroll
        for (int q = 0; q < 4; ++q) v[q] = unpkh4(xb[t % 3][q >> 1][2 * (q & 1)], xb[t % 3][q >> 1][2 * (q & 1) + 1]);
        float s = 0.f;
#pragma unroll
        for (int q = 0; q < 4; ++q) { f32x4 y = {0.f, 0.f, 0.f, 0.f};
#pragma unroll
            for (int k = 0; k < 4; ++k) { const f32x2 lo = __builtin_amdgcn_cvt_pk_f32_fp8((int)yq[k][q], false), hi = __builtin_amdgcn_cvt_pk_f32_fp8((int)yq[k][q], true);
                y.x += gk[k] * lo[0]; y.y += gk[k] * lo[1]; y.z += gk[k] * hi[0]; y.w += gk[k] * hi[1]; }
            v[q] = v[q] + g2[q] * y; s += (v[q].x * v[q].x + v[q].y * v[q].y) + (v[q].z * v[q].z + v[q].w * v[q].w); }
        const float r = 1.0f / sqrtf(wave_sum(s) * (1.0f / D) + EPS);
        if (last) {
#pragma unroll
            for (int q = 0; q < 4; ++q) *(f32x4*)(KOUT + (size_t)m * D + c0 + 4 * q) = v[q] * r * sh[q];
        } else {
            unsigned w8[4]; unsigned wb[8];
            *(u32x4*)(X + (size_t)m * D + c0) = (u32x4){pkh2(v[0].x, v[0].y), pkh2(v[0].z, v[0].w), pkh2(v[1].x, v[1].y), pkh2(v[1].z, v[1].w)};
            *(u32x4*)(X + (size_t)m * D + c0 + 8) = (u32x4){pkh2(v[2].x, v[2].y), pkh2(v[2].z, v[2].w), pkh2(v[3].x, v[3].y), pkh2(v[3].z, v[3].w)};
#pragma unroll
            for (int q = 0; q < 4; ++q) {
                const f32x4 h = v[q] * r * (1.0f + sc[q]) + sh[q]; wb[2 * q] = pk2(h.x, h.y); wb[2 * q + 1] = pk2(h.z, h.w); w8[q] = pk4_fp8(h.x, h.y, h.z, h.w); }
            *(u32x4*)(XN + (size_t)m * D + c0) = (u32x4){wb[0], wb[1], wb[2], wb[3]}; *(u32x4*)(XN + (size_t)m * D + c0 + 8) = (u32x4){wb[4], wb[5], wb[6], wb[7]};
            *(u32x4*)(XN8 + (size_t)m * D + c0) = (u32x4){w8[0], w8[1], w8[2], w8[3]};
        }
    }
}
#undef CMB_ISSUE

template <int NTN> struct MoeSched {
    const LAS int* tst; int total, G, c; int deg = 0;
    __device__ __forceinline__ bool next(int i, pg8::Unit& u) const {
        const int L = i * G + c; if (L >= total) return false;
        const int rt = L / NTN, j = L - rt * NTN; const int e = tst[2048 + rt];
        u.pm = rt; u.pn = e * NTN + j;
        if (DUP_MASK && deg) { u.pm = 0; u.pn = j; }
        return true;
    }
    __device__ __forceinline__ void a_ready(const pg8::Unit&) const {}
    __device__ __forceinline__ void done(const pg8::Unit&) const {}
};
struct EpiMoe1 {
    static constexpr bool PERM = true, AFTER_DRAIN = false;
    bf16* ACT; const float* b1;
    __device__ __forceinline__ void operator()(const f32x4 (&acc)[2][2][4][2], const pg8::Unit& u, int wr, int wc, int fr, int fq) const {
        asm volatile("" : "+v"(fr), "+v"(fq));
        const int e = u.pn >> 3, j = u.pn & 7, row0 = u.pm * 256 + wr * 64 + fr, c0 = j * 128 + 32 * wc + 8 * fq;
        f32x4 bg[2], bl[2];
#pragma unroll
        for (int n = 0; n < 2; ++n) { bg[n] = *(const f32x4*)(b1 + (size_t)e * 2048 + c0 + 4 * n); bl[n] = *(const f32x4*)(b1 + (size_t)e * 2048 + 1024 + c0 + 4 * n); }
#pragma unroll
        for (int ai = 0; ai < 2; ++ai)
#pragma unroll
            for (int m = 0; m < 4; ++m) { unsigned w[4];
#pragma unroll
                for (int n = 0; n < 2; ++n) { const f32x4 g = acc[ai][0][m][n] + bg[n], li = acc[ai][1][m][n] + bl[n]; float o[4];
#pragma unroll
                    for (int q = 0; q < 4; ++q) { const float gl = fminf(g[q], 7.0f), ln = fminf(fmaxf(li[q], -7.0f), 7.0f);
                        o[q] = gl * (ln + 1.0f) * __builtin_amdgcn_rcpf(1.0f + __builtin_amdgcn_exp2f(-2.4554669595930156f * gl)); }
                    w[2 * n] = pg8::cvt_pk_bf16(o[0], o[1]); w[2 * n + 1] = pg8::cvt_pk_bf16(o[2], o[3]); }
                *(u32x4*)(ACT + (size_t)(row0 + ai * 128 + m * 16) * D + c0) = (u32x4){w[0], w[1], w[2], w[3]}; }
    }
};
struct EpiMoe2 {
    static constexpr bool PERM = true, AFTER_DRAIN = false;
    bf16* YP; const float* b2; const float* rowgate;
    __device__ __forceinline__ void operator()(const f32x4 (&acc)[2][2][4][2], const pg8::Unit& u, int wr, int wc, int fr, int fq) const {
        asm volatile("" : "+v"(fr), "+v"(fq));
        const int e = u.pn >> 2, row0 = u.pm * 256 + wr * 64 + fr, c0 = (u.pn & 3) * 256 + 32 * wc + 8 * fq;
        f32x4 bv[2][2];
#pragma unroll
        for (int bj = 0; bj < 2; ++bj)
#pragma unroll
            for (int n = 0; n < 2; ++n) bv[bj][n] = *(const f32x4*)(b2 + (size_t)e * 1024 + c0 + bj * 128 + 4 * n);
#pragma unroll
        for (int ai = 0; ai < 2; ++ai)
#pragma unroll
            for (int m = 0; m < 4; ++m) { const int row = row0 + ai * 128 + m * 16; const float g = rowgate[row];
#pragma unroll
                for (int bj = 0; bj < 2; ++bj) { const f32x4 v0 = (acc[ai][bj][m][0] + bv[bj][0]) * g, v1 = (acc[ai][bj][m][1] + bv[bj][1]) * g;
                    *(u32x4*)(YP + (size_t)row * D + c0 + bj * 128) = (u32x4){pg8::cvt_pk_bf16(v0[0], v0[1]), pg8::cvt_pk_bf16(v0[2], v0[3]), pg8::cvt_pk_bf16(v1[0], v1[1]), pg8::cvt_pk_bf16(v1[2], v1[3])}; } }
    }
};

struct EpiW1 {
    unsigned char* ACT8; const float* b1;
    __device__ __forceinline__ void operator()(const f32x4 (&acc)[4][8], const pg8::Unit& u, int wr, int wc, int fr, int fq) const {
        asm volatile("" : "+v"(fr), "+v"(fq));
        const int e = u.pn >> 3, j = u.pn & 7, row0 = u.pm * 256 + wr * 64 + fr, c0 = j * 128 + wc * 64 + 4 * fq;
#pragma unroll
        for (int n = 0; n < 4; ++n) { const f32x4 bg = *(const f32x4*)(b1 + (size_t)e * 2048 + c0 + 16 * n), bl = *(const f32x4*)(b1 + (size_t)e * 2048 + 1024 + c0 + 16 * n);
#pragma unroll
            for (int m = 0; m < 4; ++m) { const f32x4 g = acc[m][n] + bg, li = acc[m][4 + n] + bl; float o[4];
#pragma unroll
                for (int q = 0; q < 4; ++q) { const float gl = fminf(g[q], 7.0f), ln = fminf(fmaxf(li[q], -7.0f), 7.0f);
                    o[q] = gl * (ln + 1.0f) * __builtin_amdgcn_rcpf(1.0f + __builtin_amdgcn_exp2f(-2.4554669595930156f * gl)); }
                *(unsigned*)(ACT8 + (size_t)(row0 + 16 * m) * D + c0 + 16 * n) = pk4_fp8(o[0], o[1], o[2], o[3]); } }
    }
};
struct EpiW2 {
    bf16* YP; const float* b2; const float* rowgate;
    __device__ __forceinline__ void operator()(const f32x4 (&acc)[4][8], const pg8::Unit& u, int wr, int wc, int fr, int fq) const {
        asm volatile("" : "+v"(fr), "+v"(fq));
        const int e = u.pn >> 2, row0 = u.pm * 256 + wr * 64 + fr, c0 = (u.pn & 3) * 256 + wc * 128 + 4 * fq;
        float gt[4];
#pragma unroll
        for (int m = 0; m < 4; ++m) gt[m] = rowgate[row0 + 16 * m];
#pragma unroll
        for (int n = 0; n < 8; ++n) { const f32x4 bv = *(const f32x4*)(b2 + (size_t)e * 1024 + c0 + 16 * n);
#pragma unroll
            for (int m = 0; m < 4; ++m) { const f32x4 v = (acc[m][n] + bv) * gt[m];
                *(u32x2*)(YP + (size_t)(row0 + 16 * m) * D + c0 + 16 * n) = (u32x2){pg8::cvt_pk_bf16(v[0], v[1]), pg8::cvt_pk_bf16(v[2], v[3])}; } }
    }
};
typedef __bf16 bf16x2_nt __attribute__((ext_vector_type(2)));
__device__ __forceinline__ unsigned cvtpk_c(float lo, float hi) { f32x2 v = {lo, hi}; bf16x2_nt b = __builtin_convertvector(v, bf16x2_nt); return __builtin_bit_cast(unsigned, b); }
struct EpiP1 {
    static constexpr bool PERM = true, AFTER_DRAIN = false, BIAS_INIT = true;
    static constexpr bool GATHER_A = true;
    unsigned char* ACT8; const float* b1; const unsigned short* rowmap; const LAS int* tst;
    __device__ __forceinline__ const unsigned short* rowsrc(const pg8::Unit& u) const { const int e = u.pn >> 3; return rowmap + (size_t)e * 16384 + (size_t)(u.pm - tst[e]) * 256; }
    static constexpr int NSTORE = 4;
    __device__ __forceinline__ const float* bias_src(const pg8::Unit& u, int q) const { return b1 + (size_t)(u.pn >> 3) * 2048 + (q >> 5) * 1024 + (u.pn & 7) * 128 + 4 * (q & 31); }
    __device__ __forceinline__ void load_bias(f32x4 (&nb)[4], const PG8_LAS float* sl, int wc, int fq) const {
        const PG8_LAS float* bp = sl + 16 * wc + 4 * fq;
        nb[0] = *(const PG8_LAS f32x4*)bp; nb[1] = *(const PG8_LAS f32x4*)(bp + 128); nb[2] = *(const PG8_LAS f32x4*)(bp + 64); nb[3] = *(const PG8_LAS f32x4*)(bp + 128 + 64);
    }
    __device__ __forceinline__ void set_bias(f32x4 (&acc)[2][2][4][2], const f32x4 (&nb)[4]) const {
#pragma unroll
        for (int bj = 0; bj < 2; ++bj)
#pragma unroll
            for (int ai = 0; ai < 2; ++ai)
#pragma unroll
                for (int m = 0; m < 4; ++m) { acc[ai][bj][m][0] = nb[2 * bj]; acc[ai][bj][m][1] = nb[2 * bj + 1] + 1.0f; }
    }
    __device__ __forceinline__ void operator()(const f32x4 (&acc)[2][2][4][2], const pg8::Unit& u, int wr, int wc, int fr, int fq) const {
        asm volatile("" : "+v"(fr), "+v"(fq));
        const int j = u.pn & 7, rowb = u.pm * 256 + wr * 64 + 16 * fq + fr, cb = j * 128 + 16 * wc;
#pragma unroll
        for (int ai = 0; ai < 2; ++ai)
#pragma unroll
            for (int bj = 0; bj < 2; ++bj) { unsigned d[4];
#pragma unroll
                for (int m = 0; m < 4; ++m) { const f32x4 g = acc[ai][bj][m][0], li = acc[ai][bj][m][1]; float o[4];
#pragma unroll
                    for (int q = 0; q < 4; ++q) { const float gl = fminf(g[q], 7.0f), ln1 = fminf(fmaxf(li[q], -6.0f), 8.0f);
                        o[q] = gl * ln1 * __builtin_amdgcn_rcpf(1.0f + __builtin_amdgcn_exp2f(-2.4554669595930156f * gl)); }
                    d[m] = pk4_fp8(o[0], o[1], o[2], o[3]); }
                { auto s02 = __builtin_amdgcn_permlane32_swap(d[0], d[2], false, false); d[0] = s02[0]; d[2] = s02[1]; }
                { auto s13 = __builtin_amdgcn_permlane32_swap(d[1], d[3], false, false); d[1] = s13[0]; d[3] = s13[1]; }
                { auto t01 = __builtin_amdgcn_permlane16_swap(d[0], d[1], false, false); d[0] = t01[0]; d[1] = t01[1]; }
                { auto t23 = __builtin_amdgcn_permlane16_swap(d[2], d[3], false, false); d[2] = t23[0]; d[3] = t23[1]; }
                *(u32x4*)(ACT8 + (size_t)(rowb + ai * 128) * D + cb + bj * 64) = (u32x4){d[0], d[1], d[2], d[3]}; }
    }
};
struct EpiP2 {
    static constexpr bool PERM = true, AFTER_DRAIN = false, BIAS_INIT = true;
    bf16* YP; const float* b2; int skip = 0;
    static constexpr int NSTORE = 8;
    __device__ __forceinline__ const float* bias_src(const pg8::Unit& u, int q) const { return b2 + (size_t)(u.pn >> 2) * 1024 + (u.pn & 3) * 256 + 4 * q; }
    __device__ __forceinline__ void load_bias(f32x4 (&nb)[4], const PG8_LAS float* sl, int wc, int fq) const {
        const PG8_LAS float* bp = sl + 32 * wc + 8 * fq;
        nb[0] = *(const PG8_LAS f32x4*)bp; nb[1] = *(const PG8_LAS f32x4*)(bp + 4); nb[2] = *(const PG8_LAS f32x4*)(bp + 128); nb[3] = *(const PG8_LAS f32x4*)(bp + 128 + 4);
    }
    __device__ __forceinline__ void set_bias(f32x4 (&acc)[2][2][4][2], const f32x4 (&nb)[4]) const {
#pragma unroll
        for (int bj = 0; bj < 2; ++bj)
#pragma unroll
            for (int ai = 0; ai < 2; ++ai)
#pragma unroll
                for (int m = 0; m < 4; ++m) { acc[ai][bj][m][0] = nb[2 * bj]; acc[ai][bj][m][1] = nb[2 * bj + 1]; }
    }
    __device__ __forceinline__ void operator()(const f32x4 (&acc)[2][2][4][2], const pg8::Unit& u, int wr, int wc, int fr, int fq) const {
        if (DUP_MASK != 0 && skip == 1) return;
        asm volatile("" : "+v"(fr), "+v"(fq));
        const int rowb = u.pm * 256 + wr * 64 + fr + 16 * (fq & 1), cb = (u.pn & 3) * 256 + 32 * wc + 8 * (fq & ~1);
#pragma unroll
        for (int ai = 0; ai < 2; ++ai)
#pragma unroll
            for (int bj = 0; bj < 2; ++bj)
#pragma unroll
                for (int mp = 0; mp < 2; ++mp) { unsigned lo[2], hi[2];
#pragma unroll
                    for (int i = 0; i < 2; ++i) { const f32x4 v0 = acc[ai][bj][2 * mp + i][0], v1 = acc[ai][bj][2 * mp + i][1];
                        lo[i] = pk4_fp8(16.f * v0[0], 16.f * v0[1], 16.f * v0[2], 16.f * v0[3]); hi[i] = pk4_fp8(16.f * v1[0], 16.f * v1[1], 16.f * v1[2], 16.f * v1[3]); }
                    { auto t = __builtin_amdgcn_permlane16_swap(lo[0], lo[1], false, false); lo[0] = t[0]; lo[1] = t[1]; }
                    { auto t = __builtin_amdgcn_permlane16_swap(hi[0], hi[1], false, false); hi[0] = t[0]; hi[1] = t[1]; }
                    *(u32x4*)((unsigned char*)YP + (size_t)(rowb + ai * 128 + mp * 32) * D + cb + bj * 128) = (u32x4){lo[0], hi[0], lo[1], hi[1]}; }
    }
};
struct EpiF8Moe1 {
    unsigned char* ACT8; const float* b1;
    __device__ __forceinline__ void operator()(const f32x4 (&acc)[4][4], const pg8::Unit& u, int wr, int wc, int fr, int fq) const {
        asm volatile("" : "+v"(fr), "+v"(fq));
        const int e = u.pn >> 4, j = u.pn & 15, row0 = u.pm * 256 + wr * 64 + fr, c0 = j * 64 + wc * 32 + 4 * fq;
        f32x4 bg[2], bl[2];
#pragma unroll
        for (int n = 0; n < 2; ++n) { bg[n] = *(const f32x4*)(b1 + (size_t)e * 2048 + c0 + 16 * n); bl[n] = *(const f32x4*)(b1 + (size_t)e * 2048 + 1024 + c0 + 16 * n); }
#pragma unroll
        for (int m = 0; m < 4; ++m)
#pragma unroll
            for (int n = 0; n < 2; ++n) { const f32x4 g = acc[m][n] + bg[n], li = acc[m][2 + n] + bl[n]; float o[4];
#pragma unroll
                for (int q = 0; q < 4; ++q) { const float gl = fminf(g[q], 7.0f), ln = fminf(fmaxf(li[q], -7.0f), 7.0f);
                    o[q] = gl * (ln + 1.0f) * __builtin_amdgcn_rcpf(1.0f + __builtin_amdgcn_exp2f(-2.4554669595930156f * gl)); }
                *(unsigned*)(ACT8 + (size_t)(row0 + 16 * m) * D + c0 + 16 * n) = pk4_fp8(o[0], o[1], o[2], o[3]); }
    }
};
struct EpiF8Moe2 {
    bf16* YP; const float* b2; const float* rowgate;
    __device__ __forceinline__ void operator()(const f32x4 (&acc)[4][4], const pg8::Unit& u, int wr, int wc, int fr, int fq) const {
        asm volatile("" : "+v"(fr), "+v"(fq));
        const int e = u.pn >> 3, row0 = u.pm * 256 + wr * 64 + fr, c0 = (u.pn & 7) * 128 + wc * 64 + 4 * fq;
        f32x4 bv[4];
#pragma unroll
        for (int n = 0; n < 4; ++n) bv[n] = *(const f32x4*)(b2 + (size_t)e * 1024 + c0 + 16 * n);
#pragma unroll
        for (int m = 0; m < 4; ++m) { const int row = row0 + 16 * m; const float g = rowgate[row];
#pragma unroll
            for (int n = 0; n < 4; ++n) { const f32x4 v = (acc[m][n] + bv[n]) * g;
                *(u32x2*)(YP + (size_t)row * D + c0 + 16 * n) = (u32x2){pg8::cvt_pk_bf16(v[0], v[1]), pg8::cvt_pk_bf16(v[2], v[3])}; } }
    }
};
namespace att {
typedef short s16x4 __attribute__((ext_vector_type(4)));
typedef float f32x16 __attribute__((ext_vector_type(16)));
constexpr int DH = 128, NW = 8, QBLK = 32, KVBLK = 64, QB = NW * QBLK;
constexpr int SHM_V = KVBLK * DH * 2, SHM_K = KVBLK * DH * 2;
constexpr int BODY_LDS = 2 * SHM_V + 2 * SHM_K + NW * 64 * 4;
constexpr int LDS_KB = BODY_LDS;
constexpr int LDS_BM = LDS_KB + 8192;
constexpr int LDS_SCAN = LDS_BM + 16384;
constexpr int LDS_GN = LDS_SCAN + 256;
constexpr float THR = 8.f;
#define KSWZ(row, colB) ((row) * 256 + ((colB) ^ (((row) & 7) << 4)))
#define SBAR() __builtin_amdgcn_sched_barrier(0)
__device__ __forceinline__ int v_st(int k, int c) { const int kk = (k & ~0xC) | ((k & 4) << 1) | ((k & 8) >> 1); return ((kk >> 3) * 4 + (c >> 5)) * 512 + ((kk & 7) * 32 + (c & 31)) * 2; }
__device__ __forceinline__ int v_rd_base(int lane) { return ((lane & 3) << 3) | (((lane >> 2) & 3) << 6) | (((lane >> 4) & 1) << 5) | (((lane >> 5) & 1) << 8); }
constexpr int v_rd_off(int d0, int ks, int half) { return d0 * 512 + ks * 4096 + half * 2048; }
__device__ __forceinline__ int crow(int r, int hi) { return (r & 3) + 8 * (r >> 2) + 4 * hi; }
__device__ __forceinline__ unsigned cvtpk(float lo, float hi) { unsigned r; asm volatile("v_cvt_pk_bf16_f32 %0, %1, %2" : "=v"(r) : "v"(lo), "v"(hi)); return r; }
__device__ __forceinline__ bf16x8 load8(const bf16* p) { return *reinterpret_cast<const bf16x8*>(p); }
__device__ __forceinline__ void mask_tile(f32x16& p0, f32x16& p1, int dq, unsigned W) {
    const float NEG = -__builtin_inff();
#pragma unroll
    for (int r = 0; r < 16; ++r) { const int c = (r & 3) + 8 * (r >> 2);
        if ((unsigned)(dq - c) >= W) p0[r] = NEG;
        if ((unsigned)(dq - c - 32) >= W) p1[r] = NEG; }
}
template <int MODE> __device__ __forceinline__ void partialSM(f32x16& p0, f32x16& p1, float& m_reg, float& mn, float& alpha) {
    constexpr float SCALE = MODE == 0 ? 0.08838834764831845f : 1.0f;
    float pmax = p0[0]; for (int r = 1; r < 16; ++r) pmax = fmaxf(pmax, p0[r]); for (int r = 0; r < 16; ++r) pmax = fmaxf(pmax, p1[r]);
    { auto rr = __builtin_amdgcn_permlane32_swap(__float_as_uint(pmax), __float_as_uint(pmax), false, false);
      pmax = fmaxf(__uint_as_float(rr[0]), __uint_as_float(rr[1])); }
    constexpr float C2 = 1.4426950408889634f * SCALE;
    if (__builtin_expect(__all((pmax - m_reg) * SCALE <= THR), 1)) { mn = m_reg; alpha = 1.f; }
    else { mn = fmaxf(m_reg, pmax); alpha = __builtin_amdgcn_exp2f((m_reg - mn) * C2); m_reg = mn; }
    const float mnL = -mn * C2;
    for (int r = 0; r < 16; ++r) p0[r] = fmaf(p0[r], C2, mnL); for (int r = 0; r < 16; ++r) p1[r] = fmaf(p1[r], C2, mnL);
    for (int r = 0; r < 16; ++r) p0[r] = __builtin_amdgcn_exp2f(p0[r]);
}
__device__ __forceinline__ void finishSM(f32x16& p0, f32x16& p1, float alpha, float& l_reg, bf16x8& pa0, bf16x8& pa1, bf16x8& pa2, bf16x8& pa3) {
    for (int r = 0; r < 16; ++r) p1[r] = __builtin_amdgcn_exp2f(p1[r]);
    float ps = 0; for (int r = 0; r < 16; ++r) ps += p0[r]; for (int r = 0; r < 16; ++r) ps += p1[r];
    { auto rr = __builtin_amdgcn_permlane32_swap(__float_as_uint(ps), __float_as_uint(ps), false, false);
      ps = __uint_as_float(rr[0]) + __uint_as_float(rr[1]); }
    l_reg = l_reg * alpha + ps;
#define PK4(P, B_, OUT) do { unsigned a0 = cvtpk(P[B_+0], P[B_+1]), a1 = cvtpk(P[B_+2], P[B_+3]);                          \
        unsigned b0 = cvtpk(P[B_+4], P[B_+5]), b1 = cvtpk(P[B_+6], P[B_+7]);                                             \
        auto r0 = __builtin_amdgcn_permlane32_swap(a0, b0, false, false); auto r1 = __builtin_amdgcn_permlane32_swap(a1, b1, false, false); \
        u32x4 w = {r0[0], r1[0], r0[1], r1[1]}; OUT = *reinterpret_cast<bf16x8*>(&w); } while (0)
    PK4(p0, 0, pa0); PK4(p0, 8, pa1); PK4(p1, 0, pa2); PK4(p1, 8, pa3);
}
template <int MODE> __device__ __forceinline__ void cinit(f32x16& p0, f32x16& p1, const char* lds, int kbase, int hi, int tq, int t) {
    if constexpr (MODE == 0) {
        const float* kb = (const float*)(lds + LDS_KB) + kbase + 4 * hi;
#pragma unroll
        for (int g = 0; g < 4; ++g) { const f32x4 a = *(const f32x4*)(kb + 8 * g), b = *(const f32x4*)(kb + 32 + 8 * g);
            p0[4 * g] = a[0]; p0[4 * g + 1] = a[1]; p0[4 * g + 2] = a[2]; p0[4 * g + 3] = a[3]; p1[4 * g] = b[0]; p1[4 * g + 1] = b[1]; p1[4 * g + 2] = b[2]; p1[4 * g + 3] = b[3]; }
    } else {
        const u32x2 w = *(const u32x2*)((const unsigned*)(lds + LDS_BM) + tq * 64 + 2 * t);
        const unsigned lo = w.x >> (4 * hi), hh = w.y >> (4 * hi);
        const float NEG = -__builtin_inff();
#pragma unroll
        for (int r = 0; r < 16; ++r) { const int c = (r & 3) + 8 * (r >> 2); p0[r] = ((lo >> c) & 1u) ? 0.f : NEG; p1[r] = ((hh >> c) & 1u) ? 0.f : NEG; }
    }
}
template <int KB>
__device__ __forceinline__ void qkt(f32x16& p0, f32x16& p1, const char* K_lds, int r32, int hi, const bf16x8* qr) {
    const char* kb[4];
#pragma unroll
    for (int dd = 0; dd < 4; ++dd) kb[dd] = K_lds + KB * SHM_K + KSWZ(r32, (dd * 16 + hi * 8) * 2);
#pragma unroll
    for (int d0 = 0; d0 < 8; ++d0) { const char* a = kb[d0 & 3] + (d0 >> 2) * 128;
        bf16x8 b0 = *reinterpret_cast<const bf16x8*>(a);
        bf16x8 b1 = *reinterpret_cast<const bf16x8*>(a + 32 * 256);
        p0 = __builtin_amdgcn_mfma_f32_32x32x16_bf16(b0, qr[d0], p0, 0, 0, 0);
        p1 = __builtin_amdgcn_mfma_f32_32x32x16_bf16(b1, qr[d0], p1, 0, 0, 0); }
}
template <int VB>
__device__ __forceinline__ void pv_tile(f32x16* o, int vb0, bf16x8 pa0, bf16x8 pa1, bf16x8 pa2, bf16x8 pa3) {
#define TRRD(dst, off) asm volatile("ds_read_b64_tr_b16 %0, %1 offset:%2" : "=&v"(dst) : "v"(vb0), "i"(off) : "memory")
#define PV_D0(d0) do { s16x4 l0, l1, l2, l3, h0, h1, h2, h3; constexpr int b_ = VB * SHM_V + v_rd_off(d0, 0, 0); \
        TRRD(l0, b_); TRRD(h0, b_ + 2048); TRRD(l1, b_ + 4096); TRRD(h1, b_ + 6144); TRRD(l2, b_ + 8192); TRRD(h2, b_ + 10240); TRRD(l3, b_ + 12288); TRRD(h3, b_ + 14336); \
        asm volatile("s_waitcnt lgkmcnt(0)" ::: "memory"); SBAR();   \
        o[d0] = __builtin_amdgcn_mfma_f32_32x32x16_bf16(pa0, (bf16x8){l0[0], l0[1], l0[2], l0[3], h0[0], h0[1], h0[2], h0[3]}, o[d0], 0, 0, 0);   \
        o[d0] = __builtin_amdgcn_mfma_f32_32x32x16_bf16(pa1, (bf16x8){l1[0], l1[1], l1[2], l1[3], h1[0], h1[1], h1[2], h1[3]}, o[d0], 0, 0, 0);   \
        o[d0] = __builtin_amdgcn_mfma_f32_32x32x16_bf16(pa2, (bf16x8){l2[0], l2[1], l2[2], l2[3], h2[0], h2[1], h2[2], h2[3]}, o[d0], 0, 0, 0);   \
        o[d0] = __builtin_amdgcn_mfma_f32_32x32x16_bf16(pa3, (bf16x8){l3[0], l3[1], l3[2], l3[3], h3[0], h3[1], h3[2], h3[3]}, o[d0], 0, 0, 0); } while (0)
    PV_D0(0); PV_D0(1); PV_D0(2); PV_D0(3);
#undef PV_D0
}
struct BlockRef { const bf16* Q; const bf16* K; const bf16* V; bf16* O; int ldo; int P0; int NT; const float* g; };
struct Seam { bf16x8 qr[8]; bf16x8 st_v0, st_v1, st_k0, st_k1; };
__device__ __forceinline__ bf16x8 nrm8(bf16x8 x, const float* gl) {
    const f32x4 g0 = *(const f32x4*)gl, g1 = *(const f32x4*)(gl + 4);
    float f[8]; float ss = 0.f;
#pragma unroll
    for (int i = 0; i < 8; ++i) { f[i] = bf2f((unsigned short)x[i]); ss += f[i] * f[i]; }
    ss += __builtin_bit_cast(float, __builtin_amdgcn_update_dpp(0, __builtin_bit_cast(int, ss), 0x128, 0xf, 0xf, false));
    ss += __builtin_bit_cast(float, __builtin_amdgcn_update_dpp(0, __builtin_bit_cast(int, ss), 0x124, 0xf, 0xf, false));
    ss += __builtin_bit_cast(float, __builtin_amdgcn_update_dpp(0, __builtin_bit_cast(int, ss), 0x122, 0xf, 0xf, false));
    ss += __builtin_bit_cast(float, __builtin_amdgcn_update_dpp(0, __builtin_bit_cast(int, ss), 0x121, 0xf, 0xf, false));
    const float r = __builtin_amdgcn_rsqf(ss * (1.0f / 128.0f) + EPS);
    u32x4 w = {cvtpk(f[0] * r * g0[0], f[1] * r * g0[1]), cvtpk(f[2] * r * g0[2], f[3] * r * g0[3]), cvtpk(f[4] * r * g1[0], f[5] * r * g1[1]), cvtpk(f[6] * r * g1[2], f[7] * r * g1[3])};
    return *reinterpret_cast<bf16x8*>(&w);
}
#define ROW(p, k0, rr) ((p) + (size_t)((k0) + (rr)) * DH + sc)
#define VMW() asm volatile("s_waitcnt vmcnt(0)" ::: "memory")
#define VMWN(n) asm volatile("s_waitcnt vmcnt(%0)" :: "i"(n) : "memory")
#define STG_IDS() int tid_s = tid; asm volatile("" : "+v"(tid_s)); const int sr = tid_s >> 4, sc = (tid_s & 15) * 8
#define SLOAD_H(Kp, Vp, k0) do { STG_IDS(); if constexpr (MODE == 0) { S.st_v0 = load8(ROW(Vp, k0, sr)); S.st_v1 = load8(ROW(Vp, k0, 32 + sr)); }             \
                         S.st_k0 = load8(ROW(Kp, k0, sr)); S.st_k1 = load8(ROW(Kp, k0, 32 + sr)); } while (0)
#define NORMKV() do { if constexpr (MODE == 1) { S.st_v0 = S.st_k0; S.st_v1 = S.st_k1; } } while (0)
#define SWRITE_HK(bf) do { STG_IDS(); const int kws = KSWZ(sr, sc * 2); *(bf16x8*)(K_lds + (bf) * SHM_K + kws) = S.st_k0; *(bf16x8*)(K_lds + (bf) * SHM_K + kws + 32 * 256) = S.st_k1; } while (0)
#define SWRITE_HV(bf) do { STG_IDS(); const int vst0 = v_st(sr, sc), vst1 = v_st(32 + sr, sc); *(bf16x8*)(V_lds + (bf) * SHM_V + vst0) = S.st_v0; *(bf16x8*)(V_lds + (bf) * SHM_V + vst1) = S.st_v1; } while (0)
#define SWRITE_H(bf) do { SWRITE_HV(bf); SWRITE_HK(bf); } while (0)
template <int MODE>
__device__ __forceinline__ void prime(const BlockRef& cur, char* lds, Seam& S, const int tid) {
    const int wid = __builtin_amdgcn_readfirstlane(tid >> 6), lane = tid & 63, r32 = lane & 31, hi = lane >> 5;
    char* K_lds = lds + 2 * SHM_V;
    for (int d0 = 0; d0 < 8; ++d0) S.qr[d0] = load8(cur.Q + (size_t)(wid * QBLK + r32) * DH + d0 * 16 + hi * 8);
    SLOAD_H(cur.K, cur.V, 0); VMW(); NORMKV(); SWRITE_HK(0);
    __syncthreads();
}
template <int MODE>
__device__ __forceinline__ void block(const BlockRef& cur, const BlockRef& nxt, char* lds, Seam& S, const int tid) {
    const int wid = __builtin_amdgcn_readfirstlane(tid >> 6), lane = tid & 63, r32 = lane & 31, hi = lane >> 5;
    const int NT = cur.NT;
    const int qlo = cur.P0 + wid * QBLK, qm = qlo + r32 - 4 * hi;
    const int tq = wid * 8 + (r32 >> 2);
    constexpr unsigned W = 1u << 30;
    char* V_lds = lds; char* K_lds = lds + 2 * SHM_V;
    float* ws = (float*)(lds + 2 * SHM_V + 2 * SHM_K) + wid * 64; float* li_l = ws, * al_l = ws + 32;
    float m_reg = -1e30f, l_reg = 0; f32x16 o[4]; { const f32x16 z16 = ozero16(); o[0] = z16; o[1] = z16; o[2] = z16; o[3] = z16; }
    const int vb0 = (int)(uintptr_t)V_lds + v_rd_base(lane);
    const bf16* Kh = cur.K; const bf16* Vh = cur.V;
#define RESC(a) do { if (__any((a) < 1.f)) { if (hi == 0) al_l[r32] = (a); asm volatile("s_waitcnt lgkmcnt(0)" ::: "memory");              \
                     for (int d_ = 0; d_ < 4; ++d_) for (int r = 0; r < 16; ++r) o[d_][r] *= al_l[crow(r, hi)]; } } while (0)
#define KBASE(t) ((t) * KVBLK)
#define MASKT(P0_, P1_, t) do { if constexpr (MODE == 0) { const int kb_ = KBASE(t); if (kb_ + KVBLK - 1 > qlo) mask_tile(P0_, P1_, qm - kb_, W); } } while (0)
    constexpr int NQL = 8;
#define SEAM_K0() do { VMWN(NQL); NORMKV(); SWRITE_HK(0); SBAR(); } while (0)
    f32x16 pA0, pA1, pB0, pB1; float mnA, mnB, alA, alB; bf16x8 pa0, pa1, pa2, pa3;
    SWRITE_HV(0); SBAR();
    if (NT > 1) { SLOAD_H(Kh, Vh, KBASE(1)); }
    SBAR(); cinit<MODE>(pA0, pA1, lds, KBASE(0), hi, tq, 0); qkt<0>(pA0, pA1, K_lds, r32, hi, S.qr);
    MASKT(pA0, pA1, 0); partialSM<MODE>(pA0, pA1, m_reg, mnA, alA);
    if (NT > 1) { VMW(); NORMKV(); SWRITE_H(1); }
    __syncthreads();
#define HALF_STEP(PX0, PX1, mnX, alX, PY0, PY1, alY, t, KB, VB, SB) do {                                                      \
        SBAR(); cinit<MODE>(PX0, PX1, lds, KBASE(t), hi, tq, (t)); qkt<KB>(PX0, PX1, K_lds, r32, hi, S.qr);                     \
        finishSM(PY0, PY1, alY, l_reg, pa0, pa1, pa2, pa3); SBAR();                                                           \
        if ((t) + 1 < NT) { SLOAD_H(Kh, Vh, KBASE((t) + 1)); SBAR(); }                                                        \
        pv_tile<VB>(o, vb0, pa0, pa1, pa2, pa3); MASKT(PX0, PX1, (t)); partialSM<MODE>(PX0, PX1, m_reg, mnX, alX);             \
        __syncthreads();                                                                                                      \
        if ((t) + 1 < NT) { VMW(); NORMKV(); SWRITE_H(SB); }                                                                  \
        RESC(alX); __syncthreads(); } while (0)
    for (int t = 1; t + 1 < NT; t += 2) {
        HALF_STEP(pB0, pB1, mnB, alB, pA0, pA1, alA, t, 1, 0, 0);
        HALF_STEP(pA0, pA1, mnA, alA, pB0, pB1, alB, t + 1, 0, 1, 1);
    }
    const bool even = (NT & 1) == 0;
    if (even) { SBAR(); cinit<MODE>(pB0, pB1, lds, KBASE(NT - 1), hi, tq, NT - 1); qkt<1>(pB0, pB1, K_lds, r32, hi, S.qr); SBAR(); }
    SBAR();
    finishSM(pA0, pA1, alA, l_reg, pa0, pa1, pa2, pa3); SBAR();
    pv_tile<0>(o, vb0, pa0, pa1, pa2, pa3);
    if (even) { MASKT(pB0, pB1, NT - 1); partialSM<MODE>(pB0, pB1, m_reg, mnB, alB); __syncthreads(); RESC(alB);
        finishSM(pB0, pB1, alB, l_reg, pa0, pa1, pa2, pa3); SBAR(); pv_tile<1>(o, vb0, pa0, pa1, pa2, pa3); }
    SBAR();
    if (hi == 0) li_l[r32] = l_reg; asm volatile("s_waitcnt lgkmcnt(0)" ::: "memory");
    float rli[16];
#pragma unroll
    for (int r = 0; r < 16; ++r) rli[r] = __builtin_amdgcn_rcpf(li_l[crow(r, hi)]);
    constexpr int LDO = MODE == 0 ? 512 : 128;
    bf16* Ow = cur.O + (size_t)(wid * QBLK) * LDO;
#pragma unroll
    for (int r = 0; r < 16; ++r) { const int orow = crow(r, hi);
#pragma unroll
        for (int d0 = 0; d0 < 4; ++d0) { const float v = o[d0][r] * rli[r];
            const float vn = qxor1(v);
            if ((r32 & 1) == 0) *(unsigned*)(Ow + (size_t)orow * LDO + d0 * 32 + r32) = cvtpk(v, vn); } }
    __syncthreads();
#undef RESC
#undef KBASE
#undef MASKT
#undef SEAM_K0
#undef HALF_STEP
}
#undef ROW
#undef VMWN
#undef SLOAD_H
#undef STG_IDS
#undef NORMKV
#undef SWRITE_HK
#undef SWRITE_HV
#undef SWRITE_H
#undef PK4
#undef TRRD
}

constexpr size_t WS_MLQK = 848 * MiB, WS_MLV = 864 * MiB, WS_MLO = 880 * MiB, WS_QABS = 896 * MiB, WS_CKV = 912 * MiB, WS_IK = 916 * MiB, WS_SCAL = 918 * MiB, WS_IQ = 920 * MiB;
constexpr size_t WS_FXQ = 928 * MiB, WS_FXK = 944 * MiB, WS_FXV = 960 * MiB, WS_GATES = 976 * MiB, WS_YCAT = 1072 * MiB, WS_MERGED = 1120 * MiB;
constexpr size_t WS_CLOC = 1152 * MiB, WS_CPREV = 1184 * MiB, WS_MLST = 1200 * MiB, WS_SCORE = 1208 * MiB, WS_XN1_8 = 1352 * MiB  , WS_WIN8 = 1368 * MiB  , WS_MERGED8 = 1384 * MiB  , WS_WOUT8 = 1400 * MiB  , WS_CKVN = 1402 * MiB  , WS_END2 = 1406 * MiB;
constexpr int CW_Q = 512;

struct EpiInProj {
    static constexpr bool PERM = true, AFTER_DRAIN = false, BIAS_INIT = true;
    const float* bias; unsigned char* ws;
    __device__ __forceinline__ const float* bias_src(const pg8::Unit& u, int q) const { return bias + u.pn * 256 + 4 * q; }
    __device__ __forceinline__ void load_bias(f32x4 (&nb)[4], const PG8_LAS float* sl, int wc, int fq) const {
        const PG8_LAS float* bp = sl + 32 * wc + 8 * fq;
        nb[0] = *(const PG8_LAS f32x4*)bp; nb[1] = *(const PG8_LAS f32x4*)(bp + 4); nb[2] = *(const PG8_LAS f32x4*)(bp + 128); nb[3] = *(const PG8_LAS f32x4*)(bp + 128 + 4);
    }
    __device__ __forceinline__ void set_bias(f32x4 (&acc)[2][2][4][2], const f32x4 (&nb)[4]) const {
#pragma unroll
        for (int bj = 0; bj < 2; ++bj)
#pragma unroll
            for (int ai = 0; ai < 2; ++ai)
#pragma unroll
                for (int m = 0; m < 4; ++m) { acc[ai][bj][m][0] = nb[2 * bj]; acc[ai][bj][m][1] = nb[2 * bj + 1]; }
    }
    __device__ __forceinline__ void operator()(const f32x4 (&acc)[2][2][4][2], const pg8::Unit& u, int wr, int wc, int fr, int fq) const {
        asm volatile("" : "+v"(fr), "+v"(fq));
        const int pn = u.pn, row0 = u.pm * 256 + wr * 64 + fr, b = u.pm >> 3;
#pragma unroll
        for (int bj = 0; bj < 2; ++bj) {
            const int c8 = 128 * bj + 32 * wc + 8 * fq;
            bf16* base = nullptr; int pitch = 0; float* fbase = nullptr;
            if (pn < 2) { base = (bf16*)(ws + WS_MLQK) + pn * 256 + c8; pitch = 512; }
            else if (pn < 4) { base = (bf16*)(ws + WS_MLV) + (pn - 2) * 256 + c8; pitch = 512; }
            else if (pn < 6) { base = (bf16*)(ws + WS_MLO) + (pn - 4) * 256 + c8; pitch = 512; }
            else if (pn < 8) { base = (bf16*)(ws + WS_QABS) + (pn - 6) * 256 + c8; pitch = 512; }
            else if (pn == 8) { if (c8 < 128) { base = (bf16*)(ws + WS_CKV) + c8; pitch = 128; } else if (c8 < 192) { base = (bf16*)(ws + WS_IK) + (c8 - 128); pitch = 64; }
                                else if (c8 < 208) { fbase = (float*)(ws + WS_SCAL) + (c8 - 192); } }
            else if (pn == 9) { base = (bf16*)(ws + WS_IQ) + c8; pitch = 256; }
            else if (pn < 16) { const int t = (pn - 10) >> 1, hh = ((pn - 10) & 1) * 2 + bj;
                base = (bf16*)(ws + WS_FXQ + (size_t)t * (WS_FXK - WS_FXQ)) + (size_t)(b * 3 + hh) * 2048 * 128 + 32 * wc + 8 * fq; pitch = 128; }
            else { base = (bf16*)(ws + WS_GATES) + (pn - 16) * 256 + c8; pitch = 3072; }
            if (base) {
#pragma unroll
                for (int ai = 0; ai < 2; ++ai)
#pragma unroll
                    for (int m = 0; m < 4; ++m) { const int row = row0 + ai * 128 + m * 16; const f32x4 v0 = acc[ai][bj][m][0], v1 = acc[ai][bj][m][1];
                        *(u32x4*)(base + (size_t)row * pitch) = (u32x4){pg8::cvt_pk_bf16(v0[0], v0[1]), pg8::cvt_pk_bf16(v0[2], v0[3]), pg8::cvt_pk_bf16(v1[0], v1[1]), pg8::cvt_pk_bf16(v1[2], v1[3])}; }
            } else if (fbase) {
#pragma unroll
                for (int ai = 0; ai < 2; ++ai)
#pragma unroll
                    for (int m = 0; m < 4; ++m) { const int row = row0 + ai * 128 + m * 16; *(f32x4*)(fbase + (size_t)row * 16) = acc[ai][bj][m][0]; *(f32x4*)(fbase + (size_t)row * 16 + 4) = acc[ai][bj][m][1]; }
            }
        }
    }
};
struct InProjSched {
    pg8::StaticOrder so; int f8;
    __device__ __forceinline__ bool next(int i, pg8::Unit& u) const { if (!so.next(i, u)) return false; u.pn = f8 ? (u.pn < 6 ? u.pn : u.pn + 4) : u.pn + 6; return true; }
    __device__ __forceinline__ void a_ready(const pg8::Unit&) const {}
    __device__ __forceinline__ void done(const pg8::Unit&) const {}
};
struct EpiInProj8 {
    static constexpr bool PERM = true, AFTER_DRAIN = false, BIAS_INIT = true;
    static constexpr int NSTORE = 16;
    const float* bias; unsigned char* ws;
    __device__ __forceinline__ const float* bias_src(const pg8::Unit& u, int q) const { return bias + u.pn * 256 + 4 * q; }
    __device__ __forceinline__ void load_bias(f32x4 (&nb)[4], const PG8_LAS float* sl, int wc, int fq) const {
        const PG8_LAS float* bp = sl + 32 * wc + 8 * fq;
        nb[0] = *(const PG8_LAS f32x4*)bp; nb[1] = *(const PG8_LAS f32x4*)(bp + 4); nb[2] = *(const PG8_LAS f32x4*)(bp + 128); nb[3] = *(const PG8_LAS f32x4*)(bp + 128 + 4);
    }
    __device__ __forceinline__ void set_bias(f32x4 (&acc)[2][2][4][2], const f32x4 (&nb)[4]) const {
#pragma unroll
        for (int bj = 0; bj < 2; ++bj)
#pragma unroll
            for (int ai = 0; ai < 2; ++ai)
#pragma unroll
                for (int m = 0; m < 4; ++m) { acc[ai][bj][m][0] = nb[2 * bj]; acc[ai][bj][m][1] = nb[2 * bj + 1]; }
    }
    __device__ __forceinline__ void operator()(const f32x4 (&acc)[2][2][4][2], const pg8::Unit& u, int wr, int wc, int fr, int fq) const {
        asm volatile("" : "+v"(fr), "+v"(fq));
        const int pn = u.pn, row0 = u.pm * 256 + wr * 64 + fr, b = u.pm >> 3;
#pragma unroll
        for (int bj = 0; bj < 2; ++bj) {
            const int c8 = 128 * bj + 32 * wc + 8 * fq;
            bf16* base; int pitch;
            if (pn < 2) { base = (bf16*)(ws + WS_MLQK) + pn * 256 + c8; pitch = 512; }
            else if (pn < 4) { base = (bf16*)(ws + WS_MLV) + (pn - 2) * 256 + c8; pitch = 512; }
            else if (pn < 6) { base = (bf16*)(ws + WS_MLO) + (pn - 4) * 256 + c8; pitch = 512; }
            else if (pn < 16) { const int t = (pn - 10) >> 1, hh = ((pn - 10) & 1) * 2 + bj;
                base = (bf16*)(ws + WS_FXQ + (size_t)t * (WS_FXK - WS_FXQ)) + (size_t)(b * 3 + hh) * 2048 * 128 + 32 * wc + 8 * fq; pitch = 128; }
            else { base = (bf16*)(ws + WS_GATES) + (pn - 16) * 256 + c8; pitch = 3072; }
#pragma unroll
            for (int ai = 0; ai < 2; ++ai)
#pragma unroll
                for (int m = 0; m < 4; ++m) { const int row = row0 + ai * 128 + m * 16; const f32x4 v0 = acc[ai][bj][m][0], v1 = acc[ai][bj][m][1];
                    *(u32x4*)(base + (size_t)row * pitch) = (u32x4){pg8::cvt_pk_bf16(v0[0], v0[1]), pg8::cvt_pk_bf16(v0[2], v0[3]), pg8::cvt_pk_bf16(v1[0], v1[1]), pg8::cvt_pk_bf16(v1[2], v1[3])}; }
        }
    }
};
struct BranchSched {
    int G, c, brpack, nbr;
    __device__ __forceinline__ bool next(int i, pg8::Unit& u) const {
        const int tile = (i / nbr) * G + c, br = (brpack >> (2 * (i % nbr))) & 3; if (tile >= 256) return false;
        u.pm = br * 64 + (tile >> 2); u.pn = br * 4 + (tile & 3); return true;
    }
    __device__ __forceinline__ void a_ready(const pg8::Unit&) const {}
    __device__ __forceinline__ void done(const pg8::Unit&) const {}
};
struct EpiBranch {
    static constexpr bool PERM = true, AFTER_DRAIN = false;
    static constexpr int NSTORE = 32;
    const bf16* gates; bf16* merged; int br0; unsigned char* merged8;
    __device__ __forceinline__ void operator()(const f32x4 (&acc)[2][2][4][2], const pg8::Unit& u, int wr, int wc, int fr, int fq) const {
        asm volatile("" : "+v"(fr), "+v"(fq));
        const int br = u.pm >> 6, row0 = (u.pm & 63) * 256 + wr * 64 + fr, col0 = (u.pn & 3) * 256 + 32 * wc + 8 * fq;
        u32x4 gqn[2], oldn[2];
#pragma unroll
        for (int bj = 0; bj < 2; ++bj) { gqn[bj] = *(const u32x4*)(gates + (size_t)row0 * 3072 + br * 1024 + col0 + bj * 128);
            oldn[bj] = (br != br0) ? *(const u32x4*)(merged + (size_t)row0 * 1024 + col0 + bj * 128) : (u32x4){0u, 0u, 0u, 0u}; }
#pragma unroll
        for (int gi = 0; gi < 8; ++gi) { const int ai = gi >> 2, m = gi & 3, row = row0 + ai * 128 + m * 16;
            u32x4 gq[2], old[2];
#pragma unroll
            for (int bj = 0; bj < 2; ++bj) { gq[bj] = gqn[bj]; old[bj] = oldn[bj]; }
            if (gi < 7) { const int rown = row0 + ((gi + 1) >> 2) * 128 + ((gi + 1) & 3) * 16;
#pragma unroll
                for (int bj = 0; bj < 2; ++bj) { gqn[bj] = *(const u32x4*)(gates + (size_t)rown * 3072 + br * 1024 + col0 + bj * 128);
                    if (br != br0) oldn[bj] = *(const u32x4*)(merged + (size_t)rown * 1024 + col0 + bj * 128); } }
#pragma unroll
            for (int bj = 0; bj < 2; ++bj) { const int col = col0 + bj * 128;
                float v[8];
#pragma unroll
                for (int q = 0; q < 4; ++q) { const float g0 = bf2f(gq[bj][q] & 0xffffu), g1 = bf2f(gq[bj][q] >> 16);
                    v[2 * q] = acc[ai][bj][m][q >> 1][(2 * q) & 3] * __builtin_amdgcn_rcpf(1.0f + __builtin_amdgcn_exp2f(-1.4426950408889634f * g0));
                    v[2 * q + 1] = acc[ai][bj][m][q >> 1][(2 * q + 1) & 3] * __builtin_amdgcn_rcpf(1.0f + __builtin_amdgcn_exp2f(-1.4426950408889634f * g1)); }
                if (br != br0) {
#pragma unroll
                    for (int q = 0; q < 4; ++q) { v[2 * q] += bf2f(old[bj][q] & 0xffffu); v[2 * q + 1] += bf2f(old[bj][q] >> 16); } }
                if (br == 2) *(u32x2*)(merged8 + (size_t)row * 1024 + col) = (u32x2){pk4_fp8(v[0], v[1], v[2], v[3]), pk4_fp8(v[4], v[5], v[6], v[7])};
                else *(u32x4*)(merged + (size_t)row * 1024 + col) = (u32x4){pg8::cvt_pk_bf16(v[0], v[1]), pg8::cvt_pk_bf16(v[2], v[3]), pg8::cvt_pk_bf16(v[4], v[5]), pg8::cvt_pk_bf16(v[6], v[7])}; }
            asm volatile("" ::: "memory"); }
    }
};
struct EpiOutProj {
    static constexpr bool PERM = true, AFTER_DRAIN = false;
    const float* xsrc; unsigned short* X; const float* modl; int src16;
    __device__ __forceinline__ void operator()(const f32x4 (&acc)[2][2][4][2], const pg8::Unit& u, int wr, int wc, int fr, int fq) const {
        asm volatile("" : "+v"(fr), "+v"(fq));
        const int row0 = u.pm * 256 + wr * 64 + fr, col0 = u.pn * 256 + wc * 32 + 8 * fq; const float* g1 = modl + (size_t)(u.pm >> 3) * 6144 + 2048;
        f32x4 gv[2][2];
#pragma unroll
        for (int bj = 0; bj < 2; ++bj)
#pragma unroll
            for (int n = 0; n < 2; ++n) gv[bj][n] = *(const f32x4*)(g1 + col0 + bj * 128 + n * 4);
        const unsigned short* xs16 = (const unsigned short*)xsrc;
        f32x4 xn[2][2]; u32x4 xr[2];
        if (src16) {
#pragma unroll
            for (int bj = 0; bj < 2; ++bj) xr[bj] = *(const u32x4*)(xs16 + (size_t)row0 * 1024 + col0 + bj * 128);
        } else {
#pragma unroll
            for (int bj = 0; bj < 2; ++bj)
#pragma unroll
                for (int n = 0; n < 2; ++n) xn[bj][n] = *(const f32x4*)(xsrc + (size_t)row0 * 1024 + col0 + bj * 128 + n * 4);
        }
#pragma unroll
        for (int gi = 0; gi < 8; ++gi) { const int ai = gi >> 2, m = gi & 3; const size_t off = (size_t)(row0 + ai * 128 + m * 16) * 1024 + col0;
            f32x4 xc[2][2];
            if (src16) {
#pragma unroll
                for (int bj = 0; bj < 2; ++bj) { xc[bj][0] = unpkh4(xr[bj][0], xr[bj][1]); xc[bj][1] = unpkh4(xr[bj][2], xr[bj][3]); }
            } else {
#pragma unroll
                for (int bj = 0; bj < 2; ++bj)
#pragma unroll
                    for (int n = 0; n < 2; ++n) xc[bj][n] = xn[bj][n];
            }
            if (gi < 7) { const size_t offn = (size_t)(row0 + ((gi + 1) >> 2) * 128 + ((gi + 1) & 3) * 16) * 1024 + col0;
                if (src16) {
#pragma unroll
                    for (int bj = 0; bj < 2; ++bj) xr[bj] = *(const u32x4*)(xs16 + offn + bj * 128);
                } else {
#pragma unroll
                    for (int bj = 0; bj < 2; ++bj)
#pragma unroll
                        for (int n = 0; n < 2; ++n) xn[bj][n] = *(const f32x4*)(xsrc + offn + bj * 128 + n * 4);
                } }
#pragma unroll
            for (int bj = 0; bj < 2; ++bj) { const f32x4 v0 = xc[bj][0] + gv[bj][0] * acc[ai][bj][m][0], v1 = xc[bj][1] + gv[bj][1] * acc[ai][bj][m][1];
                *(u32x4*)(X + off + bj * 128) = (u32x4){pkh2(v0[0], v0[1]), pkh2(v0[2], v0[3]), pkh2(v1[0], v1[1]), pkh2(v1[2], v1[3])}; }
            asm volatile("" ::: "memory"); }
    }
};

__device__ __forceinline__ float logsigf(float f) { return fminf(f, 0.f) - __logf(1.0f + __expf(-fabsf(f))); }
__device__ __forceinline__ void fox_unit(Frame& F, int b, int h, int qb) {
    char* lds = (char*)F.lds; const int tid = F.tid, lane = (F.tid & 63), wid = F.wave;
    const int n = (qb + 1) * 256;
    const size_t hb = (size_t)(b * 4 + h) * 2048 * 128;
    att::BlockRef r{WSP(bf16, WS_FXQ) + hb + (size_t)qb * 256 * 128, WSP(bf16, WS_FXK) + hb, WSP(bf16, WS_FXV) + hb,
                    WSP(bf16, WS_YCAT) + (size_t)2 * M * 512 + (size_t)(b * 2048 + qb * 256) * 512 + h * 128, 512, qb * 256, 4 * (qb + 1), nullptr};
    att::Seam S;
    float fraw[4];
    {   const float* fsrc = WSP(float, WS_SCAL) + (size_t)b * 2048 * 16 + 12 + h;
#pragma unroll
        for (int q = 0; q < 4; ++q) { const int s = 4 * tid + q; fraw[q] = (s < n) ? fsrc[(size_t)s * 16] : 0.f; } }
    att::prime<0>(r, lds, S, tid);
    {   float ls[4], run = 0.f;
#pragma unroll
        for (int q = 0; q < 4; ++q) { const int s = 4 * tid + q; const float v = (s < n) ? logsigf(fraw[q]) : 0.f; run += v; ls[q] = run; }
        float incl = run;
#pragma unroll
        for (int off = 1; off < 64; off <<= 1) { const float t = lshfl(incl, (lane - off) & 63); if (lane >= off) incl += t; }
        float* scan = (float*)(lds + att::LDS_SCAN);
        if (lane == 63) scan[wid] = incl;
        __syncthreads();
        float base = 0.f;
        for (int w2 = 0; w2 < wid; ++w2) base += scan[w2];
        const float excl = base + incl - run;
        *(f32x4*)((float*)(lds + att::LDS_KB) + 4 * tid) = (f32x4){-(excl + ls[0]) * 11.313708498984761f, -(excl + ls[1]) * 11.313708498984761f, -(excl + ls[2]) * 11.313708498984761f, -(excl + ls[3]) * 11.313708498984761f};
        __syncthreads();
    }
    att::block<0>(r, r, lds, S, tid);
}
constexpr size_t WS_NLOC = WS_MLST, WS_NPREV = WS_MLST + 262144, WS_MLOC = WS_MLST + 524288, WS_BLAST = WS_MLOC + 4096, WS_MPREV = WS_BLAST + 4096;
namespace ml {
using att::f32x16; using att::s16x4;
constexpr int L_Q = 0, L_K = 8192, L_V = 16384, L_HID = 32768, L_G = L_HID + 64 * 132 * 4, L_WS = L_G + 2048;
__device__ __forceinline__ void stage_conv(char* tile, const bf16* X, const float* cw, const float* cb, int row0, int spos0, int ch0, float scale, int tid) {
    const int s = tid >> 3, ch = ch0 + (tid & 7) * 8;
    float a[8];
    { const f32x4 b0 = *(const f32x4*)(cb + ch), b1 = *(const f32x4*)(cb + ch + 4); a[0] = b0[0]; a[1] = b0[1]; a[2] = b0[2]; a[3] = b0[3]; a[4] = b1[0]; a[5] = b1[1]; a[6] = b1[2]; a[7] = b1[3]; }
#pragma unroll
    for (int j = 0; j < 4; ++j) { if (spos0 + s - 3 + j >= 0) {
            const bf16x8 x = *(const bf16x8*)(X + (size_t)(row0 + s - 3 + j) * 512 + ch);
            const f32x4 w0 = *(const f32x4*)(cw + j * 512 + ch), w1 = *(const f32x4*)(cw + j * 512 + ch + 4);
#pragma unroll
            for (int i = 0; i < 4; ++i) { a[i] += w0[i] * bf2f((unsigned short)x[i]); a[4 + i] += w1[i] * bf2f((unsigned short)x[4 + i]); } } }
#pragma unroll
    for (int i = 0; i < 8; ++i) a[i] = a[i] * scale / (1.0f + __expf(-a[i]));
    *(u32x4*)(tile + (s * 64 + (tid & 7) * 8) * 2) = (u32x4){att::cvtpk(a[0], a[1]), att::cvtpk(a[2], a[3]), att::cvtpk(a[4], a[5]), att::cvtpk(a[6], a[7])};
}
__device__ __forceinline__ void stage_conv4(char* tile0, const bf16* X, const float* cw, const float* cb, int row0, int spos0, int ch0, float scale, int tid) {
    const int s = tid >> 3, ch = ch0 + (tid & 7) * 8;
    bf16x8 x[4][4];
#pragma unroll
    for (int c = 0; c < 4; ++c)
#pragma unroll
        for (int j = 0; j < 4; ++j) { const int sp = spos0 + 64 * c + s - 3 + j; x[c][j] = *(const bf16x8*)(X + (size_t)(row0 + 64 * c + s - 3 + j + (sp < 0 ? 3 : 0)) * 512 + ch); }
    f32x4 w0[4], w1[4];
#pragma unroll
    for (int j = 0; j < 4; ++j) { w0[j] = *(const f32x4*)(cw + j * 512 + ch); w1[j] = *(const f32x4*)(cw + j * 512 + ch + 4); }
    const f32x4 b0 = *(const f32x4*)(cb + ch), b1 = *(const f32x4*)(cb + ch + 4);
#pragma unroll
    for (int c = 0; c < 4; ++c) { float a[8] = {b0[0], b0[1], b0[2], b0[3], b1[0], b1[1], b1[2], b1[3]};
#pragma unroll
        for (int j = 0; j < 4; ++j) { const float msk = (spos0 + 64 * c + s - 3 + j >= 0) ? 1.0f : 0.0f;
#pragma unroll
            for (int i = 0; i < 4; ++i) { a[i] += msk * w0[j][i] * bf2f((unsigned short)x[c][j][i]); a[4 + i] += msk * w1[j][i] * bf2f((unsigned short)x[c][j][4 + i]); } }
#pragma unroll
        for (int i = 0; i < 8; ++i) a[i] = a[i] * scale / (1.0f + __expf(-a[i]));
        *(u32x4*)(tile0 + c * 8192 + (s * 64 + (tid & 7) * 8) * 2) = (u32x4){att::cvtpk(a[0], a[1]), att::cvtpk(a[2], a[3]), att::cvtpk(a[4], a[5]), att::cvtpk(a[6], a[7])}; }
}
__device__ __forceinline__ void stage_v(char* V_lds, const bf16* Vg, int row0, int h, int tid) {
    const int sr = tid >> 4, sc = (tid & 15) * 8;
    const bf16x8 v0 = *(const bf16x8*)(Vg + (size_t)(row0 + sr) * 512 + h * 128 + sc), v1 = *(const bf16x8*)(Vg + (size_t)(row0 + 32 + sr) * 512 + h * 128 + sc);
    *(bf16x8*)(V_lds + att::v_st(sr, sc)) = v0; *(bf16x8*)(V_lds + att::v_st(32 + sr, sc)) = v1;
}
__device__ __forceinline__ void stage_gates(float* G, const float* scal, int row0, int h, int lane, float& b_last, float& m_loc) {
    const float ig = scal[(size_t)(row0 + lane) * 16 + h], f = logsigf(scal[(size_t)(row0 + lane) * 16 + 4 + h]);
    float b = f;
#pragma unroll
    for (int off = 1; off < 64; off <<= 1) { const float t = lshfl(b, (lane - off) & 63); if (lane >= off) b += t; }
    b_last = __builtin_bit_cast(float, __builtin_amdgcn_readlane(__builtin_bit_cast(int, b), 63));
    const float wst = b_last - b + ig; float mx = wst;
#pragma unroll
    for (int off = 1; off < 64; off <<= 1) mx = fmaxf(mx, lshfl(mx, lane ^ off));
    m_loc = mx;
    G[lane] = b; G[64 + lane] = ig - b; G[128 + lane] = __expf(wst - mx);
}
#define TRRD(dst, off) asm volatile("ds_read_b64_tr_b16 %0, %1 offset:%2" : "=&v"(dst) : "v"(vb), "i"(off) : "memory")
#define VFRAG(l_, h_) (bf16x8){l_[0], l_[1], l_[2], l_[3], h_[0], h_[1], h_[2], h_[3]}
__device__ __forceinline__ void mma_v(f32x16& acc, int vb, bf16x8 pa0, bf16x8 pa1, bf16x8 pa2, bf16x8 pa3) {
    s16x4 l0, l1, l2, l3, h0, h1, h2, h3;
    TRRD(l0, 0); TRRD(h0, 2048); TRRD(l1, 4096); TRRD(h1, 6144); TRRD(l2, 8192); TRRD(h2, 10240); TRRD(l3, 12288); TRRD(h3, 14336);
    asm volatile("s_waitcnt lgkmcnt(0)" ::: "memory"); __builtin_amdgcn_sched_barrier(0);
    acc = __builtin_amdgcn_mfma_f32_32x32x16_bf16(pa0, VFRAG(l0, h0), acc, 0, 0, 0);
    acc = __builtin_amdgcn_mfma_f32_32x32x16_bf16(pa1, VFRAG(l1, h1), acc, 0, 0, 0);
    acc = __builtin_amdgcn_mfma_f32_32x32x16_bf16(pa2, VFRAG(l2, h2), acc, 0, 0, 0);
    acc = __builtin_amdgcn_mfma_f32_32x32x16_bf16(pa3, VFRAG(l3, h3), acc, 0, 0, 0);
}
#undef TRRD
#undef VFRAG
__device__ __forceinline__ void unit_local(Frame& F, int l, int u) {
    char* lds = (char*)F.lds; const int tid = F.tid, lane = tid & 63, wid = F.wave, r32 = lane & 31, hi = lane >> 5;
    const int bh = u >> 5, c = u & 31, b = bh >> 2, h = bh & 3, row0 = b * 2048 + c * 64;
    float* G = (float*)(lds + L_G);
    stage_conv(lds + L_K, WSP(bf16, WS_MLQK), KIN(I_CONVW) + (size_t)l * 2048, KIN(I_CONVB) + (size_t)l * 512, row0, c * 64, 256 + h * 64, 1.0f, tid);
    stage_v(lds + L_V, WSP(bf16, WS_MLV), row0, h, tid);
    if (wid == 0) { float bl, mlc; stage_gates(G, WSP(float, WS_SCAL), row0, h, lane, bl, mlc); if (lane == 0) { WSP(float, WS_MLOC)[u] = mlc; WSP(float, WS_BLAST)[u] = bl; } }
    __syncthreads();
    const int kblk = wid >> 2, vblk = wid & 3;
    bf16x8 pa[4];
    const unsigned short* Kc = (const unsigned short*)(lds + L_K);
#pragma unroll
    for (int ks = 0; ks < 4; ++ks) { float w[8];
#pragma unroll
        for (int j = 0; j < 8; ++j) { const int s = 16 * ks + 8 * hi + j; w[j] = bf2f(Kc[s * 64 + kblk * 32 + r32]) * G[128 + s]; }
        u32x4 q = {att::cvtpk(w[0], w[1]), att::cvtpk(w[2], w[3]), att::cvtpk(w[4], w[5]), att::cvtpk(w[6], w[7])}; pa[ks] = *reinterpret_cast<bf16x8*>(&q); }
    f32x16 acc = ozero16();
    mma_v(acc, (int)(uintptr_t)(lds + L_V) + att::v_rd_base(lane) + vblk * 512, pa[0], pa[1], pa[2], pa[3]);
    float* cl = WSP(float, WS_CLOC) + (size_t)u * 8192 + (size_t)(vblk * 32 + r32) * 64 + kblk * 32 + 4 * hi;
#pragma unroll
    for (int g = 0; g < 4; ++g) *(f32x4*)(cl + 8 * g) = (f32x4){acc[4 * g], acc[4 * g + 1], acc[4 * g + 2], acc[4 * g + 3]};
    if (tid < 64) { float s_ = 0.f; for (int s = 0; s < 64; ++s) s_ += G[128 + s] * bf2f(Kc[s * 64 + tid]); WSP(float, WS_NLOC)[(size_t)u * 64 + tid] = s_; }
    __syncthreads();
}
__device__ __forceinline__ void scan_item(Frame& F, int it) {
    const int tid = F.tid;
    float* dec_l = (float*)F.lds; float* scl_l = dec_l + 32; float* mpr_l = dec_l + 64;
    {
        const int bh = it / 5, seg = it % 5;
        __syncthreads();
        if (tid < 32) { dec_l[96 + tid] = WSP(float, WS_MLOC)[bh * 32 + tid]; dec_l[128 + tid] = WSP(float, WS_BLAST)[bh * 32 + tid]; }
        __syncthreads();
        if (tid == 0) { float m = -__builtin_inff();
            for (int c = 0; c < 32; ++c) { const float ml_ = dec_l[96 + c], bl = dec_l[128 + c], mn = fmaxf(bl + m, ml_);
                mpr_l[c] = m; dec_l[c] = __expf(bl + m - mn); scl_l[c] = __expf(ml_ - mn); m = mn; } }
        __syncthreads();
        if (seg < 4) { const int e = seg * 2048 + tid * 4; const float* cl = WSP(float, WS_CLOC) + (size_t)bh * 32 * 8192 + e; bf16* cp = WSP(bf16, WS_CPREV) + (size_t)bh * 32 * 8192 + e;
            f32x4 v[32];
#pragma unroll
            for (int c = 0; c < 32; ++c) v[c] = *(const f32x4*)(cl + (size_t)c * 8192);
            f32x4 st = ozero4();
#pragma unroll
            for (int c = 0; c < 32; ++c) { *(u32x2*)(cp + (size_t)c * 8192) = (u32x2){pk2(st[0], st[1]), pk2(st[2], st[3])}; st = dec_l[c] * st + scl_l[c] * v[c]; }
        } else if (tid < 64) { const float* nl = WSP(float, WS_NLOC) + (size_t)bh * 32 * 64 + tid; float* np = WSP(float, WS_NPREV) + (size_t)bh * 32 * 64 + tid;
            float v[32];
#pragma unroll
            for (int c = 0; c < 32; ++c) v[c] = nl[(size_t)c * 64];
            float st = 0.f;
#pragma unroll
            for (int c = 0; c < 32; ++c) { np[(size_t)c * 64] = st; if (tid == 0) WSP(float, WS_MPREV)[bh * 32 + c] = mpr_l[c]; st = dec_l[c] * st + scl_l[c] * v[c]; }
        }
    }
}
__device__ __forceinline__ void unit_out(Frame& F, int l, int u) {
    char* lds = (char*)F.lds; const int tid = F.tid, lane = tid & 63, wid = F.wave, r32 = lane & 31, hi = lane >> 5;
    const int bh = u >> 5, c = u & 31, b = bh >> 2, h = bh & 3, row0 = b * 2048 + c * 64;
    float* G = (float*)(lds + L_G);
    stage_conv(lds + L_Q, WSP(bf16, WS_MLQK), KIN(I_CONVW) + (size_t)l * 2048, KIN(I_CONVB) + (size_t)l * 512, row0, c * 64, h * 64, 0.125f, tid);
    stage_conv(lds + L_K, WSP(bf16, WS_MLQK), KIN(I_CONVW) + (size_t)l * 2048, KIN(I_CONVB) + (size_t)l * 512, row0, c * 64, 256 + h * 64, 1.0f, tid);
    stage_v(lds + L_V, WSP(bf16, WS_MLV), row0, h, tid);
    if (wid == 0) { float bl, mlc; stage_gates(G, WSP(float, WS_SCAL), row0, h, lane, bl, mlc); G[192 + lane] = WSP(float, WS_NPREV)[(size_t)u * 64 + lane]; }
    __syncthreads();
    const int rb = wid >> 2, vblk = wid & 3, t = rb * 32 + r32;
    bf16x8 qf[4];
#pragma unroll
    for (int ks = 0; ks < 4; ++ks) qf[ks] = *(const bf16x8*)(lds + L_Q + t * 128 + (16 * ks + 8 * hi) * 2);
    f32x16 p0 = ozero16(), p1 = p0;
#pragma unroll
    for (int ks = 0; ks < 4; ++ks) { const bf16x8 k0 = *(const bf16x8*)(lds + L_K + r32 * 128 + (16 * ks + 8 * hi) * 2), k1 = *(const bf16x8*)(lds + L_K + (32 + r32) * 128 + (16 * ks + 8 * hi) * 2);
        p0 = __builtin_amdgcn_mfma_f32_32x32x16_bf16(k0, qf[ks], p0, 0, 0, 0); p1 = __builtin_amdgcn_mfma_f32_32x32x16_bf16(k1, qf[ks], p1, 0, 0, 0); }
    const float bt = G[t], inter = bt + WSP(float, WS_MPREV)[u];
    const float NEG = -__builtin_inff();
    f32x16 d0, d1; float mo = inter;
#pragma unroll
    for (int r = 0; r < 16; ++r) { const int s0 = att::crow(r, hi), s1 = 32 + s0; d0[r] = (s0 <= t) ? bt + G[64 + s0] : NEG; d1[r] = (s1 <= t) ? bt + G[64 + s1] : NEG; mo = fmaxf(mo, fmaxf(d0[r], d1[r])); }
    { auto rr = __builtin_amdgcn_permlane32_swap(__float_as_uint(mo), __float_as_uint(mo), false, false); mo = fmaxf(__uint_as_float(rr[0]), __uint_as_float(rr[1])); }
    float den = 0.f;
#pragma unroll
    for (int r = 0; r < 16; ++r) { p0[r] *= __expf(d0[r] - mo); p1[r] *= __expf(d1[r] - mo); den += p0[r] + p1[r]; }
    const float a_int = __expf(inter - mo);
    float nd = 0.f;
#pragma unroll
    for (int ks = 0; ks < 4; ++ks)
#pragma unroll
        for (int j = 0; j < 8; ++j) nd += G[192 + 16 * ks + 8 * hi + j] * bf2f((unsigned short)qf[ks][j]);
    den += a_int * nd;
    { auto rr = __builtin_amdgcn_permlane32_swap(__float_as_uint(den), __float_as_uint(den), false, false); den = __uint_as_float(rr[0]) + __uint_as_float(rr[1]); }
    float* wsl = (float*)(lds + L_WS) + wid * 64;
    if (hi == 0) wsl[r32] = 1.0f / fmaxf(fabsf(den), __expf(-mo));
    bf16x8 pa0, pa1, pa2, pa3;
#define PK4(P, B_, OUT) do { unsigned a0 = att::cvtpk(P[B_+0], P[B_+1]), a1 = att::cvtpk(P[B_+2], P[B_+3]);                          \
        unsigned b0 = att::cvtpk(P[B_+4], P[B_+5]), b1 = att::cvtpk(P[B_+6], P[B_+7]);                                             \
        auto r0 = __builtin_amdgcn_permlane32_swap(a0, b0, false, false); auto r1 = __builtin_amdgcn_permlane32_swap(a1, b1, false, false); \
        u32x4 w = {r0[0], r1[0], r0[1], r1[1]}; OUT = *reinterpret_cast<bf16x8*>(&w); } while (0)
    PK4(p0, 0, pa0); PK4(p0, 8, pa1); PK4(p1, 0, pa2); PK4(p1, 8, pa3);
#undef PK4
    f32x16 o = ozero16();
    mma_v(o, (int)(uintptr_t)(lds + L_V) + att::v_rd_base(lane) + vblk * 512, pa0, pa1, pa2, pa3);
    const bf16* cp = WSP(bf16, WS_CPREV) + (size_t)u * 8192 + (size_t)(vblk * 32 + r32) * 64 + 8 * hi;
#pragma unroll
    for (int ks = 0; ks < 4; ++ks) { float w[8];
#pragma unroll
        for (int j = 0; j < 8; ++j) w[j] = a_int * bf2f((unsigned short)qf[ks][j]);
        u32x4 q = {att::cvtpk(w[0], w[1]), att::cvtpk(w[2], w[3]), att::cvtpk(w[4], w[5]), att::cvtpk(w[6], w[7])};
        o = __builtin_amdgcn_mfma_f32_32x32x16_bf16(*reinterpret_cast<bf16x8*>(&q), *(const bf16x8*)(cp + 16 * ks), o, 0, 0, 0); }
    asm volatile("s_waitcnt lgkmcnt(0)" ::: "memory");
    float* hid = (float*)(lds + L_HID);
#pragma unroll
    for (int r = 0; r < 16; ++r) { const int tr = att::crow(r, hi); hid[(rb * 32 + tr) * 132 + vblk * 32 + r32] = o[r] * wsl[tr]; }
    __syncthreads();
    {   const int row = tid >> 3, seg = (tid & 7) * 16; const float* hr = hid + row * 132 + seg;
        float v[16], ss = 0.f;
#pragma unroll
        for (int i = 0; i < 4; ++i) { const f32x4 q = *(const f32x4*)(hr + 4 * i); v[4 * i] = q[0]; v[4 * i + 1] = q[1]; v[4 * i + 2] = q[2]; v[4 * i + 3] = q[3]; ss += (q[0] * q[0] + q[1] * q[1]) + (q[2] * q[2] + q[3] * q[3]); }
        ss += qxor1(ss); ss += qxor2(ss); ss += hmirror(ss);
        const float rn = 1.0f / sqrtf(ss * (1.0f / 128.0f) + EPS);
        const float* gn = KIN(I_MLG) + (size_t)l * 512 + h * 128 + seg;
        const bf16* og = WSP(bf16, WS_MLO) + (size_t)(row0 + row) * 512 + h * 128 + seg;
        const u32x4 o0 = *(const u32x4*)og, o1 = *(const u32x4*)(og + 8); unsigned w[8];
#pragma unroll
        for (int i = 0; i < 8; ++i) { const unsigned oo = i < 4 ? o0[i] : o1[i - 4]; const float g0 = bf2f(oo & 0xffffu), g1 = bf2f(oo >> 16);
            const float y0 = v[2 * i] * rn * gn[2 * i] / (1.0f + __expf(-g0)), y1 = v[2 * i + 1] * rn * gn[2 * i + 1] / (1.0f + __expf(-g1));
            w[i] = att::cvtpk(y0, y1); }
        bf16* yo = WSP(bf16, WS_YCAT) + (size_t)(row0 + row) * 512 + h * 128 + seg;
        *(u32x4*)yo = (u32x4){w[0], w[1], w[2], w[3]}; *(u32x4*)(yo + 8) = (u32x4){w[4], w[5], w[6], w[7]};
    }
    __syncthreads();
}
__device__ __forceinline__ void unit_out4(Frame& F, int l, int u4) {
    char* lds = (char*)F.lds; const int tid = F.tid, lane = tid & 63, wid = F.wave, r32 = lane & 31, hi = lane >> 5;
    const int bh = u4 >> 3, g4 = u4 & 7, b = bh >> 2, h = bh & 3, row00 = b * 2048 + g4 * 256;
    constexpr int O_Q = 0, O_K = 32768, O_V = 65536, O_G = LDSCTL_OFF + 1024, O_WS = O_G + 4096;
    const float* cw = KIN(I_CONVW) + (size_t)l * 2048; const float* cb = KIN(I_CONVB) + (size_t)l * 512;
    stage_conv4(lds + O_Q, WSP(bf16, WS_MLQK), cw, cb, row00, g4 * 256, h * 64, 0.125f, tid);
    stage_conv4(lds + O_K, WSP(bf16, WS_MLQK), cw, cb, row00, g4 * 256, 256 + h * 64, 1.0f, tid);
#pragma unroll
    for (int c = 0; c < 4; ++c) stage_v(lds + O_V + c * 16384, WSP(bf16, WS_MLV), row00 + 64 * c, h, tid);
    if (wid < 4) { float bl, mlc; float* G = (float*)(lds + O_G) + wid * 256; stage_gates(G, WSP(float, WS_SCAL), row00 + 64 * wid, h, lane, bl, mlc);
        G[192 + lane] = WSP(float, WS_NPREV)[((size_t)bh * 32 + g4 * 4 + wid) * 64 + lane]; }
    const int c = wid >> 1, t = 32 * (wid & 1) + r32; const size_t u = (size_t)bh * 32 + g4 * 4 + c;
    bf16x8 cpf[4][4];
#pragma unroll
    for (int d0 = 0; d0 < 4; ++d0)
#pragma unroll
        for (int ks = 0; ks < 4; ++ks) cpf[d0][ks] = *(const bf16x8*)(WSP(bf16, WS_CPREV) + u * 8192 + (size_t)(d0 * 32 + r32) * 64 + 8 * hi + 16 * ks);
    const float mprev_u = WSP(float, WS_MPREV)[u];
    __syncthreads();
    const float* G = (const float*)(lds + O_G) + c * 256;
    bf16x8 qf[4];
#pragma unroll
    for (int ks = 0; ks < 4; ++ks) qf[ks] = *(const bf16x8*)(lds + O_Q + c * 8192 + t * 128 + (16 * ks + 8 * hi) * 2);
    f32x16 p0 = ozero16(), p1 = p0;
#pragma unroll
    for (int ks = 0; ks < 4; ++ks) { const bf16x8 k0 = *(const bf16x8*)(lds + O_K + c * 8192 + r32 * 128 + (16 * ks + 8 * hi) * 2), k1 = *(const bf16x8*)(lds + O_K + c * 8192 + (32 + r32) * 128 + (16 * ks + 8 * hi) * 2);
        p0 = __builtin_amdgcn_mfma_f32_32x32x16_bf16(k0, qf[ks], p0, 0, 0, 0); p1 = __builtin_amdgcn_mfma_f32_32x32x16_bf16(k1, qf[ks], p1, 0, 0, 0); }
    const float bt = G[t], inter = bt + mprev_u;
    const float NEG = -__builtin_inff();
    float mo = inter;
    {   f32x16 d0, d1;
#pragma unroll
        for (int r = 0; r < 16; ++r) { const int s0 = att::crow(r, hi), s1 = 32 + s0; d0[r] = (s0 <= t) ? bt + G[64 + s0] : NEG; d1[r] = (s1 <= t) ? bt + G[64 + s1] : NEG; mo = fmaxf(mo, fmaxf(d0[r], d1[r])); }
        { auto rr = __builtin_amdgcn_permlane32_swap(__float_as_uint(mo), __float_as_uint(mo), false, false); mo = fmaxf(__uint_as_float(rr[0]), __uint_as_float(rr[1])); }
#pragma unroll
        for (int r = 0; r < 16; ++r) { p0[r] *= __expf(d0[r] - mo); p1[r] *= __expf(d1[r] - mo); }
    }
    float den = 0.f;
#pragma unroll
    for (int r = 0; r < 16; ++r) den += p0[r] + p1[r];
    const float a_int = __expf(inter - mo);
    float nd = 0.f;
#pragma unroll
    for (int ks = 0; ks < 4; ++ks)
#pragma unroll
        for (int j = 0; j < 8; ++j) nd += G[192 + 16 * ks + 8 * hi + j] * bf2f((unsigned short)qf[ks][j]);
    den += a_int * nd;
    { auto rr = __builtin_amdgcn_permlane32_swap(__float_as_uint(den), __float_as_uint(den), false, false); den = __uint_as_float(rr[0]) + __uint_as_float(rr[1]); }
    float* wsl = (float*)(lds + O_WS) + wid * 64;
    if (hi == 0) wsl[r32] = 1.0f / fmaxf(fabsf(den), __expf(-mo));
    bf16x8 pa0, pa1, pa2, pa3;
#define PK4(P, B_, OUT) do { unsigned a0 = att::cvtpk(P[B_+0], P[B_+1]), a1 = att::cvtpk(P[B_+2], P[B_+3]);                          \
        unsigned b0 = att::cvtpk(P[B_+4], P[B_+5]), b1 = att::cvtpk(P[B_+6], P[B_+7]);                                             \
        auto r0 = __builtin_amdgcn_permlane32_swap(a0, b0, false, false); auto r1 = __builtin_amdgcn_permlane32_swap(a1, b1, false, false); \
        u32x4 w = {r0[0], r1[0], r0[1], r1[1]}; OUT = *reinterpret_cast<bf16x8*>(&w); } while (0)
    PK4(p0, 0, pa0); PK4(p0, 8, pa1); PK4(p1, 0, pa2); PK4(p1, 8, pa3);
#undef PK4
    bf16x8 qa[4];
#pragma unroll
    for (int ks = 0; ks < 4; ++ks) { float w[8];
#pragma unroll
        for (int j = 0; j < 8; ++j) w[j] = a_int * bf2f((unsigned short)qf[ks][j]);
        u32x4 q = {att::cvtpk(w[0], w[1]), att::cvtpk(w[2], w[3]), att::cvtpk(w[4], w[5]), att::cvtpk(w[6], w[7])}; qa[ks] = *reinterpret_cast<bf16x8*>(&q); }
    f32x16 o[4];
    const int vbase = (int)(uintptr_t)(lds + O_V + c * 16384) + att::v_rd_base(lane);
#pragma unroll
    for (int d0 = 0; d0 < 4; ++d0) { o[d0] = ozero16();
        mma_v(o[d0], vbase + d0 * 512, pa0, pa1, pa2, pa3);
#pragma unroll
        for (int ks = 0; ks < 4; ++ks) o[d0] = __builtin_amdgcn_mfma_f32_32x32x16_bf16(qa[ks], cpf[d0][ks], o[d0], 0, 0, 0); }
    asm volatile("s_waitcnt lgkmcnt(0)" ::: "memory");
    float rinv[16];
#pragma unroll
    for (int r = 0; r < 16; ++r) rinv[r] = wsl[att::crow(r, hi)];
    __syncthreads();
    unsigned short* ht = (unsigned short*)(lds + wid * 8704);
#pragma unroll
    for (int r = 0; r < 16; ++r) { const int tr = att::crow(r, hi);
#pragma unroll
        for (int d0 = 0; d0 < 4; ++d0) ht[tr * 136 + d0 * 32 + r32] = (unsigned short)f2bf(o[d0][r] * rinv[r]); }
    asm volatile("s_waitcnt lgkmcnt(0)" ::: "memory");
    {   const int row = lane >> 1, seg = (lane & 1) * 64; const unsigned short* hr = ht + row * 136 + seg;
        u32x4 hv[8]; float ss = 0.f;
#pragma unroll
        for (int i = 0; i < 8; ++i) { hv[i] = *(const u32x4*)(hr + 8 * i);
#pragma unroll
            for (int q = 0; q < 4; ++q) { const float a = bf2f(hv[i][q] & 0xffffu), b2 = bf2f(hv[i][q] >> 16); ss += a * a + b2 * b2; } }
        ss += __builtin_bit_cast(float, __builtin_amdgcn_update_dpp(0, __builtin_bit_cast(int, ss), 0xB1, 0xf, 0xf, false));
        const float rn = 1.0f / sqrtf(ss * (1.0f / 128.0f) + EPS);
        const int grow = row00 + 64 * c + 32 * (wid & 1) + row;
        const float* gn = KIN(I_MLG) + (size_t)l * 512 + h * 128 + seg;
        const bf16* og = WSP(bf16, WS_MLO) + (size_t)grow * 512 + h * 128 + seg;
        bf16* yo = WSP(bf16, WS_YCAT) + (size_t)grow * 512 + h * 128 + seg;
#pragma unroll
        for (int i = 0; i < 8; ++i) { const u32x4 oo = *(const u32x4*)(og + 8 * i); const f32x4 g0 = *(const f32x4*)(gn + 8 * i), g1 = *(const f32x4*)(gn + 8 * i + 4); unsigned w[4];
#pragma unroll
            for (int q = 0; q < 4; ++q) { const float a = bf2f(hv[i][q] & 0xffffu), b2 = bf2f(hv[i][q] >> 16), ga = bf2f(oo[q] & 0xffffu), gb = bf2f(oo[q] >> 16);
                const float wa = q < 2 ? g0[2 * q] : g1[2 * q - 4], wb = q < 2 ? g0[2 * q + 1] : g1[2 * q - 3];
                w[q] = att::cvtpk(a * rn * wa / (1.0f + __expf(-ga)), b2 * rn * wb / (1.0f + __expf(-gb))); }
            *(u32x4*)(yo + 8 * i) = (u32x4){w[0], w[1], w[2], w[3]}; }
    }
    __syncthreads();
}
__device__ __forceinline__ void unit_local4(Frame& F, int l, int u4) {
    char* lds = (char*)F.lds; const int tid = F.tid, lane = tid & 63, wid = F.wave, r32 = lane & 31, hi = lane >> 5;
    const int bh = u4 >> 3, g4 = u4 & 7, b = bh >> 2, h = bh & 3, row00 = b * 2048 + g4 * 256;
    constexpr int O_K = 32768, O_V = 65536, O_G = LDSCTL_OFF + 1024;
    stage_conv4(lds + O_K, WSP(bf16, WS_MLQK), KIN(I_CONVW) + (size_t)l * 2048, KIN(I_CONVB) + (size_t)l * 512, row00, g4 * 256, 256 + h * 64, 1.0f, tid);
#pragma unroll
    for (int c = 0; c < 4; ++c) stage_v(lds + O_V + c * 16384, WSP(bf16, WS_MLV), row00 + 64 * c, h, tid);
    if (wid < 4) { float bl, mlc; stage_gates((float*)(lds + O_G) + wid * 256, WSP(float, WS_SCAL), row00 + 64 * wid, h, lane, bl, mlc);
        if (lane == 0) { WSP(float, WS_MLOC)[bh * 32 + g4 * 4 + wid] = mlc; WSP(float, WS_BLAST)[bh * 32 + g4 * 4 + wid] = bl; } }
    __syncthreads();
    const int c = wid >> 1, kblk = wid & 1; const size_t u = (size_t)bh * 32 + g4 * 4 + c;
    const float* G = (const float*)(lds + O_G) + c * 256;
    const unsigned short* Kc = (const unsigned short*)(lds + O_K + c * 8192);
    bf16x8 pa[4];
#pragma unroll
    for (int ks = 0; ks < 4; ++ks) { float w[8];
#pragma unroll
        for (int j = 0; j < 8; ++j) { const int s = 16 * ks + 8 * hi + j; w[j] = bf2f(Kc[s * 64 + kblk * 32 + r32]) * G[128 + s]; }
        u32x4 q = {att::cvtpk(w[0], w[1]), att::cvtpk(w[2], w[3]), att::cvtpk(w[4], w[5]), att::cvtpk(w[6], w[7])}; pa[ks] = *reinterpret_cast<bf16x8*>(&q); }
    const int vbase = (int)(uintptr_t)(lds + O_V + c * 16384) + att::v_rd_base(lane);
#pragma unroll
    for (int vblk = 0; vblk < 4; ++vblk) { f32x16 acc = ozero16();
        mma_v(acc, vbase + vblk * 512, pa[0], pa[1], pa[2], pa[3]);
        float* cl = WSP(float, WS_CLOC) + u * 8192 + (size_t)(vblk * 32 + r32) * 64 + kblk * 32 + 4 * hi;
#pragma unroll
        for (int g = 0; g < 4; ++g) *(f32x4*)(cl + 8 * g) = (f32x4){acc[4 * g], acc[4 * g + 1], acc[4 * g + 2], acc[4 * g + 3]}; }
    if (tid < 256) { const int c2 = tid >> 6, k = tid & 63; const float* G2 = (const float*)(lds + O_G) + c2 * 256; const unsigned short* K2 = (const unsigned short*)(lds + O_K + c2 * 8192);
        float s_ = 0.f; for (int s = 0; s < 64; ++s) s_ += G2[128 + s] * bf2f(K2[s * 64 + k]); WSP(float, WS_NLOC)[((size_t)bh * 32 + g4 * 4 + c2) * 64 + k] = s_; }
    __syncthreads();
}
}
__device__ __forceinline__ int wave_sum_i(int v) {
    v += __builtin_amdgcn_update_dpp(0, v, 0x128, 0xf, 0xf, false);
    v += __builtin_amdgcn_update_dpp(0, v, 0x124, 0xf, 0xf, false);
    v += __builtin_amdgcn_update_dpp(0, v, 0x122, 0xf, 0xf, false);
    v += __builtin_amdgcn_update_dpp(0, v, 0x121, 0xf, 0xf, false);
    return __builtin_amdgcn_readlane(v, 0) + __builtin_amdgcn_readlane(v, 16) + __builtin_amdgcn_readlane(v, 32) + __builtin_amdgcn_readlane(v, 48);
}
__device__ __forceinline__ unsigned sortkey(float f) { unsigned u = __float_as_uint(f); u = (u == 0x80000000u) ? 0u : u; return (u & 0x80000000u) ? ~u : (u | 0x80000000u); }
__device__ __forceinline__ void transpose32(unsigned (&A)[32]) {
    unsigned m = 0x0000FFFFu;
#pragma unroll
    for (int j = 16; j != 0; j >>= 1, m ^= (m << j)) {
#pragma unroll
        for (int k = 0; k < 32; k = (k + j + 1) & ~j) { const unsigned t = (A[k] ^ (A[k + j] >> j)) & m; A[k] ^= t; A[k + j] ^= (t << j); }
    }
}
__device__ __forceinline__ void dsa_select_pair(const float* SC, unsigned* bm, int q0, int nt, int lane) {
    unsigned ka[32], kb[32], A[32], B[32];
#pragma unroll
    for (int j = 0; j < 32; ++j) { if (j < nt) { ka[j] = sortkey(SC[(size_t)q0 * 2048 + 64 * j + lane]); kb[j] = sortkey(SC[(size_t)(q0 + 1) * 2048 + 64 * j + lane]); } else { ka[j] = 0u; kb[j] = 0u; } A[j] = ka[j]; B[j] = kb[j]; }
    transpose32(A); transpose32(B);
    unsigned pa = 0u, pb = 0u; int npa = 1 << 30, npb = 1 << 30;
    for (int rep_ = 0; rep_ < 1 + ((DUP_MASK >> 26) & 1); ++rep_) { pa = 0u; pb = 0u; npa = 1 << 30; npb = 1 << 30; asm volatile("" : "+s"(pa), "+s"(pb));
    unsigned alA = 0xffffffffu, alB = 0xffffffffu; int abA = 0, abB = 0;
#pragma unroll
    for (int bit = 31; bit >= 0; --bit) {
        const unsigned tA = alA & A[31 - bit], tB = alB & B[31 - bit];
        const int cA = __builtin_popcount(tA) + abA, cB = __builtin_popcount(tB) + abB;
        const int nA = wave_sum_i(cA), nB = wave_sum_i(cB);
        if (nA >= 256) { alA = tA; pa |= 1u << bit; npa = nA; } else { alA ^= tA; abA = cA; }
        if (nB >= 256) { alB = tB; pb |= 1u << bit; npb = nB; } else { alB ^= tB; abB = cB; }
        if (npa == 256 && npb == 256) break;
    } }
#pragma unroll
    for (int which = 0; which < 2; ++which) {
        const unsigned prefix = which ? pb : pa; const int np = which ? npb : npa;
        int ngt = 0;
        if (np != 256) {
#pragma unroll
            for (int j = 0; j < 32; ++j) ngt += ((which ? kb[j] : ka[j]) > prefix) ? 1 : 0;
            ngt = wave_sum_i(ngt);
        }
        const int need = 256 - ngt; int running = 0; unsigned keep0 = 0u, keep1 = 0u;
#pragma unroll
        for (int j = 0; j < 32; ++j) { if (j < nt) { const unsigned k_ = which ? kb[j] : ka[j];
                bool sel;
                if (np == 256) sel = k_ >= prefix;
                else { const bool eq = k_ == prefix; const unsigned long long e = __ballot(eq);
                    const int rank = running + (int)__builtin_amdgcn_mbcnt_hi((unsigned)(e >> 32), __builtin_amdgcn_mbcnt_lo((unsigned)e, 0u));
                    sel = (k_ > prefix) || (eq && rank < need); running += __builtin_popcountll(e); }
                const unsigned long long m = __ballot(sel);
                if (lane == j) { keep0 = (unsigned)m; keep1 = (unsigned)(m >> 32); } } }
        if (lane < nt) *(u32x2*)(bm + (q0 + which) * 64 + 2 * lane) = (u32x2){keep0, keep1};
    }
}
constexpr int CW_DEP = 8192;
__device__ __forceinline__ unsigned* dep_word(int l, int kind, int bh) { return (unsigned*)KCTL + CW_DEP + 64 * (l * 64 + kind * 32 + bh); }
__device__ __forceinline__ void dep_signal(Frame& F, unsigned* w) {
    asm volatile("s_waitcnt vmcnt(0)" ::: "memory");
    __syncthreads();
    if (F.wave == 0 && hw_lane() == 0) { __builtin_amdgcn_fence(__ATOMIC_RELEASE, "agent"); asm volatile("s_waitcnt vmcnt(0)" ::: "memory"); (void)xb_add(w, 1u); }
}
__device__ __forceinline__ void dep_wait(Frame& F, unsigned* w, unsigned target) {
    if (F.wave == 0 && hw_lane() == 0) { unsigned sp = 0u; while (xb_ld(w) < target) { __builtin_amdgcn_s_sleep(2); if (++sp > (1u << 24)) break; }
        __builtin_amdgcn_fence(__ATOMIC_ACQUIRE, "agent"); asm volatile("s_waitcnt vmcnt(0)" ::: "memory"); }
    __syncthreads();
}
__device__ __forceinline__ unsigned* dep_nrm(int l, int b) { return (unsigned*)KCTL + CW_DEP + 64 * (128 + l * 8 + b); }
__device__ __forceinline__ void ckv_norm_item(Frame& F, int l, int item) {
    const int lane = F.tid & 63, sc = (lane & 15) * 8;
    const float* g = KIN(I_KVG) + (size_t)l * 128 + sc;
#pragma unroll
    for (int i = 0; i < 8; ++i) { const size_t row = (size_t)item * 256 + F.wave * 32 + i * 4 + (lane >> 4);
        const bf16x8 x = *(const bf16x8*)(WSP(bf16, WS_CKV) + row * 128 + sc);
        *(bf16x8*)(WSP(bf16, WS_CKVN) + row * 128 + sc) = att::nrm8(x, g); }
}
__device__ __forceinline__ void dsa_unit(Frame& F, int l, int b, int cq) {
    char* lds = (char*)F.lds; const int tid = F.tid, lane = tid & 63, wid = F.wave, r32 = lane & 31, hi = lane >> 5;
    const int m0 = b * 2048 + cq * 64, nvis = 64 * (cq + 1);
    float* SC = WSP(float, WS_SCORE) + (size_t)blockIdx.x * 64 * 2048;
    for (int rep_ = 0; rep_ < 1 + ((DUP_MASK >> 25) & 1); ++rep_)
    {
        bf16x8 af[4];
        const bf16* qa = WSP(bf16, WS_IQ) + ((size_t)(m0 + 8 * wid) * 4 + r32) * 64 + 8 * hi;
#pragma unroll
        for (int ks = 0; ks < 4; ++ks) af[ks] = *(const bf16x8*)(qa + 16 * ks);
        float wq[4][4];
#pragma unroll
        for (int g = 0; g < 4; ++g) { const f32x4 w4 = *(const f32x4*)(WSP(float, WS_SCAL) + (size_t)(m0 + 8 * wid + 2 * g + hi) * 16 + 8);
            wq[g][0] = w4[0] * 0.0625f; wq[g][1] = w4[1] * 0.0625f; wq[g][2] = w4[2] * 0.0625f; wq[g][3] = w4[3] * 0.0625f; }
        const bf16* kg = WSP(bf16, WS_IK) + ((size_t)b * 2048 + (tid >> 3)) * 64 + (tid & 7) * 8;
        const int kw = (tid >> 3) * 144 + (tid & 7) * 16;
        bf16x8 stg = *(const bf16x8*)kg;
        *(bf16x8*)(lds + kw) = stg;
        __syncthreads();
        const int ntile = cq + 1;
        for (int t = 0; t < ntile; ++t) {
            const char* kb_ = lds + (t & 1) * 9216;
            if (t + 1 < ntile) stg = *(const bf16x8*)(kg + (size_t)(t + 1) * 64 * 64);
#pragma unroll
            for (int kb = 0; kb < 2; ++kb) {
                att::f32x16 d = ozero16();
#pragma unroll
                for (int ks = 0; ks < 4; ++ks) d = __builtin_amdgcn_mfma_f32_32x32x16_bf16(af[ks], *(const bf16x8*)(kb_ + (32 * kb + r32) * 144 + (16 * ks + 8 * hi) * 2), d, 0, 0, 0);
                float sv[4];
#pragma unroll
                for (int g = 0; g < 4; ++g) sv[g] = wq[g][0] * fmaxf(d[4 * g], 0.f) + wq[g][1] * fmaxf(d[4 * g + 1], 0.f) + wq[g][2] * fmaxf(d[4 * g + 2], 0.f) + wq[g][3] * fmaxf(d[4 * g + 3], 0.f);
                {
                    const bool up = (r32 & 2) != 0, od = (r32 & 1) != 0;
                    const float x1 = up ? sv[0] : sv[2], y1 = up ? sv[1] : sv[3]; const float rx1 = qxor2(x1), ry1 = qxor2(y1);
                    if (up) { sv[0] = rx1; sv[1] = ry1; } else { sv[2] = rx1; sv[3] = ry1; }
                    const float x2 = od ? sv[0] : sv[1], y2 = od ? sv[2] : sv[3]; const float rx2 = qxor1(x2), ry2 = qxor1(y2);
                    if (od) { sv[0] = rx2; sv[2] = ry2; } else { sv[1] = rx2; sv[3] = ry2; }
                    *(f32x4*)(SC + (size_t)(8 * wid + 2 * (r32 & 3) + hi) * 2048 + t * 64 + kb * 32 + (r32 & ~3)) = (f32x4){sv[0], sv[1], sv[2], sv[3]}; }
            }
            if (t + 1 < ntile) *(bf16x8*)(lds + ((t + 1) & 1) * 9216 + kw) = stg;
            asm volatile("s_waitcnt lgkmcnt(0)" ::: "memory"); __builtin_amdgcn_s_barrier(); asm volatile("" ::: "memory");
        }
    }
    asm volatile("s_waitcnt vmcnt(0)" ::: "memory"); __builtin_amdgcn_fence(__ATOMIC_ACQUIRE, "agent"); asm volatile("s_waitcnt vmcnt(0)" ::: "memory");
    {
        unsigned* bm = (unsigned*)(lds + att::LDS_BM);
        const int nt = cq + 1;
        if (nvis <= 256) {
            for (int ql = 0; ql < 8; ++ql) if (32 * lane < nvis) bm[(8 * wid + ql) * 64 + lane] = 0xffffffffu;
        } else {
            for (int qp = 0; qp < 4; ++qp) dsa_select_pair(SC, bm, 8 * wid + 2 * qp, nt, lane);
        }
    }
    __syncthreads();
    dep_wait(F, dep_nrm(l, b), 8u);
    att::BlockRef r{WSP(bf16, WS_QABS) + (size_t)m0 * 512, WSP(bf16, WS_CKVN) + (size_t)b * 2048 * 128, WSP(bf16, WS_CKVN) + (size_t)b * 2048 * 128,
                    WSP(bf16, WS_YCAT) + (size_t)M * 512 + (size_t)m0 * 512, 128, 0, cq + 1, KIN(I_KVG) + (size_t)l * 128};
    if (tid < 128) ((float*)(lds + att::LDS_GN))[tid] = r.g[tid];
    __syncthreads();
    att::Seam S;
    for (int rep_ = 0; rep_ < 1 + ((DUP_MASK >> 27) & 1); ++rep_) { att::prime<1>(r, lds, S, tid); att::block<1>(r, r, lds, S, tid); }
}
__device__ __forceinline__ void mixer_queue(Frame& F, int l, int qidx) {
    PHASE_BEGIN();
    volatile LAS int* qslot = (volatile LAS int*)(F.lds + LDSCTL_OFF + 192);
    unsigned* heads = (unsigned*)KCTL + CW_Q + 64 * (8 * qidx);
    constexpr int NQ = 8 + 32 + 32 + 32 + 20 + 32;
    int q = (int)(xb_xcc_id() & 7u), stolen = 0;
    for (;;) {
        __syncthreads();
        if (F.tid == 0) {
            int li = (int)__hip_atomic_fetch_add(heads + 64 * q, 1u, __ATOMIC_RELAXED, __HIP_MEMORY_SCOPE_AGENT), qq = q;
            while (li >= NQ && stolen < 8) {
                int found = -1;
                for (int s2 = 1; s2 < 8; ++s2) { const int c = (q + s2) & 7; if (found < 0 && (int)__hip_atomic_load(heads + 64 * c, __ATOMIC_RELAXED, __HIP_MEMORY_SCOPE_AGENT) < NQ) found = c; }
                if (found < 0) break;
                qq = found; li = (int)__hip_atomic_fetch_add(heads + 64 * qq, 1u, __ATOMIC_RELAXED, __HIP_MEMORY_SCOPE_AGENT);
                if (li >= NQ) ++stolen;
            }
            qslot[0] = li; qslot[1] = qq; }
        __syncthreads();
        const int li = qslot[0], b = qslot[1];
        if (li >= NQ) break;
        PHASE_BEGIN();
        if (li < 8) { const int item = b * 8 + li; ckv_norm_item(F, l, item); dep_signal(F, dep_nrm(l, b)); continue; }
        int j = li - 8;
        if (j < 32) { dsa_unit(F, l, b, 31 - j); continue; }
        j -= 32;
        if (j < 32) { fox_unit(F, b, j & 3, 7 - (j >> 2)); continue; }
        j -= 32;
        if (j < 32) { const int item = b * 32 + j; ml::unit_local4(F, l, item); dep_signal(F, dep_word(l, 0, item >> 3)); continue; }
        j -= 32;
        if (j < 20) { const int item = b * 20 + j; dep_wait(F, dep_word(l, 0, item / 5), 8u); ml::scan_item(F, item); dep_signal(F, dep_word(l, 1, item / 5)); continue; }
        j -= 20;
        { const int item = b * 32 + j; dep_wait(F, dep_word(l, 1, item >> 3), 5u); ml::unit_out4(F, l, item); }
    }
}


__global__ void __launch_bounds__(NTHREADS, 2) fwd_kernel(Args args) {
    extern __shared__ __attribute__((aligned(16))) unsigned char lds[];
    cg::grid_group grid = cg::this_grid();
    Frame F;
    F.lds = (LAS unsigned char*)lds;
    F.wave = __builtin_amdgcn_readfirstlane((int)threadIdx.x >> 6); F.tid = F.wave * 64 + hw_lane();
    volatile LAS unsigned* MISC = (volatile LAS unsigned*)(F.lds + MISC_OFF);
    for (int u = F.tid; u < (LDS_BYTES - LDSCTL_OFF) / 4; u += NTHREADS) ((LAS unsigned*)(F.lds + LDSCTL_OFF))[u] = 0u;
    __syncthreads();
    (void)xcd_barrier_post((unsigned*)KCTL + CW_BAR, MISC + 8, F.tid == 0);
    if (KARGS->ws == nullptr) grid.sync();
#define GRID_BAR() do { XcdBarrier bar_; bar_.bar = (unsigned*)KCTL + CW_BAR; bar_.x = xb_xcc_id(); bar_.st = (volatile LAS unsigned*)(F.lds + MISC_OFF) + 8; bar_.t0 = (F.wave == 0) && (hw_lane() == 0); xcd_barrier(bar_); } while (0)
#define REPS(k) (((DUP_MASK >> (k)) & 1) && l == 0 ? 2 : 1)
    for (int rep = 0; rep < ((DUP_MASK & 1) ? 2 : 1); ++rep) { p0_prologue(F); p0_moe_weights(F); GRID_BAR(); }
    norm_rows(F, KIN(I_X), 0, 0, 1024); GRID_BAR();
    for (int l = 0; l < DEPTH; ++l) {
        const float* xsrc = (l == 0) ? KIN(I_X) : WSP(float, WS_X);
        for (int rep = 0; rep < REPS(1); ++rep) {
            {   PHASE_BEGIN(); pg8::Gemm g{WSP(bf16, WS_XN), WSP(bf16, WS_WIN_T) + (size_t)l * NV * 1024, M, NV, 1024};
                InProjSched Sc; Sc.so.init(M, 4 * 256, GRIDN, (int)blockIdx.x); Sc.f8 = 0; EpiInProj E{WSP(float, WS_BINP) + (size_t)l * NV, (unsigned char*)KWS};
                pg8::gemm_phase<EpiInProj, InProjSched, true, true>(F.lds, g, Sc, E, F.tid); }
            {   PHASE_BEGIN(); pg8::Gemm g{(const bf16*)WSP(unsigned char, WS_XN1_8), (const bf16*)(WSP(unsigned char, WS_WIN8) + (size_t)l * NV * 1024), M, NV, 512};
                InProjSched Sc; Sc.so.init(M, 24 * 256, GRIDN, (int)blockIdx.x); Sc.f8 = 1; EpiInProj8 E{WSP(float, WS_BINP) + (size_t)l * NV, (unsigned char*)KWS};
                pg8::gemm_phase<EpiInProj8, InProjSched, false, true, true>(F.lds, g, Sc, E, F.tid); }
            GRID_BAR(); }
        mixer_queue(F, l, l); GRID_BAR();
        for (int rep = 0; rep < REPS(4); ++rep) {
            {   PHASE_BEGIN(); pg8::Gemm g{WSP(bf16, WS_YCAT), WSP(bf16, WS_WBR_T) + (size_t)l * 3072 * 512, 3 * M, 3072, 512};
                BranchSched Sc{GRIDN, vcu_id(), 0 | (1 << 2) | (2 << 4), 3}; EpiBranch E{WSP(bf16, WS_GATES), WSP(bf16, WS_MERGED), 0, WSP(unsigned char, WS_MERGED8)};
                pg8::gemm_phase<EpiBranch, BranchSched, true, true>(F.lds, g, Sc, E, F.tid); }
            GRID_BAR();
            {   PHASE_BEGIN(); pg8::Gemm g{(const bf16*)WSP(unsigned char, WS_MERGED8), (const bf16*)(WSP(unsigned char, WS_WOUT8) + (size_t)l * 1024 * 1024), M, 1024, 512};
                pg8::StaticOrder Sc; Sc.init(M, 1024, GRIDN, (int)blockIdx.x); EpiOutProj E{xsrc, WSP(unsigned short, WS_X), WSP(float, WS_MOD) + (size_t)l * 8 * 6144, l > 0 ? 1 : 0};
                pg8::gemm_phase<EpiOutProj, pg8::StaticOrder, false, true, true>(F.lds, g, Sc, E, F.tid); }
            GRID_BAR(); }
        xsrc = WSP(float, WS_X);
        if (((DUP_MASK >> 16) & 1) && l == 0) { route_phase(F, l, xsrc, true); GRID_BAR(); }
        route_phase(F, l, xsrc); GRID_BAR();
        gather_phase(F, l);
        const LAS int* tst = (const LAS int*)(F.lds + LDSCTL_OFF);
        for (int rep = 0; rep < REPS(6); ++rep) {
            {   PHASE_BEGIN(); pg8::Gemm gp{(const bf16*)WSP(unsigned char, WS_XN8), (const bf16*)(WSP(unsigned char, WS_W1T) + (size_t)l * 32 * 2048 * 1024), MP, 32 * 2048, 512};
                MoeSched<8> Sc{tst, tst[32] * 8, GRIDN, vcu_id()}; EpiP1 E{WSP(unsigned char, WS_ACT8), KIN(I_B1) + (size_t)l * 32 * 2048, WSP(unsigned short, WS_AS8), tst};
                pg8::gemm_phase<EpiP1, MoeSched<8>, true, true, true>(F.lds, gp, Sc, E, F.tid); }
            GRID_BAR(); }
        for (int rep = 0; rep < REPS(18); ++rep) {
        {   PHASE_BEGIN(); f8::Gemm g{WSP(unsigned char, WS_ACT8), WSP(unsigned char, WS_W2T) + (size_t)l * 32 * 1024 * 1024, 1024};
            MoeSched<4> Sc{tst, tst[32] * 4, GRIDN, vcu_id(), (DUP_MASK >> 24) & 1 & ((rep == 0 && l == 0) ? 1 : 0)}; EpiP2 E{WSP(bf16, WS_ASORT), KIN(I_B2) + (size_t)l * 32 * 1024, (((DUP_MASK >> 22) & 3) && rep == 0 && l == 0) ? ((DUP_MASK >> 22) & 3) : 0};
            pg8::Gemm gp{(const bf16*)g.A, (const bf16*)g.Bt, MP, 32 * 1024, 512, (((DUP_MASK >> 21) & 1) && rep == 0 && l == 0) ? 2 : 0};
            {
                const int nmax = (Sc.total + GRIDN - 1) / GRIDN, nmine = (Sc.total - Sc.c + GRIDN - 1) / GRIDN;
                if (nmine < nmax) { __builtin_amdgcn_s_sleep(100); __builtin_amdgcn_s_sleep(100); } }
            pg8::gemm_phase<EpiP2, MoeSched<4>, false, true, true>(F.lds, gp, Sc, E, F.tid); }
        GRID_BAR(); }
        if (((DUP_MASK >> 17) & 1) && l == 0) { combine_phase(F, l, xsrc, false, true); GRID_BAR(); }
        combine_phase(F, l, xsrc, l == DEPTH - 1);
        if (l != DEPTH - 1) GRID_BAR();
    }
}

extern "C" void kernel_launch(void* const* d_in, const int* in_sizes, int n_in, void* d_out, int out_size, void* d_ws, size_t ws_size, hipStream_t stream) {
    static int grid = 0;
    if (grid == 0) {
        if (n_in != 23 || out_size != M * D || ws_size < WS_END2) { fprintf(stderr, "kernel_launch: unexpected shapes (n_in %d out %d ws %zu)\n", n_in, out_size, ws_size); grid = -1; return; }
        int dev = 0, cus = 0, per_cu = 0;
        (void)hipGetDevice(&dev);
        (void)hipDeviceGetAttribute(&cus, hipDeviceAttributeMultiprocessorCount, dev);
        (void)hipFuncSetAttribute((const void*)fwd_kernel, hipFuncAttributeMaxDynamicSharedMemorySize, LDS_BYTES);
        (void)hipOccupancyMaxActiveBlocksPerMultiprocessor(&per_cu, (const void*)fwd_kernel, NTHREADS, LDS_BYTES);
        if (per_cu < 1) { fprintf(stderr, "kernel_launch: occupancy query says %d blocks/CU\n", per_cu); per_cu = 1; }
        grid = cus;
    }
    if (grid < 0) return;
    (void)hipMemsetAsync((char*)d_ws + WS_CTL, 0, CTL_ZERO_BYTES, stream);
    Args a{};
    for (int i = 0; i < 23; ++i) a.in[i] = (const float*)d_in[i];
    a.out = (float*)d_out; a.ws = (unsigned char*)d_ws;
    void* kargs[] = {&a};
    hipError_t e = hipLaunchCooperativeKernel((const void*)fwd_kernel, dim3(grid), dim3(NTHREADS), kargs, LDS_BYTES, stream);
    if (e != hipSuccess) fprintf(stderr, "cooperative launch failed: %s (grid %d)\n", hipGetErrorString(e), grid);
}
```
